# Optimizing an MI355X kernel written in HIP

```python
import jax, jax.numpy as jnp
from jax import lax
import numpy as np

D_MODEL = 1024
BATCH = 16
SEQ = 2048
DEPTH = 2

GRID_W = 64
CTX_LEN = 256
RET_HEADS = 4
RET_HEAD_DIM = 64
RET_WIDTH = RET_HEADS * RET_HEAD_DIM
RET_CHUNK = 128
ROPE_BASE = 10000.0
CONV_WIDTH = D_MODEL // 4
CONV_KERNEL = 31
GMLP_WIDTH = D_MODEL // 4
GMLP_GROUPS = 4
GMLP_CHUNK = 128
FNET_WIDTH = D_MODEL // 4
FNET_GROUPS = 4
N_BRANCH = 4
D_FF = ((8 * D_MODEL // 3 + 127) // 128) * 128
FFN_KERNEL = 3
EPS = 1e-6

RET_Q = 0
RET_K = RET_Q + RET_WIDTH
RET_V = RET_K + RET_WIDTH
RET_G = RET_V + RET_WIDTH
CONF_OFF = RET_G + RET_WIDTH
GMLP_OFF = CONF_OFF + 2 * CONV_WIDTH
FNET_OFF = GMLP_OFF + 2 * GMLP_WIDTH
GATE_OFF = FNET_OFF + FNET_WIDTH
IN_COLS = GATE_OFF + N_BRANCH * D_MODEL

kernel_name = "hybrid_retention_conformer_gmlp_fnet_dit"


def rms_norm(x, gain):
    xf = x.astype(jnp.float32)
    y = xf * lax.rsqrt(jnp.mean(xf * xf, axis=-1, keepdims=True) + EPS)
    return (y * gain.astype(jnp.float32)).astype(x.dtype)


def layer_norm(x, gain, bias):
    xf = x.astype(jnp.float32)
    xc = xf - jnp.mean(xf, axis=-1, keepdims=True)
    y = xc * lax.rsqrt(jnp.mean(xc * xc, axis=-1, keepdims=True) + EPS)
    return (y * gain.astype(jnp.float32) + bias.astype(jnp.float32)).astype(x.dtype)


def modulate(x, gain, shift, scale):
    return rms_norm(x, gain) * (1 + scale) + shift


def split_heads(t):
    return t.reshape(t.shape[0], t.shape[1], RET_HEADS, RET_HEAD_DIM)


def rotary(t, pos):
    half = t.shape[-1] // 2
    inv_freq = ROPE_BASE ** (-jnp.arange(half, dtype=jnp.float32) / half)
    ang = pos.astype(jnp.float32)[:, None] * inv_freq[None, :]
    cos = jnp.cos(ang)[None, :, None, :]
    sin = jnp.sin(ang)[None, :, None, :]
    tf = t.astype(jnp.float32)
    t1, t2 = tf[..., :half], tf[..., half:]
    return jnp.concatenate([t1 * cos - t2 * sin, t1 * sin + t2 * cos], axis=-1).astype(t.dtype)


def retention_q(proj, pos):
    return rotary(split_heads(proj[..., RET_Q:RET_K]), pos)


def retention_kv(kv_cols, pos):
    k = rotary(split_heads(kv_cols[..., :RET_WIDTH]), pos) * RET_HEAD_DIM ** -0.5
    v = split_heads(kv_cols[..., RET_WIDTH:])
    return k, v


def retention_scan(q, k, v, log_g, state0):
    B_, L, H, d = q.shape
    n_chunks = L // RET_CHUNK
    qc = q.reshape(B_, n_chunks, RET_CHUNK, H, d)
    kc = k.reshape(B_, n_chunks, RET_CHUNK, H, d)
    vc = v.reshape(B_, n_chunks, RET_CHUNK, H, d)
    idx = jnp.arange(RET_CHUNK, dtype=jnp.float32)
    diff = idx[:, None] - idx[None, :]
    decay_mask = jnp.where(diff >= 0, jnp.exp(log_g[:, None, None] * jnp.maximum(diff, 0.0)), 0.0)
    scores = jnp.einsum('bnihd,bnjhd->bnhij', qc, kc) * decay_mask
    intra = jnp.einsum('bnhij,bnjhd->bnihd', scores, vc)
    w_kv = jnp.exp(log_g[:, None] * (RET_CHUNK - 1 - idx)[None, :])
    kv = jnp.einsum('bnjhd,hj,bnjhe->bnhde', kc, w_kv, vc)
    chunk_decay = jnp.exp(log_g * RET_CHUNK)[None, :, None, None]

    def step(s, kv_n):
        return chunk_decay * s + kv_n, s

    _, prev = lax.scan(step, state0, jnp.moveaxis(kv, 1, 0))
    prev = jnp.moveaxis(prev, 0, 1)
    w_q = jnp.exp(log_g[:, None] * (idx + 1.0)[None, :])
    cross = jnp.einsum('bnihd,bnhde,hi->bnihe', qc, prev, w_q)
    return (intra + cross).reshape(B_, L, H, d)


def retention_final_state(k, v, log_g):
    L = k.shape[1]
    w = jnp.exp(log_g[:, None] * (L - 1 - jnp.arange(L, dtype=jnp.float32))[None, :])
    return jnp.einsum('blhd,hl,blhe->bhde', k, w, v)


def head_norm(o, gain):
    B_, L, H, d = o.shape
    of = o.astype(jnp.float32)
    oc = of - jnp.mean(of, axis=-1, keepdims=True)
    y = oc * lax.rsqrt(jnp.mean(oc * oc, axis=-1, keepdims=True) + EPS)
    return y.reshape(B_, L, H * d) * gain.astype(jnp.float32)


def depthwise_conv(x, w, b):
    nd = w.ndim - 1
    dn = {1: ('NWC', 'WIO', 'NWC'), 2: ('NHWC', 'HWIO', 'NHWC')}[nd]
    pad = [((kw - 1) // 2, (kw - 1) // 2) for kw in w.shape[:-1]]
    y = lax.conv_general_dilated(x, w[..., None, :], (1,) * nd, pad,
                                 dimension_numbers=dn, feature_group_count=x.shape[-1])
    return y + b


def conformer_conv(a, w_dw, b_dw, ln_g, ln_b, w_o):
    h = a[..., :CONV_WIDTH] * jax.nn.sigmoid(a[..., CONV_WIDTH:])
    h = depthwise_conv(h, w_dw, b_dw)
    h = jax.nn.silu(layer_norm(h, ln_g, ln_b))
    return h @ w_o


def spatial_gating(z, ln_g, ln_b, w_s, b_s, w_o):
    z = jax.nn.gelu(z, approximate=False)
    u, v = z[..., :GMLP_WIDTH], z[..., GMLP_WIDTH:]
    v = layer_norm(v, ln_g, ln_b)
    B_, L, _ = v.shape
    vc = v.reshape(B_, L // GMLP_CHUNK, GMLP_CHUNK, GMLP_GROUPS, GMLP_WIDTH // GMLP_GROUPS)
    sv = jnp.einsum('gij,bnjgc->bnigc', w_s, vc) + b_s.T[:, :, None]
    return (u * sv.reshape(B_, L, GMLP_WIDTH)) @ w_o


def fourier_mix(f, w_o):
    B_, L, _ = f.shape
    fg = f.astype(jnp.float32).reshape(B_, L, FNET_GROUPS, FNET_WIDTH // FNET_GROUPS)
    m = jnp.fft.fftn(fg, axes=(1, 3), norm='ortho').real
    return m.reshape(B_, L, FNET_WIDTH).astype(f.dtype) @ w_o


def token_mixers(proj, q, k, v, s_f, s_b, log_g, lp):
    o = retention_scan(q, k, v, log_g[0], s_f)
    o = o + retention_scan(q[:, ::-1], k[:, ::-1], v[:, ::-1], log_g[1], s_b)[:, ::-1]
    o = head_norm(o, lp['ret_gn']).astype(proj.dtype)
    ret = (jax.nn.silu(proj[..., RET_G:CONF_OFF]) * o) @ lp['w_ret_o']
    conf = conformer_conv(proj[..., CONF_OFF:GMLP_OFF], lp['conv_dw'], lp['conv_db'],
                          lp['conv_ln_g'], lp['conv_ln_b'], lp['w_conv_o'])
    gm = spatial_gating(proj[..., GMLP_OFF:FNET_OFF], lp['gmlp_ln_g'], lp['gmlp_ln_b'],
                        lp['gmlp_ws'], lp['gmlp_bs'], lp['w_gmlp_o'])
    fn = fourier_mix(proj[..., FNET_OFF:GATE_OFF], lp['w_fnet_o'])
    g = jax.nn.sigmoid(proj[..., GATE_OFF:] + lp['b_gate'])
    merged = (g[..., 0:D_MODEL] * ret + g[..., D_MODEL:2 * D_MODEL] * conf
              + g[..., 2 * D_MODEL:3 * D_MODEL] * gm + g[..., 3 * D_MODEL:] * fn)
    return merged @ lp['w_out']


def conv_ffn(h, w_up, dw, db, w_down, on_grid):
    up = h @ w_up
    a, b = up[..., :D_FF], up[..., D_FF:]
    if on_grid:
        B_, L, _ = a.shape
        rows = L // GRID_W
        a = depthwise_conv(a.reshape(B_, rows, GRID_W, D_FF), dw, db).reshape(B_, L, D_FF)
    else:
        a = depthwise_conv(a, dw[FFN_KERNEL // 2], db)
    return (jax.nn.silu(a) * b) @ w_down


def setup_inputs(seed: int = 0) -> dict:
    key = jax.random.key(seed)
    keys = iter(jax.random.split(key, 40))
    f32 = jnp.float32

    def nrm(shape, scale):
        return scale * jax.random.normal(next(keys), shape, f32)

    def ones_noisy(shape):
        return 1.0 + nrm(shape, 0.02)

    gamma0 = 1.0 - 2.0 ** (-5.0 - jnp.arange(RET_HEADS, dtype=f32))
    logit0 = jnp.log(gamma0) - jnp.log1p(-gamma0)
    return {
        'x': nrm((BATCH, SEQ, D_MODEL), 1.0),
        'c': nrm((BATCH, D_MODEL), 1.0),
        'ctx': nrm((BATCH, CTX_LEN, D_MODEL), 1.0),
        'c_ctx': nrm((D_MODEL,), 1.0),
        'w_ada': nrm((DEPTH, D_MODEL, 6 * D_MODEL), 0.5 * D_MODEL ** -0.5),
        'b_ada': nrm((DEPTH, 6 * D_MODEL), 0.02),
        'g_norm1': ones_noisy((DEPTH, D_MODEL)),
        'g_norm2': ones_noisy((DEPTH, D_MODEL)),
        'w_in': nrm((DEPTH, D_MODEL, IN_COLS), D_MODEL ** -0.5),
        'b_gate': nrm((DEPTH, N_BRANCH * D_MODEL), 0.02),
        'ret_decay': logit0 + nrm((DEPTH, 2, RET_HEADS), 0.1),
        'ret_gn': ones_noisy((DEPTH, RET_WIDTH)),
        'w_ret_o': nrm((DEPTH, RET_WIDTH, D_MODEL), RET_WIDTH ** -0.5),
        'conv_dw': nrm((DEPTH, CONV_KERNEL, CONV_WIDTH), CONV_KERNEL ** -0.5),
        'conv_db': nrm((DEPTH, CONV_WIDTH), 0.02),
        'conv_ln_g': ones_noisy((DEPTH, CONV_WIDTH)),
        'conv_ln_b': nrm((DEPTH, CONV_WIDTH), 0.02),
        'w_conv_o': nrm((DEPTH, CONV_WIDTH, D_MODEL), CONV_WIDTH ** -0.5),
        'gmlp_ln_g': ones_noisy((DEPTH, GMLP_WIDTH)),
        'gmlp_ln_b': nrm((DEPTH, GMLP_WIDTH), 0.02),
        'gmlp_ws': nrm((DEPTH, GMLP_GROUPS, GMLP_CHUNK, GMLP_CHUNK), GMLP_CHUNK ** -0.5),
        'gmlp_bs': ones_noisy((DEPTH, GMLP_GROUPS, GMLP_CHUNK)),
        'w_gmlp_o': nrm((DEPTH, GMLP_WIDTH, D_MODEL), GMLP_WIDTH ** -0.5),
        'w_fnet_o': nrm((DEPTH, FNET_WIDTH, D_MODEL), FNET_WIDTH ** -0.5),
        'w_out': nrm((DEPTH, D_MODEL, D_MODEL), D_MODEL ** -0.5),
        'w_ffn_up': nrm((DEPTH, D_MODEL, 2 * D_FF), D_MODEL ** -0.5),
        'ffn_dw': nrm((DEPTH, FFN_KERNEL, FFN_KERNEL, D_FF), 1.0 / FFN_KERNEL),
        'ffn_db': nrm((DEPTH, D_FF), 0.02),
        'w_ffn_down': nrm((DEPTH, D_FF, D_MODEL), D_FF ** -0.5),
        'g_final': ones_noisy((D_MODEL,)),
    }


def reference(x, c, ctx, c_ctx, w_ada, b_ada, g_norm1, g_norm2, w_in, b_gate, ret_decay, ret_gn,
              w_ret_o, conv_dw, conv_db, conv_ln_g, conv_ln_b, w_conv_o, gmlp_ln_g, gmlp_ln_b,
              gmlp_ws, gmlp_bs, w_gmlp_o, w_fnet_o, w_out, w_ffn_up, ffn_dw, ffn_db, w_ffn_down,
              g_final):
    B_, L, _ = x.shape
    n_ctx = ctx.shape[1]
    pos_ctx = jnp.arange(n_ctx, dtype=jnp.int32)
    pos_lat = n_ctx + jnp.arange(L, dtype=jnp.int32)
    xc = ctx
    for l in range(DEPTH):
        last = l == DEPTH - 1
        sh1, sc1, ga1, sh2, sc2, ga2 = jnp.split(jax.nn.silu(c) @ w_ada[l] + b_ada[l], 6, axis=-1)
        csh1, csc1, cga1, csh2, csc2, cga2 = jnp.split(jax.nn.silu(c_ctx) @ w_ada[l] + b_ada[l], 6, axis=-1)
        log_g = jax.nn.log_sigmoid(ret_decay[l].astype(jnp.float32))
        lp = dict(ret_gn=ret_gn[l], w_ret_o=w_ret_o[l], conv_dw=conv_dw[l], conv_db=conv_db[l],
                  conv_ln_g=conv_ln_g[l], conv_ln_b=conv_ln_b[l], w_conv_o=w_conv_o[l],
                  gmlp_ln_g=gmlp_ln_g[l], gmlp_ln_b=gmlp_ln_b[l], gmlp_ws=gmlp_ws[l],
                  gmlp_bs=gmlp_bs[l], w_gmlp_o=w_gmlp_o[l], w_fnet_o=w_fnet_o[l],
                  b_gate=b_gate[l], w_out=w_out[l])

        hc = modulate(xc, g_norm1[l], csh1, csc1)
        if last:
            k_c, v_c = retention_kv(hc @ w_in[l, :, RET_K:RET_G], pos_ctx)
        else:
            proj_c = hc @ w_in[l]
            k_c, v_c = retention_kv(proj_c[..., RET_K:RET_G], pos_ctx)
            zero = jnp.zeros((B_, RET_HEADS, RET_HEAD_DIM, RET_HEAD_DIM), jnp.float32)
            mix_c = token_mixers(proj_c, retention_q(proj_c, pos_ctx), k_c, v_c, zero, zero, log_g, lp)
        s_f = retention_final_state(k_c, v_c, log_g[0])
        s_b = retention_final_state(k_c[:, ::-1], v_c[:, ::-1], log_g[1])

        hx = modulate(x, g_norm1[l], sh1[:, None], sc1[:, None])
        proj_x = hx @ w_in[l]
        k_x, v_x = retention_kv(proj_x[..., RET_K:RET_G], pos_lat)
        mix_x = token_mixers(proj_x, retention_q(proj_x, pos_lat), k_x, v_x, s_f, s_b, log_g, lp)
        x = x + ga1[:, None] * mix_x

        hx = modulate(x, g_norm2[l], sh2[:, None], sc2[:, None])
        x = x + ga2[:, None] * conv_ffn(hx, w_ffn_up[l], ffn_dw[l], ffn_db[l], w_ffn_down[l], True)
        if not last:
            xc = xc + cga1 * mix_c
            hc = modulate(xc, g_norm2[l], csh2, csc2)
            xc = xc + cga2 * conv_ffn(hc, w_ffn_up[l], ffn_dw[l], ffn_db[l], w_ffn_down[l], False)
    return rms_norm(x, g_final)
```

```cpp
#include <hip/hip_runtime.h>
#include <hip/hip_cooperative_groups.h>
#include <cstdio>
#include <cstdint>
namespace cg = cooperative_groups;

#define LAS __attribute__((address_space(3)))
typedef unsigned short bf16_t;
typedef short bf16x8 __attribute__((ext_vector_type(8)));
typedef float f32x4 __attribute__((ext_vector_type(4)));
typedef float f32x2 __attribute__((ext_vector_type(2)));
typedef unsigned u32x4 __attribute__((ext_vector_type(4)));
typedef unsigned u32x2 __attribute__((ext_vector_type(2)));

#ifndef ONE_LAUNCH
#define ONE_LAUNCH 1
#endif

constexpr int NTHREADS = 512, NWAVES = 8;
constexpr int NBLK = 256;
constexpr int D = 1024, NB = 16, SEQ = 2048, CTXL = 256, DFF = 2816;
constexpr int NCOLS = 6656;
constexpr int PMW = 2560, GTW = 4096, UPW = 5632;
constexpr int IN_COLS = 6400;
constexpr float EPS = 1e-6f;
constexpr int NG = 2, GB = 8;
constexpr int R_LAT = GB * SEQ, R_CTX = NB * CTXL, R = R_LAT + R_CTX;
constexpr int NLT = R_LAT / 256, NCT = R_CTX / 256;
constexpr int N_KV_LAT = GB * 4 * 16, N_KV_CTX = NB * 4 * 2, N_KV = N_KV_LAT + N_KV_CTX;

constexpr size_t al256(size_t x) { return (x + 255) & ~(size_t)255; }
constexpr size_t OFF_BAR = 0;
constexpr size_t OFF_ADAP = 65536;
constexpr size_t OFF_MOD = OFF_ADAP + al256((size_t)8 * 2 * 17 * 6144 * 4);
constexpr size_t OFF_SHW1 = OFF_MOD + al256((size_t)2 * 17 * 6144 * 4);
constexpr size_t OFF_SHW2 = OFF_SHW1 + al256((size_t)2 * 17 * NCOLS * 4);
constexpr size_t OFF_ROPE = OFF_SHW2 + al256((size_t)2 * 17 * UPW * 4);
constexpr size_t OFF_LOGG = OFF_ROPE + al256((size_t)2 * 2304 * 32 * 4);
constexpr size_t OFF_DM = OFF_LOGG + 256;
constexpr size_t OFF_DC = OFF_DM + (size_t)2048 * 2048 * 2;
constexpr size_t OFF_W = OFF_DC + (size_t)256 * 256 * 2;
constexpr size_t W_IN = 0, W_O = W_IN + (size_t)NCOLS * 1024 * 2, W_OUT = W_O + (size_t)4 * 1024 * 256 * 2, W_UP = W_OUT + (size_t)1024 * 1024 * 2,
                 W_DN = W_UP + (size_t)UPW * 1024 * 2, W_LAYER = W_DN + (size_t)1024 * DFF * 2;
constexpr size_t OFF_XC = OFF_W + 2 * W_LAYER;
constexpr size_t OFF_AP = OFF_XC + (size_t)NB * CTXL * D * 4;
constexpr size_t OFF_AP1 = OFF_AP + (size_t)R * D * 2;
constexpr size_t OFF_SS = OFF_AP1 + (size_t)R_LAT * D * 2;
constexpr size_t OFF_S = OFF_SS + (size_t)R * 16 * 4;
constexpr size_t OFF_KV = OFF_S + (size_t)R * D * 2;
constexpr size_t OFF_KVC = OFF_KV + (size_t)N_KV_LAT * 2 * 4096 * 4;
constexpr size_t OFF_PQT = OFF_KVC + (size_t)2 * N_KV_CTX * 2 * 4096 * 4;
constexpr size_t OFF_PQTC = OFF_PQT + (size_t)GB * 256 * 2048 * 2;
constexpr size_t OFF_BIG = OFF_PQTC + (size_t)NB * 256 * 256 * 2;
constexpr size_t OFF_GT = OFF_BIG + (size_t)R * PMW * 2;
constexpr size_t WS_END = OFF_BIG + ((size_t)R * PMW * 2 + (size_t)R * GTW > (size_t)R * UPW * 2 ? (size_t)R * PMW * 2 + (size_t)R * GTW : (size_t)R * UPW * 2);
static_assert(WS_END <= (size_t)512 * 1024 * 1024, "workspace map exceeds 512 MiB");
static_assert((size_t)R * UPW * 2 <= WS_END - OFF_BIG, "UP overlay");

constexpr int SCR_BYTES = 139264;
constexpr int MISC_OFF = SCR_BYTES;
constexpr int LDS_BYTES = 161792;

__device__ __forceinline__ float bf2f(unsigned v) { return __uint_as_float(v << 16); }
__device__ __forceinline__ unsigned cvt_pk_bf16(float lo, float hi) { unsigned r; asm volatile("v_cvt_pk_bf16_f32 %0, %1, %2" : "=v"(r) : "v"(lo), "v"(hi)); return r; }
__device__ __forceinline__ bf16_t f2bf(float f) { return (bf16_t)(cvt_pk_bf16(f, 0.f) & 0xffffu); }
__device__ __forceinline__ void unpack8(const u32x4 w, float* f) {
    f[0] = bf2f(w.x & 0xffffu); f[1] = __uint_as_float(w.x & 0xffff0000u); f[2] = bf2f(w.y & 0xffffu); f[3] = __uint_as_float(w.y & 0xffff0000u);
    f[4] = bf2f(w.z & 0xffffu); f[5] = __uint_as_float(w.z & 0xffff0000u); f[6] = bf2f(w.w & 0xffffu); f[7] = __uint_as_float(w.w & 0xffff0000u);
}
__device__ __forceinline__ u32x4 pack8(const float* f) { u32x4 w; w.x = cvt_pk_bf16(f[0], f[1]); w.y = cvt_pk_bf16(f[2], f[3]); w.z = cvt_pk_bf16(f[4], f[5]); w.w = cvt_pk_bf16(f[6], f[7]); return w; }
__device__ __forceinline__ float shx(float v, int m, int lane) { return __int_as_float(__builtin_amdgcn_ds_bpermute((lane ^ m) << 2, __float_as_int(v))); }
template <int CTRL> __device__ __forceinline__ float dpp_mov(float v) { return __int_as_float(__builtin_amdgcn_update_dpp(0, __float_as_int(v), CTRL, 0xF, 0xF, false)); }
__device__ __forceinline__ float wave_sum(float v, int  ) {
    v += dpp_mov<0xB1>(v); v += dpp_mov<0x4E>(v); v += dpp_mov<0x141>(v); v += dpp_mov<0x140>(v);
    const int vi = __float_as_int(v);
    const float s0 = __int_as_float(__builtin_amdgcn_readlane(vi, 0)), s1 = __int_as_float(__builtin_amdgcn_readlane(vi, 16)), s2 = __int_as_float(__builtin_amdgcn_readlane(vi, 32)), s3 = __int_as_float(__builtin_amdgcn_readlane(vi, 48));
    return (s0 + s1) + (s2 + s3);
}
__device__ __forceinline__ float fast_rcp(float x) { return __builtin_amdgcn_rcpf(x); }
__device__ __forceinline__ float sigmoidf_(float x) { return fast_rcp(1.f + __expf(-x)); }
__device__ __forceinline__ float siluf_(float x) { return x * sigmoidf_(x); }
__device__ __forceinline__ float geluf_(float v) {
    const float av = fabsf(v), d = av * 0.2316418882f + 1.0f;
    const float t = fast_rcp(d);
    float q = t * 0.5307027145f + (-0.7265760135f); q = q * t + 0.7107068705f; q = q * t + (-0.142248368f); q = q * t + 0.127414796f; q = q * t;
    const float e = __builtin_amdgcn_exp2f((v * v) * (-0.72134752044f));
    const float m = v * (q * e);
    return v < 0.f ? m : v - m;
}
__device__ __forceinline__ f32x4 mfma16(bf16x8 a, bf16x8 b, f32x4 c) { return __builtin_amdgcn_mfma_f32_16x16x32_bf16(a, b, c, 0, 0, 0); }
__device__ __forceinline__ float sin_rev(float r) { return __builtin_amdgcn_sinf(r); }
__device__ __forceinline__ float cos_rev(float r) { return __builtin_amdgcn_cosf(r); }

#define XB_TMO      128
#define XB_XCNT(j)  (256  + 64 * (j))
#define XB_XSUB(j)  (1280 + 64 * (j))
#define XB_XGEN(j)  (2304 + 64 * (j))
#define XB_TOP      3328
#define XB_TOPGEN   3392
#define XCD_BAR_WORDS 3456
#define XB_SPIN_CAP (1u << 20)
__device__ __forceinline__ unsigned xb_ld(unsigned* p)              { return __hip_atomic_load(p, __ATOMIC_RELAXED, __HIP_MEMORY_SCOPE_AGENT); }
__device__ __forceinline__ unsigned xb_add(unsigned* p, unsigned v) { return __hip_atomic_fetch_add(p, v, __ATOMIC_RELAXED, __HIP_MEMORY_SCOPE_AGENT); }
__device__ __forceinline__ unsigned xb_xcc_id() { return (unsigned)__builtin_amdgcn_s_getreg((3 << 11) | 20) & 0xFu; }
#define XB_SPIN(cond, bar) do { unsigned _sp = 0; while (cond) { __builtin_amdgcn_s_sleep(1); \
    if ((++_sp & 255u) == 0u) { if (xb_ld(&(bar)[XB_TMO])) break; if (_sp > XB_SPIN_CAP) { atomicAdd(&(bar)[XB_TMO], 1u); break; } } } } while (0)
struct XcdBarrier { unsigned* bar; unsigned x; volatile LAS unsigned* st; };
__device__ __forceinline__ XcdBarrier xcd_barrier_post(unsigned* bar, volatile LAS unsigned* st) {
    XcdBarrier b; b.bar = bar; b.x = xb_xcc_id(); b.st = st;
    if (threadIdx.x == 0) (void)xb_add(&bar[XB_XCNT(b.x)], 1u);
    return b;
}
__device__ __forceinline__ void xcd_barrier_complete(unsigned* bar, unsigned x, unsigned& nloc, unsigned& nx) {
    const unsigned G = NBLK;
    unsigned sum, cnt, mine, sp = 0u;
    for (;;) {
        sum = 0u; cnt = 0u; mine = 0u;
#pragma unroll
        for (unsigned j = 0; j < 16; ++j) { const unsigned c = xb_ld(&bar[XB_XCNT(j)]); sum += c; cnt += (c > 0u) ? 1u : 0u; mine = (j == x) ? c : mine; }
        if (sum == G) break;
        __builtin_amdgcn_s_sleep(1);
        if ((++sp & 255u) == 0u) { if (xb_ld(&bar[XB_TMO])) break; if (sp > XB_SPIN_CAP) { atomicAdd(&bar[XB_TMO], 1u); break; } }
    }
    nloc = mine > 0u ? mine : 1u; nx = cnt > 0u ? cnt : 1u;
}
__device__ __forceinline__ void xcd_barrier(const XcdBarrier& b) {
    asm volatile("s_waitcnt vmcnt(0)" ::: "memory");
    __syncthreads();
    if (threadIdx.x == 0) {
        unsigned* bar = b.bar; unsigned bx_ = b.x; asm volatile("" : "+s"(bx_));
        __builtin_amdgcn_s_waitcnt(0);
        unsigned nloc = b.st[0], nx = b.st[1];
        if (nloc == 0u) { xcd_barrier_complete(bar, bx_, nloc, nx); b.st[0] = nloc; b.st[1] = nx; }
        const unsigned old = xb_add(&bar[XB_XSUB(bx_)], 1u);
        const unsigned gen = old / nloc;
        if (old + 1u == (gen + 1u) * nloc) {
            __builtin_amdgcn_fence(__ATOMIC_RELEASE, "agent");
            asm volatile("s_waitcnt vmcnt(0)" ::: "memory");
            const unsigned og = xb_add(&bar[XB_TOP], 1u);
            const unsigned tg = og / nx;
            if (og + 1u == (tg + 1u) * nx) xb_add(&bar[XB_TOPGEN], 1u);
            else XB_SPIN(xb_ld(&bar[XB_TOPGEN]) == tg, bar);
            __builtin_amdgcn_fence(__ATOMIC_ACQUIRE, "agent");
            xb_add(&bar[XB_XGEN(bx_)], 1u);
            asm volatile("s_waitcnt vmcnt(0)" ::: "memory");
        } else {
            XB_SPIN(xb_ld(&bar[XB_XGEN(bx_)]) == gen, bar);
            __builtin_amdgcn_fence(__ATOMIC_ACQUIRE, "agent");
            asm volatile("s_waitcnt vmcnt(0)" ::: "memory");
        }
    }
    __syncthreads();
}

namespace pg8 {
constexpr int BM = 256, BK = 64, HALF = 128, HTB = HALF * BK * 2, NXCD = 8, WGM = 8;
__host__ __device__ __forceinline__ int lds_byte(int r, int c) { const int st = (r >> 4) * 2 + (c >> 5), rr = r & 15, cc = c & 31, ob = rr * 64 + cc * 2; return st * 1024 + (ob ^ (((ob >> 9) & 1) << 5)); }
__host__ __device__ __forceinline__ void stage_rc(int b, int& R_, int& C_) { const int st = b / 1024, sb = b % 1024, swz = sb ^ (((sb >> 9) & 1) << 5); R_ = (st >> 1) * 16 + swz / 64; C_ = (st & 1) * 32 + (swz % 64) / 2; }
__host__ __device__ __forceinline__ int perm32(int rho) { const int n = rho >> 4, i = rho & 15; return 8 * (i >> 2) + 4 * n + (i & 3); }

struct Unit { int pm, pn, seg; unsigned A, B; };
__device__ __forceinline__ const char* sgpr_ptr(const char* p) {
    const unsigned long long v = (unsigned long long)p;
    const unsigned lo = (unsigned)__builtin_amdgcn_readfirstlane((int)(unsigned)v), hi = (unsigned)__builtin_amdgcn_readfirstlane((int)(unsigned)(v >> 32));
    typedef const char __attribute__((address_space(1)))* gp_t;
    return (const char*)(gp_t)(((unsigned long long)hi << 32) | (unsigned long long)lo);
}

__device__ __forceinline__ void tile_order(int L, int nM, int nN, int& pm, int& pn) {
    const int nwg = nM * nN; int wgid = L;
    { const int q = nwg / NXCD, r = nwg % NXCD, xcd = wgid % NXCD, off = wgid / NXCD; wgid = (xcd < r ? xcd * (q + 1) : r * (q + 1) + (xcd - r) * q) + off; }
    const int nig = WGM * nN, gid = wgid / nig, fm = gid * WGM, gsz = (nM - fm) < WGM ? (nM - fm) : WGM;
    pm = fm + ((wgid % nig) % gsz); pn = (wgid % nig) / gsz;
}
struct TileSched {
    int n1M, n1N, n2M, n2N, pn2_0, pm2_x, G, c, nseg;
    unsigned A, B, a_tstep, b_tstep, a_segstep, b_segstep;
    __device__ __forceinline__ bool next(int i, Unit& u) const {
        const int ti = i / nseg, seg = i - ti * nseg;
        const int L = ti * G + c, n1 = n1M * n1N, n2 = n2M * n2N;
        int pm, pn;
        if (L < n1) tile_order(L, n1M, n1N, pm, pn);
        else if (L < n1 + n2) { tile_order(L - n1, n2M, n2N, pm, pn); pm += n1M + pm2_x; pn += pn2_0; }
        else return false;
        pm = __builtin_amdgcn_readfirstlane(pm); pn = __builtin_amdgcn_readfirstlane(pn);
        u.pm = pm; u.pn = pn; u.seg = seg;
        u.A = A + (unsigned)pm * a_tstep + (unsigned)seg * a_segstep; u.B = B + (unsigned)pn * b_tstep + (unsigned)seg * b_segstep;
        return true;
    }
};

constexpr int TB_OFF = 131072;
constexpr int SHB_OFF = 147456;
template <class Epi, class Sched>
__device__ __forceinline__ void gemm_phase(LAS unsigned char* lds, const unsigned char* wsb, const int tid_in, const int K, const int lda, const int ldb, const bool perm, const Sched& S, const Epi& E) {
    __builtin_amdgcn_s_waitcnt(0x0F70);
    int tid = tid_in; asm volatile("" : "+v"(tid));
    const int wid = __builtin_amdgcn_readfirstlane(tid >> 6), lane = tid & 63, wr = wid >> 2, wc = wid & 3, fr = lane & 15, fq = lane >> 4;
    const int nt = K / BK;
    unsigned voffA[2], voffB[2];
#pragma unroll
    for (int i = 0; i < 2; ++i) { int R_, C_; stage_rc(tid * 16 + i * 8192, R_, C_); const int Rb = perm ? ((R_ & ~31) + perm32(R_ & 31)) : R_;
        voffA[i] = (unsigned)(R_ * lda + C_) * 2u; voffB[i] = (unsigned)(Rb * ldb + C_) * 2u; }
    const unsigned kstep = (unsigned)(BK * 2);
    const unsigned hA = (unsigned)HALF * lda * 2, hB = (unsigned)HALF * ldb * 2;
    const unsigned ldsw = (unsigned)wid * 1024u;
    const int aoff = lds_byte(wr * 64 + fr, fq * 8), boff = lds_byte(wc * 32 + fr, fq * 8);
#define PG8_SA(b, h) (((b) * 2 + (h)) * HTB)
#define PG8_SB(b, h) ((4 + (b) * 2 + (h)) * HTB)
#define PG8_STAGE(bufoff, goff, voff) do { _Pragma("unroll") for (int _i = 0; _i < 2; ++_i) \
        __builtin_amdgcn_global_load_lds((const unsigned*)(wsb + (unsigned)((goff) + (voff)[_i])), (LAS unsigned*)(lds + (bufoff) + ldsw + _i * 8192), 16, 0, 0); } while (0)
#define PG8_LDA(dst, b, h) do { _Pragma("unroll") for (int m = 0; m < 4; ++m) _Pragma("unroll") for (int k = 0; k < 2; ++k) dst[m][k] = *(const LAS bf16x8*)(lds + PG8_SA(b, h) + aoff + m * 2048 + k * 1024); } while (0)
#define PG8_LDB(dst, b, h) do { _Pragma("unroll") for (int n = 0; n < 2; ++n) _Pragma("unroll") for (int k = 0; k < 2; ++k) dst[n][k] = *(const LAS bf16x8*)(lds + PG8_SB(b, h) + boff + n * 2048 + k * 1024); } while (0)
#define PG8_MMA(ai, bj, At, Bt) do { __builtin_amdgcn_s_setprio(1); _Pragma("unroll") for (int m = 0; m < 4; ++m) _Pragma("unroll") for (int n = 0; n < 2; ++n) _Pragma("unroll") for (int k = 0; k < 2; ++k) \
        acc[ai][bj][m][n] = __builtin_amdgcn_mfma_f32_16x16x32_bf16(Bt[n][k], At[m][k], acc[ai][bj][m][n], 0, 0, 0); __builtin_amdgcn_s_setprio(0); } while (0)
#define PG8_WAIT_V(n) asm volatile("s_waitcnt vmcnt(" #n ")" ::: "memory")
#define PG8_WAIT_L(n) asm volatile("s_waitcnt lgkmcnt(" #n ")" ::: "memory")
#define PG8_BAR __builtin_amdgcn_s_barrier()
#define PG8_SCHED __builtin_amdgcn_sched_barrier(0)
#define PG8_ZERO() do { _Pragma("unroll") for (int a = 0; a < 2; ++a) _Pragma("unroll") for (int b = 0; b < 2; ++b) _Pragma("unroll") for (int m = 0; m < 4; ++m) _Pragma("unroll") for (int n = 0; n < 2; ++n) acc[a][b][m][n] = (f32x4){0.f, 0.f, 0.f, 0.f}; } while (0)
    Unit cur, nxt; int ui = 0;
    if (!S.next(0, cur)) return;
    f32x4 acc[2][2][4][2];
    PG8_ZERO();
    bf16x8 At[4][2], B0[2][2], B1[2][2];
    unsigned cA = cur.A, cB = cur.B;
    E.prefetch(cur, wid, lane, lds + SHB_OFF);
    PG8_STAGE(PG8_SB(0, 0), cB, voffB); PG8_STAGE(PG8_SB(0, 1), cB + hB, voffB); PG8_STAGE(PG8_SA(0, 0), cA, voffA); PG8_STAGE(PG8_SA(0, 1), cA + hA, voffA);
    if (wr == 1) PG8_BAR;
    PG8_WAIT_V(2); PG8_BAR;
    PG8_STAGE(PG8_SB(1, 0), cB + kstep, voffB); PG8_STAGE(PG8_SA(1, 0), cA + kstep, voffA); PG8_STAGE(PG8_SB(1, 1), cB + hB + kstep, voffB);
    PG8_WAIT_V(6); PG8_BAR;
    for (;;) {
        const bool has_next = S.next(ui + 1, nxt);
        const unsigned nA = has_next ? nxt.A : cA, nB = has_next ? nxt.B : cB;
#define PG8_PASS(WX) do { \
            const bool last = (t == nt - 2); \
            unsigned tk = (unsigned)t * (unsigned)kstep; asm volatile("" : "+s"(tk)); \
            const unsigned a1 = cA + tk + kstep; \
            const unsigned a2 = last ? nA : cA + tk + 2 * kstep, b2 = last ? nB : cB + tk + 2 * kstep; \
            const unsigned a3 = a2 + kstep, b3 = b2 + kstep; \
            PG8_LDB(B0, 0, 0); PG8_LDB(B1, 0, 1); PG8_SCHED; PG8_LDA(At, 0, 0); PG8_STAGE(PG8_SA(1, 1), a1 + hA, voffA); \
            WX; PG8_WAIT_L(0); PG8_BAR; PG8_MMA(0, 0, At, B0); PG8_MMA(0, 1, At, B1); PG8_BAR; PG8_SCHED; \
            PG8_LDA(At, 0, 1); PG8_STAGE(PG8_SB(0, 0), b2, voffB); PG8_STAGE(PG8_SB(0, 1), b2 + hB, voffB); PG8_STAGE(PG8_SA(0, 0), a2, voffA); \
            WX; PG8_WAIT_L(0); PG8_BAR; PG8_MMA(1, 0, At, B0); PG8_MMA(1, 1, At, B1); PG8_BAR; PG8_SCHED; \
            PG8_LDB(B0, 1, 0); PG8_LDB(B1, 1, 1); PG8_SCHED; PG8_LDA(At, 1, 0); PG8_STAGE(PG8_SA(0, 1), a2 + hA, voffA); \
            PG8_WAIT_V(8); PG8_WAIT_L(0); PG8_BAR; PG8_MMA(0, 0, At, B0); PG8_MMA(0, 1, At, B1); PG8_BAR; PG8_SCHED; \
            PG8_LDA(At, 1, 1); PG8_STAGE(PG8_SB(1, 0), b3, voffB); PG8_STAGE(PG8_SB(1, 1), b3 + hB, voffB); PG8_STAGE(PG8_SA(1, 0), a3, voffA); \
            PG8_WAIT_V(8); PG8_WAIT_L(0); PG8_BAR; PG8_MMA(1, 0, At, B0); PG8_MMA(1, 1, At, B1); PG8_BAR; PG8_SCHED; \
        } while (0)
        int t = 0;
        if (Epi::XST > 0 && ui > 0) { PG8_PASS(asm volatile("s_waitcnt vmcnt(%0)" :: "n"(8 + Epi::XST) : "memory")); t = 2; }
        for (; t < nt; t += 2) PG8_PASS(PG8_WAIT_V(8));
#undef PG8_PASS
        if (wr == 0) PG8_BAR;
        unsigned zz = 0u; asm volatile("" : "+s"(zz)); const int le = (int)__builtin_amdgcn_mbcnt_hi(~0u, __builtin_amdgcn_mbcnt_lo(~0u, zz));
        if (E(acc, cur, wr, wc, le & 15, le >> 4, lds + TB_OFF + ldsw, lds + SHB_OFF + (ui & 1) * 3072)) PG8_ZERO();
        if (!has_next) break;
        cur = nxt; cA = nA; cB = nB; ++ui;
        E.prefetch(cur, wid, le, lds + SHB_OFF + (ui & 1) * 3072);
        if (wr == 1) PG8_BAR;
    }
    PG8_WAIT_V(0);
    PG8_BAR;
#undef PG8_SA
#undef PG8_SB
#undef PG8_STAGE
#undef PG8_LDA
#undef PG8_LDB
#undef PG8_MMA
#undef PG8_WAIT_V
#undef PG8_WAIT_L
#undef PG8_BAR
#undef PG8_SCHED
#undef PG8_ZERO
}
}

enum { I_x = 0, I_c = 1, I_ctx = 2, I_c_ctx = 3, I_w_ada = 4, I_b_ada = 5, I_g_norm1 = 6, I_g_norm2 = 7, I_w_in = 8, I_b_gate = 9, I_ret_decay = 10, I_ret_gn = 11, I_w_ret_o = 12, I_conv_dw = 13, I_conv_db = 14, I_conv_ln_g = 15, I_conv_ln_b = 16, I_w_conv_o = 17, I_gmlp_ln_g = 18, I_gmlp_ln_b = 19, I_gmlp_ws = 20, I_gmlp_bs = 21, I_w_gmlp_o = 22, I_w_fnet_o = 23, I_w_out = 24, I_w_ffn_up = 25, I_ffn_dw = 26, I_ffn_db = 27, I_w_ffn_down = 28, I_g_final = 29 };
struct KArgs { const float* in[30]; float* out; unsigned char* ws; int ph_lo, ph_hi; };
constexpr int PTAB_OFF = MISC_OFF + 4096;
struct KP {
    float* out; unsigned char* ws; LAS unsigned char* ldsb; LAS unsigned char* ptab; int tid_, bx_;
    __device__ __forceinline__ const float* in(int k) const {
        const LAS unsigned* t = (const LAS unsigned*)ptab + 2 * k;
        const unsigned lo = (unsigned)__builtin_amdgcn_readfirstlane((int)t[0]), hi = (unsigned)__builtin_amdgcn_readfirstlane((int)t[1]);
        typedef const float __attribute__((address_space(1)))* gcfp_t;
        return (const float*)(gcfp_t)(((unsigned long long)hi << 32) | (unsigned long long)lo);
    }
};

struct RowInfo { int mi; size_t xrow0; bool is_ctx; };
__device__ __forceinline__ RowInfo row_info(int g, int pm) {
    RowInfo ri;
    if (pm < NLT) { const int b = g * GB + (pm >> 3); ri.mi = b; ri.xrow0 = (size_t)b * SEQ + (size_t)(pm & 7) * 256; ri.is_ctx = false; }
    else { const int b = pm - NLT; ri.mi = 16; ri.xrow0 = (size_t)b * CTXL; ri.is_ctx = true; }
    return ri;
}

__device__ __forceinline__ unsigned ap_off(int g) { return g == 0 ? (unsigned)OFF_AP : (unsigned)OFF_AP1; }
__device__ __forceinline__ unsigned ssa_off(int g) { return (unsigned)OFF_SS + (unsigned)(g * 2) * (unsigned)(R * 4); }
__device__ __forceinline__ unsigned ssb_off(int g) { return (unsigned)OFF_SS + (unsigned)(g * 2 + 1) * (unsigned)(R * 4); }

constexpr int TB2_DELTA = 153600 - 131072;
__device__ __forceinline__ void st_rows16x2(LAS unsigned char* tb, bf16_t* base, size_t ld, int fr, int fq, u32x4 w0, u32x4 w1) {
    const int wo = 64 * fr + 16 * (fq ^ ((fr >> 2) & 3));
    *(LAS u32x4*)(tb + wo) = w0; *(LAS u32x4*)(tb + TB2_DELTA + wo) = w1;
    const int l2 = fq * 16 + fr, r2 = l2 >> 2, q2 = l2 & 3, ro = 64 * r2 + 16 * (q2 ^ ((r2 >> 2) & 3));
    const u32x4 t0 = *(const LAS u32x4*)(tb + ro), t1 = *(const LAS u32x4*)(tb + TB2_DELTA + ro);
    bf16_t* d = base + (size_t)r2 * ld + 8 * q2;
    *(u32x4*)d = t0; *(u32x4*)(d + 128) = t1;
}
__device__ __forceinline__ void st_rows16(LAS unsigned char* tb, bf16_t* base, size_t ld, int fr, int fq, u32x4 w) {
    *(LAS u32x4*)(tb + 64 * fr + 16 * (fq ^ ((fr >> 2) & 3))) = w;
    const int l2 = fq * 16 + fr, r2 = l2 >> 2, q2 = l2 & 3;
    const u32x4 t = *(const LAS u32x4*)(tb + 64 * r2 + 16 * (q2 ^ ((r2 >> 2) & 3)));
    *(u32x4*)(base + (size_t)r2 * ld + 8 * q2) = t;
}
struct EpiWin {
    static constexpr bool PERM = true; static constexpr int XST = 16;
    const float* ss; const float* shw; const float* bgate; bf16_t* PM; bf16_t* GT; int g;
    __device__ __forceinline__ void prefetch(const pg8::Unit& u, int wid, int lane, LAS unsigned char* shb) const {
        const int ctile = u.pn * 256;
        if (wid == 0) { const RowInfo ri = row_info(g, u.pm); __builtin_amdgcn_global_load_lds((const unsigned*)(shw + (size_t)ri.mi * NCOLS + ctile + lane * 4), (LAS unsigned*)shb, 16, 0, 0); }
        else if (wid == 1) __builtin_amdgcn_global_load_lds((const unsigned*)(ss + u.pm * 256 + lane * 4), (LAS unsigned*)(shb + 1024), 16, 0, 0);
        else if (wid == 2 && ctile >= PMW) __builtin_amdgcn_global_load_lds((const unsigned*)(bgate + (ctile - PMW) + lane * 4), (LAS unsigned*)(shb + 2048), 16, 0, 0);
    }
    __device__ __forceinline__ bool operator()(f32x4 (&acc)[2][2][4][2], const pg8::Unit& u, int wr, int wc, int fr, int fq, LAS unsigned char* tb, const LAS unsigned char* shb) const {
        const int ctile = u.pn * 256, cb = wc * 32 + 8 * fq;
        const bool gate = ctile >= PMW;
        f32x4 sh[2][2];
#pragma unroll
        for (int bj = 0; bj < 2; ++bj)
#pragma unroll
            for (int n = 0; n < 2; ++n) { sh[bj][n] = *(const LAS f32x4*)(shb + (bj * 128 + cb + 4 * n) * 4);
                if (gate) sh[bj][n] = (sh[bj][n] + *(const LAS f32x4*)(shb + 2048 + (bj * 128 + cb + 4 * n) * 4)) * (-1.44269504089f) - 7.99435343686f; }
        float rsv[8];
#pragma unroll
        for (int q = 0; q < 8; ++q) rsv[q] = __builtin_amdgcn_rsqf(*(const LAS float*)(shb + 1024 + ((q >> 2) * 128 + wr * 64 + (q & 3) * 16 + fr) * 4) * (1.0f / 1024.0f) + EPS);
#pragma unroll
        for (int ai = 0; ai < 2; ++ai)
#pragma unroll
            for (int m = 0; m < 4; ++m) {
                const int r = u.pm * 256 + ai * 128 + wr * 64 + m * 16 + fr;
                const float rs = rsv[ai * 4 + m], rsg = rs * (-1.44269504089f);
                u32x4 wp[2];
#pragma unroll
                for (int bj = 0; bj < 2; ++bj) {
                    if (gate) {
                        const f32x4 e0 = acc[ai][bj][m][0] * rsg + sh[bj][0], e1 = acc[ai][bj][m][1] * rsg + sh[bj][1];
                        u32x2 wq = (u32x2){0u, 0u};
#pragma unroll
                        for (int j = 0; j < 4; ++j) {
                            const float y0 = fast_rcp(__builtin_amdgcn_fmed3f(__builtin_amdgcn_exp2f(e0[j]) + (1.0f / 255.0f), 0.f, 1.f)), y1 = fast_rcp(__builtin_amdgcn_fmed3f(__builtin_amdgcn_exp2f(e1[j]) + (1.0f / 255.0f), 0.f, 1.f));
                            wq.x = __builtin_amdgcn_cvt_pk_u8_f32(y0, j, wq.x); wq.y = __builtin_amdgcn_cvt_pk_u8_f32(y1, j, wq.y); }
                        *(u32x2*)((unsigned char*)GT + ((size_t)(u.pm * 16 + ((ctile - PMW) >> 8)) * 16 + (ai * 4 + m) * 2 + bj) * 4096 + ((wr * 4 + wc) * 64 + fq * 16 + fr) * 8) = wq;
                        continue;
                    }
                    const f32x4 v0 = acc[ai][bj][m][0] * rs + sh[bj][0], v1 = acc[ai][bj][m][1] * rs + sh[bj][1];
                    wp[bj].x = cvt_pk_bf16(v0[0], v0[1]); wp[bj].y = cvt_pk_bf16(v0[2], v0[3]); wp[bj].z = cvt_pk_bf16(v1[0], v1[1]); wp[bj].w = cvt_pk_bf16(v1[2], v1[3]);
                }
                if (!gate) st_rows16x2(tb, PM + (size_t)(r - fr) * PMW + ctile + wc * 32, PMW, fr, fq, wp[0], wp[1]);
            }
        return true;
    }
};
struct EpiUp {
    static constexpr bool PERM = true; static constexpr int XST = 16;
    const float* ss; const float* shw; bf16_t* UP; int g;
    __device__ __forceinline__ void prefetch(const pg8::Unit& u, int wid, int lane, LAS unsigned char* shb) const {
        if (wid == 0) { const RowInfo ri = row_info(g, u.pm); __builtin_amdgcn_global_load_lds((const unsigned*)(shw + (size_t)ri.mi * UPW + u.pn * 256 + lane * 4), (LAS unsigned*)shb, 16, 0, 0); }
        else if (wid == 1) __builtin_amdgcn_global_load_lds((const unsigned*)(ss + u.pm * 256 + lane * 4), (LAS unsigned*)(shb + 1024), 16, 0, 0);
    }
    __device__ __forceinline__ bool operator()(f32x4 (&acc)[2][2][4][2], const pg8::Unit& u, int wr, int wc, int fr, int fq, LAS unsigned char* tb, const LAS unsigned char* shb) const {
        const int ctile = u.pn * 256, cb = wc * 32 + 8 * fq;
        f32x4 sh[2][2];
#pragma unroll
        for (int bj = 0; bj < 2; ++bj)
#pragma unroll
            for (int n = 0; n < 2; ++n) sh[bj][n] = *(const LAS f32x4*)(shb + (bj * 128 + cb + 4 * n) * 4);
        float rsv[8];
#pragma unroll
        for (int q = 0; q < 8; ++q) rsv[q] = __builtin_amdgcn_rsqf(*(const LAS float*)(shb + 1024 + ((q >> 2) * 128 + wr * 64 + (q & 3) * 16 + fr) * 4) * (1.0f / 1024.0f) + EPS);
#pragma unroll
        for (int ai = 0; ai < 2; ++ai)
#pragma unroll
            for (int m = 0; m < 4; ++m) {
                const int r = u.pm * 256 + ai * 128 + wr * 64 + m * 16 + fr;
                const float rs = rsv[ai * 4 + m];
                u32x4 w[2];
#pragma unroll
                for (int bj = 0; bj < 2; ++bj) {
                    const f32x4 v0 = acc[ai][bj][m][0] * rs + sh[bj][0], v1 = acc[ai][bj][m][1] * rs + sh[bj][1];
                    w[bj].x = cvt_pk_bf16(v0[0], v0[1]); w[bj].y = cvt_pk_bf16(v0[2], v0[3]); w[bj].z = cvt_pk_bf16(v1[0], v1[1]); w[bj].w = cvt_pk_bf16(v1[2], v1[3]);
                }
                st_rows16x2(tb, UP + (size_t)(r - fr) * UPW + ctile + wc * 32, UPW, fr, fq, w[0], w[1]);
            }
        return true;
    }
};
struct EpiResid {
    static constexpr bool PERM = false; static constexpr int XST = 0;
    const float *xin_lat, *xin_ctx; float *xout_lat, *xout_ctx; const float* ga; const float* Gn; bf16_t* AP; float* ss; int g;
    __device__ __forceinline__ void prefetch(const pg8::Unit& u, int wid, int lane, LAS unsigned char* shb) const {
        if (wid == 0) { const RowInfo ri = row_info(g, u.pm); __builtin_amdgcn_global_load_lds((const unsigned*)(ga + (size_t)ri.mi * 6144 + u.pn * 256 + lane * 4), (LAS unsigned*)shb, 16, 0, 0); }
        else if (wid == 1 && Gn) { const RowInfo ri = row_info(g, u.pm); __builtin_amdgcn_global_load_lds((const unsigned*)(Gn + (size_t)ri.mi * 6144 + u.pn * 256 + lane * 4), (LAS unsigned*)(shb + 1024), 16, 0, 0); }
    }
    __device__ __forceinline__ bool operator()(f32x4 (&acc)[2][2][4][2], const pg8::Unit& u, int wr, int wc, int fr, int fq, LAS unsigned char* tb, const LAS unsigned char* shb) const {
        const RowInfo ri = row_info(g, u.pm);
        const float* xin = ri.is_ctx ? xin_ctx : xin_lat; float* xout = ri.is_ctx ? xout_ctx : xout_lat;
        const int l2 = fq * 16 + fr, r2 = l2 >> 2, q2 = l2 & 3;
        LAS unsigned char* wa = tb + 64 * fr + 16 * (fq ^ ((fr >> 2) & 3));
        const LAS unsigned char* ra = tb + 64 * r2 + 16 * (q2 ^ ((r2 >> 2) & 3));
        const int c0 = u.pn * 256 + wc * 32 + 4 * q2;
        const bool gnp = Gn != nullptr;
        const LAS unsigned char* gl = shb + (wc * 32 + 4 * q2) * 4;
        const size_t xbase = (ri.xrow0 + (size_t)(wr * 64 + r2)) * D + c0;
        const int rbase = u.pm * 256 + wr * 64 + r2;
        f32x4 xc[4], xn_[4];
#pragma unroll
        for (int q = 0; q < 4; ++q) xc[q] = *(const f32x4*)(xin + xbase + (q >> 1) * 128 + (q & 1) * 16);
#pragma unroll
        for (int st = 0; st < 8; ++st) {
            const int ai = st >> 2, m = st & 3;
            if (st < 7) { const int ai2 = (st + 1) >> 2, m2 = (st + 1) & 3; const size_t o2 = xbase + (size_t)(ai2 * 128 + m2 * 16) * D;
#pragma unroll
                for (int q = 0; q < 4; ++q) xn_[q] = *(const f32x4*)(xin + o2 + (q >> 1) * 128 + (q & 1) * 16); }
            asm volatile("" ::: "memory");
            const size_t xo = xbase + (size_t)(ai * 128 + m * 16) * D; const int r = rbase + ai * 128 + m * 16;
            float sq = 0.f;
#pragma unroll
            for (int q = 0; q < 4; ++q) { const int bj = q >> 1, n = q & 1;
                *(LAS f32x4*)wa = acc[ai][bj][m][n];
                const f32x4 at = *(const LAS f32x4*)ra;
                const f32x4 xv = xc[q] + *(const LAS f32x4*)(gl + (bj * 128 + n * 16) * 4) * at;
                *(f32x4*)(xout + xo + bj * 128 + n * 16) = xv;
                sq += (xv[0] * xv[0] + xv[1] * xv[1]) + (xv[2] * xv[2] + xv[3] * xv[3]);
                if (gnp) { const f32x4 a = xv * *(const LAS f32x4*)(gl + 1024 + (bj * 128 + n * 16) * 4); u32x2 w; w.x = cvt_pk_bf16(a[0], a[1]); w.y = cvt_pk_bf16(a[2], a[3]);
                    *(u32x2*)(AP + (size_t)r * D + c0 + bj * 128 + n * 16) = w; } }
            sq += dpp_mov<0xB1>(sq); sq += dpp_mov<0x4E>(sq);
            if (q2 == 0) atomicAdd(ss + r, sq);
            asm volatile("" ::: "memory");
#pragma unroll
            for (int q = 0; q < 4; ++q) xc[q] = xn_[q];
        }
        return true;
    }
};
struct EpiDft {
    static constexpr bool PERM = true; static constexpr int XST = 0;
    bf16_t* S; int row_base, rows_per_seq; float scale;
    __device__ __forceinline__ void prefetch(const pg8::Unit&, int, int, LAS unsigned char*) const {}
    __device__ __forceinline__ bool operator()(f32x4 (&acc)[2][2][4][2], const pg8::Unit& u, int wr, int wc, int fr, int fq, LAS unsigned char* tb, const LAS unsigned char*) const {
        const int cb = wc * 32 + 8 * fq;
#pragma unroll
        for (int ai = 0; ai < 2; ++ai)
#pragma unroll
            for (int m = 0; m < 4; ++m) {
                const int r = row_base + u.pn * rows_per_seq + u.pm * 256 + ai * 128 + wr * 64 + m * 16 + fr;
#pragma unroll
                for (int bj = 0; bj < 2; ++bj) {
                    const f32x4 v0 = acc[ai][bj][m][0] * scale, v1 = acc[ai][bj][m][1] * scale;
                    u32x4 w; w.x = cvt_pk_bf16(v0[0], v0[1]); w.y = cvt_pk_bf16(v0[2], v0[3]); w.z = cvt_pk_bf16(v1[0], v1[1]); w.w = cvt_pk_bf16(v1[2], v1[3]);
                    st_rows16(tb, S + (size_t)(r - fr) * D + 768 + bj * 128 + wc * 32, D, fr, fq, w);
                }
            }
        return true;
    }
};
struct EpiMerge {
    static constexpr bool PERM = true; static constexpr int XST = 0;
    const unsigned char* GT; bf16_t* MG;
    __device__ __forceinline__ void prefetch(const pg8::Unit&, int, int, LAS unsigned char*) const {}
    __device__ __forceinline__ bool operator()(f32x4 (&acc)[2][2][4][2], const pg8::Unit& u, int wr, int wc, int fr, int fq, LAS unsigned char* tb, const LAS unsigned char*) const {
        const int cb = u.pn * 256 + wc * 32 + 8 * fq, i = u.seg;
        const int thr = ((wr * 4 + wc) * 64 + fq * 16 + fr) * 8;
        const unsigned char* gi = GT + (size_t)(u.pm * 16 + i * 4 + u.pn) * 16 * 4096 + thr;
        const unsigned char* gn = gi + (size_t)4 * 16 * 4096;
        u32x2 ti[16], tn[16];
#pragma unroll
        for (int q = 0; q < 16; ++q) { ti[q] = *(const u32x2*)(gi + q * 4096); tn[q] = (i < 3) ? *(const u32x2*)(gn + q * 4096) : (u32x2){0u, 0u}; }
#pragma unroll
        for (int q = 0; q < 16; ++q) { const int ai = q >> 3, m = (q >> 1) & 3, bj = q & 1;
            float f[8];
#pragma unroll
            for (int j = 0; j < 8; ++j) { const unsigned a = ((j < 4 ? ti[q].x : ti[q].y) >> (8 * (j & 3))) & 0xffu, b = ((j < 4 ? tn[q].x : tn[q].y) >> (8 * (j & 3))) & 0xffu;
                f[j] = (i < 3) ? (float)a * fast_rcp((float)b) : (float)a * (1.0f / 255.0f); }
            f32x4 v0 = acc[ai][bj][m][0], v1 = acc[ai][bj][m][1];
#pragma unroll
            for (int j = 0; j < 4; ++j) { v0[j] *= f[j]; v1[j] *= f[4 + j]; }
            if (i < 3) { acc[ai][bj][m][0] = v0; acc[ai][bj][m][1] = v1; }
            else { const int r = u.pm * 256 + ai * 128 + wr * 64 + m * 16 + fr;
                u32x4 w; w.x = cvt_pk_bf16(v0[0], v0[1]); w.y = cvt_pk_bf16(v0[2], v0[3]); w.z = cvt_pk_bf16(v1[0], v1[1]); w.w = cvt_pk_bf16(v1[2], v1[3]);
                st_rows16(tb, MG + (size_t)(r - fr) * D + u.pn * 256 + wc * 32 + bj * 128, D, fr, fq, w); }
        }
        return i == 3;
    }
};

__device__ __forceinline__ void transpose_item(const float* src, int ld_src, int k0, int n0, bf16_t* dst, int ld_dst, int dst_row0, LAS float* scr, int lane) {
    const int kr = lane >> 3, nq = lane & 7;
    f32x4 v[8];
#pragma unroll
    for (int i = 0; i < 8; ++i) v[i] = *(const f32x4*)(src + (size_t)(k0 + i * 8 + kr) * ld_src + n0 + nq * 4);
#pragma unroll
    for (int i = 0; i < 8; ++i) { LAS float* d_ = scr + (i * 8 + kr) * 33 + nq * 4; d_[0] = v[i][0]; d_[1] = v[i][1]; d_[2] = v[i][2]; d_[3] = v[i][3]; }
    asm volatile("s_waitcnt lgkmcnt(0)" ::: "memory");
    const int c = lane & 7;
#pragma unroll
    for (int j = 0; j < 4; ++j) { const int n = (lane >> 3) + 8 * j; const LAS float* s = scr + (8 * c) * 33 + n;
        u32x4 o; o.x = cvt_pk_bf16(s[0 * 33], s[1 * 33]); o.y = cvt_pk_bf16(s[2 * 33], s[3 * 33]); o.z = cvt_pk_bf16(s[4 * 33], s[5 * 33]); o.w = cvt_pk_bf16(s[6 * 33], s[7 * 33]);
        *(u32x4*)(dst + (size_t)(dst_row0 + n) * ld_dst + k0 + 8 * c) = o; }
    asm volatile("s_waitcnt lgkmcnt(0)" ::: "memory");
}

__device__ __forceinline__ void weight_prep(const KP& p, LAS unsigned char* lds, int l_lo, int l_hi, int b0, int nb) {
    int tid = p.tid_; asm volatile("" : "+v"(tid)); const int wave = tid >> 6, lane = tid & 63, G = nb, bx = p.bx_ - b0;
    unsigned char* ws = p.ws;
    if (bx < 0 || bx >= nb) return;
    {
        LAS float* scr = (LAS float*)(lds + wave * 16384);
        const int gw = bx * NWAVES + wave, NGW = G * NWAVES;
        constexpr int I_IN1 = 16 * 64, I_IN2 = 16 * 128, I_O = 4 * 32, I_OUT = 16 * 32, I_UP = 16 * 176, I_DN = 44 * 32;
        constexpr int PER_L = I_IN1 + I_IN2 + 4 * I_O + I_OUT + I_UP + I_DN;
        for (int it = l_lo * PER_L + gw; it < l_hi * PER_L; it += NGW) {
            const int l = it / PER_L; int r = it % PER_L;
            bf16_t* wl = (bf16_t*)(ws + OFF_W + (size_t)l * W_LAYER);
            if (r < I_IN1) { const int kb = r / 64, nb = r % 64; transpose_item(p.in(I_w_in) + (size_t)l * D * IN_COLS, IN_COLS, kb * 64, nb * 32, wl + W_IN / 2, D, nb * 32, scr, lane); continue; } r -= I_IN1;
            if (r < I_IN2) { const int kb = r / 128, nb = r % 128; transpose_item(p.in(I_w_in) + (size_t)l * D * IN_COLS, IN_COLS, kb * 64, 2304 + nb * 32, wl + W_IN / 2, D, PMW + nb * 32, scr, lane); continue; } r -= I_IN2;
            if (r < 4 * I_O) { const int br = r / I_O, rr = r % I_O, kb = rr / 32, nb = rr % 32;
                const float* src = (br == 0 ? p.in(I_w_ret_o) : br == 1 ? p.in(I_w_conv_o) : br == 2 ? p.in(I_w_gmlp_o) : p.in(I_w_fnet_o)) + (size_t)l * 256 * D;
                transpose_item(src, D, kb * 64, nb * 32, wl + W_O / 2 + (size_t)br * 1024 * 256, 256, nb * 32, scr, lane); continue; } r -= 4 * I_O;
            if (r < I_OUT) { const int kb = r / 32, nb = r % 32; transpose_item(p.in(I_w_out) + (size_t)l * D * D, D, kb * 64, nb * 32, wl + W_OUT / 2, D, nb * 32, scr, lane); continue; } r -= I_OUT;
            if (r < I_UP) { const int kb = r / 176, nb = r % 176; transpose_item(p.in(I_w_ffn_up) + (size_t)l * D * UPW, UPW, kb * 64, nb * 32, wl + W_UP / 2, D, nb * 32, scr, lane); continue; } r -= I_UP;
            { const int kb = r / 32, nb = r % 32; transpose_item(p.in(I_w_ffn_down) + (size_t)l * DFF * D, D, kb * 64, nb * 32, wl + W_DN / 2, DFF, nb * 32, scr, lane); }
        }
        __syncthreads();
    }
    {
        LAS float* tile = (LAS float*)lds;
        LAS float* tab = (LAS float*)(lds + 64 * 65 * 4);
        for (int it = l_lo * 64 + bx; it < l_hi * 64; it += G) {
            const int l = it / 64, gq = (it / 16) % 4, kb = it % 16;
            __syncthreads();
            if (tid < 64) { tab[tid] = cos_rev((float)tid * (1.0f / 64.0f)) * 0.125f; tab[64 + tid] = sin_rev((float)tid * (1.0f / 64.0f)) * 0.125f; }
            for (int i = tid; i < 64 * 64; i += NTHREADS) { const int kk = i / 64, cc = i % 64; tile[kk * 65 + cc] = p.in(I_w_in)[((size_t)l * D + kb * 64 + kk) * IN_COLS + 2048 + gq * 64 + cc]; }
            __syncthreads();
            const int which = tid >> 8, nl = (tid & 255) >> 2, kq = tid & 3;
            float acc[16];
#pragma unroll
            for (int j = 0; j < 16; ++j) acc[j] = 0.f;
            for (int cc = 0; cc < 64; ++cc) { const float coef = tab[which * 64 + ((cc * nl) & 63)];
#pragma unroll
                for (int j = 0; j < 16; ++j) acc[j] += coef * tile[(kq * 16 + j) * 65 + cc]; }
            bf16_t* wl = (bf16_t*)(ws + OFF_W + (size_t)l * W_LAYER + W_IN);
            bf16_t* dst = wl + (size_t)(2048 + which * 256 + gq * 64 + nl) * D + kb * 64 + kq * 16;
            *(u32x4*)dst = pack8(acc); *(u32x4*)(dst + 8) = pack8(acc + 8);
        }
        __syncthreads();
    }
}
__device__ __forceinline__ void phase_prep_a(const KP& p, LAS unsigned char* lds) {
    int tid = p.tid_; asm volatile("" : "+v"(tid)); const int wave = tid >> 6, lane = tid & 63, G = NBLK, bx = p.bx_;
    unsigned char* ws = p.ws;
    {
        LAS float* sl = (LAS float*)lds;
        float* adap = (float*)(ws + OFF_ADAP);
        for (int it = bx; it < 2 * 12 * 8; it += G) {
            const int l = it / 96, nch = (it / 8) % 12, kc = it % 8;
            __syncthreads();
            for (int i = tid; i < 17 * 128; i += NTHREADS) { const int mi = i / 128, k = kc * 128 + (i % 128); const float cv = mi < 16 ? p.in(I_c)[mi * D + k] : p.in(I_c_ctx)[k]; sl[i] = siluf_(cv); }
            __syncthreads();
            const int n = nch * 512 + tid;
            float acc[17];
#pragma unroll
            for (int mi = 0; mi < 17; ++mi) acc[mi] = 0.f;
            const float* wp = p.in(I_w_ada) + ((size_t)l * D + kc * 128) * 6144 + n;
#pragma unroll 1
            for (int k0 = 0; k0 < 128; k0 += 16) { float w[16];
#pragma unroll
                for (int k = 0; k < 16; ++k) w[k] = wp[(size_t)(k0 + k) * 6144];
#pragma unroll
                for (int k = 0; k < 16; ++k)
#pragma unroll
                    for (int mi = 0; mi < 17; ++mi) acc[mi] += sl[mi * 128 + k0 + k] * w[k]; }
#pragma unroll
            for (int mi = 0; mi < 17; ++mi) adap[(((size_t)kc * 2 + l) * 17 + mi) * 6144 + n] = acc[mi];
        }
        __syncthreads();
    }
    weight_prep(p, lds, 0, 1, 0, G);
    {
        const size_t gt = (size_t)bx * NTHREADS + tid, GT_ = (size_t)G * NTHREADS;
        float* rc = (float*)(ws + OFF_ROPE); float* rsn = rc + 2304 * 32;
        for (size_t i = gt; i < (size_t)2304 * 32; i += GT_) { const int pos = (int)(i / 32), fi = (int)(i % 32);
            const float inv = exp2f(-(float)fi * (13.287712379549449f / 32.0f));
            const float ang = (float)pos * inv;
            const double rev = (double)ang * 0.15915494309189535; const float fr_ = (float)(rev - floor(rev));
            rc[i] = cos_rev(fr_); rsn[i] = sin_rev(fr_); }
        bf16_t* dm = (bf16_t*)(ws + OFF_DM);
        for (size_t i = gt; i < (size_t)2048 * 256; i += GT_) { const int n = (int)(i / 256), k8 = (int)(i % 256) * 8; float v[8];
#pragma unroll
            for (int j = 0; j < 8; ++j) { const int kk = k8 + j; if (kk <= 1024) v[j] = cos_rev((float)((n * kk) & 2047) * (1.0f / 2048.0f)); else v[j] = -sin_rev((float)((n * (kk - 1024)) & 2047) * (1.0f / 2048.0f)); }
            *(u32x4*)(dm + (size_t)n * 2048 + k8) = pack8(v); }
        bf16_t* dc = (bf16_t*)(ws + OFF_DC);
        for (size_t i = gt; i < (size_t)256 * 32; i += GT_) { const int n = (int)(i / 32), k8 = (int)(i % 32) * 8; float v[8];
#pragma unroll
            for (int j = 0; j < 8; ++j) { const int kk = k8 + j; if (kk <= 128) v[j] = cos_rev((float)((n * kk) & 255) * (1.0f / 256.0f)); else v[j] = -sin_rev((float)((n * (kk - 128)) & 255) * (1.0f / 256.0f)); }
            *(u32x4*)(dc + (size_t)n * 256 + k8) = pack8(v); }
        if (gt < 16) { const float xx = p.in(I_ret_decay)[gt]; ((float*)(ws + OFF_LOGG))[gt] = (float)(-log1p(exp(-(double)xx))); }
    }
}

__device__ __forceinline__ void phase_prep_b(const KP& p) {
    const size_t gt = (size_t)p.bx_ * NTHREADS + p.tid_, GT_ = (size_t)NBLK * NTHREADS;
    const float* adap = (const float*)(p.ws + OFF_ADAP); float* mod = (float*)(p.ws + OFF_MOD);
    for (size_t i = gt; i < (size_t)2 * 17 * 6144; i += GT_) {
        const int l = (int)(i / (17 * 6144)), n = (int)(i % 6144), j = n / 1024, k = n % 1024;
        float v = p.in(I_b_ada)[l * 6144 + n];
#pragma unroll
        for (int kc = 0; kc < 8; ++kc) v += adap[(size_t)kc * 2 * 17 * 6144 + i];
        if (j == 1) v = p.in(I_g_norm1)[l * D + k] * (1.f + v);
        if (j == 4) v = p.in(I_g_norm2)[l * D + k] * (1.f + v);
        mod[i] = v;
    }
}

__device__ __forceinline__ void phase_prep_c(const KP& p, LAS unsigned char* lds, int l_lo, int l_hi, int b0, int nb) {
    int tid = p.tid_; asm volatile("" : "+v"(tid)); const int wave = tid >> 6, lane = tid & 63, G = nb;
    if (p.bx_ < b0 || p.bx_ >= b0 + nb) return;
    LAS unsigned char* shb = lds;
    const int gw = (p.bx_ - b0) * NWAVES + wave, NGW = G * NWAVES;
    const int c = lane & 15, gq = lane >> 4;
    for (int combo = 2 * l_lo; combo < 2 * l_hi; ++combo) {
        const int l = combo >> 1, which = combo & 1;
        const float* mod = (const float*)(p.ws + OFF_MOD) + (size_t)l * 17 * 6144 + (which ? 3 : 0) * 1024;
        __syncthreads();
        for (int i = tid; i < 32 * 128; i += NTHREADS) { const int row = i >> 7, ch = i & 127; float f[8];
#pragma unroll
            for (int j = 0; j < 8; ++j) f[j] = row < 17 ? mod[(size_t)row * 6144 + ch * 8 + j] : 0.f;
            *(LAS u32x4*)(shb + row * 2048 + ((ch ^ (row & 7)) << 4)) = pack8(f); }
        __syncthreads();
        const int ncol = which ? UPW : NCOLS;
        const bf16_t* W = (const bf16_t*)(p.ws + OFF_W + (size_t)l * W_LAYER + (which ? W_UP : W_IN));
        float* dst = (float*)(p.ws + (which ? OFF_SHW2 : OFF_SHW1)) + (size_t)l * 17 * ncol;
        for (int nb16 = gw; nb16 < ncol / 16; nb16 += NGW) {
            const bf16_t* wrow = W + (size_t)(nb16 * 16 + c) * D + 8 * gq;
            const f32x4 z4 = (f32x4){0.f, 0.f, 0.f, 0.f};
            f32x4 acc0 = z4, acc1 = z4;
#pragma unroll 1
            for (int t0 = 0; t0 < 32; t0 += 8) {
                bf16x8 bfr[8];
#pragma unroll
                for (int q = 0; q < 8; ++q) bfr[q] = *(const bf16x8*)(wrow + 32 * (t0 + q));
#pragma unroll
                for (int q = 0; q < 8; ++q) { const int ch = 4 * (t0 + q) + gq;
                    const bf16x8 a0 = *(const LAS bf16x8*)(shb + c * 2048 + ((ch ^ (c & 7)) << 4)), a1 = *(const LAS bf16x8*)(shb + (16 + c) * 2048 + ((ch ^ (c & 7)) << 4));
                    acc0 = mfma16(a0, bfr[q], acc0); acc1 = mfma16(a1, bfr[q], acc1); }
            }
            const int n = nb16 * 16 + c;
#pragma unroll
            for (int r = 0; r < 4; ++r) dst[(size_t)(4 * gq + r) * ncol + n] = acc0[r];
            if (gq == 0) dst[(size_t)16 * ncol + n] = acc1[0];
        }
    }
    __syncthreads();
}

__device__ __forceinline__ void phase_g0(const KP& p, int g, int b0, int nb) {
    int tid = p.tid_; asm volatile("" : "+v"(tid)); const int wave = tid >> 6, lane = tid & 63;
    if (p.bx_ < b0 || p.bx_ >= b0 + nb) return;
    const int gw = (p.bx_ - b0) * NWAVES + wave, NGW = nb * NWAVES;
    const float* mod = (const float*)(p.ws + OFF_MOD);
    bf16_t* AP = (bf16_t*)(p.ws + ap_off(g)); float* ss = (float*)(p.ws + ssa_off(g));
    const int nrows = g == 0 ? R : R_LAT;
    for (int r0 = gw; r0 < nrows; r0 += 2 * NGW) {
        f32x4 v[2][4], gg[2][4]; int rr[2]; bool ok[2];
#pragma unroll
        for (int h = 0; h < 2; ++h) { rr[h] = r0 + h * NGW; ok[h] = rr[h] < nrows; const int r = ok[h] ? rr[h] : r0;
            const RowInfo ri = row_info(g, r >> 8);
            const float* xr = (ri.is_ctx ? p.in(I_ctx) : p.in(I_x)) + (ri.xrow0 + (size_t)(r & 255)) * D;
            const float* G1 = mod + (size_t)ri.mi * 6144 + 1024;
#pragma unroll
            for (int j = 0; j < 4; ++j) { v[h][j] = *(const f32x4*)(xr + j * 256 + lane * 4); gg[h][j] = *(const f32x4*)(G1 + j * 256 + lane * 4); } }
#pragma unroll
        for (int h = 0; h < 2; ++h) { if (!ok[h]) continue; const int r = rr[h];
            float s_ = 0.f;
#pragma unroll
            for (int j = 0; j < 4; ++j) { const f32x4 x = v[h][j];
                s_ += (x[0] * x[0] + x[1] * x[1]) + (x[2] * x[2] + x[3] * x[3]);
                const f32x4 a = x * gg[h][j]; u32x2 w; w.x = cvt_pk_bf16(a[0], a[1]); w.y = cvt_pk_bf16(a[2], a[3]);
                *(u32x2*)(AP + (size_t)r * D + j * 256 + lane * 4) = w; }
            s_ = wave_sum(s_, lane);
            if (lane == 0) ss[r] = s_; }
    }
}

__device__ __forceinline__ void phase_final(const KP& p, int g, int b0, int nb) {
    int tid = p.tid_; asm volatile("" : "+v"(tid)); const int wave = tid >> 6, lane = tid & 63;
    if (p.bx_ < b0 || p.bx_ >= b0 + nb) return;
    const int gw = (p.bx_ - b0) * NWAVES + wave, NGW = nb * NWAVES;
    const float* ss = (const float*)(p.ws + ssa_off(g));
    const f32x4 gf0 = *(const f32x4*)(p.in(I_g_final) + lane * 4), gf1 = *(const f32x4*)(p.in(I_g_final) + 256 + lane * 4), gf2 = *(const f32x4*)(p.in(I_g_final) + 512 + lane * 4), gf3 = *(const f32x4*)(p.in(I_g_final) + 768 + lane * 4);
    for (int r0 = gw; r0 < R_LAT; r0 += 2 * NGW) {
        f32x4 v[2][4]; float sv[2];
#pragma unroll
        for (int h = 0; h < 2; ++h) { const int r = (r0 + h * NGW < R_LAT) ? r0 + h * NGW : r0; sv[h] = ss[r];
            const float* xr = p.out + ((size_t)g * R_LAT + r) * D;
#pragma unroll
            for (int j = 0; j < 4; ++j) v[h][j] = *(const f32x4*)(xr + j * 256 + lane * 4); }
#pragma unroll
        for (int h = 0; h < 2; ++h) { const int r = r0 + h * NGW; if (r >= R_LAT) continue;
            const float rs = __builtin_amdgcn_rsqf(sv[h] * (1.0f / 1024.0f) + EPS);
            float* xr = p.out + ((size_t)g * R_LAT + r) * D;
            *(f32x4*)(xr + lane * 4) = v[h][0] * rs * gf0; *(f32x4*)(xr + 256 + lane * 4) = v[h][1] * rs * gf1;
            *(f32x4*)(xr + 512 + lane * 4) = v[h][2] * rs * gf2; *(f32x4*)(xr + 768 + lane * 4) = v[h][3] * rs * gf3; }
    }
}

struct ChunkInfo { int row0, pos0, h; };
__device__ __forceinline__ ChunkInfo chunk_info(int item) {
    ChunkInfo ci;
    if (item < N_KV_LAT) { const int gb = item >> 6, ch = item & 15; ci.h = (item >> 4) & 3; ci.row0 = gb * SEQ + ch * 128; ci.pos0 = CTXL + ch * 128; }
    else { const int it2 = item - N_KV_LAT, gb = it2 >> 3, ch = it2 & 1; ci.h = (it2 >> 1) & 3; ci.row0 = R_LAT + gb * CTXL + ch * 128; ci.pos0 = ch * 128; }
    return ci;
}
__device__ __forceinline__ void load_chunk_f32(const int tid, const bf16_t* PM, int row0, int col0, LAS float* dst, int st) {
#pragma unroll
    for (int q = 0; q < 2; ++q) { const int idx = tid + q * NTHREADS, row = idx >> 3, cc = idx & 7; float f[8];
        unpack8(*(const u32x4*)(PM + (size_t)(row0 + row) * PMW + col0 + cc * 8), f);
        *(LAS f32x4*)(dst + row * st + cc * 8) = (f32x4){f[0], f[1], f[2], f[3]}; *(LAS f32x4*)(dst + row * st + cc * 8 + 4) = (f32x4){f[4], f[5], f[6], f[7]}; }
}
__device__ __forceinline__ void rotary_lds(const int tid, LAS float* buf, int st, int pos0, const float* rc, const float* rsn, float scale) {
#pragma unroll
    for (int q = 0; q < 8; ++q) { const int pidx = tid + q * NTHREADS, row = pidx >> 5, i = pidx & 31;
        const float c = rc[(pos0 + row) * 32 + i], s = rsn[(pos0 + row) * 32 + i];
        const float t1 = buf[row * st + i], t2 = buf[row * st + i + 32];
        buf[row * st + i] = (t1 * c - t2 * s) * scale; buf[row * st + i + 32] = (t1 * s + t2 * c) * scale; }
}

__device__ __forceinline__ void ret_kv_item(const KP& p, LAS unsigned char* lds, int l, int item) {
    int tid = p.tid_; asm volatile("" : "+v"(tid));
    const bf16_t* PM = (const bf16_t*)(p.ws + OFF_BIG);
    const float* rc = (const float*)(p.ws + OFF_ROPE); const float* rsn = rc + 2304 * 32;
    const float* logg = (const float*)(p.ws + OFF_LOGG) + l * 8;
    LAS unsigned char* KfT = lds;
    LAS unsigned char* KbT = lds + 16384;
    LAS unsigned char* Vt = lds + 32768;
    const ChunkInfo ci = chunk_info(item);
    __syncthreads();
    {
        const int row = tid >> 2, pc = tid & 3, pos = ci.pos0 + row;
        const bf16_t* src = PM + (size_t)(ci.row0 + row) * PMW + ci.h * 64;
        const float lgf = logg[ci.h], lgb = logg[4 + ci.h];
        const float wf = 0.125f * __expf(lgf * (float)(127 - row)), wb = 0.125f * __expf(lgb * (float)row);
        float cs[8], sn[8], t1[8], t2[8];
        { const f32x4 c0 = *(const f32x4*)(rc + pos * 32 + pc * 8), c1 = *(const f32x4*)(rc + pos * 32 + pc * 8 + 4), s0 = *(const f32x4*)(rsn + pos * 32 + pc * 8), s1 = *(const f32x4*)(rsn + pos * 32 + pc * 8 + 4);
#pragma unroll
          for (int j = 0; j < 4; ++j) { cs[j] = c0[j]; cs[4 + j] = c1[j]; sn[j] = s0[j]; sn[4 + j] = s1[j]; } }
        unpack8(*(const u32x4*)(src + 256 + pc * 8), t1); unpack8(*(const u32x4*)(src + 256 + 32 + pc * 8), t2);
        const int jo = (row & 7) * 2, jc = row >> 3;
#pragma unroll
        for (int j = 0; j < 8; ++j) {
            const float o1 = t1[j] * cs[j] - t2[j] * sn[j], o2 = t1[j] * sn[j] + t2[j] * cs[j];
            const int d1 = pc * 8 + j, d2 = 32 + pc * 8 + j;
            *(LAS unsigned short*)(KfT + d1 * 256 + ((jc ^ (d1 & 15)) << 4) + jo) = f2bf(o1 * wf); *(LAS unsigned short*)(KfT + d2 * 256 + ((jc ^ (d2 & 15)) << 4) + jo) = f2bf(o2 * wf);
            *(LAS unsigned short*)(KbT + d1 * 256 + ((jc ^ (d1 & 15)) << 4) + jo) = f2bf(o1 * wb); *(LAS unsigned short*)(KbT + d2 * 256 + ((jc ^ (d2 & 15)) << 4) + jo) = f2bf(o2 * wb);
        }
        const u32x4 v0 = *(const u32x4*)(src + 512 + pc * 16), v1 = *(const u32x4*)(src + 512 + pc * 16 + 8);
        const unsigned vv[8] = {v0.x, v0.y, v0.z, v0.w, v1.x, v1.y, v1.z, v1.w};
#pragma unroll
        for (int e2 = 0; e2 < 8; ++e2)
#pragma unroll
            for (int hh = 0; hh < 2; ++hh) { const int e = pc * 16 + e2 * 2 + hh; const unsigned short val = (unsigned short)(hh ? (vv[e2] >> 16) : (vv[e2] & 0xffffu));
                *(LAS unsigned short*)(Vt + e * 256 + ((jc ^ (e & 15)) << 4) + jo) = val; }
    }
    __syncthreads();
    const int w = __builtin_amdgcn_readfirstlane(tid >> 6), lane = tid & 63, c = lane & 15, gq = lane >> 4;
    const int dir = w >> 2, db = w & 3, d = 16 * db + c;
    LAS unsigned char* KT = dir ? KbT : KfT;
    const f32x4 z4 = (f32x4){0.f, 0.f, 0.f, 0.f};
    f32x4 acc[4] = {z4, z4, z4, z4};
#pragma unroll
    for (int t = 0; t < 4; ++t) {
        const bf16x8 af = *(const LAS bf16x8*)(KT + d * 256 + (((4 * t + gq) ^ (d & 15)) << 4));
#pragma unroll
        for (int eb = 0; eb < 4; ++eb) { const int e = 16 * eb + c;
            const bf16x8 bfr = *(const LAS bf16x8*)(Vt + e * 256 + (((4 * t + gq) ^ (e & 15)) << 4));
            acc[eb] = mfma16(af, bfr, acc[eb]); }
    }
    float* kv = (item < N_KV_LAT ? (float*)(p.ws + OFF_KV) + (size_t)item * 8192 : (float*)(p.ws + OFF_KVC) + (size_t)(l * N_KV_CTX + item - N_KV_LAT) * 8192) + dir * 4096;
#pragma unroll
    for (int eb = 0; eb < 4; ++eb)
#pragma unroll
        for (int r = 0; r < 4; ++r) kv[(16 * db + 4 * gq + r) * 64 + 16 * eb + c] = acc[eb][r];
}

__device__ __forceinline__ void ret_out_item(const KP& p, LAS unsigned char* lds, int g, int l, int item) {
    int tid = p.tid_; asm volatile("" : "+v"(tid));
    const bf16_t* PM = (const bf16_t*)(p.ws + OFF_BIG);
    const float* rc = (const float*)(p.ws + OFF_ROPE); const float* rsn = rc + 2304 * 32;
    const float* logg = (const float*)(p.ws + OFF_LOGG) + l * 8;
    LAS unsigned char* Qb = lds;
    LAS unsigned char* Kb = lds + 16384;
    LAS unsigned char* Vt = lds + 32768;
    LAS unsigned char* SfT = lds + 49152;
    LAS unsigned char* SbT = lds + 57344;
    LAS float* dtab = (LAS float*)(lds + 65536);
    const ChunkInfo ci = chunk_info(item);
    __syncthreads();
    {
        const int row = tid >> 2, pc = tid & 3, pos = ci.pos0 + row;
        const bf16_t* src = PM + (size_t)(ci.row0 + row) * PMW + ci.h * 64;
        float cs[8], sn[8];
        { const f32x4 c0 = *(const f32x4*)(rc + pos * 32 + pc * 8), c1 = *(const f32x4*)(rc + pos * 32 + pc * 8 + 4), s0 = *(const f32x4*)(rsn + pos * 32 + pc * 8), s1 = *(const f32x4*)(rsn + pos * 32 + pc * 8 + 4);
#pragma unroll
          for (int j = 0; j < 4; ++j) { cs[j] = c0[j]; cs[4 + j] = c1[j]; sn[j] = s0[j]; sn[4 + j] = s1[j]; } }
#pragma unroll
        for (int qk = 0; qk < 2; ++qk) {
            float t1[8], t2[8], o1[8], o2[8];
            unpack8(*(const u32x4*)(src + qk * 256 + pc * 8), t1); unpack8(*(const u32x4*)(src + qk * 256 + 32 + pc * 8), t2);
            const float sc = qk ? 0.125f : 1.0f;
#pragma unroll
            for (int j = 0; j < 8; ++j) { o1[j] = (t1[j] * cs[j] - t2[j] * sn[j]) * sc; o2[j] = (t1[j] * sn[j] + t2[j] * cs[j]) * sc; }
            LAS unsigned char* dst = (qk ? Kb : Qb) + row * 128;
            *(LAS u32x4*)(dst + ((pc ^ (row & 7)) << 4)) = pack8(o1);
            *(LAS u32x4*)(dst + (((4 + pc) ^ (row & 7)) << 4)) = pack8(o2);
        }
        {
            const u32x4 v0 = *(const u32x4*)(src + 512 + pc * 16), v1 = *(const u32x4*)(src + 512 + pc * 16 + 8);
            const unsigned vv[8] = {v0.x, v0.y, v0.z, v0.w, v1.x, v1.y, v1.z, v1.w};
#pragma unroll
            for (int e2 = 0; e2 < 8; ++e2)
#pragma unroll
                for (int hh = 0; hh < 2; ++hh) { const int e = pc * 16 + e2 * 2 + hh; const unsigned short val = (unsigned short)(hh ? (vv[e2] >> 16) : (vv[e2] & 0xffffu));
                    *(LAS unsigned short*)(Vt + e * 256 + ((((row >> 2) ^ (2 * (e & 15))) << 3)) + (row & 3) * 2) = val; }
        }
        {
            const int d = tid >> 3, e0 = (tid & 7) * 8;
            const float* KV = (const float*)(p.ws + OFF_KV) + d * 64 + e0;
            const float* KVC = (const float*)(p.ws + OFF_KVC) + (size_t)l * N_KV_CTX * 8192 + d * 64 + e0;
            const f32x4 z = (f32x4){0.f, 0.f, 0.f, 0.f};
            f32x4 fa = z, fb = z, ba = z, bb = z;
            if (item < N_KV_LAT) {
                const int ch = item & 15, lat0 = item - ch, c0 = (g * GB + (item >> 6)) * 8 + ci.h * 2;
                const float l128f = logg[ci.h] * 128.f, l128b = logg[4 + ci.h] * 128.f;
#pragma unroll 1
                for (int t0 = 0; t0 < 20; t0 += 10) {
                    f32x4 xa[10], xb[10]; float wt[10]; bool isf[10];
#pragma unroll
                    for (int q = 0; q < 10; ++q) { const int t = t0 + q; const bool fw = t < ch + 2; isf[q] = fw;
                        const int k = fw ? t - 2 : t - (ch + 2) - 2;
                        const float* x; if (fw) x = k < 0 ? KVC + (size_t)(c0 + k + 2) * 8192 : KV + (size_t)(lat0 + k) * 8192;
                        else x = (k < 0 ? KVC + (size_t)(c0 - 1 - k) * 8192 : KV + (size_t)(lat0 + 15 - k) * 8192) + 4096;
                        const bool valid = t < 19; if (!valid) x = KVC;
                        wt[q] = valid ? (fw ? __expf(l128f * (float)(ch - 1 - k)) : __expf(l128b * (float)(14 - ch - k))) : 0.f;
                        xa[q] = *(const f32x4*)x; xb[q] = *(const f32x4*)(x + 4); }
#pragma unroll
                    for (int q = 0; q < 10; ++q) { if (isf[q]) { fa += xa[q] * wt[q]; fb += xb[q] * wt[q]; } else { ba += xa[q] * wt[q]; bb += xb[q] * wt[q]; } }
                }
            } else {
                const int it2 = item - N_KV_LAT, ch = it2 & 1, c0 = it2 - ch;
                if (ch == 1) { const float* x = KVC + (size_t)c0 * 8192; fa = *(const f32x4*)x; fb = *(const f32x4*)(x + 4); }
                else { const float* x = KVC + (size_t)(c0 + 1) * 8192 + 4096; ba = *(const f32x4*)x; bb = *(const f32x4*)(x + 4); }
            }
#pragma unroll
            for (int dir = 0; dir < 2; ++dir) { const f32x4 a = dir ? ba : fa, b = dir ? bb : fb;
                LAS unsigned char* dstT = dir ? SbT : SfT; const float vals[8] = {a[0], a[1], a[2], a[3], b[0], b[1], b[2], b[3]};
#pragma unroll
                for (int jj = 0; jj < 8; ++jj) { const int e = e0 + jj; *(LAS unsigned short*)(dstT + e * 128 + (((d >> 3) ^ (e & 7)) << 4) + (d & 7) * 2) = f2bf(vals[jj]); } }
        }
        const float lgf = logg[ci.h], lgb = logg[4 + ci.h];
        if (tid <= 256) { const int t = tid - 128; dtab[tid] = t > 0 ? __expf(lgf * (float)t) : (t < 0 ? __expf(lgb * (float)(-t)) : 2.0f); }
    }
    __syncthreads();
    const int w = __builtin_amdgcn_readfirstlane(tid >> 6), lane = tid & 63, c = lane & 15, gq = lane >> 4;
    const int il = 16 * w + c;
    f32x4 g4v[4]; u32x2 grv[4];
    { const float* gn_ = p.in(I_ret_gn) + l * 256 + ci.h * 64; const bf16_t* gsrc_ = PM + (size_t)(ci.row0 + il) * PMW + 768 + ci.h * 64;
#pragma unroll
      for (int eb = 0; eb < 4; ++eb) { g4v[eb] = *(const f32x4*)(gn_ + 16 * eb + 4 * gq); grv[eb] = *(const u32x2*)(gsrc_ + 16 * eb + 4 * gq); } }
    bf16x8 qf[2];
#pragma unroll
    for (int ks = 0; ks < 2; ++ks) qf[ks] = *(const LAS bf16x8*)(Qb + il * 128 + (((4 * ks + gq) ^ (il & 7)) << 4));
    const f32x4 z4 = (f32x4){0.f, 0.f, 0.f, 0.f};
    f32x4 st[8];
#pragma unroll
    for (int jb = 0; jb < 8; ++jb) { const int j = 16 * jb + c;
        const bf16x8 k0 = *(const LAS bf16x8*)(Kb + j * 128 + (((0 + gq) ^ (j & 7)) << 4)), k1 = *(const LAS bf16x8*)(Kb + j * 128 + (((4 + gq) ^ (j & 7)) << 4));
        st[jb] = mfma16(k0, qf[0], z4); st[jb] = mfma16(k1, qf[1], st[jb]); }
#pragma unroll
    for (int jb = 0; jb < 8; ++jb)
#pragma unroll
        for (int r = 0; r < 4; ++r) st[jb][r] *= dtab[128 + il - (16 * jb + 4 * gq + r)];
    f32x4 oT[4], cf[4], cb[4];
#pragma unroll
    for (int eb = 0; eb < 4; ++eb) { oT[eb] = z4; cf[eb] = z4; cb[eb] = z4; }
#pragma unroll
    for (int t = 0; t < 4; ++t) {
        union { u32x4 u; bf16x8 v; } pk;
        pk.u.x = cvt_pk_bf16(st[2 * t][0], st[2 * t][1]); pk.u.y = cvt_pk_bf16(st[2 * t][2], st[2 * t][3]);
        pk.u.z = cvt_pk_bf16(st[2 * t + 1][0], st[2 * t + 1][1]); pk.u.w = cvt_pk_bf16(st[2 * t + 1][2], st[2 * t + 1][3]);
#pragma unroll
        for (int eb = 0; eb < 4; ++eb) { const int e = 16 * eb + c;
            union { u32x4 u; bf16x8 v; } va;
            const u32x2 lo = *(const LAS u32x2*)(Vt + e * 256 + (((8 * t + gq) ^ (2 * (e & 15))) << 3)), hi = *(const LAS u32x2*)(Vt + e * 256 + (((8 * t + 4 + gq) ^ (2 * (e & 15))) << 3));
            va.u.x = lo.x; va.u.y = lo.y; va.u.z = hi.x; va.u.w = hi.y;
            oT[eb] = mfma16(va.v, pk.v, oT[eb]); }
    }
#pragma unroll
    for (int eb = 0; eb < 4; ++eb) { const int e = 16 * eb + c;
#pragma unroll
        for (int ks = 0; ks < 2; ++ks) {
            const bf16x8 af = *(const LAS bf16x8*)(SfT + e * 128 + (((4 * ks + gq) ^ (e & 7)) << 4)), ab = *(const LAS bf16x8*)(SbT + e * 128 + (((4 * ks + gq) ^ (e & 7)) << 4));
            cf[eb] = mfma16(af, qf[ks], cf[eb]); cb[eb] = mfma16(ab, qf[ks], cb[eb]); } }
    const float wqf = dtab[128 + il + 1], wqb = dtab[il];
    float o[16]; float sm = 0.f;
#pragma unroll
    for (int eb = 0; eb < 4; ++eb)
#pragma unroll
        for (int r = 0; r < 4; ++r) { o[eb * 4 + r] = oT[eb][r] + wqf * cf[eb][r] + wqb * cb[eb][r]; sm += o[eb * 4 + r]; }
    sm += shx(sm, 16, lane); sm += shx(sm, 32, lane);
    const float mean = sm * (1.0f / 64.0f);
    float vq = 0.f;
#pragma unroll
    for (int e = 0; e < 16; ++e) { o[e] -= mean; vq += o[e] * o[e]; }
    vq += shx(vq, 16, lane); vq += shx(vq, 32, lane);
    const float rstd = __builtin_amdgcn_rsqf(vq * (1.0f / 64.0f) + EPS);
    bf16_t* S = (bf16_t*)(p.ws + OFF_S) + (size_t)(ci.row0 + il) * D + ci.h * 64;
#pragma unroll
    for (int eb = 0; eb < 4; ++eb) { const int e0 = 16 * eb + 4 * gq;
        const f32x4 g4 = g4v[eb]; const u32x2 gr = grv[eb];
        const float g0 = bf2f(gr.x & 0xffffu), g1 = __uint_as_float(gr.x & 0xffff0000u), g2 = bf2f(gr.y & 0xffffu), g3 = __uint_as_float(gr.y & 0xffff0000u);
        u32x2 wv; wv.x = cvt_pk_bf16(o[eb * 4 + 0] * rstd * g4[0] * siluf_(g0), o[eb * 4 + 1] * rstd * g4[1] * siluf_(g1));
        wv.y = cvt_pk_bf16(o[eb * 4 + 2] * rstd * g4[2] * siluf_(g2), o[eb * 4 + 3] * rstd * g4[3] * siluf_(g3));
        *(u32x2*)(S + e0) = wv; }
}

__device__ __forceinline__ void conf_item(const KP& p, LAS unsigned char* lds, int l, int item) {
    int tid = p.tid_; asm volatile("" : "+v"(tid)); const int wave = tid >> 6, lane = tid & 63;
    const bf16_t* PM = (const bf16_t*)(p.ws + OFF_BIG);
    LAS float* hbuf = (LAS float*)lds;
    LAS float* ybuf = (LAS float*)(lds + 65536);
    int seqrow0, L, n0;
    if (item < R_LAT / 32) { seqrow0 = (item >> 6) * SEQ; L = SEQ; n0 = (item & 63) * 32; }
    else { const int it2 = item - R_LAT / 32; seqrow0 = R_LAT + (it2 >> 3) * CTXL; L = CTXL; n0 = (it2 & 7) * 32; }
    __syncthreads();
    {
        u32x4 a1[4], a2[4]; bool ok[4];
#pragma unroll
        for (int q = 0; q < 4; ++q) { const int idx = tid + q * NTHREADS, hr = idx >> 5, cc = idx & 31, tok = n0 - 15 + hr;
            ok[q] = idx < 62 * 32 && tok >= 0 && tok < L;
            const bf16_t* src = PM + (size_t)(seqrow0 + (ok[q] ? tok : n0)) * PMW + 1024 + cc * 8;
            a1[q] = *(const u32x4*)src; a2[q] = *(const u32x4*)(src + 256); }
#pragma unroll
        for (int q = 0; q < 4; ++q) { const int idx = tid + q * NTHREADS, hr = idx >> 5, cc = idx & 31;
            if (idx < 62 * 32) { float x1[8], x2[8], hv[8]; unpack8(a1[q], x1); unpack8(a2[q], x2);
#pragma unroll
                for (int j = 0; j < 8; ++j) hv[j] = ok[q] ? x1[j] * sigmoidf_(x2[j]) : 0.f;
                *(LAS f32x4*)(hbuf + hr * 256 + cc * 8) = (f32x4){hv[0], hv[1], hv[2], hv[3]}; *(LAS f32x4*)(hbuf + hr * 256 + cc * 8 + 4) = (f32x4){hv[4], hv[5], hv[6], hv[7]}; } }
    }
    __syncthreads();
    { const int c = tid & 255, q = tid >> 8;
      float w[31], xw[46];
#pragma unroll
      for (int j = 0; j < 31; ++j) w[j] = p.in(I_conv_dw)[((size_t)l * 31 + j) * 256 + c];
      const float bias = p.in(I_conv_db)[l * 256 + c];
#pragma unroll
      for (int j = 0; j < 46; ++j) xw[j] = hbuf[(q * 16 + j) * 256 + c];
#pragma unroll
      for (int tt = 0; tt < 16; ++tt) { float y = bias;
#pragma unroll
          for (int j = 0; j < 31; ++j) y += w[j] * xw[tt + j];
          ybuf[(q * 16 + tt) * 256 + c] = y; } }
    __syncthreads();
    { const f32x4 lg = *(const f32x4*)(p.in(I_conv_ln_g) + l * 256 + lane * 4), lb = *(const f32x4*)(p.in(I_conv_ln_b) + l * 256 + lane * 4);
      bf16_t* S = (bf16_t*)(p.ws + OFF_S);
#pragma unroll
      for (int t4 = 0; t4 < 4; ++t4) { const int tt = wave * 4 + t4;
          f32x4 v = *(const LAS f32x4*)(ybuf + tt * 256 + lane * 4);
          const float mean = wave_sum((v[0] + v[1]) + (v[2] + v[3]), lane) * (1.0f / 256.0f);
          v = v - mean;
          const float var = wave_sum((v[0] * v[0] + v[1] * v[1]) + (v[2] * v[2] + v[3] * v[3]), lane) * (1.0f / 256.0f);
          const float rstd = __builtin_amdgcn_rsqf(var + EPS);
          f32x4 y = v * rstd * lg + lb;
#pragma unroll
          for (int j = 0; j < 4; ++j) y[j] = siluf_(y[j]);
          u32x2 w2; w2.x = cvt_pk_bf16(y[0], y[1]); w2.y = cvt_pk_bf16(y[2], y[3]);
          *(u32x2*)(S + (size_t)(seqrow0 + n0 + tt) * D + 256 + lane * 4) = w2; } }
}

__device__ __forceinline__ void gmlp_item(const KP& p, LAS unsigned char* lds, int l, int item) {
    int tid = p.tid_; asm volatile("" : "+v"(tid)); const int wave = __builtin_amdgcn_readfirstlane(tid >> 6), lane = tid & 63;
    const bf16_t* PM = (const bf16_t*)(p.ws + OFF_BIG);
    LAS unsigned char* vT = lds;
    const int row0 = item * 128;
    __syncthreads();
    { const f32x4 lg = *(const f32x4*)(p.in(I_gmlp_ln_g) + l * 256 + lane * 4), lb = *(const f32x4*)(p.in(I_gmlp_ln_b) + l * 256 + lane * 4);
      u32x2 zz[16];
#pragma unroll
      for (int t16 = 0; t16 < 16; ++t16) zz[t16] = *(const u32x2*)(PM + (size_t)(row0 + wave * 16 + t16) * PMW + 1792 + lane * 4);
#pragma unroll
      for (int t16 = 0; t16 < 16; ++t16) { const int tt = wave * 16 + t16;
          f32x4 v = (f32x4){geluf_(bf2f(zz[t16].x & 0xffffu)), geluf_(__uint_as_float(zz[t16].x & 0xffff0000u)), geluf_(bf2f(zz[t16].y & 0xffffu)), geluf_(__uint_as_float(zz[t16].y & 0xffff0000u))};
          const float mean = wave_sum((v[0] + v[1]) + (v[2] + v[3]), lane) * (1.0f / 256.0f);
          v = v - mean;
          const float var = wave_sum((v[0] * v[0] + v[1] * v[1]) + (v[2] * v[2] + v[3] * v[3]), lane) * (1.0f / 256.0f);
          const float rstd = __builtin_amdgcn_rsqf(var + EPS);
          v = v * rstd * lg + lb;
          const int jc = tt >> 3, jo = (tt & 7) * 2;
#pragma unroll
          for (int q = 0; q < 4; ++q) { const int cc = lane * 4 + q; *(LAS unsigned short*)(vT + cc * 256 + ((jc ^ (cc & 15)) << 4) + jo) = f2bf(v[q]); } } }
    __syncthreads();
    const int c = lane & 15, gq = lane >> 4, gw = wave & 3, ih = wave >> 2;
    const float* wsr = p.in(I_gmlp_ws) + (((size_t)l * 4 + gw) * 128 + ih * 64) * 128 + (size_t)c * 128 + 8 * gq;
    const f32x4 z4 = (f32x4){0.f, 0.f, 0.f, 0.f};
    f32x4 acc[4][4];
#pragma unroll
    for (int ib = 0; ib < 4; ++ib)
#pragma unroll
        for (int cb = 0; cb < 4; ++cb) acc[ib][cb] = z4;
    f32x4 wa[4][2], wb[4][2];
#pragma unroll
    for (int ib = 0; ib < 4; ++ib) { wa[ib][0] = *(const f32x4*)(wsr + ib * 16 * 128); wa[ib][1] = *(const f32x4*)(wsr + ib * 16 * 128 + 4); }
#pragma unroll
    for (int t = 0; t < 4; ++t) {
        if (t < 3) {
#pragma unroll
            for (int ib = 0; ib < 4; ++ib) { wb[ib][0] = *(const f32x4*)(wsr + ib * 16 * 128 + 32 * (t + 1)); wb[ib][1] = *(const f32x4*)(wsr + ib * 16 * 128 + 32 * (t + 1) + 4); } }
        bf16x8 bfr[4];
#pragma unroll
        for (int cb = 0; cb < 4; ++cb) { const int cc = 64 * gw + 16 * cb + c; bfr[cb] = *(const LAS bf16x8*)(vT + cc * 256 + (((4 * t + gq) ^ (cc & 15)) << 4)); }
#pragma unroll
        for (int ib = 0; ib < 4; ++ib) {
            union { u32x4 u; bf16x8 v; } af;
            af.u.x = cvt_pk_bf16(wa[ib][0][0], wa[ib][0][1]); af.u.y = cvt_pk_bf16(wa[ib][0][2], wa[ib][0][3]); af.u.z = cvt_pk_bf16(wa[ib][1][0], wa[ib][1][1]); af.u.w = cvt_pk_bf16(wa[ib][1][2], wa[ib][1][3]);
#pragma unroll
            for (int cb = 0; cb < 4; ++cb) acc[ib][cb] = mfma16(af.v, bfr[cb], acc[ib][cb]);
        }
#pragma unroll
        for (int ib = 0; ib < 4; ++ib) { wa[ib][0] = wb[ib][0]; wa[ib][1] = wb[ib][1]; }
    }
    const float* bs = p.in(I_gmlp_bs) + ((size_t)l * 4 + gw) * 128 + ih * 64;
    bf16_t* S = (bf16_t*)(p.ws + OFF_S);
#pragma unroll
    for (int ib = 0; ib < 4; ++ib) {
        unsigned short uu[4][4]; float bsv[4];
#pragma unroll
        for (int r = 0; r < 4; ++r) { const int il = 16 * ib + 4 * gq + r; bsv[r] = bs[il];
#pragma unroll
            for (int cb = 0; cb < 4; ++cb) uu[r][cb] = PM[(size_t)(row0 + ih * 64 + il) * PMW + 1536 + 64 * gw + 16 * cb + c]; }
#pragma unroll
        for (int r = 0; r < 4; ++r) { const int i = ih * 64 + 16 * ib + 4 * gq + r;
#pragma unroll
            for (int cb = 0; cb < 4; ++cb) S[(size_t)(row0 + i) * D + 512 + 64 * gw + 16 * cb + c] = f2bf(geluf_(bf2f(uu[r][cb])) * (acc[ib][cb][r] + bsv[r])); }
    }
}

__device__ __forceinline__ void fnet_t_item(const KP& p, LAS unsigned char* lds, int item) {
    int tid = p.tid_; asm volatile("" : "+v"(tid));
    const bf16_t* PM = (const bf16_t*)(p.ws + OFF_BIG);
    LAS float* T = (LAS float*)lds;
    int seqrow0, L, s_local, cblk, kb; bf16_t* dstbase;
    if (item < GB * 4 * 16) { s_local = item >> 6; cblk = (item >> 4) & 3; kb = item & 15; L = SEQ; seqrow0 = s_local * SEQ; dstbase = (bf16_t*)(p.ws + OFF_PQT); }
    else { const int it2 = item - GB * 4 * 16; s_local = it2 >> 3; cblk = (it2 >> 1) & 3; kb = it2 & 1; L = CTXL; seqrow0 = R_LAT + s_local * CTXL; dstbase = (bf16_t*)(p.ws + OFF_PQTC); }
    __syncthreads();
    for (int idx = tid; idx < 4 * 64 * 8; idx += NTHREADS) { const int which = idx >> 9, r = (idx >> 3) & 63, cc = idx & 7, k = kb * 64 + r;
        const int tok = (which & 1) ? (L - k) : k; const int col = (which < 2 ? 2048 : 2304) + cblk * 64 + cc * 8; float f[8];
        if (tok < L) unpack8(*(const u32x4*)(PM + (size_t)(seqrow0 + tok) * PMW + col), f);
        else {
#pragma unroll
            for (int j = 0; j < 8; ++j) f[j] = 0.f; }
#pragma unroll
        for (int j = 0; j < 8; ++j) T[(which * 64 + r) * 65 + cc * 8 + j] = f[j]; }
    __syncthreads();
    const int c = tid >> 3, kq = tid & 7;
    float pe[8], qo[8];
#pragma unroll
    for (int e = 0; e < 8; ++e) { const int kl = kq * 8 + e; pe[e] = T[(0 * 64 + kl) * 65 + c] + T[(1 * 64 + kl) * 65 + c]; qo[e] = T[(2 * 64 + kl) * 65 + c] - T[(3 * 64 + kl) * 65 + c]; }
    if (kb == 0 && kq == 0) qo[0] = bf2f(PM[(size_t)(seqrow0 + L / 2) * PMW + 2048 + cblk * 64 + c]);
    bf16_t* dst = dstbase + (size_t)(s_local * 256 + cblk * 64 + c) * L;
    *(u32x4*)(dst + kb * 64 + kq * 8) = pack8(pe);
    *(u32x4*)(dst + L / 2 + kb * 64 + kq * 8) = pack8(qo);
}

__device__ __forceinline__ u32x4 ld8p(const bf16_t* p, bool ok) { return ok ? *(const u32x4*)p : (u32x4){0u, 0u, 0u, 0u}; }
__device__ __forceinline__ void fma8(float* y, const u32x4 a, const float* w) { float f[8]; unpack8(a, f);
#pragma unroll
    for (int j = 0; j < 8; ++j) y[j] += f[j] * w[j]; }
__device__ __forceinline__ void phase_ffn_conv(const KP& p, int g, int l, int parts, int b0, int nb, int halves) {
    int tid = p.tid_; asm volatile("" : "+v"(tid));
    if (parts & 1) { float* ssA = (float*)(p.ws + ssa_off(g)); for (int i = p.bx_ * NTHREADS + tid; i < R; i += NBLK * NTHREADS) ssA[i] = 0.f; }
    if (tid >= 352 || p.bx_ < b0 || p.bx_ >= b0 + nb) return;
    bf16_t* UP = (bf16_t*)(p.ws + OFF_BIG);
    const int c8 = tid * 8, G = nb, bx = p.bx_ - b0;
    const float* dw = p.in(I_ffn_dw) + (size_t)l * 9 * DFF + c8; const float* db = p.in(I_ffn_db) + (size_t)l * DFF + c8;
    float w[9][8], bias[8];
#pragma unroll
    for (int k = 0; k < 9; ++k) { const f32x4 w0 = *(const f32x4*)(dw + k * DFF), w1 = *(const f32x4*)(dw + k * DFF + 4);
#pragma unroll
        for (int j = 0; j < 4; ++j) { w[k][j] = w0[j]; w[k][4 + j] = w1[j]; } }
    { const f32x4 b0 = *(const f32x4*)db, b1 = *(const f32x4*)(db + 4);
#pragma unroll
      for (int j = 0; j < 4; ++j) { bias[j] = b0[j]; bias[4 + j] = b1[j]; } }
    if (parts & 2)
    for (int it0 = bx; it0 < GB * 32 * halves; it0 += G) {
        const int rid0 = it0 / halves, hf = it0 - rid0 * halves;
        const int rid = (G == 256 && halves == 1) ? ((rid0 & 7) * 32 + (rid0 >> 3)) : rid0;
        const int gb = rid >> 5, gr = rid & 31;
        const int c_lo = hf * (64 / halves), c_hi = c_lo + 64 / halves;
        const bool up = gr > 0, dn = gr < 31;
        const bf16_t* a1 = UP + (size_t)(gb * SEQ + gr * 64 + c_lo) * UPW + c8;
        const bf16_t* a0 = a1 - (size_t)64 * UPW; const bf16_t* a2 = a1 + (size_t)64 * UPW;
        const bool lf = c_lo > 0;
        u32x4 L0 = ld8p(a0 - UPW, up && lf), L1 = ld8p(a1 - UPW, lf), L2 = ld8p(a2 - UPW, dn && lf), M0 = ld8p(a0, up), M1 = ld8p(a1, true), M2 = ld8p(a2, dn);
        u32x4 R0 = ld8p(a0 + UPW, up), R1 = ld8p(a1 + UPW, true), R2 = ld8p(a2 + UPW, dn);
        bf16_t* hp = UP + (size_t)(gb * SEQ + gr * 64 + c_lo) * UPW + DFF + c8;
        u32x4 bq = *(const u32x4*)hp;
#pragma unroll 1
        for (int gc = c_lo; gc < c_hi; ++gc) {
            const bool nt2 = gc < 62; const size_t o = (size_t)(gc - c_lo + 2) * UPW;
            const u32x4 N0 = ld8p(a0 + o, up && nt2), N1 = ld8p(a1 + o, nt2), N2 = ld8p(a2 + o, dn && nt2);
            const u32x4 bn = ld8p(hp + UPW, gc < 63);
            float y[8];
#pragma unroll
            for (int j = 0; j < 8; ++j) y[j] = bias[j];
            fma8(y, L0, w[0]); fma8(y, M0, w[1]); fma8(y, R0, w[2]);
            fma8(y, L1, w[3]); fma8(y, M1, w[4]); fma8(y, R1, w[5]);
            fma8(y, L2, w[6]); fma8(y, M2, w[7]); fma8(y, R2, w[8]);
            float bv[8]; unpack8(bq, bv);
#pragma unroll
            for (int j = 0; j < 8; ++j) y[j] = siluf_(y[j]) * bv[j];
            *(u32x4*)hp = pack8(y);
            L0 = M0; L1 = M1; L2 = M2; M0 = R0; M1 = R1; M2 = R2; R0 = N0; R1 = N1; R2 = N2; bq = bn; hp += UPW;
        }
    }
    if (parts & 4) {
        for (int it = bx; it < R_CTX / 8; it += G) {
            const int s_ = it >> 5, t0 = (it & 31) * 8;
            const bf16_t* a = UP + (size_t)(R_LAT + s_ * CTXL + t0) * UPW + c8;
            u32x4 Lq = ld8p(a - UPW, t0 > 0), Mq = ld8p(a, true);
#pragma unroll 1
            for (int t = 0; t < 8; ++t) {
                const u32x4 Rq = ld8p(a + (size_t)(t + 1) * UPW, t0 + t + 1 < CTXL);
                bf16_t* hp = UP + (size_t)(R_LAT + s_ * CTXL + t0 + t) * UPW + DFF + c8;
                const u32x4 bq = *(const u32x4*)hp;
                float y[8];
#pragma unroll
                for (int j = 0; j < 8; ++j) y[j] = bias[j];
                fma8(y, Lq, w[3]); fma8(y, Mq, w[4]); fma8(y, Rq, w[5]);
                float bv[8]; unpack8(bq, bv);
#pragma unroll
                for (int j = 0; j < 8; ++j) y[j] = siluf_(y[j]) * bv[j];
                *(u32x4*)hp = pack8(y);
                Lq = Mq; Mq = Rq;
            }
        }
    }
}

#ifndef DUP_LP
#define DUP_LP 0
#endif

__device__ __forceinline__ unsigned wl_off(int l) { return (unsigned)OFF_W + (unsigned)l * (unsigned)W_LAYER; }
__device__ __forceinline__ unsigned mod_off(int l) { return (unsigned)OFF_MOD + (unsigned)l * (unsigned)(17 * 6144 * 4); }

__device__ __forceinline__ void ph_l1(const KP& p, LAS unsigned char* lds, int g, int l) {
    unsigned char* ws = p.ws; const bool ctx_full = (g == 0 && l == 0);
    pg8::TileSched S{}; S.G = NBLK; S.c = p.bx_; S.nseg = 1;
    S.n1M = NLT; S.n1N = NCOLS / 256; S.n2M = g == 0 ? NCT : 0; S.n2N = ctx_full ? NCOLS / 256 : 2; S.pn2_0 = ctx_full ? 0 : 1;
    S.A = ap_off(g); S.B = (unsigned)(wl_off(l) + (unsigned)W_IN); S.a_tstep = (unsigned)256 * D * 2; S.b_tstep = (unsigned)256 * D * 2;
    EpiWin E{(const float*)(ws + ssa_off(g)), (const float*)(ws + (unsigned)OFF_SHW1 + (unsigned)l * (unsigned)(17 * NCOLS * 4)), p.in(I_b_gate) + (size_t)l * GTW, (bf16_t*)(ws + OFF_BIG), (bf16_t*)(ws + OFF_GT), g};
    pg8::gemm_phase(lds, p.ws, p.tid_, D, D, D, true, S, E);
}
__device__ __forceinline__ void ph_l2(const KP& p, LAS unsigned char* lds, int g, int l) {
    const bool ctx_full = (g == 0 && l == 0); const int G = NBLK;
    const int n_kv = g == 0 ? N_KV : N_KV_LAT, n_conf = (ctx_full ? R : R_LAT) / 32, n_gm = (ctx_full ? R : R_LAT) / 128, n_fn = GB * 4 * 16 + (ctx_full ? NB * 4 * 2 : 0);
    const int total = n_kv + n_conf + n_gm + n_fn;
    { float* ssB = (float*)(p.ws + ssb_off(g)); for (int i = p.bx_ * NTHREADS + p.tid_; i < R; i += G * NTHREADS) ssB[i] = 0.f; }
    const int bx = p.bx_, n_small = total - n_gm, nb2 = G - n_gm, head = (nb2 > 0 && 7 * nb2 < n_small) ? 7 * nb2 : 0;
#define L2_SMALL(t_) do { int t = (t_); if (t < n_kv) ret_kv_item(p, lds, l, t); else if ((t -= n_kv) < n_fn) fnet_t_item(p, lds, t); else conf_item(p, lds, l, t - n_fn); } while (0)
    if (bx < n_gm) gmlp_item(p, lds, l, bx);
    else if (head) { for (int r7 = 0; r7 < 7; ++r7) L2_SMALL(r7 * nb2 + (bx - n_gm)); }
    for (int t2 = head + bx; t2 < n_small; t2 += G) L2_SMALL(t2);
#undef L2_SMALL
    __syncthreads();
}
__device__ __forceinline__ void ph_l3(const KP& p, LAS unsigned char* lds, int g, int l) {
    unsigned char* ws = p.ws; const bool ctx_full = (g == 0 && l == 0); const int G = NBLK, bx = p.bx_;
    const int nd = 64 + (ctx_full ? NB : 0);
    if (bx < nd) {
        const bool isc = bx >= 64;
        const int Kd = isc ? CTXL : SEQ;
        pg8::TileSched S{}; S.G = G; S.nseg = 1;
        S.n1M = isc ? 1 : 8; S.n1N = isc ? NB : GB; S.c = isc ? bx - 64 : bx;
        S.A = (unsigned)((isc ? OFF_DC : OFF_DM)); S.B = (unsigned)((isc ? OFF_PQTC : OFF_PQT)); S.a_tstep = (unsigned)256 * Kd * 2; S.b_tstep = (unsigned)256 * Kd * 2;
        EpiDft E{(bf16_t*)(ws + OFF_S), isc ? R_LAT : 0, Kd, isc ? 0.0625f : 0.02209708691207961f};
        pg8::gemm_phase(lds, p.ws, p.tid_, Kd, Kd, Kd, true, S, E);
    } else {
        const int n = ctx_full ? N_KV : N_KV_LAT;
        for (int it = bx - nd; it < n; it += G - nd) ret_out_item(p, lds, g, l, it);
        __syncthreads();
    }
}
__device__ __forceinline__ void ph_l5(const KP& p, LAS unsigned char* lds, int g, int l) {
    unsigned char* ws = p.ws; const bool ctx_full = (g == 0 && l == 0);
    pg8::TileSched S{}; S.G = NBLK; S.c = p.bx_; S.nseg = 4;
    S.n1M = NLT; S.n1N = 4; S.n2M = ctx_full ? NCT : 0; S.n2N = 4;
    S.A = (unsigned)(OFF_S); S.B = (unsigned)(wl_off(l) + (unsigned)W_O); S.a_tstep = (unsigned)256 * D * 2; S.b_tstep = (unsigned)256 * 256 * 2; S.a_segstep = (unsigned)256 * 2; S.b_segstep = (unsigned)1024 * 256 * 2;
    EpiMerge E{(const unsigned char*)(ws + OFF_GT), (bf16_t*)(ws + OFF_BIG)};
    pg8::gemm_phase(lds, p.ws, p.tid_, 256, D, 256, true, S, E);
}
__device__ __forceinline__ void ph_l6(const KP& p, LAS unsigned char* lds, int g, int l) {
    unsigned char* ws = p.ws; const bool ctx_full = (g == 0 && l == 0);
    pg8::TileSched S{}; S.G = NBLK; S.c = p.bx_; S.nseg = 1;
    S.n1M = NLT; S.n1N = 4; S.n2M = ctx_full ? NCT : 0; S.n2N = 4;
    S.A = (unsigned)(OFF_BIG); S.B = (unsigned)(wl_off(l) + (unsigned)W_OUT); S.a_tstep = (unsigned)256 * D * 2; S.b_tstep = (unsigned)256 * D * 2;
    EpiResid E{l == 0 ? p.in(I_x) : (const float*)p.out, l == 0 ? p.in(I_ctx) : (const float*)(ws + OFF_XC), p.out, (float*)(ws + OFF_XC),
               (const float*)(ws + mod_off(l) + 2 * 4096), (const float*)(ws + mod_off(l) + 4 * 4096), (bf16_t*)(ws + ap_off(g)), (float*)(ws + ssb_off(g)), g};
    pg8::gemm_phase(lds, p.ws, p.tid_, D, D, D, false, S, E);
}
__device__ __forceinline__ void ph_l7(const KP& p, LAS unsigned char* lds, int g, int l) {
    unsigned char* ws = p.ws; const bool ctx_full = (g == 0 && l == 0);
    pg8::TileSched S{}; S.G = NBLK; S.c = p.bx_; S.nseg = 1;
    S.n1M = NLT; S.n1N = UPW / 256; S.n2M = ctx_full ? NCT : 0; S.n2N = UPW / 256;
    S.A = ap_off(g); S.B = (unsigned)(wl_off(l) + (unsigned)W_UP); S.a_tstep = (unsigned)256 * D * 2; S.b_tstep = (unsigned)256 * D * 2;
    EpiUp E{(const float*)(ws + ssb_off(g)), (const float*)(ws + (unsigned)OFF_SHW2 + (unsigned)l * (unsigned)(17 * UPW * 4)), (bf16_t*)(ws + OFF_BIG), g};
    pg8::gemm_phase(lds, p.ws, p.tid_, D, D, D, true, S, E);
}
__device__ __forceinline__ void ph_l9(const KP& p, LAS unsigned char* lds, int g, int l, int which = 0) {
    unsigned char* ws = p.ws; const bool ctx_full = (g == 0 && l == 0);
    pg8::TileSched S{}; S.G = NBLK; S.c = p.bx_; S.nseg = 1;
    S.n1M = which == 2 ? 0 : NLT; S.n1N = 4; S.n2M = (ctx_full && which != 1) ? NCT : 0; S.n2N = 4;
    if (which == 2) S.pm2_x = NLT;
    S.A = (unsigned)OFF_BIG + (unsigned)DFF * 2u; S.B = (unsigned)(wl_off(l) + (unsigned)W_DN); S.a_tstep = (unsigned)256 * UPW * 2; S.b_tstep = (unsigned)256 * DFF * 2;
    EpiResid E{p.out, (const float*)(ws + OFF_XC), p.out, (float*)(ws + OFF_XC), (const float*)(ws + mod_off(l) + 5 * 4096),
               l == 0 ? (const float*)(ws + mod_off(1) + 4096) : nullptr, (bf16_t*)(ws + ap_off(g)), (float*)(ws + ssa_off(g)), g};
    pg8::gemm_phase(lds, p.ws, p.tid_, DFF, UPW, DFF, false, S, E);
}

__global__ void __launch_bounds__(NTHREADS) mega(KArgs a) {
    extern __shared__ __attribute__((aligned(16))) unsigned char lds_raw[];
    LAS unsigned char* lds = (LAS unsigned char*)lds_raw;
    volatile LAS unsigned* misc = (volatile LAS unsigned*)(lds + MISC_OFF);
    if (threadIdx.x < 64) misc[threadIdx.x] = 0u;
    if (threadIdx.x < 30) { const unsigned long long v = (unsigned long long)a.in[threadIdx.x]; LAS unsigned* t = (LAS unsigned*)(lds + PTAB_OFF) + 2 * threadIdx.x; t[0] = (unsigned)v; t[1] = (unsigned)(v >> 32); }
    __syncthreads();
    const int wid_s = __builtin_amdgcn_readfirstlane((int)(threadIdx.x >> 6));
    cg::grid_group grid = cg::this_grid();
    XcdBarrier xb = xcd_barrier_post((unsigned*)(a.ws + OFF_BAR), misc + 8);
    grid.sync();
#define MK_Q() KP q; { int w_ = wid_s, b_ = blockIdx.x; unsigned z_ = 0u; asm volatile("" : "+s"(w_), "+s"(b_), "+s"(z_)); int t_ = (w_ << 6) | (int)__builtin_amdgcn_mbcnt_hi(~0u, __builtin_amdgcn_mbcnt_lo(~0u, z_)); asm volatile("" : "+v"(t_)); q.tid_ = t_; q.bx_ = b_; q.ws = a.ws + z_; q.out = a.out + z_; q.ldsb = lds; q.ptab = lds + PTAB_OFF + z_; }
#define PHASE(call) do { MK_Q(); call; xcd_barrier(xb); } while (0)
    PHASE(phase_prep_a(q, lds));
    PHASE(phase_prep_b(q));
    PHASE(phase_prep_c(q, lds, 0, 1, 0, NBLK); phase_g0(q, 0, 0, NBLK));
    for (int g = 0; g < NG; ++g) {
        for (int l = 0; l < 2; ++l) {
            { MK_Q(); ph_l1(q, lds, g, l); }
            PHASE(if (g == 0 && l == 0) weight_prep(q, lds, 1, 2, 32, NBLK - 32);
                  if (g == 1 && l == 0) phase_final(q, 0, 128, NBLK - 128));
            if (DUP_LP == 1) PHASE(ph_l1(q, lds, g, l));
            PHASE(ph_l2(q, lds, g, l));
            if (DUP_LP == 2) PHASE(ph_l2(q, lds, g, l));
            PHASE(ph_l3(q, lds, g, l));
            if (DUP_LP == 3) PHASE(ph_l3(q, lds, g, l));
            PHASE(ph_l5(q, lds, g, l); if (g == 0 && l == 0) phase_prep_c(q, lds, 1, 2, 64, NBLK - 64));
            if (DUP_LP == 5) PHASE(ph_l5(q, lds, g, l));
            PHASE(ph_l6(q, lds, g, l); if (g == 0 && l == 0) phase_g0(q, 1, 64, NBLK - 64));
            PHASE(ph_l7(q, lds, g, l));
            if (DUP_LP == 7) PHASE(ph_l7(q, lds, g, l));
            if (g == 0 && l == 0) {
                PHASE(phase_ffn_conv(q, g, l, 1 | 4, 0, NBLK, 1));
                PHASE(ph_l9(q, lds, g, l, 2); phase_ffn_conv(q, g, l, 2, 64, NBLK - 64, 4));
                PHASE(ph_l9(q, lds, g, l, 1));
            } else {
                PHASE(phase_ffn_conv(q, g, l, 1 | 2, 0, NBLK, 1));
                PHASE(ph_l9(q, lds, g, l));
            }
        }
        if (g == NG - 1) { MK_Q(); phase_final(q, g, 0, NBLK); }
    }
#undef PHASE
#undef MK_Q
}

extern "C" void kernel_launch(void* const* d_in, const int* in_sizes, int n_in, void* d_out, int out_size, void* d_ws, size_t ws_size, hipStream_t stream) {
    static int grid = 0;
    if (grid == 0) {
        int dev = 0, cus = 0, per_cu = 0;
        (void)hipGetDevice(&dev);
        (void)hipDeviceGetAttribute(&cus, hipDeviceAttributeMultiprocessorCount, dev);
        (void)hipFuncSetAttribute((const void*)mega, hipFuncAttributeMaxDynamicSharedMemorySize, LDS_BYTES);
        (void)hipOccupancyMaxActiveBlocksPerMultiprocessor(&per_cu, (const void*)mega, NTHREADS, LDS_BYTES);
        grid = NBLK;
        if (n_in != 30 || ws_size < WS_END || per_cu < 1 || cus * per_cu < NBLK) { fprintf(stderr, "kernel_launch: unexpected n_in %d / ws %zu (need %zu) / per_cu %d\n", n_in, ws_size, (size_t)WS_END, per_cu); }
    }
    (void)hipMemsetAsync(d_ws, 0, 16384, stream);
    KArgs a{};
    for (int i = 0; i < 30; ++i) a.in[i] = (const float*)d_in[i];
    a.out = (float*)d_out; a.ws = (unsigned char*)d_ws;
    void* args[] = {&a};
    hipError_t e = hipLaunchCooperativeKernel((const void*)mega, dim3(grid), dim3(NTHREADS), args, LDS_BYTES, stream);
    if (e != hipSuccess) fprintf(stderr, "cooperative launch failed: %s (grid %d)\n", hipGetErrorString(e), grid);
}
```

```cpp
#include <hip/hip_runtime.h>
#include <hip/hip_cooperative_groups.h>
#include <cstdio>
#include <cstdint>
namespace cg = cooperative_groups;

#define LAS __attribute__((address_space(3)))
typedef unsigned short bf16_t;
typedef short bf16x8 __attribute__((ext_vector_type(8)));
typedef float f32x4 __attribute__((ext_vector_type(4)));
typedef float f32x2 __attribute__((ext_vector_type(2)));
typedef unsigned u32x4 __attribute__((ext_vector_type(4)));
typedef unsigned u32x2 __attribute__((ext_vector_type(2)));

#ifndef ONE_LAUNCH
#define ONE_LAUNCH 1
#endif

constexpr int NTHREADS = 512, NWAVES = 8;
constexpr int NBLK = 256;
constexpr int D = 1024, NB = 16, SEQ = 2048, CTXL = 256, DFF = 2816;
constexpr int NCOLS = 6656;
constexpr int PMW = 2560, GTW = 4096, UPW = 5632;
constexpr int IN_COLS = 6400;
constexpr float EPS = 1e-6f;
constexpr int NG = 2, GB = 8;
constexpr int R_LAT = GB * SEQ, R_CTX = NB * CTXL, R = R_LAT + R_CTX;
constexpr int NLT = R_LAT / 256, NCT = R_CTX / 256;
constexpr int N_KV_LAT = GB * 4 * 16, N_KV_CTX = NB * 4 * 2, N_KV = N_KV_LAT + N_KV_CTX;

constexpr size_t al256(size_t x) { return (x + 255) & ~(size_t)255; }
constexpr size_t OFF_BAR = 0;
constexpr size_t OFF_ADAP = 65536;
constexpr size_t OFF_MOD = OFF_ADAP + al256((size_t)8 * 2 * 17 * 6144 * 4);
constexpr size_t OFF_SHW1 = OFF_MOD + al256((size_t)2 * 17 * 6144 * 4);
constexpr size_t OFF_SHW2 = OFF_SHW1 + al256((size_t)2 * 17 * NCOLS * 4);
constexpr size_t OFF_ROPE = OFF_SHW2 + al256((size_t)2 * 17 * UPW * 4);
constexpr size_t OFF_LOGG = OFF_ROPE + al256((size_t)2 * 2304 * 32 * 4);
constexpr size_t OFF_DM = OFF_LOGG + 256;
constexpr size_t OFF_DC = OFF_DM + (size_t)2048 * 2048 * 2;
constexpr size_t OFF_W = OFF_DC + (size_t)256 * 256 * 2;
constexpr size_t W_IN = 0, W_O = W_IN + (size_t)NCOLS * 1024 * 2, W_OUT = W_O + (size_t)4 * 1024 * 256 * 2, W_UP = W_OUT + (size_t)1024 * 1024 * 2,
                 W_DN = W_UP + (size_t)UPW * 1024 * 2, W_LAYER = W_DN + (size_t)1024 * DFF * 2;
constexpr size_t OFF_XC = OFF_W + 2 * W_LAYER;
constexpr size_t OFF_AP = OFF_XC + (size_t)NB * CTXL * D * 4;
constexpr size_t OFF_AP1 = OFF_AP + (size_t)R * D * 2;
constexpr size_t OFF_SS = OFF_AP1 + (size_t)R_LAT * D * 2;
constexpr size_t OFF_S = OFF_SS + (size_t)R * 16 * 4;
constexpr size_t OFF_KV = OFF_S + (size_t)R * D * 2;
constexpr size_t OFF_KVC = OFF_KV + (size_t)N_KV_LAT * 2 * 4096 * 4;
constexpr size_t OFF_PQT = OFF_KVC + (size_t)2 * N_KV_CTX * 2 * 4096 * 4;
constexpr size_t OFF_PQTC = OFF_PQT + (size_t)GB * 256 * 2048 * 2;
constexpr size_t OFF_BIG = OFF_PQTC + (size_t)NB * 256 * 256 * 2;
constexpr size_t OFF_GT = OFF_BIG + (size_t)R * PMW * 2;
constexpr size_t WS_END = OFF_BIG + ((size_t)R * PMW * 2 + (size_t)R * GTW > (size_t)R * UPW * 2 ? (size_t)R * PMW * 2 + (size_t)R * GTW : (size_t)R * UPW * 2);
static_assert(WS_END <= (size_t)512 * 1024 * 1024, "workspace map exceeds 512 MiB");
static_assert((size_t)R * UPW * 2 <= WS_END - OFF_BIG, "UP overlay");

constexpr int SCR_BYTES = 139264;
constexpr int MISC_OFF = SCR_BYTES;
constexpr int LDS_BYTES = 161792;

__device__ __forceinline__ float bf2f(unsigned v) { return __uint_as_float(v << 16); }
__device__ __forceinline__ unsigned cvt_pk_bf16(float lo, float hi) { unsigned r; asm volatile("v_cvt_pk_bf16_f32 %0, %1, %2" : "=v"(r) : "v"(lo), "v"(hi)); return r; }
__device__ __forceinline__ bf16_t f2bf(float f) { return (bf16_t)(cvt_pk_bf16(f, 0.f) & 0xffffu); }
__device__ __forceinline__ void unpack8(const u32x4 w, float* f) {
    f[0] = bf2f(w.x & 0xffffu); f[1] = __uint_as_float(w.x & 0xffff0000u); f[2] = bf2f(w.y & 0xffffu); f[3] = __uint_as_float(w.y & 0xffff0000u);
    f[4] = bf2f(w.z & 0xffffu); f[5] = __uint_as_float(w.z & 0xffff0000u); f[6] = bf2f(w.w & 0xffffu); f[7] = __uint_as_float(w.w & 0xffff0000u);
}
__device__ __forceinline__ u32x4 pack8(const float* f) { u32x4 w; w.x = cvt_pk_bf16(f[0], f[1]); w.y = cvt_pk_bf16(f[2], f[3]); w.z = cvt_pk_bf16(f[4], f[5]); w.w = cvt_pk_bf16(f[6], f[7]); return w; }
__device__ __forceinline__ float shx(float v, int m, int lane) { return __int_as_float(__builtin_amdgcn_ds_bpermute((lane ^ m) << 2, __float_as_int(v))); }
template <int CTRL> __device__ __forceinline__ float dpp_mov(float v) { return __int_as_float(__builtin_amdgcn_update_dpp(0, __float_as_int(v), CTRL, 0xF, 0xF, false)); }
__device__ __forceinline__ float wave_sum(float v, int  ) {
    v += dpp_mov<0xB1>(v); v += dpp_mov<0x4E>(v); v += dpp_mov<0x141>(v); v += dpp_mov<0x140>(v);
    const int vi = __float_as_int(v);
    const float s0 = __int_as_float(__builtin_amdgcn_readlane(vi, 0)), s1 = __int_as_float(__builtin_amdgcn_readlane(vi, 16)), s2 = __int_as_float(__builtin_amdgcn_readlane(vi, 32)), s3 = __int_as_float(__builtin_amdgcn_readlane(vi, 48));
    return (s0 + s1) + (s2 + s3);
}
__device__ __forceinline__ float fast_rcp(float x) { return __builtin_amdgcn_rcpf(x); }
__device__ __forceinline__ float sigmoidf_(float x) { return fast_rcp(1.f + __expf(-x)); }
__device__ __forceinline__ float siluf_(float x) { return x * sigmoidf_(x); }
__device__ __forceinline__ float geluf_(float v) {
    const float av = fabsf(v), d = av * 0.2316418882f + 1.0f;
    const float t = fast_rcp(d);
    float q = t * 0.5307027145f + (-0.7265760135f); q = q * t + 0.7107068705f; q = q * t + (-0.142248368f); q = q * t + 0.127414796f; q = q * t;
    const float e = __builtin_amdgcn_exp2f((v * v) * (-0.72134752044f));
    const float m = v * (q * e);
    return v < 0.f ? m : v - m;
}
__device__ __forceinline__ f32x4 mfma16(bf16x8 a, bf16x8 b, f32x4 c) { return __builtin_amdgcn_mfma_f32_16x16x32_bf16(a, b, c, 0, 0, 0); }
__device__ __forceinline__ float sin_rev(float r) { return __builtin_amdgcn_sinf(r); }
__device__ __forceinline__ float cos_rev(float r) { return __builtin_amdgcn_cosf(r); }

#define XB_TMO      128
#define XB_XCNT(j)  (256  + 64 * (j))
#define XB_XSUB(j)  (1280 + 64 * (j))
#define XB_XGEN(j)  (2304 + 64 * (j))
#define XB_TOP      3328
#define XB_TOPGEN   3392
#define XCD_BAR_WORDS 3456
#define XB_SPIN_CAP (1u << 20)
__device__ __forceinline__ unsigned xb_ld(unsigned* p)              { return __hip_atomic_load(p, __ATOMIC_RELAXED, __HIP_MEMORY_SCOPE_AGENT); }
__device__ __forceinline__ unsigned xb_add(unsigned* p, unsigned v) { return __hip_atomic_fetch_add(p, v, __ATOMIC_RELAXED, __HIP_MEMORY_SCOPE_AGENT); }
__device__ __forceinline__ unsigned xb_xcc_id() { return (unsigned)__builtin_amdgcn_s_getreg((3 << 11) | 20) & 0xFu; }
#define XB_SPIN(cond, bar) do { unsigned _sp = 0; while (cond) { __builtin_amdgcn_s_sleep(1); \
    if ((++_sp & 255u) == 0u) { if (xb_ld(&(bar)[XB_TMO])) break; if (_sp > XB_SPIN_CAP) { atomicAdd(&(bar)[XB_TMO], 1u); break; } } } } while (0)
struct XcdBarrier { unsigned* bar; unsigned x; volatile LAS unsigned* st; };
__device__ __forceinline__ XcdBarrier xcd_barrier_post(unsigned* bar, volatile LAS unsigned* st) {
    XcdBarrier b; b.bar = bar; b.x = xb_xcc_id(); b.st = st;
    if (threadIdx.x == 0) (void)xb_add(&bar[XB_XCNT(b.x)], 1u);
    return b;
}
__device__ __forceinline__ void xcd_barrier_complete(unsigned* bar, unsigned x, unsigned& nloc, unsigned& nx) {
    const unsigned G = NBLK;
    unsigned sum, cnt, mine, sp = 0u;
    for (;;) {
        sum = 0u; cnt = 0u; mine = 0u;
#pragma unroll
        for (unsigned j = 0; j < 16; ++j) { const unsigned c = xb_ld(&bar[XB_XCNT(j)]); sum += c; cnt += (c > 0u) ? 1u : 0u; mine = (j == x) ? c : mine; }
        if (sum == G) break;
        __builtin_amdgcn_s_sleep(1);
        if ((++sp & 255u) == 0u) { if (xb_ld(&bar[XB_TMO])) break; if (sp > XB_SPIN_CAP) { atomicAdd(&bar[XB_TMO], 1u); break; } }
    }
    nloc = mine > 0u ? mine : 1u; nx = cnt > 0u ? cnt : 1u;
}
__device__ __forceinline__ void xcd_barrier(const XcdBarrier& b) {
    asm volatile("s_waitcnt vmcnt(0)" ::: "memory");
    __syncthreads();
    if (threadIdx.x == 0) {
        unsigned* bar = b.bar; unsigned bx_ = b.x; asm volatile("" : "+s"(bx_));
        __builtin_amdgcn_s_waitcnt(0);
        unsigned nloc = b.st[0], nx = b.st[1];
        if (nloc == 0u) { xcd_barrier_complete(bar, bx_, nloc, nx); b.st[0] = nloc; b.st[1] = nx; }
        const unsigned old = xb_add(&bar[XB_XSUB(bx_)], 1u);
        const unsigned gen = old / nloc;
        if (old + 1u == (gen + 1u) * nloc) {
            __builtin_amdgcn_fence(__ATOMIC_RELEASE, "agent");
            asm volatile("s_waitcnt vmcnt(0)" ::: "memory");
            const unsigned og = xb_add(&bar[XB_TOP], 1u);
            const unsigned tg = og / nx;
            if (og + 1u == (tg + 1u) * nx) xb_add(&bar[XB_TOPGEN], 1u);
            else XB_SPIN(xb_ld(&bar[XB_TOPGEN]) == tg, bar);
            __builtin_amdgcn_fence(__ATOMIC_ACQUIRE, "agent");
            xb_add(&bar[XB_XGEN(bx_)], 1u);
            asm volatile("s_waitcnt vmcnt(0)" ::: "memory");
        } else {
            XB_SPIN(xb_ld(&bar[XB_XGEN(bx_)]) == gen, bar);
            __builtin_amdgcn_fence(__ATOMIC_ACQUIRE, "agent");
            asm volatile("s_waitcnt vmcnt(0)" ::: "memory");
        }
    }
    __syncthreads();
}

namespace pg8 {
constexpr int BM = 256, BK = 64, HALF = 128, HTB = HALF * BK * 2, NXCD = 8, WGM = 8;
__host__ __device__ __forceinline__ int lds_byte(int r, int c) { const int st = (r >> 4) * 2 + (c >> 5), rr = r & 15, cc = c & 31, ob = rr * 64 + cc * 2; return st * 1024 + (ob ^ (((ob >> 9) & 1) << 5)); }
__host__ __device__ __forceinline__ void stage_rc(int b, int& R_, int& C_) { const int st = b / 1024, sb = b % 1024, swz = sb ^ (((sb >> 9) & 1) << 5); R_ = (st >> 1) * 16 + swz / 64; C_ = (st & 1) * 32 + (swz % 64) / 2; }
__host__ __device__ __forceinline__ int perm32(int rho) { const int n = rho >> 4, i = rho & 15; return 8 * (i >> 2) + 4 * n + (i & 3); }

struct Unit { int pm, pn, seg; unsigned A, B; };
__device__ __forceinline__ const char* sgpr_ptr(const char* p) {
    const unsigned long long v = (unsigned long long)p;
    const unsigned lo = (unsigned)__builtin_amdgcn_readfirstlane((int)(unsigned)v), hi = (unsigned)__builtin_amdgcn_readfirstlane((int)(unsigned)(v >> 32));
    typedef const char __attribute__((address_space(1)))* gp_t;
    return (const char*)(gp_t)(((unsigned long long)hi << 32) | (unsigned long long)lo);
}

__device__ __forceinline__ void tile_order(int L, int nM, int nN, int& pm, int& pn) {
    const int nwg = nM * nN; int wgid = L;
    { const int q = nwg / NXCD, r = nwg % NXCD, xcd = wgid % NXCD, off = wgid / NXCD; wgid = (xcd < r ? xcd * (q + 1) : r * (q + 1) + (xcd - r) * q) + off; }
    const int nig = WGM * nN, gid = wgid / nig, fm = gid * WGM, gsz = (nM - fm) < WGM ? (nM - fm) : WGM;
    pm = fm + ((wgid % nig) % gsz); pn = (wgid % nig) / gsz;
}
struct TileSched {
    int n1M, n1N, n2M, n2N, pn2_0, pm2_x, G, c, nseg;
    unsigned A, B, a_tstep, b_tstep, a_segstep, b_segstep;
    __device__ __forceinline__ bool next(int i, Unit& u) const {
        const int ti = i / nseg, seg = i - ti * nseg;
        const int L = ti * G + c, n1 = n1M * n1N, n2 = n2M * n2N;
        int pm, pn;
        if (L < n1) tile_order(L, n1M, n1N, pm, pn);
        else if (L < n1 + n2) { tile_order(L - n1, n2M, n2N, pm, pn); pm += n1M + pm2_x; pn += pn2_0; }
        else return false;
        pm = __builtin_amdgcn_readfirstlane(pm); pn = __builtin_amdgcn_readfirstlane(pn);
        u.pm = pm; u.pn = pn; u.seg = seg;
        u.A = A + (unsigned)pm * a_tstep + (unsigned)seg * a_segstep; u.B = B + (unsigned)pn * b_tstep + (unsigned)seg * b_segstep;
        return true;
    }
};

constexpr int TB_OFF = 131072;
constexpr int SHB_OFF = 147456;
template <class Epi, class Sched>
__device__ __forceinline__ void gemm_phase(LAS unsigned char* lds, const unsigned char* wsb, const int tid_in, const int K, const int lda, const int ldb, const bool perm, const Sched& S, const Epi& E) {
    __builtin_amdgcn_s_waitcnt(0x0F70);
    int tid = tid_in; asm volatile("" : "+v"(tid));
    const int wid = __builtin_amdgcn_readfirstlane(tid >> 6), lane = tid & 63, wr = wid >> 2, wc = wid & 3, fr = lane & 15, fq = lane >> 4;
    const int nt = K / BK;
    unsigned voffA[2], voffB[2];
#pragma unroll
    for (int i = 0; i < 2; ++i) { int R_, C_; stage_rc(tid * 16 + i * 8192, R_, C_); const int Rb = perm ? ((R_ & ~31) + perm32(R_ & 31)) : R_;
        voffA[i] = (unsigned)(R_ * lda + C_) * 2u; voffB[i] = (unsigned)(Rb * ldb + C_) * 2u; }
    const unsigned kstep = (unsigned)(BK * 2);
    const unsigned hA = (unsigned)HALF * lda * 2, hB = (unsigned)HALF * ldb * 2;
    const unsigned ldsw = (unsigned)wid * 1024u;
    const int aoff = lds_byte(wr * 64 + fr, fq * 8), boff = lds_byte(wc * 32 + fr, fq * 8);
#define PG8_SA(b, h) (((b) * 2 + (h)) * HTB)
#define PG8_SB(b, h) ((4 + (b) * 2 + (h)) * HTB)
#define PG8_STAGE(bufoff, goff, voff) do { _Pragma("unroll") for (int _i = 0; _i < 2; ++_i) \
        __builtin_amdgcn_global_load_lds((const unsigned*)(wsb + (unsigned)((goff) + (voff)[_i])), (LAS unsigned*)(lds + (bufoff) + ldsw + _i * 8192), 16, 0, 0); } while (0)
#define PG8_LDA(dst, b, h) do { _Pragma("unroll") for (int m = 0; m < 4; ++m) _Pragma("unroll") for (int k = 0; k < 2; ++k) dst[m][k] = *(const LAS bf16x8*)(lds + PG8_SA(b, h) + aoff + m * 2048 + k * 1024); } while (0)
#define PG8_LDB(dst, b, h) do { _Pragma("unroll") for (int n = 0; n < 2; ++n) _Pragma("unroll") for (int k = 0; k < 2; ++k) dst[n][k] = *(const LAS bf16x8*)(lds + PG8_SB(b, h) + boff + n * 2048 + k * 1024); } while (0)
#define PG8_MMA(ai, bj, At, Bt) do { __builtin_amdgcn_s_setprio(1); _Pragma("unroll") for (int m = 0; m < 4; ++m) _Pragma("unroll") for (int n = 0; n < 2; ++n) _Pragma("unroll") for (int k = 0; k < 2; ++k) \
        acc[ai][bj][m][n] = __builtin_amdgcn_mfma_f32_16x16x32_bf16(Bt[n][k], At[m][k], acc[ai][bj][m][n], 0, 0, 0); __builtin_amdgcn_s_setprio(0); } while (0)
#define PG8_WAIT_V(n) asm volatile("s_waitcnt vmcnt(" #n ")" ::: "memory")
#define PG8_WAIT_L(n) asm volatile("s_waitcnt lgkmcnt(" #n ")" ::: "memory")
#define PG8_BAR __builtin_amdgcn_s_barrier()
#define PG8_SCHED __builtin_amdgcn_sched_barrier(0)
#define PG8_ZERO() do { _Pragma("unroll") for (int a = 0; a < 2; ++a) _Pragma("unroll") for (int b = 0; b < 2; ++b) _Pragma("unroll") for (int m = 0; m < 4; ++m) _Pragma("unroll") for (int n = 0; n < 2; ++n) acc[a][b][m][n] = (f32x4){0.f, 0.f, 0.f, 0.f}; } while (0)
    Unit cur, nxt; int ui = 0;
    if (!S.next(0, cur)) return;
    f32x4 acc[2][2][4][2];
    PG8_ZERO();
    bf16x8 At[4][2], B0[2][2], B1[2][2];
    unsigned cA = cur.A, cB = cur.B;
    E.prefetch(cur, wid, lane, lds + SHB_OFF);
    PG8_STAGE(PG8_SB(0, 0), cB, voffB); PG8_STAGE(PG8_SB(0, 1), cB + hB, voffB); PG8_STAGE(PG8_SA(0, 0), cA, voffA); PG8_STAGE(PG8_SA(0, 1), cA + hA, voffA);
    if (wr == 1) PG8_BAR;
    PG8_WAIT_V(2); PG8_BAR;
    PG8_STAGE(PG8_SB(1, 0), cB + kstep, voffB); PG8_STAGE(PG8_SA(1, 0), cA + kstep, voffA); PG8_STAGE(PG8_SB(1, 1), cB + hB + kstep, voffB);
    PG8_WAIT_V(6); PG8_BAR;
    for (;;) {
        const bool has_next = S.next(ui + 1, nxt);
        const unsigned nA = has_next ? nxt.A : cA, nB = has_next ? nxt.B : cB;
#define PG8_PASS(WX) do { \
            const bool last = (t == nt - 2); \
            unsigned tk = (unsigned)t * (unsigned)kstep; asm volatile("" : "+s"(tk)); \
            const unsigned a1 = cA + tk + kstep; \
            const unsigned a2 = last ? nA : cA + tk + 2 * kstep, b2 = last ? nB : cB + tk + 2 * kstep; \
            const unsigned a3 = a2 + kstep, b3 = b2 + kstep; \
            PG8_LDB(B0, 0, 0); PG8_LDB(B1, 0, 1); PG8_SCHED; PG8_LDA(At, 0, 0); PG8_STAGE(PG8_SA(1, 1), a1 + hA, voffA); \
            WX; PG8_WAIT_L(0); PG8_BAR; PG8_MMA(0, 0, At, B0); PG8_MMA(0, 1, At, B1); PG8_BAR; PG8_SCHED; \
            PG8_LDA(At, 0, 1); PG8_STAGE(PG8_SB(0, 0), b2, voffB); PG8_STAGE(PG8_SB(0, 1), b2 + hB, voffB); PG8_STAGE(PG8_SA(0, 0), a2, voffA); \
            WX; PG8_WAIT_L(0); PG8_BAR; PG8_MMA(1, 0, At, B0); PG8_MMA(1, 1, At, B1); PG8_BAR; PG8_SCHED; \
            PG8_LDB(B0, 1, 0); PG8_LDB(B1, 1, 1); PG8_SCHED; PG8_LDA(At, 1, 0); PG8_STAGE(PG8_SA(0, 1), a2 + hA, voffA); \
            PG8_WAIT_V(8); PG8_WAIT_L(0); PG8_BAR; PG8_MMA(0, 0, At, B0); PG8_MMA(0, 1, At, B1); PG8_BAR; PG8_SCHED; \
            PG8_LDA(At, 1, 1); PG8_STAGE(PG8_SB(1, 0), b3, voffB); PG8_STAGE(PG8_SB(1, 1), b3 + hB, voffB); PG8_STAGE(PG8_SA(1, 0), a3, voffA); \
            PG8_WAIT_V(8); PG8_WAIT_L(0); PG8_BAR; PG8_MMA(1, 0, At, B0); PG8_MMA(1, 1, At, B1); PG8_BAR; PG8_SCHED; \
        } while (0)
        int t = 0;
        if (Epi::XST > 0 && ui > 0) { PG8_PASS(asm volatile("s_waitcnt vmcnt(%0)" :: "n"(8 + Epi::XST) : "memory")); t = 2; }
        for (; t < nt; t += 2) PG8_PASS(PG8_WAIT_V(8));
#undef PG8_PASS
        if (wr == 0) PG8_BAR;
        unsigned zz = 0u; asm volatile("" : "+s"(zz)); const int le = (int)__builtin_amdgcn_mbcnt_hi(~0u, __builtin_amdgcn_mbcnt_lo(~0u, zz));
        if (E(acc, cur, wr, wc, le & 15, le >> 4, lds + TB_OFF + ldsw, lds + SHB_OFF + (ui & 1) * 3072)) PG8_ZERO();
        if (!has_next) break;
        cur = nxt; cA = nA; cB = nB; ++ui;
        E.prefetch(cur, wid, le, lds + SHB_OFF + (ui & 1) * 3072);
        if (wr == 1) PG8_BAR;
    }
    PG8_WAIT_V(0);
    PG8_BAR;
#undef PG8_SA
#undef PG8_SB
#undef PG8_STAGE
#undef PG8_LDA
#undef PG8_LDB
#undef PG8_MMA
#undef PG8_WAIT_V
#undef PG8_WAIT_L
#undef PG8_BAR
#undef PG8_SCHED
#undef PG8_ZERO
}
}

enum { I_x = 0, I_c = 1, I_ctx = 2, I_c_ctx = 3, I_w_ada = 4, I_b_ada = 5, I_g_norm1 = 6, I_g_norm2 = 7, I_w_in = 8, I_b_gate = 9, I_ret_decay = 10, I_ret_gn = 11, I_w_ret_o = 12, I_conv_dw = 13, I_conv_db = 14, I_conv_ln_g = 15, I_conv_ln_b = 16, I_w_conv_o = 17, I_gmlp_ln_g = 18, I_gmlp_ln_b = 19, I_gmlp_ws = 20, I_gmlp_bs = 21, I_w_gmlp_o = 22, I_w_fnet_o = 23, I_w_out = 24, I_w_ffn_up = 25, I_ffn_dw = 26, I_ffn_db = 27, I_w_ffn_down = 28, I_g_final = 29 };
struct KArgs { const float* in[30]; float* out; unsigned char* ws; int ph_lo, ph_hi; };
constexpr int PTAB_OFF = MISC_OFF + 4096;
struct KP {
    float* out; unsigned char* ws; LAS unsigned char* ldsb; LAS unsigned char* ptab; int tid_, bx_;
    __device__ __forceinline__ const float* in(int k) const {
        const LAS unsigned* t = (const LAS unsigned*)ptab + 2 * k;
        const unsigned lo = (unsigned)__builtin_amdgcn_readfirstlane((int)t[0]), hi = (unsigned)__builtin_amdgcn_readfirstlane((int)t[1]);
        typedef const float __attribute__((address_space(1)))* gcfp_t;
        return (const float*)(gcfp_t)(((unsigned long long)hi << 32) | (unsigned long long)lo);
    }
};

struct RowInfo { int mi; size_t xrow0; bool is_ctx; };
__device__ __forceinline__ RowInfo row_info(int g, int pm) {
    RowInfo ri;
    if (pm < NLT) { const int b = g * GB + (pm >> 3); ri.mi = b; ri.xrow0 = (size_t)b * SEQ + (size_t)(pm & 7) * 256; ri.is_ctx = false; }
    else { const int b = pm - NLT; ri.mi = 16; ri.xrow0 = (size_t)b * CTXL; ri.is_ctx = true; }
    return ri;
}

__device__ __forceinline__ unsigned ap_off(int g) { return g == 0 ? (unsigned)OFF_AP : (unsigned)OFF_AP1; }
__device__ __forceinline__ unsigned ssa_off(int g) { return (unsigned)OFF_SS + (unsigned)(g * 2) * (unsigned)(R * 4); }
__device__ __forceinline__ unsigned ssb_off(int g) { return (unsigned)OFF_SS + (unsigned)(g * 2 + 1) * (unsigned)(R * 4); }

constexpr int TB2_DELTA = 153600 - 131072;
__device__ __forceinline__ void st_rows16x2(LAS unsigned char* tb, bf16_t* base, size_t ld, int fr, int fq, u32x4 w0, u32x4 w1) {
    const int wo = 64 * fr + 16 * (fq ^ ((fr >> 2) & 3));
    *(LAS u32x4*)(tb + wo) = w0; *(LAS u32x4*)(tb + TB2_DELTA + wo) = w1;
    const int l2 = fq * 16 + fr, r2 = l2 >> 2, q2 = l2 & 3, ro = 64 * r2 + 16 * (q2 ^ ((r2 >> 2) & 3));
    const u32x4 t0 = *(const LAS u32x4*)(tb + ro), t1 = *(const LAS u32x4*)(tb + TB2_DELTA + ro);
    bf16_t* d = base + (size_t)r2 * ld + 8 * q2;
    *(u32x4*)d = t0; *(u32x4*)(d + 128) = t1;
}
__device__ __forceinline__ void st_rows16(LAS unsigned char* tb, bf16_t* base, size_t ld, int fr, int fq, u32x4 w) {
    *(LAS u32x4*)(tb + 64 * fr + 16 * (fq ^ ((fr >> 2) & 3))) = w;
    const int l2 = fq * 16 + fr, r2 = l2 >> 2, q2 = l2 & 3;
    const u32x4 t = *(const LAS u32x4*)(tb + 64 * r2 + 16 * (q2 ^ ((r2 >> 2) & 3)));
    *(u32x4*)(base + (size_t)r2 * ld + 8 * q2) = t;
}
struct EpiWin {
    static constexpr bool PERM = true; static constexpr int XST = 16;
    const float* ss; const float* shw; const float* bgate; bf16_t* PM; bf16_t* GT; int g;
    __device__ __forceinline__ void prefetch(const pg8::Unit& u, int wid, int lane, LAS unsigned char* shb) const {
        const int ctile = u.pn * 256;
        if (wid == 0) { const RowInfo ri = row_info(g, u.pm); __builtin_amdgcn_global_load_lds((const unsigned*)(shw + (size_t)ri.mi * NCOLS + ctile + lane * 4), (LAS unsigned*)shb, 16, 0, 0); }
        else if (wid == 1) __builtin_amdgcn_global_load_lds((const unsigned*)(ss + u.pm * 256 + lane * 4), (LAS unsigned*)(shb + 1024), 16, 0, 0);
        else if (wid == 2 && ctile >= PMW) __builtin_amdgcn_global_load_lds((const unsigned*)(bgate + (ctile - PMW) + lane * 4), (LAS unsigned*)(shb + 2048), 16, 0, 0);
    }
    __device__ __forceinline__ bool operator()(f32x4 (&acc)[2][2][4][2], const pg8::Unit& u, int wr, int wc, int fr, int fq, LAS unsigned char* tb, const LAS unsigned char* shb) const {
        const int ctile = u.pn * 256, cb = wc * 32 + 8 * fq;
        const bool gate = ctile >= PMW;
        f32x4 sh[2][2];
#pragma unroll
        for (int bj = 0; bj < 2; ++bj)
#pragma unroll
            for (int n = 0; n < 2; ++n) { sh[bj][n] = *(const LAS f32x4*)(shb + (bj * 128 + cb + 4 * n) * 4);
                if (gate) sh[bj][n] = (sh[bj][n] + *(const LAS f32x4*)(shb + 2048 + (bj * 128 + cb + 4 * n) * 4)) * (-1.44269504089f) - 7.99435343686f; }
        float rsv[8];
#pragma unroll
        for (int q = 0; q < 8; ++q) rsv[q] = __builtin_amdgcn_rsqf(*(const LAS float*)(shb + 1024 + ((q >> 2) * 128 + wr * 64 + (q & 3) * 16 + fr) * 4) * (1.0f / 1024.0f) + EPS);
#pragma unroll
        for (int ai = 0; ai < 2; ++ai)
#pragma unroll
            for (int m = 0; m < 4; ++m) {
                const int r = u.pm * 256 + ai * 128 + wr * 64 + m * 16 + fr;
                const float rs = rsv[ai * 4 + m], rsg = rs * (-1.44269504089f);
                u32x4 wp[2];
#pragma unroll
                for (int bj = 0; bj < 2; ++bj) {
                    if (gate) {
                        const f32x4 e0 = acc[ai][bj][m][0] * rsg + sh[bj][0], e1 = acc[ai][bj][m][1] * rsg + sh[bj][1];
                        u32x2 wq = (u32x2){0u, 0u};
#pragma unroll
                        for (int j = 0; j < 4; ++j) {
                            const float y0 = fast_rcp(__builtin_amdgcn_fmed3f(__builtin_amdgcn_exp2f(e0[j]) + (1.0f / 255.0f), 0.f, 1.f)), y1 = fast_rcp(__builtin_amdgcn_fmed3f(__builtin_amdgcn_exp2f(e1[j]) + (1.0f / 255.0f), 0.f, 1.f));
                            wq.x = __builtin_amdgcn_cvt_pk_u8_f32(y0, j, wq.x); wq.y = __builtin_amdgcn_cvt_pk_u8_f32(y1, j, wq.y); }
                        *(u32x2*)((unsigned char*)GT + ((size_t)(u.pm * 16 + ((ctile - PMW) >> 8)) * 16 + (ai * 4 + m) * 2 + bj) * 4096 + ((wr * 4 + wc) * 64 + fq * 16 + fr) * 8) = wq;
                        continue;
                    }
                    const f32x4 v0 = acc[ai][bj][m][0] * rs + sh[bj][0], v1 = acc[ai][bj][m][1] * rs + sh[bj][1];
                    wp[bj].x = cvt_pk_bf16(v0[0], v0[1]); wp[bj].y = cvt_pk_bf16(v0[2], v0[3]); wp[bj].z = cvt_pk_bf16(v1[0], v1[1]); wp[bj].w = cvt_pk_bf16(v1[2], v1[3]);
                }
                if (!gate) st_rows16x2(tb, PM + (size_t)(r - fr) * PMW + ctile + wc * 32, PMW, fr, fq, wp[0], wp[1]);
            }
        return true;
    }
};
struct EpiUp {
    static constexpr bool PERM = true; static constexpr int XST = 16;
    const float* ss; const float* shw; bf16_t* UP; int g;
    __device__ __forceinline__ void prefetch(const pg8::Unit& u, int wid, int lane, LAS unsigned char* shb) const {
        if (wid == 0) { const RowInfo ri = row_info(g, u.pm); __builtin_amdgcn_global_load_lds((const unsigned*)(shw + (size_t)ri.mi * UPW + u.pn * 256 + lane * 4), (LAS unsigned*)shb, 16, 0, 0); }
        else if (wid == 1) __builtin_amdgcn_global_load_lds((const unsigned*)(ss + u.pm * 256 + lane * 4), (LAS unsigned*)(shb + 1024), 16, 0, 0);
    }
    __device__ __forceinline__ bool operator()(f32x4 (&acc)[2][2][4][2], const pg8::Unit& u, int wr, int wc, int fr, int fq, LAS unsigned char* tb, const LAS unsigned char* shb) const {
        const int ctile = u.pn * 256, cb = wc * 32 + 8 * fq;
        f32x4 sh[2][2];
#pragma unroll
        for (int bj = 0; bj < 2; ++bj)
#pragma unroll
            for (int n = 0; n < 2; ++n) sh[bj][n] = *(const LAS f32x4*)(shb + (bj * 128 + cb + 4 * n) * 4);
        float rsv[8];
#pragma unroll
        for (int q = 0; q < 8; ++q) rsv[q] = __builtin_amdgcn_rsqf(*(const LAS float*)(shb + 1024 + ((q >> 2) * 128 + wr * 64 + (q & 3) * 16 + fr) * 4) * (1.0f / 1024.0f) + EPS);
#pragma unroll
        for (int ai = 0; ai < 2; ++ai)
#pragma unroll
            for (int m = 0; m < 4; ++m) {
                const int r = u.pm * 256 + ai * 128 + wr * 64 + m * 16 + fr;
                const float rs = rsv[ai * 4 + m];
                u32x4 w[2];
#pragma unroll
                for (int bj = 0; bj < 2; ++bj) {
                    const f32x4 v0 = acc[ai][bj][m][0] * rs + sh[bj][0], v1 = acc[ai][bj][m][1] * rs + sh[bj][1];
                    w[bj].x = cvt_pk_bf16(v0[0], v0[1]); w[bj].y = cvt_pk_bf16(v0[2], v0[3]); w[bj].z = cvt_pk_bf16(v1[0], v1[1]); w[bj].w = cvt_pk_bf16(v1[2], v1[3]);
                }
                st_rows16x2(tb, UP + (size_t)(r - fr) * UPW + ctile + wc * 32, UPW, fr, fq, w[0], w[1]);
            }
        return true;
    }
};
struct EpiResid {
    static constexpr bool PERM = false; static constexpr int XST = 0;
    const float *xin_lat, *xin_ctx; float *xout_lat, *xout_ctx; const float* ga; const float* Gn; bf16_t* AP; float* ss; int g;
    __device__ __forceinline__ void prefetch(const pg8::Unit& u, int wid, int lane, LAS unsigned char* shb) const {
        if (wid == 0) { const RowInfo ri = row_info(g, u.pm); __builtin_amdgcn_global_load_lds((const unsigned*)(ga + (size_t)ri.mi * 6144 + u.pn * 256 + lane * 4), (LAS unsigned*)shb, 16, 0, 0); }
        else if (wid == 1 && Gn) { const RowInfo ri = row_info(g, u.pm); __builtin_amdgcn_global_load_lds((const unsigned*)(Gn + (size_t)ri.mi * 6144 + u.pn * 256 + lane * 4), (LAS unsigned*)(shb + 1024), 16, 0, 0); }
    }
    __device__ __forceinline__ bool operator()(f32x4 (&acc)[2][2][4][2], const pg8::Unit& u, int wr, int wc, int fr, int fq, LAS unsigned char* tb, const LAS unsigned char* shb) const {
        const RowInfo ri = row_info(g, u.pm);
        const float* xin = ri.is_ctx ? xin_ctx : xin_lat; float* xout = ri.is_ctx ? xout_ctx : xout_lat;
        const int l2 = fq * 16 + fr, r2 = l2 >> 2, q2 = l2 & 3;
        LAS unsigned char* wa = tb + 64 * fr + 16 * (fq ^ ((fr >> 2) & 3));
        const LAS unsigned char* ra = tb + 64 * r2 + 16 * (q2 ^ ((r2 >> 2) & 3));
        const int c0 = u.pn * 256 + wc * 32 + 4 * q2;
        const bool gnp = Gn != nullptr;
        const LAS unsigned char* gl = shb + (wc * 32 + 4 * q2) * 4;
        const size_t xbase = (ri.xrow0 + (size_t)(wr * 64 + r2)) * D + c0;
        const int rbase = u.pm * 256 + wr * 64 + r2;
        f32x4 xc[4], xn_[4];
#pragma unroll
        for (int q = 0; q < 4; ++q) xc[q] = *(const f32x4*)(xin + xbase + (q >> 1) * 128 + (q & 1) * 16);
#pragma unroll
        for (int st = 0; st < 8; ++st) {
            const int ai = st >> 2, m = st & 3;
            if (st < 7) { const int ai2 = (st + 1) >> 2, m2 = (st + 1) & 3; const size_t o2 = xbase + (size_t)(ai2 * 128 + m2 * 16) * D;
#pragma unroll
                for (int q = 0; q < 4; ++q) xn_[q] = *(const f32x4*)(xin + o2 + (q >> 1) * 128 + (q & 1) * 16); }
            asm volatile("" ::: "memory");
            const size_t xo = xbase + (size_t)(ai * 128 + m * 16) * D; const int r = rbase + ai * 128 + m * 16;
            float sq = 0.f;
#pragma unroll
            for (int q = 0; q < 4; ++q) { const int bj = q >> 1, n = q & 1;
                *(LAS f32x4*)wa = acc[ai][bj][m][n];
                const f32x4 at = *(const LAS f32x4*)ra;
                const f32x4 xv = xc[q] + *(const LAS f32x4*)(gl + (bj * 128 + n * 16) * 4) * at;
                *(f32x4*)(xout + xo + bj * 128 + n * 16) = xv;
                sq += (xv[0] * xv[0] + xv[1] * xv[1]) + (xv[2] * xv[2] + xv[3] * xv[3]);
                if (gnp) { const f32x4 a = xv * *(const LAS f32x4*)(gl + 1024 + (bj * 128 + n * 16) * 4); u32x2 w; w.x = cvt_pk_bf16(a[0], a[1]); w.y = cvt_pk_bf16(a[2], a[3]);
                    *(u32x2*)(AP + (size_t)r * D + c0 + bj * 128 + n * 16) = w; } }
            sq += dpp_mov<0xB1>(sq); sq += dpp_mov<0x4E>(sq);
            if (q2 == 0) atomicAdd(ss + r, sq);
            asm volatile("" ::: "memory");
#pragma unroll
            for (int q = 0; q < 4; ++q) xc[q] = xn_[q];
        }
        return true;
    }
};
struct EpiDft {
    static constexpr bool PERM = true; static constexpr int XST = 0;
    bf16_t* S; int row_base, rows_per_seq; float scale;
    __device__ __forceinline__ void prefetch(const pg8::Unit&, int, int, LAS unsigned char*) const {}
    __device__ __forceinline__ bool operator()(f32x4 (&acc)[2][2][4][2], const pg8::Unit& u, int wr, int wc, int fr, int fq, LAS unsigned char* tb, const LAS unsigned char*) const {
        const int cb = wc * 32 + 8 * fq;
#pragma unroll
        for (int ai = 0; ai < 2; ++ai)
#pragma unroll
            for (int m = 0; m < 4; ++m) {
                const int r = row_base + u.pn * rows_per_seq + u.pm * 256 + ai * 128 + wr * 64 + m * 16 + fr;
#pragma unroll
                for (int bj = 0; bj < 2; ++bj) {
                    const f32x4 v0 = acc[ai][bj][m][0] * scale, v1 = acc[ai][bj][m][1] * scale;
                    u32x4 w; w.x = cvt_pk_bf16(v0[0], v0[1]); w.y = cvt_pk_bf16(v0[2], v0[3]); w.z = cvt_pk_bf16(v1[0], v1[1]); w.w = cvt_pk_bf16(v1[2], v1[3]);
                    st_rows16(tb, S + (size_t)(r - fr) * D + 768 + bj * 128 + wc * 32, D, fr, fq, w);
                }
            }
        return true;
    }
};
struct EpiMerge {
    static constexpr bool PERM = true; static constexpr int XST = 0;
    const unsigned char* GT; bf16_t* MG;
    __device__ __forceinline__ void prefetch(const pg8::Unit&, int, int, LAS unsigned char*) const {}
    __device__ __forceinline__ bool operator()(f32x4 (&acc)[2][2][4][2], const pg8::Unit& u, int wr, int wc, int fr, int fq, LAS unsigned char* tb, const LAS unsigned char*) const {
        const int cb = u.pn * 256 + wc * 32 + 8 * fq, i = u.seg;
        const int thr = ((wr * 4 + wc) * 64 + fq * 16 + fr) * 8;
        const unsigned char* gi = GT + (size_t)(u.pm * 16 + i * 4 + u.pn) * 16 * 4096 + thr;
        const unsigned char* gn = i < 3 ? gi + (size_t)4 * 16 * 4096 : gi;
        u32x2 ti[16], tn[16];
#pragma unroll
        for (int q = 0; q < 16; ++q) { ti[q] = *(const u32x2*)(gi + q * 4096); tn[q] = *(const u32x2*)(gn + q * 4096); }
        const unsigned last = i == 3 ? 0xffffffffu : 0u;
#pragma unroll
        for (int q = 0; q < 16; ++q) { const int ai = q >> 3, m = (q >> 1) & 3, bj = q & 1;
            f32x4 fa, fb;
#pragma unroll
            for (int j = 0; j < 4; ++j) {
                fa[j] = (float)((ti[q].x >> (8 * j)) & 0xffu) * fast_rcp((float)(((tn[q].x | last) >> (8 * j)) & 0xffu));
                fb[j] = (float)((ti[q].y >> (8 * j)) & 0xffu) * fast_rcp((float)(((tn[q].y | last) >> (8 * j)) & 0xffu)); }
            acc[ai][bj][m][0] *= fa; acc[ai][bj][m][1] *= fb;
        }
        if (i < 3) return false;
#pragma unroll
        for (int q = 0; q < 16; ++q) { const int ai = q >> 3, m = (q >> 1) & 3, bj = q & 1;
            const f32x4 v0 = acc[ai][bj][m][0], v1 = acc[ai][bj][m][1];
            const int r0 = u.pm * 256 + ai * 128 + wr * 64 + m * 16;
            u32x4 w; w.x = cvt_pk_bf16(v0[0], v0[1]); w.y = cvt_pk_bf16(v0[2], v0[3]); w.z = cvt_pk_bf16(v1[0], v1[1]); w.w = cvt_pk_bf16(v1[2], v1[3]);
            st_rows16(tb, MG + (size_t)r0 * D + u.pn * 256 + wc * 32 + bj * 128, D, fr, fq, w);
        }
        return true;
    }
};

__device__ __forceinline__ void transpose_item(const float* src, int ld_src, int k0, int n0, bf16_t* dst, int ld_dst, int dst_row0, LAS float* scr, int lane) {
    const int kr = lane >> 3, nq = lane & 7;
    f32x4 v[8];
#pragma unroll
    for (int i = 0; i < 8; ++i) v[i] = *(const f32x4*)(src + (size_t)(k0 + i * 8 + kr) * ld_src + n0 + nq * 4);
#pragma unroll
    for (int i = 0; i < 8; ++i) { LAS float* d_ = scr + (i * 8 + kr) * 33 + nq * 4; d_[0] = v[i][0]; d_[1] = v[i][1]; d_[2] = v[i][2]; d_[3] = v[i][3]; }
    asm volatile("s_waitcnt lgkmcnt(0)" ::: "memory");
    const int c = lane & 7;
#pragma unroll
    for (int j = 0; j < 4; ++j) { const int n = (lane >> 3) + 8 * j; const LAS float* s = scr + (8 * c) * 33 + n;
        u32x4 o; o.x = cvt_pk_bf16(s[0 * 33], s[1 * 33]); o.y = cvt_pk_bf16(s[2 * 33], s[3 * 33]); o.z = cvt_pk_bf16(s[4 * 33], s[5 * 33]); o.w = cvt_pk_bf16(s[6 * 33], s[7 * 33]);
        *(u32x4*)(dst + (size_t)(dst_row0 + n) * ld_dst + k0 + 8 * c) = o; }
    asm volatile("s_waitcnt lgkmcnt(0)" ::: "memory");
}

__device__ __forceinline__ void weight_prep(const KP& p, LAS unsigned char* lds, int l_lo, int l_hi, int b0, int nb) {
    int tid = p.tid_; asm volatile("" : "+v"(tid)); const int wave = tid >> 6, lane = tid & 63, G = nb, bx = p.bx_ - b0;
    unsigned char* ws = p.ws;
    if (bx < 0 || bx >= nb) return;
    {
        LAS float* scr = (LAS float*)(lds + wave * 16384);
        const int gw = bx * NWAVES + wave, NGW = G * NWAVES;
        constexpr int I_IN1 = 16 * 64, I_IN2 = 16 * 128, I_O = 4 * 32, I_OUT = 16 * 32, I_UP = 16 * 176, I_DN = 44 * 32;
        constexpr int PER_L = I_IN1 + I_IN2 + 4 * I_O + I_OUT + I_UP + I_DN;
        for (int it = l_lo * PER_L + gw; it < l_hi * PER_L; it += NGW) {
            const int l = it / PER_L; int r = it % PER_L;
            bf16_t* wl = (bf16_t*)(ws + OFF_W + (size_t)l * W_LAYER);
            if (r < I_IN1) { const int kb = r / 64, nb = r % 64; transpose_item(p.in(I_w_in) + (size_t)l * D * IN_COLS, IN_COLS, kb * 64, nb * 32, wl + W_IN / 2, D, nb * 32, scr, lane); continue; } r -= I_IN1;
            if (r < I_IN2) { const int kb = r / 128, nb = r % 128; transpose_item(p.in(I_w_in) + (size_t)l * D * IN_COLS, IN_COLS, kb * 64, 2304 + nb * 32, wl + W_IN / 2, D, PMW + nb * 32, scr, lane); continue; } r -= I_IN2;
            if (r < 4 * I_O) { const int br = r / I_O, rr = r % I_O, kb = rr / 32, nb = rr % 32;
                const float* src = (br == 0 ? p.in(I_w_ret_o) : br == 1 ? p.in(I_w_conv_o) : br == 2 ? p.in(I_w_gmlp_o) : p.in(I_w_fnet_o)) + (size_t)l * 256 * D;
                transpose_item(src, D, kb * 64, nb * 32, wl + W_O / 2 + (size_t)br * 1024 * 256, 256, nb * 32, scr, lane); continue; } r -= 4 * I_O;
            if (r < I_OUT) { const int kb = r / 32, nb = r % 32; transpose_item(p.in(I_w_out) + (size_t)l * D * D, D, kb * 64, nb * 32, wl + W_OUT / 2, D, nb * 32, scr, lane); continue; } r -= I_OUT;
            if (r < I_UP) { const int kb = r / 176, nb = r % 176; transpose_item(p.in(I_w_ffn_up) + (size_t)l * D * UPW, UPW, kb * 64, nb * 32, wl + W_UP / 2, D, nb * 32, scr, lane); continue; } r -= I_UP;
            { const int kb = r / 32, nb = r % 32; transpose_item(p.in(I_w_ffn_down) + (size_t)l * DFF * D, D, kb * 64, nb * 32, wl + W_DN / 2, DFF, nb * 32, scr, lane); }
        }
        __syncthreads();
    }
    {
        LAS float* tile = (LAS float*)lds;
        LAS float* tab = (LAS float*)(lds + 64 * 65 * 4);
        for (int it = l_lo * 64 + bx; it < l_hi * 64; it += G) {
            const int l = it / 64, gq = (it / 16) % 4, kb = it % 16;
            __syncthreads();
            if (tid < 64) { tab[tid] = cos_rev((float)tid * (1.0f / 64.0f)) * 0.125f; tab[64 + tid] = sin_rev((float)tid * (1.0f / 64.0f)) * 0.125f; }
            for (int i = tid; i < 64 * 64; i += NTHREADS) { const int kk = i / 64, cc = i % 64; tile[kk * 65 + cc] = p.in(I_w_in)[((size_t)l * D + kb * 64 + kk) * IN_COLS + 2048 + gq * 64 + cc]; }
            __syncthreads();
            const int which = tid >> 8, nl = (tid & 255) >> 2, kq = tid & 3;
            float acc[16];
#pragma unroll
            for (int j = 0; j < 16; ++j) acc[j] = 0.f;
            for (int cc = 0; cc < 64; ++cc) { const float coef = tab[which * 64 + ((cc * nl) & 63)];
#pragma unroll
                for (int j = 0; j < 16; ++j) acc[j] += coef * tile[(kq * 16 + j) * 65 + cc]; }
            bf16_t* wl = (bf16_t*)(ws + OFF_W + (size_t)l * W_LAYER + W_IN);
            bf16_t* dst = wl + (size_t)(2048 + which * 256 + gq * 64 + nl) * D + kb * 64 + kq * 16;
            *(u32x4*)dst = pack8(acc); *(u32x4*)(dst + 8) = pack8(acc + 8);
        }
        __syncthreads();
    }
}
__device__ __forceinline__ void phase_prep_a(const KP& p, LAS unsigned char* lds) {
    int tid = p.tid_; asm volatile("" : "+v"(tid)); const int wave = tid >> 6, lane = tid & 63, G = NBLK, bx = p.bx_;
    unsigned char* ws = p.ws;
    {
        LAS float* sl = (LAS float*)lds;
        float* adap = (float*)(ws + OFF_ADAP);
        for (int it = bx; it < 2 * 12 * 8; it += G) {
            const int l = it / 96, nch = (it / 8) % 12, kc = it % 8;
            __syncthreads();
            for (int i = tid; i < 17 * 128; i += NTHREADS) { const int mi = i / 128, k = kc * 128 + (i % 128); const float cv = mi < 16 ? p.in(I_c)[mi * D + k] : p.in(I_c_ctx)[k]; sl[i] = siluf_(cv); }
            __syncthreads();
            const int n = nch * 512 + tid;
            float acc[17];
#pragma unroll
            for (int mi = 0; mi < 17; ++mi) acc[mi] = 0.f;
            const float* wp = p.in(I_w_ada) + ((size_t)l * D + kc * 128) * 6144 + n;
#pragma unroll 1
            for (int k0 = 0; k0 < 128; k0 += 16) { float w[16];
#pragma unroll
                for (int k = 0; k < 16; ++k) w[k] = wp[(size_t)(k0 + k) * 6144];
#pragma unroll
                for (int k = 0; k < 16; ++k)
#pragma unroll
                    for (int mi = 0; mi < 17; ++mi) acc[mi] += sl[mi * 128 + k0 + k] * w[k]; }
#pragma unroll
            for (int mi = 0; mi < 17; ++mi) adap[(((size_t)kc * 2 + l) * 17 + mi) * 6144 + n] = acc[mi];
        }
        __syncthreads();
    }
    weight_prep(p, lds, 0, 1, 0, G);
    {
        const size_t gt = (size_t)bx * NTHREADS + tid, GT_ = (size_t)G * NTHREADS;
        float* rc = (float*)(ws + OFF_ROPE); float* rsn = rc + 2304 * 32;
        for (size_t i = gt; i < (size_t)2304 * 32; i += GT_) { const int pos = (int)(i / 32), fi = (int)(i % 32);
            const float inv = exp2f(-(float)fi * (13.287712379549449f / 32.0f));
            const float ang = (float)pos * inv;
            const double rev = (double)ang * 0.15915494309189535; const float fr_ = (float)(rev - floor(rev));
            rc[i] = cos_rev(fr_); rsn[i] = sin_rev(fr_); }
        bf16_t* dm = (bf16_t*)(ws + OFF_DM);
        for (size_t i = gt; i < (size_t)2048 * 256; i += GT_) { const int n = (int)(i / 256), k8 = (int)(i % 256) * 8; float v[8];
#pragma unroll
            for (int j = 0; j < 8; ++j) { const int kk = k8 + j; if (kk <= 1024) v[j] = cos_rev((float)((n * kk) & 2047) * (1.0f / 2048.0f)); else v[j] = -sin_rev((float)((n * (kk - 1024)) & 2047) * (1.0f / 2048.0f)); }
            *(u32x4*)(dm + (size_t)n * 2048 + k8) = pack8(v); }
        bf16_t* dc = (bf16_t*)(ws + OFF_DC);
        for (size_t i = gt; i < (size_t)256 * 32; i += GT_) { const int n = (int)(i / 32), k8 = (int)(i % 32) * 8; float v[8];
#pragma unroll
            for (int j = 0; j < 8; ++j) { const int kk = k8 + j; if (kk <= 128) v[j] = cos_rev((float)((n * kk) & 255) * (1.0f / 256.0f)); else v[j] = -sin_rev((float)((n * (kk - 128)) & 255) * (1.0f / 256.0f)); }
            *(u32x4*)(dc + (size_t)n * 256 + k8) = pack8(v); }
        if (gt < 16) { const float xx = p.in(I_ret_decay)[gt]; ((float*)(ws + OFF_LOGG))[gt] = (float)(-log1p(exp(-(double)xx))); }
    }
}

__device__ __forceinline__ void phase_prep_b(const KP& p) {
    const size_t gt = (size_t)p.bx_ * NTHREADS + p.tid_, GT_ = (size_t)NBLK * NTHREADS;
    const float* adap = (const float*)(p.ws + OFF_ADAP); float* mod = (float*)(p.ws + OFF_MOD);
    for (size_t i = gt; i < (size_t)2 * 17 * 6144; i += GT_) {
        const int l = (int)(i / (17 * 6144)), n = (int)(i % 6144), j = n / 1024, k = n % 1024;
        float v = p.in(I_b_ada)[l * 6144 + n];
#pragma unroll
        for (int kc = 0; kc < 8; ++kc) v += adap[(size_t)kc * 2 * 17 * 6144 + i];
        if (j == 1) v = p.in(I_g_norm1)[l * D + k] * (1.f + v);
        if (j == 4) v = p.in(I_g_norm2)[l * D + k] * (1.f + v);
        mod[i] = v;
    }
}

__device__ __forceinline__ void phase_prep_c(const KP& p, LAS unsigned char* lds, int l_lo, int l_hi, int b0, int nb) {
    int tid = p.tid_; asm volatile("" : "+v"(tid)); const int wave = tid >> 6, lane = tid & 63, G = nb;
    if (p.bx_ < b0 || p.bx_ >= b0 + nb) return;
    LAS unsigned char* shb = lds;
    const int gw = (p.bx_ - b0) * NWAVES + wave, NGW = G * NWAVES;
    const int c = lane & 15, gq = lane >> 4;
    for (int combo = 2 * l_lo; combo < 2 * l_hi; ++combo) {
        const int l = combo >> 1, which = combo & 1;
        const float* mod = (const float*)(p.ws + OFF_MOD) + (size_t)l * 17 * 6144 + (which ? 3 : 0) * 1024;
        __syncthreads();
        for (int i = tid; i < 32 * 128; i += NTHREADS) { const int row = i >> 7, ch = i & 127; float f[8];
#pragma unroll
            for (int j = 0; j < 8; ++j) f[j] = row < 17 ? mod[(size_t)row * 6144 + ch * 8 + j] : 0.f;
            *(LAS u32x4*)(shb + row * 2048 + ((ch ^ (row & 7)) << 4)) = pack8(f); }
        __syncthreads();
        const int ncol = which ? UPW : NCOLS;
        const bf16_t* W = (const bf16_t*)(p.ws + OFF_W + (size_t)l * W_LAYER + (which ? W_UP : W_IN));
        float* dst = (float*)(p.ws + (which ? OFF_SHW2 : OFF_SHW1)) + (size_t)l * 17 * ncol;
        for (int nb16 = gw; nb16 < ncol / 16; nb16 += NGW) {
            const bf16_t* wrow = W + (size_t)(nb16 * 16 + c) * D + 8 * gq;
            const f32x4 z4 = (f32x4){0.f, 0.f, 0.f, 0.f};
            f32x4 acc0 = z4, acc1 = z4;
#pragma unroll 1
            for (int t0 = 0; t0 < 32; t0 += 8) {
                bf16x8 bfr[8];
#pragma unroll
                for (int q = 0; q < 8; ++q) bfr[q] = *(const bf16x8*)(wrow + 32 * (t0 + q));
#pragma unroll
                for (int q = 0; q < 8; ++q) { const int ch = 4 * (t0 + q) + gq;
                    const bf16x8 a0 = *(const LAS bf16x8*)(shb + c * 2048 + ((ch ^ (c & 7)) << 4)), a1 = *(const LAS bf16x8*)(shb + (16 + c) * 2048 + ((ch ^ (c & 7)) << 4));
                    acc0 = mfma16(a0, bfr[q], acc0); acc1 = mfma16(a1, bfr[q], acc1); }
            }
            const int n = nb16 * 16 + c;
#pragma unroll
            for (int r = 0; r < 4; ++r) dst[(size_t)(4 * gq + r) * ncol + n] = acc0[r];
            if (gq == 0) dst[(size_t)16 * ncol + n] = acc1[0];
        }
    }
    __syncthreads();
}

__device__ __forceinline__ void phase_g0(const KP& p, int g, int b0, int nb) {
    int tid = p.tid_; asm volatile("" : "+v"(tid)); const int wave = tid >> 6, lane = tid & 63;
    if (p.bx_ < b0 || p.bx_ >= b0 + nb) return;
    const int gw = (p.bx_ - b0) * NWAVES + wave, NGW = nb * NWAVES;
    const float* mod = (const float*)(p.ws + OFF_MOD);
    bf16_t* AP = (bf16_t*)(p.ws + ap_off(g)); float* ss = (float*)(p.ws + ssa_off(g));
    const int nrows = g == 0 ? R : R_LAT;
    for (int r0 = gw; r0 < nrows; r0 += 2 * NGW) {
        f32x4 v[2][4], gg[2][4]; int rr[2]; bool ok[2];
#pragma unroll
        for (int h = 0; h < 2; ++h) { rr[h] = r0 + h * NGW; ok[h] = rr[h] < nrows; const int r = ok[h] ? rr[h] : r0;
            const RowInfo ri = row_info(g, r >> 8);
            const float* xr = (ri.is_ctx ? p.in(I_ctx) : p.in(I_x)) + (ri.xrow0 + (size_t)(r & 255)) * D;
            const float* G1 = mod + (size_t)ri.mi * 6144 + 1024;
#pragma unroll
            for (int j = 0; j < 4; ++j) { v[h][j] = *(const f32x4*)(xr + j * 256 + lane * 4); gg[h][j] = *(const f32x4*)(G1 + j * 256 + lane * 4); } }
#pragma unroll
        for (int h = 0; h < 2; ++h) { if (!ok[h]) continue; const int r = rr[h];
            float s_ = 0.f;
#pragma unroll
            for (int j = 0; j < 4; ++j) { const f32x4 x = v[h][j];
                s_ += (x[0] * x[0] + x[1] * x[1]) + (x[2] * x[2] + x[3] * x[3]);
                const f32x4 a = x * gg[h][j]; u32x2 w; w.x = cvt_pk_bf16(a[0], a[1]); w.y = cvt_pk_bf16(a[2], a[3]);
                *(u32x2*)(AP + (size_t)r * D + j * 256 + lane * 4) = w; }
            s_ = wave_sum(s_, lane);
            if (lane == 0) ss[r] = s_; }
    }
}

__device__ __forceinline__ void phase_final(const KP& p, int g, int b0, int nb) {
    int tid = p.tid_; asm volatile("" : "+v"(tid)); const int wave = tid >> 6, lane = tid & 63;
    if (p.bx_ < b0 || p.bx_ >= b0 + nb) return;
    const int gw = (p.bx_ - b0) * NWAVES + wave, NGW = nb * NWAVES;
    const float* ss = (const float*)(p.ws + ssa_off(g));
    const f32x4 gf0 = *(const f32x4*)(p.in(I_g_final) + lane * 4), gf1 = *(const f32x4*)(p.in(I_g_final) + 256 + lane * 4), gf2 = *(const f32x4*)(p.in(I_g_final) + 512 + lane * 4), gf3 = *(const f32x4*)(p.in(I_g_final) + 768 + lane * 4);
    for (int r0 = gw; r0 < R_LAT; r0 += 2 * NGW) {
        f32x4 v[2][4]; float sv[2];
#pragma unroll
        for (int h = 0; h < 2; ++h) { const int r = (r0 + h * NGW < R_LAT) ? r0 + h * NGW : r0; sv[h] = ss[r];
            const float* xr = p.out + ((size_t)g * R_LAT + r) * D;
#pragma unroll
            for (int j = 0; j < 4; ++j) v[h][j] = *(const f32x4*)(xr + j * 256 + lane * 4); }
#pragma unroll
        for (int h = 0; h < 2; ++h) { const int r = r0 + h * NGW; if (r >= R_LAT) continue;
            const float rs = __builtin_amdgcn_rsqf(sv[h] * (1.0f / 1024.0f) + EPS);
            float* xr = p.out + ((size_t)g * R_LAT + r) * D;
            *(f32x4*)(xr + lane * 4) = v[h][0] * rs * gf0; *(f32x4*)(xr + 256 + lane * 4) = v[h][1] * rs * gf1;
            *(f32x4*)(xr + 512 + lane * 4) = v[h][2] * rs * gf2; *(f32x4*)(xr + 768 + lane * 4) = v[h][3] * rs * gf3; }
    }
}

struct ChunkInfo { int row0, pos0, h; };
__device__ __forceinline__ ChunkInfo chunk_info(int item) {
    ChunkInfo ci;
    if (item < N_KV_LAT) { const int gb = item >> 6, ch = item & 15; ci.h = (item >> 4) & 3; ci.row0 = gb * SEQ + ch * 128; ci.pos0 = CTXL + ch * 128; }
    else { const int it2 = item - N_KV_LAT, gb = it2 >> 3, ch = it2 & 1; ci.h = (it2 >> 1) & 3; ci.row0 = R_LAT + gb * CTXL + ch * 128; ci.pos0 = ch * 128; }
    return ci;
}
__device__ __forceinline__ void load_chunk_f32(const int tid, const bf16_t* PM, int row0, int col0, LAS float* dst, int st) {
#pragma unroll
    for (int q = 0; q < 2; ++q) { const int idx = tid + q * NTHREADS, row = idx >> 3, cc = idx & 7; float f[8];
        unpack8(*(const u32x4*)(PM + (size_t)(row0 + row) * PMW + col0 + cc * 8), f);
        *(LAS f32x4*)(dst + row * st + cc * 8) = (f32x4){f[0], f[1], f[2], f[3]}; *(LAS f32x4*)(dst + row * st + cc * 8 + 4) = (f32x4){f[4], f[5], f[6], f[7]}; }
}
__device__ __forceinline__ void rotary_lds(const int tid, LAS float* buf, int st, int pos0, const float* rc, const float* rsn, float scale) {
#pragma unroll
    for (int q = 0; q < 8; ++q) { const int pidx = tid + q * NTHREADS, row = pidx >> 5, i = pidx & 31;
        const float c = rc[(pos0 + row) * 32 + i], s = rsn[(pos0 + row) * 32 + i];
        const float t1 = buf[row * st + i], t2 = buf[row * st + i + 32];
        buf[row * st + i] = (t1 * c - t2 * s) * scale; buf[row * st + i + 32] = (t1 * s + t2 * c) * scale; }
}

__device__ __forceinline__ void ret_kv_item(const KP& p, LAS unsigned char* lds, int l, int item) {
    int tid = p.tid_; asm volatile("" : "+v"(tid));
    const bf16_t* PM = (const bf16_t*)(p.ws + OFF_BIG);
    const float* rc = (const float*)(p.ws + OFF_ROPE); const float* rsn = rc + 2304 * 32;
    const float* logg = (const float*)(p.ws + OFF_LOGG) + l * 8;
    LAS unsigned char* KfT = lds;
    LAS unsigned char* KbT = lds + 16384;
    LAS unsigned char* Vt = lds + 32768;
    const ChunkInfo ci = chunk_info(item);
    __syncthreads();
    {
        const int row = tid >> 2, pc = tid & 3, pos = ci.pos0 + row;
        const bf16_t* src = PM + (size_t)(ci.row0 + row) * PMW + ci.h * 64;
        const float lgf = logg[ci.h], lgb = logg[4 + ci.h];
        const float wf = 0.125f * __expf(lgf * (float)(127 - row)), wb = 0.125f * __expf(lgb * (float)row);
        float cs[8], sn[8], t1[8], t2[8];
        { const f32x4 c0 = *(const f32x4*)(rc + pos * 32 + pc * 8), c1 = *(const f32x4*)(rc + pos * 32 + pc * 8 + 4), s0 = *(const f32x4*)(rsn + pos * 32 + pc * 8), s1 = *(const f32x4*)(rsn + pos * 32 + pc * 8 + 4);
#pragma unroll
          for (int j = 0; j < 4; ++j) { cs[j] = c0[j]; cs[4 + j] = c1[j]; sn[j] = s0[j]; sn[4 + j] = s1[j]; } }
        unpack8(*(const u32x4*)(src + 256 + pc * 8), t1); unpack8(*(const u32x4*)(src + 256 + 32 + pc * 8), t2);
        const int jo = (row & 7) * 2, jc = row >> 3;
#pragma unroll
        for (int j = 0; j < 8; ++j) {
            const float o1 = t1[j] * cs[j] - t2[j] * sn[j], o2 = t1[j] * sn[j] + t2[j] * cs[j];
            const int d1 = pc * 8 + j, d2 = 32 + pc * 8 + j;
            *(LAS unsigned short*)(KfT + d1 * 256 + ((jc ^ (d1 & 15)) << 4) + jo) = f2bf(o1 * wf); *(LAS unsigned short*)(KfT + d2 * 256 + ((jc ^ (d2 & 15)) << 4) + jo) = f2bf(o2 * wf);
            *(LAS unsigned short*)(KbT + d1 * 256 + ((jc ^ (d1 & 15)) << 4) + jo) = f2bf(o1 * wb); *(LAS unsigned short*)(KbT + d2 * 256 + ((jc ^ (d2 & 15)) << 4) + jo) = f2bf(o2 * wb);
        }
        const u32x4 v0 = *(const u32x4*)(src + 512 + pc * 16), v1 = *(const u32x4*)(src + 512 + pc * 16 + 8);
        const unsigned vv[8] = {v0.x, v0.y, v0.z, v0.w, v1.x, v1.y, v1.z, v1.w};
#pragma unroll
        for (int e2 = 0; e2 < 8; ++e2)
#pragma unroll
            for (int hh = 0; hh < 2; ++hh) { const int e = pc * 16 + e2 * 2 + hh; const unsigned short val = (unsigned short)(hh ? (vv[e2] >> 16) : (vv[e2] & 0xffffu));
                *(LAS unsigned short*)(Vt + e * 256 + ((jc ^ (e & 15)) << 4) + jo) = val; }
    }
    __syncthreads();
    const int w = __builtin_amdgcn_readfirstlane(tid >> 6), lane = tid & 63, c = lane & 15, gq = lane >> 4;
    const int dir = w >> 2, db = w & 3, d = 16 * db + c;
    LAS unsigned char* KT = dir ? KbT : KfT;
    const f32x4 z4 = (f32x4){0.f, 0.f, 0.f, 0.f};
    f32x4 acc[4] = {z4, z4, z4, z4};
#pragma unroll
    for (int t = 0; t < 4; ++t) {
        const bf16x8 af = *(const LAS bf16x8*)(KT + d * 256 + (((4 * t + gq) ^ (d & 15)) << 4));
#pragma unroll
        for (int eb = 0; eb < 4; ++eb) { const int e = 16 * eb + c;
            const bf16x8 bfr = *(const LAS bf16x8*)(Vt + e * 256 + (((4 * t + gq) ^ (e & 15)) << 4));
            acc[eb] = mfma16(af, bfr, acc[eb]); }
    }
    float* kv = (item < N_KV_LAT ? (float*)(p.ws + OFF_KV) + (size_t)item * 8192 : (float*)(p.ws + OFF_KVC) + (size_t)(l * N_KV_CTX + item - N_KV_LAT) * 8192) + dir * 4096;
#pragma unroll
    for (int eb = 0; eb < 4; ++eb)
#pragma unroll
        for (int r = 0; r < 4; ++r) kv[(16 * db + 4 * gq + r) * 64 + 16 * eb + c] = acc[eb][r];
}

__device__ __forceinline__ void ret_out_item(const KP& p, LAS unsigned char* lds, int g, int l, int item) {
    int tid = p.tid_; asm volatile("" : "+v"(tid));
    const bf16_t* PM = (const bf16_t*)(p.ws + OFF_BIG);
    const float* rc = (const float*)(p.ws + OFF_ROPE); const float* rsn = rc + 2304 * 32;
    const float* logg = (const float*)(p.ws + OFF_LOGG) + l * 8;
    LAS unsigned char* Qb = lds;
    LAS unsigned char* Kb = lds + 16384;
    LAS unsigned char* Vt = lds + 32768;
    LAS unsigned char* SfT = lds + 49152;
    LAS unsigned char* SbT = lds + 57344;
    LAS float* dtab = (LAS float*)(lds + 65536);
    const ChunkInfo ci = chunk_info(item);
    __syncthreads();
    {
        const int row = tid >> 2, pc = tid & 3, pos = ci.pos0 + row;
        const bf16_t* src = PM + (size_t)(ci.row0 + row) * PMW + ci.h * 64;
        float cs[8], sn[8];
        { const f32x4 c0 = *(const f32x4*)(rc + pos * 32 + pc * 8), c1 = *(const f32x4*)(rc + pos * 32 + pc * 8 + 4), s0 = *(const f32x4*)(rsn + pos * 32 + pc * 8), s1 = *(const f32x4*)(rsn + pos * 32 + pc * 8 + 4);
#pragma unroll
          for (int j = 0; j < 4; ++j) { cs[j] = c0[j]; cs[4 + j] = c1[j]; sn[j] = s0[j]; sn[4 + j] = s1[j]; } }
#pragma unroll
        for (int qk = 0; qk < 2; ++qk) {
            float t1[8], t2[8], o1[8], o2[8];
            unpack8(*(const u32x4*)(src + qk * 256 + pc * 8), t1); unpack8(*(const u32x4*)(src + qk * 256 + 32 + pc * 8), t2);
            const float sc = qk ? 0.125f : 1.0f;
#pragma unroll
            for (int j = 0; j < 8; ++j) { o1[j] = (t1[j] * cs[j] - t2[j] * sn[j]) * sc; o2[j] = (t1[j] * sn[j] + t2[j] * cs[j]) * sc; }
            LAS unsigned char* dst = (qk ? Kb : Qb) + row * 128;
            *(LAS u32x4*)(dst + ((pc ^ (row & 7)) << 4)) = pack8(o1);
            *(LAS u32x4*)(dst + (((4 + pc) ^ (row & 7)) << 4)) = pack8(o2);
        }
        {
            const u32x4 v0 = *(const u32x4*)(src + 512 + pc * 16), v1 = *(const u32x4*)(src + 512 + pc * 16 + 8);
            const unsigned vv[8] = {v0.x, v0.y, v0.z, v0.w, v1.x, v1.y, v1.z, v1.w};
#pragma unroll
            for (int e2 = 0; e2 < 8; ++e2)
#pragma unroll
                for (int hh = 0; hh < 2; ++hh) { const int e = pc * 16 + e2 * 2 + hh; const unsigned short val = (unsigned short)(hh ? (vv[e2] >> 16) : (vv[e2] & 0xffffu));
                    *(LAS unsigned short*)(Vt + e * 256 + ((((row >> 2) ^ (2 * (e & 15))) << 3)) + (row & 3) * 2) = val; }
        }
        {
            const int d = tid >> 3, e0 = (tid & 7) * 8;
            const float* KV = (const float*)(p.ws + OFF_KV) + d * 64 + e0;
            const float* KVC = (const float*)(p.ws + OFF_KVC) + (size_t)l * N_KV_CTX * 8192 + d * 64 + e0;
            const f32x4 z = (f32x4){0.f, 0.f, 0.f, 0.f};
            f32x4 fa = z, fb = z, ba = z, bb = z;
            if (item < N_KV_LAT) {
                const int ch = item & 15, lat0 = item - ch, c0 = (g * GB + (item >> 6)) * 8 + ci.h * 2;
                const float l128f = logg[ci.h] * 128.f, l128b = logg[4 + ci.h] * 128.f;
#pragma unroll 1
                for (int t0 = 0; t0 < 20; t0 += 10) {
                    f32x4 xa[10], xb[10]; float wt[10]; bool isf[10];
#pragma unroll
                    for (int q = 0; q < 10; ++q) { const int t = t0 + q; const bool fw = t < ch + 2; isf[q] = fw;
                        const int k = fw ? t - 2 : t - (ch + 2) - 2;
                        const float* x; if (fw) x = k < 0 ? KVC + (size_t)(c0 + k + 2) * 8192 : KV + (size_t)(lat0 + k) * 8192;
                        else x = (k < 0 ? KVC + (size_t)(c0 - 1 - k) * 8192 : KV + (size_t)(lat0 + 15 - k) * 8192) + 4096;
                        const bool valid = t < 19; if (!valid) x = KVC;
                        wt[q] = valid ? (fw ? __expf(l128f * (float)(ch - 1 - k)) : __expf(l128b * (float)(14 - ch - k))) : 0.f;
                        xa[q] = *(const f32x4*)x; xb[q] = *(const f32x4*)(x + 4); }
#pragma unroll
                    for (int q = 0; q < 10; ++q) { if (isf[q]) { fa += xa[q] * wt[q]; fb += xb[q] * wt[q]; } else { ba += xa[q] * wt[q]; bb += xb[q] * wt[q]; } }
                }
            } else {
                const int it2 = item - N_KV_LAT, ch = it2 & 1, c0 = it2 - ch;
                if (ch == 1) { const float* x = KVC + (size_t)c0 * 8192; fa = *(const f32x4*)x; fb = *(const f32x4*)(x + 4); }
                else { const float* x = KVC + (size_t)(c0 + 1) * 8192 + 4096; ba = *(const f32x4*)x; bb = *(const f32x4*)(x + 4); }
            }
#pragma unroll
            for (int dir = 0; dir < 2; ++dir) { const f32x4 a = dir ? ba : fa, b = dir ? bb : fb;
                LAS unsigned char* dstT = dir ? SbT : SfT; const float vals[8] = {a[0], a[1], a[2], a[3], b[0], b[1], b[2], b[3]};
#pragma unroll
                for (int jj = 0; jj < 8; ++jj) { const int e = e0 + jj; *(LAS unsigned short*)(dstT + e * 128 + (((d >> 3) ^ (e & 7)) << 4) + (d & 7) * 2) = f2bf(vals[jj]); } }
        }
        const float lgf = logg[ci.h], lgb = logg[4 + ci.h];
        if (tid <= 256) { const int t = tid - 128; dtab[tid] = t > 0 ? __expf(lgf * (float)t) : (t < 0 ? __expf(lgb * (float)(-t)) : 2.0f); }
    }
    __syncthreads();
    const int w = __builtin_amdgcn_readfirstlane(tid >> 6), lane = tid & 63, c = lane & 15, gq = lane >> 4;
    const int il = 16 * w + c;
    f32x4 g4v[4]; u32x2 grv[4];
    { const float* gn_ = p.in(I_ret_gn) + l * 256 + ci.h * 64; const bf16_t* gsrc_ = PM + (size_t)(ci.row0 + il) * PMW + 768 + ci.h * 64;
#pragma unroll
      for (int eb = 0; eb < 4; ++eb) { g4v[eb] = *(const f32x4*)(gn_ + 16 * eb + 4 * gq); grv[eb] = *(const u32x2*)(gsrc_ + 16 * eb + 4 * gq); } }
    bf16x8 qf[2];
#pragma unroll
    for (int ks = 0; ks < 2; ++ks) qf[ks] = *(const LAS bf16x8*)(Qb + il * 128 + (((4 * ks + gq) ^ (il & 7)) << 4));
    const f32x4 z4 = (f32x4){0.f, 0.f, 0.f, 0.f};
    f32x4 st[8];
#pragma unroll
    for (int jb = 0; jb < 8; ++jb) { const int j = 16 * jb + c;
        const bf16x8 k0 = *(const LAS bf16x8*)(Kb + j * 128 + (((0 + gq) ^ (j & 7)) << 4)), k1 = *(const LAS bf16x8*)(Kb + j * 128 + (((4 + gq) ^ (j & 7)) << 4));
        st[jb] = mfma16(k0, qf[0], z4); st[jb] = mfma16(k1, qf[1], st[jb]); }
#pragma unroll
    for (int jb = 0; jb < 8; ++jb)
#pragma unroll
        for (int r = 0; r < 4; ++r) st[jb][r] *= dtab[128 + il - (16 * jb + 4 * gq + r)];
    f32x4 oT[4], cf[4], cb[4];
#pragma unroll
    for (int eb = 0; eb < 4; ++eb) { oT[eb] = z4; cf[eb] = z4; cb[eb] = z4; }
#pragma unroll
    for (int t = 0; t < 4; ++t) {
        union { u32x4 u; bf16x8 v; } pk;
        pk.u.x = cvt_pk_bf16(st[2 * t][0], st[2 * t][1]); pk.u.y = cvt_pk_bf16(st[2 * t][2], st[2 * t][3]);
        pk.u.z = cvt_pk_bf16(st[2 * t + 1][0], st[2 * t + 1][1]); pk.u.w = cvt_pk_bf16(st[2 * t + 1][2], st[2 * t + 1][3]);
#pragma unroll
        for (int eb = 0; eb < 4; ++eb) { const int e = 16 * eb + c;
            union { u32x4 u; bf16x8 v; } va;
            const u32x2 lo = *(const LAS u32x2*)(Vt + e * 256 + (((8 * t + gq) ^ (2 * (e & 15))) << 3)), hi = *(const LAS u32x2*)(Vt + e * 256 + (((8 * t + 4 + gq) ^ (2 * (e & 15))) << 3));
            va.u.x = lo.x; va.u.y = lo.y; va.u.z = hi.x; va.u.w = hi.y;
            oT[eb] = mfma16(va.v, pk.v, oT[eb]); }
    }
#pragma unroll
    for (int eb = 0; eb < 4; ++eb) { const int e = 16 * eb + c;
#pragma unroll
        for (int ks = 0; ks < 2; ++ks) {
            const bf16x8 af = *(const LAS bf16x8*)(SfT + e * 128 + (((4 * ks + gq) ^ (e & 7)) << 4)), ab = *(const LAS bf16x8*)(SbT + e * 128 + (((4 * ks + gq) ^ (e & 7)) << 4));
            cf[eb] = mfma16(af, qf[ks], cf[eb]); cb[eb] = mfma16(ab, qf[ks], cb[eb]); } }
    const float wqf = dtab[128 + il + 1], wqb = dtab[il];
    float o[16]; float sm = 0.f;
#pragma unroll
    for (int eb = 0; eb < 4; ++eb)
#pragma unroll
        for (int r = 0; r < 4; ++r) { o[eb * 4 + r] = oT[eb][r] + wqf * cf[eb][r] + wqb * cb[eb][r]; sm += o[eb * 4 + r]; }
    sm += shx(sm, 16, lane); sm += shx(sm, 32, lane);
    const float mean = sm * (1.0f / 64.0f);
    float vq = 0.f;
#pragma unroll
    for (int e = 0; e < 16; ++e) { o[e] -= mean; vq += o[e] * o[e]; }
    vq += shx(vq, 16, lane); vq += shx(vq, 32, lane);
    const float rstd = __builtin_amdgcn_rsqf(vq * (1.0f / 64.0f) + EPS);
    bf16_t* S = (bf16_t*)(p.ws + OFF_S) + (size_t)(ci.row0 + il) * D + ci.h * 64;
#pragma unroll
    for (int eb = 0; eb < 4; ++eb) { const int e0 = 16 * eb + 4 * gq;
        const f32x4 g4 = g4v[eb]; const u32x2 gr = grv[eb];
        const float g0 = bf2f(gr.x & 0xffffu), g1 = __uint_as_float(gr.x & 0xffff0000u), g2 = bf2f(gr.y & 0xffffu), g3 = __uint_as_float(gr.y & 0xffff0000u);
        u32x2 wv; wv.x = cvt_pk_bf16(o[eb * 4 + 0] * rstd * g4[0] * siluf_(g0), o[eb * 4 + 1] * rstd * g4[1] * siluf_(g1));
        wv.y = cvt_pk_bf16(o[eb * 4 + 2] * rstd * g4[2] * siluf_(g2), o[eb * 4 + 3] * rstd * g4[3] * siluf_(g3));
        *(u32x2*)(S + e0) = wv; }
}

__device__ __forceinline__ void conf_item(const KP& p, LAS unsigned char* lds, int l, int item) {
    int tid = p.tid_; asm volatile("" : "+v"(tid)); const int wave = tid >> 6, lane = tid & 63;
    const bf16_t* PM = (const bf16_t*)(p.ws + OFF_BIG);
    LAS float* hbuf = (LAS float*)lds;
    LAS float* ybuf = (LAS float*)(lds + 65536);
    int seqrow0, L, n0;
    if (item < R_LAT / 32) { seqrow0 = (item >> 6) * SEQ; L = SEQ; n0 = (item & 63) * 32; }
    else { const int it2 = item - R_LAT / 32; seqrow0 = R_LAT + (it2 >> 3) * CTXL; L = CTXL; n0 = (it2 & 7) * 32; }
    __syncthreads();
    {
        u32x4 a1[4], a2[4]; bool ok[4];
#pragma unroll
        for (int q = 0; q < 4; ++q) { const int idx = tid + q * NTHREADS, hr = idx >> 5, cc = idx & 31, tok = n0 - 15 + hr;
            ok[q] = idx < 62 * 32 && tok >= 0 && tok < L;
            const bf16_t* src = PM + (size_t)(seqrow0 + (ok[q] ? tok : n0)) * PMW + 1024 + cc * 8;
            a1[q] = *(const u32x4*)src; a2[q] = *(const u32x4*)(src + 256); }
#pragma unroll
        for (int q = 0; q < 4; ++q) { const int idx = tid + q * NTHREADS, hr = idx >> 5, cc = idx & 31;
            if (idx < 62 * 32) { float x1[8], x2[8], hv[8]; unpack8(a1[q], x1); unpack8(a2[q], x2);
#pragma unroll
                for (int j = 0; j < 8; ++j) hv[j] = ok[q] ? x1[j] * sigmoidf_(x2[j]) : 0.f;
                *(LAS f32x4*)(hbuf + hr * 256 + cc * 8) = (f32x4){hv[0], hv[1], hv[2], hv[3]}; *(LAS f32x4*)(hbuf + hr * 256 + cc * 8 + 4) = (f32x4){hv[4], hv[5], hv[6], hv[7]}; } }
    }
    __syncthreads();
    { const int c = tid & 255, q = tid >> 8;
      float w[31], xw[46];
#pragma unroll
      for (int j = 0; j < 31; ++j) w[j] = p.in(I_conv_dw)[((size_t)l * 31 + j) * 256 + c];
      const float bias = p.in(I_conv_db)[l * 256 + c];
#pragma unroll
      for (int j = 0; j < 46; ++j) xw[j] = hbuf[(q * 16 + j) * 256 + c];
#pragma unroll
      for (int tt = 0; tt < 16; ++tt) { float y = bias;
#pragma unroll
          for (int j = 0; j < 31; ++j) y += w[j] * xw[tt + j];
          ybuf[(q * 16 + tt) * 256 + c] = y; } }
    __syncthreads();
    { const f32x4 lg = *(const f32x4*)(p.in(I_conv_ln_g) + l * 256 + lane * 4), lb = *(const f32x4*)(p.in(I_conv_ln_b) + l * 256 + lane * 4);
      bf16_t* S = (bf16_t*)(p.ws + OFF_S);
#pragma unroll
      for (int t4 = 0; t4 < 4; ++t4) { const int tt = wave * 4 + t4;
          f32x4 v = *(const LAS f32x4*)(ybuf + tt * 256 + lane * 4);
          const float mean = wave_sum((v[0] + v[1]) + (v[2] + v[3]), lane) * (1.0f / 256.0f);
          v = v - mean;
          const float var = wave_sum((v[0] * v[0] + v[1] * v[1]) + (v[2] * v[2] + v[3] * v[3]), lane) * (1.0f / 256.0f);
          const float rstd = __builtin_amdgcn_rsqf(var + EPS);
          f32x4 y = v * rstd * lg + lb;
#pragma unroll
          for (int j = 0; j < 4; ++j) y[j] = siluf_(y[j]);
          u32x2 w2; w2.x = cvt_pk_bf16(y[0], y[1]); w2.y = cvt_pk_bf16(y[2], y[3]);
          *(u32x2*)(S + (size_t)(seqrow0 + n0 + tt) * D + 256 + lane * 4) = w2; } }
}

__device__ __forceinline__ void gmlp_item(const KP& p, LAS unsigned char* lds, int l, int item) {
    int tid = p.tid_; asm volatile("" : "+v"(tid)); const int wave = __builtin_amdgcn_readfirstlane(tid >> 6), lane = tid & 63;
    const bf16_t* PM = (const bf16_t*)(p.ws + OFF_BIG);
    LAS unsigned char* vT = lds;
    const int row0 = item * 128;
    __syncthreads();
    { const f32x4 lg = *(const f32x4*)(p.in(I_gmlp_ln_g) + l * 256 + lane * 4), lb = *(const f32x4*)(p.in(I_gmlp_ln_b) + l * 256 + lane * 4);
      u32x2 zz[16];
#pragma unroll
      for (int t16 = 0; t16 < 16; ++t16) zz[t16] = *(const u32x2*)(PM + (size_t)(row0 + wave * 16 + t16) * PMW + 1792 + lane * 4);
#pragma unroll
      for (int t16 = 0; t16 < 16; ++t16) { const int tt = wave * 16 + t16;
          f32x4 v = (f32x4){geluf_(bf2f(zz[t16].x & 0xffffu)), geluf_(__uint_as_float(zz[t16].x & 0xffff0000u)), geluf_(bf2f(zz[t16].y & 0xffffu)), geluf_(__uint_as_float(zz[t16].y & 0xffff0000u))};
          const float mean = wave_sum((v[0] + v[1]) + (v[2] + v[3]), lane) * (1.0f / 256.0f);
          v = v - mean;
          const float var = wave_sum((v[0] * v[0] + v[1] * v[1]) + (v[2] * v[2] + v[3] * v[3]), lane) * (1.0f / 256.0f);
          const float rstd = __builtin_amdgcn_rsqf(var + EPS);
          v = v * rstd * lg + lb;
          const int jc = tt >> 3, jo = (tt & 7) * 2;
#pragma unroll
          for (int q = 0; q < 4; ++q) { const int cc = lane * 4 + q; *(LAS unsigned short*)(vT + cc * 256 + ((jc ^ (cc & 15)) << 4) + jo) = f2bf(v[q]); } } }
    __syncthreads();
    const int c = lane & 15, gq = lane >> 4, gw = wave & 3, ih = wave >> 2;
    const float* wsr = p.in(I_gmlp_ws) + (((size_t)l * 4 + gw) * 128 + ih * 64) * 128 + (size_t)c * 128 + 8 * gq;
    const f32x4 z4 = (f32x4){0.f, 0.f, 0.f, 0.f};
    f32x4 acc[4][4];
#pragma unroll
    for (int ib = 0; ib < 4; ++ib)
#pragma unroll
        for (int cb = 0; cb < 4; ++cb) acc[ib][cb] = z4;
    f32x4 wa[4][2], wb[4][2];
#pragma unroll
    for (int ib = 0; ib < 4; ++ib) { wa[ib][0] = *(const f32x4*)(wsr + ib * 16 * 128); wa[ib][1] = *(const f32x4*)(wsr + ib * 16 * 128 + 4); }
#pragma unroll
    for (int t = 0; t < 4; ++t) {
        if (t < 3) {
#pragma unroll
            for (int ib = 0; ib < 4; ++ib) { wb[ib][0] = *(const f32x4*)(wsr + ib * 16 * 128 + 32 * (t + 1)); wb[ib][1] = *(const f32x4*)(wsr + ib * 16 * 128 + 32 * (t + 1) + 4); } }
        bf16x8 bfr[4];
#pragma unroll
        for (int cb = 0; cb < 4; ++cb) { const int cc = 64 * gw + 16 * cb + c; bfr[cb] = *(const LAS bf16x8*)(vT + cc * 256 + (((4 * t + gq) ^ (cc & 15)) << 4)); }
#pragma unroll
        for (int ib = 0; ib < 4; ++ib) {
            union { u32x4 u; bf16x8 v; } af;
            af.u.x = cvt_pk_bf16(wa[ib][0][0], wa[ib][0][1]); af.u.y = cvt_pk_bf16(wa[ib][0][2], wa[ib][0][3]); af.u.z = cvt_pk_bf16(wa[ib][1][0], wa[ib][1][1]); af.u.w = cvt_pk_bf16(wa[ib][1][2], wa[ib][1][3]);
#pragma unroll
            for (int cb = 0; cb < 4; ++cb) acc[ib][cb] = mfma16(af.v, bfr[cb], acc[ib][cb]);
        }
#pragma unroll
        for (int ib = 0; ib < 4; ++ib) { wa[ib][0] = wb[ib][0]; wa[ib][1] = wb[ib][1]; }
    }
    const float* bs = p.in(I_gmlp_bs) + ((size_t)l * 4 + gw) * 128 + ih * 64;
    bf16_t* S = (bf16_t*)(p.ws + OFF_S);
#pragma unroll
    for (int ib = 0; ib < 4; ++ib) {
        unsigned short uu[4][4]; float bsv[4];
#pragma unroll
        for (int r = 0; r < 4; ++r) { const int il = 16 * ib + 4 * gq + r; bsv[r] = bs[il];
#pragma unroll
            for (int cb = 0; cb < 4; ++cb) uu[r][cb] = PM[(size_t)(row0 + ih * 64 + il) * PMW + 1536 + 64 * gw + 16 * cb + c]; }
#pragma unroll
        for (int r = 0; r < 4; ++r) { const int i = ih * 64 + 16 * ib + 4 * gq + r;
#pragma unroll
            for (int cb = 0; cb < 4; ++cb) S[(size_t)(row0 + i) * D + 512 + 64 * gw + 16 * cb + c] = f2bf(geluf_(bf2f(uu[r][cb])) * (acc[ib][cb][r] + bsv[r])); }
    }
}

__device__ __forceinline__ void fnet_t_item(const KP& p, LAS unsigned char* lds, int item) {
    int tid = p.tid_; asm volatile("" : "+v"(tid));
    const bf16_t* PM = (const bf16_t*)(p.ws + OFF_BIG);
    LAS float* T = (LAS float*)lds;
    int seqrow0, L, s_local, cblk, kb; bf16_t* dstbase;
    if (item < GB * 4 * 16) { s_local = item >> 6; cblk = (item >> 4) & 3; kb = item & 15; L = SEQ; seqrow0 = s_local * SEQ; dstbase = (bf16_t*)(p.ws + OFF_PQT); }
    else { const int it2 = item - GB * 4 * 16; s_local = it2 >> 3; cblk = (it2 >> 1) & 3; kb = it2 & 1; L = CTXL; seqrow0 = R_LAT + s_local * CTXL; dstbase = (bf16_t*)(p.ws + OFF_PQTC); }
    __syncthreads();
    for (int idx = tid; idx < 4 * 64 * 8; idx += NTHREADS) { const int which = idx >> 9, r = (idx >> 3) & 63, cc = idx & 7, k = kb * 64 + r;
        const int tok = (which & 1) ? (L - k) : k; const int col = (which < 2 ? 2048 : 2304) + cblk * 64 + cc * 8; float f[8];
        if (tok < L) unpack8(*(const u32x4*)(PM + (size_t)(seqrow0 + tok) * PMW + col), f);
        else {
#pragma unroll
            for (int j = 0; j < 8; ++j) f[j] = 0.f; }
#pragma unroll
        for (int j = 0; j < 8; ++j) T[(which * 64 + r) * 65 + cc * 8 + j] = f[j]; }
    __syncthreads();
    const int c = tid >> 3, kq = tid & 7;
    float pe[8], qo[8];
#pragma unroll
    for (int e = 0; e < 8; ++e) { const int kl = kq * 8 + e; pe[e] = T[(0 * 64 + kl) * 65 + c] + T[(1 * 64 + kl) * 65 + c]; qo[e] = T[(2 * 64 + kl) * 65 + c] - T[(3 * 64 + kl) * 65 + c]; }
    if (kb == 0 && kq == 0) qo[0] = bf2f(PM[(size_t)(seqrow0 + L / 2) * PMW + 2048 + cblk * 64 + c]);
    bf16_t* dst = dstbase + (size_t)(s_local * 256 + cblk * 64 + c) * L;
    *(u32x4*)(dst + kb * 64 + kq * 8) = pack8(pe);
    *(u32x4*)(dst + L / 2 + kb * 64 + kq * 8) = pack8(qo);
}

__device__ __forceinline__ u32x4 ld8p(const bf16_t* p, bool ok) { return ok ? *(const u32x4*)p : (u32x4){0u, 0u, 0u, 0u}; }
__device__ __forceinline__ void fma8(float* y, const u32x4 a, const float* w) { float f[8]; unpack8(a, f);
#pragma unroll
    for (int j = 0; j < 8; ++j) y[j] += f[j] * w[j]; }
__device__ __forceinline__ void phase_ffn_conv(const KP& p, int g, int l, int parts, int b0, int nb, int halves) {
    int tid = p.tid_; asm volatile("" : "+v"(tid));
    if (parts & 1) { float* ssA = (float*)(p.ws + ssa_off(g)); for (int i = p.bx_ * NTHREADS + tid; i < R; i += NBLK * NTHREADS) ssA[i] = 0.f; }
    if (tid >= 352 || p.bx_ < b0 || p.bx_ >= b0 + nb) return;
    bf16_t* UP = (bf16_t*)(p.ws + OFF_BIG);
    const int c8 = tid * 8, G = nb, bx = p.bx_ - b0;
    const float* dw = p.in(I_ffn_dw) + (size_t)l * 9 * DFF + c8; const float* db = p.in(I_ffn_db) + (size_t)l * DFF + c8;
    float w[9][8], bias[8];
#pragma unroll
    for (int k = 0; k < 9; ++k) { const f32x4 w0 = *(const f32x4*)(dw + k * DFF), w1 = *(const f32x4*)(dw + k * DFF + 4);
#pragma unroll
        for (int j = 0; j < 4; ++j) { w[k][j] = w0[j]; w[k][4 + j] = w1[j]; } }
    { const f32x4 b0 = *(const f32x4*)db, b1 = *(const f32x4*)(db + 4);
#pragma unroll
      for (int j = 0; j < 4; ++j) { bias[j] = b0[j]; bias[4 + j] = b1[j]; } }
    if (parts & 2)
    for (int it0 = bx; it0 < GB * 32 * halves; it0 += G) {
        const int rid0 = it0 / halves, hf = it0 - rid0 * halves;
        const int rid = (G == 256 && halves == 1) ? ((rid0 & 7) * 32 + (rid0 >> 3)) : rid0;
        const int gb = rid >> 5, gr = rid & 31;
        const int c_lo = hf * (64 / halves), c_hi = c_lo + 64 / halves;
        const bool up = gr > 0, dn = gr < 31;
        const bf16_t* a1 = UP + (size_t)(gb * SEQ + gr * 64 + c_lo) * UPW + c8;
        const bf16_t* a0 = a1 - (size_t)64 * UPW; const bf16_t* a2 = a1 + (size_t)64 * UPW;
        const bool lf = c_lo > 0;
        u32x4 L0 = ld8p(a0 - UPW, up && lf), L1 = ld8p(a1 - UPW, lf), L2 = ld8p(a2 - UPW, dn && lf), M0 = ld8p(a0, up), M1 = ld8p(a1, true), M2 = ld8p(a2, dn);
        u32x4 R0 = ld8p(a0 + UPW, up), R1 = ld8p(a1 + UPW, true), R2 = ld8p(a2 + UPW, dn);
        bf16_t* hp = UP + (size_t)(gb * SEQ + gr * 64 + c_lo) * UPW + DFF + c8;
        u32x4 bq = *(const u32x4*)hp;
#pragma unroll 1
        for (int gc = c_lo; gc < c_hi; ++gc) {
            const bool nt2 = gc < 62; const size_t o = (size_t)(gc - c_lo + 2) * UPW;
            const u32x4 N0 = ld8p(a0 + o, up && nt2), N1 = ld8p(a1 + o, nt2), N2 = ld8p(a2 + o, dn && nt2);
            const u32x4 bn = ld8p(hp + UPW, gc < 63);
            float y[8];
#pragma unroll
            for (int j = 0; j < 8; ++j) y[j] = bias[j];
            fma8(y, L0, w[0]); fma8(y, M0, w[1]); fma8(y, R0, w[2]);
            fma8(y, L1, w[3]); fma8(y, M1, w[4]); fma8(y, R1, w[5]);
            fma8(y, L2, w[6]); fma8(y, M2, w[7]); fma8(y, R2, w[8]);
            float bv[8]; unpack8(bq, bv);
#pragma unroll
            for (int j = 0; j < 8; ++j) y[j] = siluf_(y[j]) * bv[j];
            *(u32x4*)hp = pack8(y);
            L0 = M0; L1 = M1; L2 = M2; M0 = R0; M1 = R1; M2 = R2; R0 = N0; R1 = N1; R2 = N2; bq = bn; hp += UPW;
        }
    }
    if (parts & 4) {
        for (int it = bx; it < R_CTX / 8; it += G) {
            const int s_ = it >> 5, t0 = (it & 31) * 8;
            const bf16_t* a = UP + (size_t)(R_LAT + s_ * CTXL + t0) * UPW + c8;
            u32x4 Lq = ld8p(a - UPW, t0 > 0), Mq = ld8p(a, true);
#pragma unroll 1
            for (int t = 0; t < 8; ++t) {
                const u32x4 Rq = ld8p(a + (size_t)(t + 1) * UPW, t0 + t + 1 < CTXL);
                bf16_t* hp = UP + (size_t)(R_LAT + s_ * CTXL + t0 + t) * UPW + DFF + c8;
                const u32x4 bq = *(const u32x4*)hp;
                float y[8];
#pragma unroll
                for (int j = 0; j < 8; ++j) y[j] = bias[j];
                fma8(y, Lq, w[3]); fma8(y, Mq, w[4]); fma8(y, Rq, w[5]);
                float bv[8]; unpack8(bq, bv);
#pragma unroll
                for (int j = 0; j < 8; ++j) y[j] = siluf_(y[j]) * bv[j];
                *(u32x4*)hp = pack8(y);
                Lq = Mq; Mq = Rq;
            }
        }
    }
}

#ifndef DUP_LP
#define DUP_LP 0
#endif

__device__ __forceinline__ unsigned wl_off(int l) { return (unsigned)OFF_W + (unsigned)l * (unsigned)W_LAYER; }
__device__ __forceinline__ unsigned mod_off(int l) { return (unsigned)OFF_MOD + (unsigned)l * (unsigned)(17 * 6144 * 4); }

__device__ __forceinline__ void ph_l1(const KP& p, LAS unsigned char* lds, int g, int l) {
    unsigned char* ws = p.ws; const bool ctx_full = (g == 0 && l == 0);
    pg8::TileSched S{}; S.G = NBLK; S.c = p.bx_; S.nseg = 1;
    S.n1M = NLT; S.n1N = NCOLS / 256; S.n2M = g == 0 ? NCT : 0; S.n2N = ctx_full ? NCOLS / 256 : 2; S.pn2_0 = ctx_full ? 0 : 1;
    S.A = ap_off(g); S.B = (unsigned)(wl_off(l) + (unsigned)W_IN); S.a_tstep = (unsigned)256 * D * 2; S.b_tstep = (unsigned)256 * D * 2;
    EpiWin E{(const float*)(ws + ssa_off(g)), (const float*)(ws + (unsigned)OFF_SHW1 + (unsigned)l * (unsigned)(17 * NCOLS * 4)), p.in(I_b_gate) + (size_t)l * GTW, (bf16_t*)(ws + OFF_BIG), (bf16_t*)(ws + OFF_GT), g};
    pg8::gemm_phase(lds, p.ws, p.tid_, D, D, D, true, S, E);
}
__device__ __forceinline__ void ph_l2(const KP& p, LAS unsigned char* lds, int g, int l) {
    const bool ctx_full = (g == 0 && l == 0); const int G = NBLK;
    const int n_kv = g == 0 ? N_KV : N_KV_LAT, n_conf = (ctx_full ? R : R_LAT) / 32, n_gm = (ctx_full ? R : R_LAT) / 128, n_fn = GB * 4 * 16 + (ctx_full ? NB * 4 * 2 : 0);
    const int total = n_kv + n_conf + n_gm + n_fn;
    { float* ssB = (float*)(p.ws + ssb_off(g)); for (int i = p.bx_ * NTHREADS + p.tid_; i < R; i += G * NTHREADS) ssB[i] = 0.f; }
    const int bx = p.bx_, n_small = total - n_gm, nb2 = G - n_gm, head = (nb2 > 0 && 7 * nb2 < n_small) ? 7 * nb2 : 0;
#define L2_SMALL(t_) do { int t = (t_); if (t < n_kv) ret_kv_item(p, lds, l, t); else if ((t -= n_kv) < n_fn) fnet_t_item(p, lds, t); else conf_item(p, lds, l, t - n_fn); } while (0)
    if (bx < n_gm) gmlp_item(p, lds, l, bx);
    else if (head) { for (int r7 = 0; r7 < 7; ++r7) L2_SMALL(r7 * nb2 + (bx - n_gm)); }
    for (int t2 = head + bx; t2 < n_small; t2 += G) L2_SMALL(t2);
#undef L2_SMALL
    __syncthreads();
}
__device__ __forceinline__ void ph_l3(const KP& p, LAS unsigned char* lds, int g, int l) {
    unsigned char* ws = p.ws; const bool ctx_full = (g == 0 && l == 0); const int G = NBLK, bx = p.bx_;
    const int nd = 64 + (ctx_full ? NB : 0);
    if (bx < nd) {
        const bool isc = bx >= 64;
        const int Kd = isc ? CTXL : SEQ;
        pg8::TileSched S{}; S.G = G; S.nseg = 1;
        S.n1M = isc ? 1 : 8; S.n1N = isc ? NB : GB; S.c = isc ? bx - 64 : bx;
        S.A = (unsigned)((isc ? OFF_DC : OFF_DM)); S.B = (unsigned)((isc ? OFF_PQTC : OFF_PQT)); S.a_tstep = (unsigned)256 * Kd * 2; S.b_tstep = (unsigned)256 * Kd * 2;
        EpiDft E{(bf16_t*)(ws + OFF_S), isc ? R_LAT : 0, Kd, isc ? 0.0625f : 0.02209708691207961f};
        pg8::gemm_phase(lds, p.ws, p.tid_, Kd, Kd, Kd, true, S, E);
    } else {
        const int n = ctx_full ? N_KV : N_KV_LAT;
        for (int it = bx - nd; it < n; it += G - nd) ret_out_item(p, lds, g, l, it);
        __syncthreads();
    }
}
__device__ __forceinline__ void ph_l5(const KP& p, LAS unsigned char* lds, int g, int l) {
    unsigned char* ws = p.ws; const bool ctx_full = (g == 0 && l == 0);
    pg8::TileSched S{}; S.G = NBLK; S.c = p.bx_; S.nseg = 4;
    S.n1M = NLT; S.n1N = 4; S.n2M = ctx_full ? NCT : 0; S.n2N = 4;
    S.A = (unsigned)(OFF_S); S.B = (unsigned)(wl_off(l) + (unsigned)W_O); S.a_tstep = (unsigned)256 * D * 2; S.b_tstep = (unsigned)256 * 256 * 2; S.a_segstep = (unsigned)256 * 2; S.b_segstep = (unsigned)1024 * 256 * 2;
    EpiMerge E{(const unsigned char*)(ws + OFF_GT), (bf16_t*)(ws + OFF_BIG)};
    pg8::gemm_phase(lds, p.ws, p.tid_, 256, D, 256, true, S, E);
}
__device__ __forceinline__ void ph_l6(const KP& p, LAS unsigned char* lds, int g, int l) {
    unsigned char* ws = p.ws; const bool ctx_full = (g == 0 && l == 0);
    pg8::TileSched S{}; S.G = NBLK; S.c = p.bx_; S.nseg = 1;
    S.n1M = NLT; S.n1N = 4; S.n2M = ctx_full ? NCT : 0; S.n2N = 4;
    S.A = (unsigned)(OFF_BIG); S.B = (unsigned)(wl_off(l) + (unsigned)W_OUT); S.a_tstep = (unsigned)256 * D * 2; S.b_tstep = (unsigned)256 * D * 2;
    EpiResid E{l == 0 ? p.in(I_x) : (const float*)p.out, l == 0 ? p.in(I_ctx) : (const float*)(ws + OFF_XC), p.out, (float*)(ws + OFF_XC),
               (const float*)(ws + mod_off(l) + 2 * 4096), (const float*)(ws + mod_off(l) + 4 * 4096), (bf16_t*)(ws + ap_off(g)), (float*)(ws + ssb_off(g)), g};
    pg8::gemm_phase(lds, p.ws, p.tid_, D, D, D, false, S, E);
}
__device__ __forceinline__ void ph_l7(const KP& p, LAS unsigned char* lds, int g, int l) {
    unsigned char* ws = p.ws; const bool ctx_full = (g == 0 && l == 0);
    pg8::TileSched S{}; S.G = NBLK; S.c = p.bx_; S.nseg = 1;
    S.n1M = NLT; S.n1N = UPW / 256; S.n2M = ctx_full ? NCT : 0; S.n2N = UPW / 256;
    S.A = ap_off(g); S.B = (unsigned)(wl_off(l) + (unsigned)W_UP); S.a_tstep = (unsigned)256 * D * 2; S.b_tstep = (unsigned)256 * D * 2;
    EpiUp E{(const float*)(ws + ssb_off(g)), (const float*)(ws + (unsigned)OFF_SHW2 + (unsigned)l * (unsigned)(17 * UPW * 4)), (bf16_t*)(ws + OFF_BIG), g};
    pg8::gemm_phase(lds, p.ws, p.tid_, D, D, D, true, S, E);
}
__device__ __forceinline__ void ph_l9(const KP& p, LAS unsigned char* lds, int g, int l, int which = 0) {
    unsigned char* ws = p.ws; const bool ctx_full = (g == 0 && l == 0);
    pg8::TileSched S{}; S.G = NBLK; S.c = p.bx_; S.nseg = 1;
    S.n1M = which == 2 ? 0 : NLT; S.n1N = 4; S.n2M = (ctx_full && which != 1) ? NCT : 0; S.n2N = 4;
    if (which == 2) S.pm2_x = NLT;
    S.A = (unsigned)OFF_BIG + (unsigned)DFF * 2u; S.B = (unsigned)(wl_off(l) + (unsigned)W_DN); S.a_tstep = (unsigned)256 * UPW * 2; S.b_tstep = (unsigned)256 * DFF * 2;
    EpiResid E{p.out, (const float*)(ws + OFF_XC), p.out, (float*)(ws + OFF_XC), (const float*)(ws + mod_off(l) + 5 * 4096),
               l == 0 ? (const float*)(ws + mod_off(1) + 4096) : nullptr, (bf16_t*)(ws + ap_off(g)), (float*)(ws + ssa_off(g)), g};
    pg8::gemm_phase(lds, p.ws, p.tid_, DFF, UPW, DFF, false, S, E);
}

__global__ void __launch_bounds__(NTHREADS) mega(KArgs a) {
    extern __shared__ __attribute__((aligned(16))) unsigned char lds_raw[];
    LAS unsigned char* lds = (LAS unsigned char*)lds_raw;
    volatile LAS unsigned* misc = (volatile LAS unsigned*)(lds + MISC_OFF);
    if (threadIdx.x < 64) misc[threadIdx.x] = 0u;
    if (threadIdx.x < 30) { const unsigned long long v = (unsigned long long)a.in[threadIdx.x]; LAS unsigned* t = (LAS unsigned*)(lds + PTAB_OFF) + 2 * threadIdx.x; t[0] = (unsigned)v; t[1] = (unsigned)(v >> 32); }
    __syncthreads();
    const int wid_s = __builtin_amdgcn_readfirstlane((int)(threadIdx.x >> 6));
    cg::grid_group grid = cg::this_grid();
    XcdBarrier xb = xcd_barrier_post((unsigned*)(a.ws + OFF_BAR), misc + 8);
    grid.sync();
#define MK_Q() KP q; { int w_ = wid_s, b_ = blockIdx.x; unsigned z_ = 0u; asm volatile("" : "+s"(w_), "+s"(b_), "+s"(z_)); int t_ = (w_ << 6) | (int)__builtin_amdgcn_mbcnt_hi(~0u, __builtin_amdgcn_mbcnt_lo(~0u, z_)); asm volatile("" : "+v"(t_)); q.tid_ = t_; q.bx_ = b_; q.ws = a.ws + z_; q.out = a.out + z_; q.ldsb = lds; q.ptab = lds + PTAB_OFF + z_; }
#define PHASE(call) do { MK_Q(); call; xcd_barrier(xb); } while (0)
    PHASE(phase_prep_a(q, lds));
    PHASE(phase_prep_b(q));
    PHASE(phase_prep_c(q, lds, 0, 1, 0, NBLK); phase_g0(q, 0, 0, NBLK));
    for (int g = 0; g < NG; ++g) {
        for (int l = 0; l < 2; ++l) {
            { MK_Q(); ph_l1(q, lds, g, l); }
            PHASE(if (g == 0 && l == 0) weight_prep(q, lds, 1, 2, 32, NBLK - 32);
                  if (g == 1 && l == 0) phase_final(q, 0, 128, NBLK - 128));
            if (DUP_LP == 1) PHASE(ph_l1(q, lds, g, l));
            PHASE(ph_l2(q, lds, g, l));
            if (DUP_LP == 2) PHASE(ph_l2(q, lds, g, l));
            PHASE(ph_l3(q, lds, g, l));
            if (DUP_LP == 3) PHASE(ph_l3(q, lds, g, l));
            PHASE(ph_l5(q, lds, g, l); if (g == 0 && l == 0) phase_prep_c(q, lds, 1, 2, 64, NBLK - 64));
            if (DUP_LP == 5) PHASE(ph_l5(q, lds, g, l));
            PHASE(ph_l6(q, lds, g, l); if (g == 0 && l == 0) phase_g0(q, 1, 64, NBLK - 64));
            PHASE(ph_l7(q, lds, g, l));
            if (DUP_LP == 7) PHASE(ph_l7(q, lds, g, l));
            if (g == 0 && l == 0) {
                PHASE(phase_ffn_conv(q, g, l, 1 | 4, 0, NBLK, 1));
                PHASE(ph_l9(q, lds, g, l, 2); phase_ffn_conv(q, g, l, 2, 64, NBLK - 64, 4));
                PHASE(ph_l9(q, lds, g, l, 1));
            } else {
                PHASE(phase_ffn_conv(q, g, l, 1 | 2, 0, NBLK, 1));
                PHASE(ph_l9(q, lds, g, l));
            }
        }
        if (g == NG - 1) { MK_Q(); phase_final(q, g, 0, NBLK); }
    }
#undef PHASE
#undef MK_Q
}

extern "C" void kernel_launch(void* const* d_in, const int* in_sizes, int n_in, void* d_out, int out_size, void* d_ws, size_t ws_size, hipStream_t stream) {
    static int grid = 0;
    if (grid == 0) {
        int dev = 0, cus = 0, per_cu = 0;
        (void)hipGetDevice(&dev);
        (void)hipDeviceGetAttribute(&cus, hipDeviceAttributeMultiprocessorCount, dev);
        (void)hipFuncSetAttribute((const void*)mega, hipFuncAttributeMaxDynamicSharedMemorySize, LDS_BYTES);
        (void)hipOccupancyMaxActiveBlocksPerMultiprocessor(&per_cu, (const void*)mega, NTHREADS, LDS_BYTES);
        grid = NBLK;
        if (n_in != 30 || ws_size < WS_END || per_cu < 1 || cus * per_cu < NBLK) { fprintf(stderr, "kernel_launch: unexpected n_in %d / ws %zu (need %zu) / per_cu %d\n", n_in, ws_size, (size_t)WS_END, per_cu); }
    }
    (void)hipMemsetAsync(d_ws, 0, 16384, stream);
    KArgs a{};
    for (int i = 0; i < 30; ++i) a.in[i] = (const float*)d_in[i];
    a.out = (float*)d_out; a.ws = (unsigned char*)d_ws;
    void* args[] = {&a};
    hipError_t e = hipLaunchCooperativeKernel((const void*)mega, dim3(grid), dim3(NTHREADS), args, LDS_BYTES, stream);
    if (e != hipSuccess) fprintf(stderr, "cooperative launch failed: %s (grid %d)\n", hipGetErrorString(e), grid);
}
```

```cpp
#include <hip/hip_runtime.h>
#include <hip/hip_cooperative_groups.h>
#include <cstdio>
#include <cstdint>
namespace cg = cooperative_groups;

#define LAS __attribute__((address_space(3)))
typedef unsigned short bf16_t;
typedef short bf16x8 __attribute__((ext_vector_type(8)));
typedef float f32x4 __attribute__((ext_vector_type(4)));
typedef float f32x2 __attribute__((ext_vector_type(2)));
typedef unsigned u32x4 __attribute__((ext_vector_type(4)));
typedef unsigned u32x2 __attribute__((ext_vector_type(2)));

#ifndef ONE_LAUNCH
#define ONE_LAUNCH 1
#endif

constexpr int NTHREADS = 512, NWAVES = 8;
constexpr int NBLK = 256;
constexpr int D = 1024, NB = 16, SEQ = 2048, CTXL = 256, DFF = 2816;
constexpr int NCOLS = 6656;
constexpr int PMW = 2560, GTW = 4096, UPW = 5632;
constexpr int IN_COLS = 6400;
constexpr float EPS = 1e-6f;
constexpr int NG = 2, GB = 8;
constexpr int R_LAT = GB * SEQ, R_CTX = NB * CTXL, R = R_LAT + R_CTX;
constexpr int NLT = R_LAT / 256, NCT = R_CTX / 256;
constexpr int N_KV_LAT = GB * 4 * 16, N_KV_CTX = NB * 4 * 2, N_KV = N_KV_LAT + N_KV_CTX;

constexpr size_t al256(size_t x) { return (x + 255) & ~(size_t)255; }
constexpr size_t OFF_BAR = 0;
constexpr size_t OFF_ADAP = 65536;
constexpr size_t OFF_MOD = OFF_ADAP + al256((size_t)8 * 2 * 17 * 6144 * 4);
constexpr size_t OFF_SHW1 = OFF_MOD + al256((size_t)2 * 17 * 6144 * 4);
constexpr size_t OFF_SHW2 = OFF_SHW1 + al256((size_t)2 * 17 * NCOLS * 4);
constexpr size_t OFF_ROPE = OFF_SHW2 + al256((size_t)2 * 17 * UPW * 4);
constexpr size_t OFF_LOGG = OFF_ROPE + al256((size_t)2 * 2304 * 32 * 4);
constexpr size_t OFF_DM = OFF_LOGG + 256;
constexpr size_t OFF_DC = OFF_DM + (size_t)2048 * 2048 * 2;
constexpr size_t OFF_W = OFF_DC + (size_t)256 * 256 * 2;
constexpr size_t W_IN = 0, W_O = W_IN + (size_t)NCOLS * 1024 * 2, W_OUT = W_O + (size_t)4 * 1024 * 256 * 2, W_UP = W_OUT + (size_t)1024 * 1024 * 2,
                 W_DN = W_UP + (size_t)UPW * 1024 * 2, W_LAYER = W_DN + (size_t)1024 * DFF * 2;
constexpr size_t OFF_XC = OFF_W + 2 * W_LAYER;
constexpr size_t OFF_AP = OFF_XC + (size_t)NB * CTXL * D * 4;
constexpr size_t OFF_AP1 = OFF_AP + (size_t)R * D * 2;
constexpr size_t OFF_SS = OFF_AP1 + (size_t)R_LAT * D * 2;
constexpr size_t OFF_S = OFF_SS + (size_t)R * 16 * 4;
constexpr size_t OFF_KV = OFF_S + (size_t)R * D * 2;
constexpr size_t OFF_KVC = OFF_KV + (size_t)N_KV_LAT * 2 * 4096 * 4;
constexpr size_t OFF_PQT = OFF_KVC + (size_t)2 * N_KV_CTX * 2 * 4096 * 4;
constexpr size_t OFF_PQTC = OFF_PQT + (size_t)GB * 256 * 2048 * 2;
constexpr size_t OFF_BIG = OFF_PQTC + (size_t)NB * 256 * 256 * 2;
constexpr size_t OFF_GT = OFF_BIG + (size_t)R * PMW * 2;
constexpr size_t WS_END = OFF_BIG + ((size_t)R * PMW * 2 + (size_t)R * GTW > (size_t)R * UPW * 2 ? (size_t)R * PMW * 2 + (size_t)R * GTW : (size_t)R * UPW * 2);
static_assert(WS_END <= (size_t)512 * 1024 * 1024, "workspace map exceeds 512 MiB");
static_assert((size_t)R * UPW * 2 <= WS_END - OFF_BIG, "UP overlay");

constexpr int SCR_BYTES = 139264;
constexpr int MISC_OFF = SCR_BYTES;
constexpr int LDS_BYTES = 161792;

__device__ __forceinline__ float bf2f(unsigned v) { return __uint_as_float(v << 16); }
__device__ __forceinline__ unsigned cvt_pk_bf16(float lo, float hi) { unsigned r; asm volatile("v_cvt_pk_bf16_f32 %0, %1, %2" : "=v"(r) : "v"(lo), "v"(hi)); return r; }
__device__ __forceinline__ bf16_t f2bf(float f) { return (bf16_t)(cvt_pk_bf16(f, 0.f) & 0xffffu); }
__device__ __forceinline__ void unpack8(const u32x4 w, float* f) {
    f[0] = bf2f(w.x & 0xffffu); f[1] = __uint_as_float(w.x & 0xffff0000u); f[2] = bf2f(w.y & 0xffffu); f[3] = __uint_as_float(w.y & 0xffff0000u);
    f[4] = bf2f(w.z & 0xffffu); f[5] = __uint_as_float(w.z & 0xffff0000u); f[6] = bf2f(w.w & 0xffffu); f[7] = __uint_as_float(w.w & 0xffff0000u);
}
__device__ __forceinline__ u32x4 pack8(const float* f) { u32x4 w; w.x = cvt_pk_bf16(f[0], f[1]); w.y = cvt_pk_bf16(f[2], f[3]); w.z = cvt_pk_bf16(f[4], f[5]); w.w = cvt_pk_bf16(f[6], f[7]); return w; }
__device__ __forceinline__ float shx(float v, int m, int lane) { return __int_as_float(__builtin_amdgcn_ds_bpermute((lane ^ m) << 2, __float_as_int(v))); }
template <int CTRL> __device__ __forceinline__ float dpp_mov(float v) { return __int_as_float(__builtin_amdgcn_update_dpp(0, __float_as_int(v), CTRL, 0xF, 0xF, false)); }
__device__ __forceinline__ float wave_sum(float v, int  ) {
    v += dpp_mov<0xB1>(v); v += dpp_mov<0x4E>(v); v += dpp_mov<0x141>(v); v += dpp_mov<0x140>(v);
    const int vi = __float_as_int(v);
    const float s0 = __int_as_float(__builtin_amdgcn_readlane(vi, 0)), s1 = __int_as_float(__builtin_amdgcn_readlane(vi, 16)), s2 = __int_as_float(__builtin_amdgcn_readlane(vi, 32)), s3 = __int_as_float(__builtin_amdgcn_readlane(vi, 48));
    return (s0 + s1) + (s2 + s3);
}
__device__ __forceinline__ float fast_rcp(float x) { return __builtin_amdgcn_rcpf(x); }
__device__ __forceinline__ float sigmoidf_(float x) { return fast_rcp(1.f + __expf(-x)); }
__device__ __forceinline__ float siluf_(float x) { return x * sigmoidf_(x); }
__device__ __forceinline__ float geluf_(float v) {
    const float av = fabsf(v), d = av * 0.2316418882f + 1.0f;
    const float t = fast_rcp(d);
    float q = t * 0.5307027145f + (-0.7265760135f); q = q * t + 0.7107068705f; q = q * t + (-0.142248368f); q = q * t + 0.127414796f; q = q * t;
    const float e = __builtin_amdgcn_exp2f((v * v) * (-0.72134752044f));
    const float m = v * (q * e);
    return v < 0.f ? m : v - m;
}
__device__ __forceinline__ f32x4 mfma16(bf16x8 a, bf16x8 b, f32x4 c) { return __builtin_amdgcn_mfma_f32_16x16x32_bf16(a, b, c, 0, 0, 0); }
__device__ __forceinline__ float sin_rev(float r) { return __builtin_amdgcn_sinf(r); }
__device__ __forceinline__ float cos_rev(float r) { return __builtin_amdgcn_cosf(r); }

#define XB_TMO      128
#define XB_XCNT(j)  (256  + 64 * (j))
#define XB_XSUB(j)  (1280 + 64 * (j))
#define XB_XGEN(j)  (2304 + 64 * (j))
#define XB_TOP      3328
#define XB_TOPGEN   3392
#define XCD_BAR_WORDS 3456
#define XB_SPIN_CAP (1u << 20)
__device__ __forceinline__ unsigned xb_ld(unsigned* p)              { return __hip_atomic_load(p, __ATOMIC_RELAXED, __HIP_MEMORY_SCOPE_AGENT); }
__device__ __forceinline__ unsigned xb_add(unsigned* p, unsigned v) { return __hip_atomic_fetch_add(p, v, __ATOMIC_RELAXED, __HIP_MEMORY_SCOPE_AGENT); }
__device__ __forceinline__ unsigned xb_xcc_id() { return (unsigned)__builtin_amdgcn_s_getreg((3 << 11) | 20) & 0xFu; }
#define XB_SPIN(cond, bar) do { unsigned _sp = 0; while (cond) { __builtin_amdgcn_s_sleep(1); \
    if ((++_sp & 255u) == 0u) { if (xb_ld(&(bar)[XB_TMO])) break; if (_sp > XB_SPIN_CAP) { atomicAdd(&(bar)[XB_TMO], 1u); break; } } } } while (0)
struct XcdBarrier { unsigned* bar; unsigned x; volatile LAS unsigned* st; };
__device__ __forceinline__ XcdBarrier xcd_barrier_post(unsigned* bar, volatile LAS unsigned* st) {
    XcdBarrier b; b.bar = bar; b.x = xb_xcc_id(); b.st = st;
    if (threadIdx.x == 0) (void)xb_add(&bar[XB_XCNT(b.x)], 1u);
    return b;
}
__device__ __forceinline__ void xcd_barrier_complete(unsigned* bar, unsigned x, unsigned& nloc, unsigned& nx) {
    const unsigned G = NBLK;
    unsigned sum, cnt, mine, sp = 0u;
    for (;;) {
        sum = 0u; cnt = 0u; mine = 0u;
#pragma unroll
        for (unsigned j = 0; j < 16; ++j) { const unsigned c = xb_ld(&bar[XB_XCNT(j)]); sum += c; cnt += (c > 0u) ? 1u : 0u; mine = (j == x) ? c : mine; }
        if (sum == G) break;
        __builtin_amdgcn_s_sleep(1);
        if ((++sp & 255u) == 0u) { if (xb_ld(&bar[XB_TMO])) break; if (sp > XB_SPIN_CAP) { atomicAdd(&bar[XB_TMO], 1u); break; } }
    }
    nloc = mine > 0u ? mine : 1u; nx = cnt > 0u ? cnt : 1u;
}
__device__ __forceinline__ void xcd_barrier(const XcdBarrier& b) {
    asm volatile("s_waitcnt vmcnt(0)" ::: "memory");
    __syncthreads();
    if (threadIdx.x == 0) {
        unsigned* bar = b.bar; unsigned bx_ = b.x; asm volatile("" : "+s"(bx_));
        __builtin_amdgcn_s_waitcnt(0);
        unsigned nloc = b.st[0], nx = b.st[1];
        if (nloc == 0u) { xcd_barrier_complete(bar, bx_, nloc, nx); b.st[0] = nloc; b.st[1] = nx; }
        const unsigned old = xb_add(&bar[XB_XSUB(bx_)], 1u);
        const unsigned gen = old / nloc;
        if (old + 1u == (gen + 1u) * nloc) {
            __builtin_amdgcn_fence(__ATOMIC_RELEASE, "agent");
            asm volatile("s_waitcnt vmcnt(0)" ::: "memory");
            const unsigned og = xb_add(&bar[XB_TOP], 1u);
            const unsigned tg = og / nx;
            if (og + 1u == (tg + 1u) * nx) xb_add(&bar[XB_TOPGEN], 1u);
            else XB_SPIN(xb_ld(&bar[XB_TOPGEN]) == tg, bar);
            __builtin_amdgcn_fence(__ATOMIC_ACQUIRE, "agent");
            xb_add(&bar[XB_XGEN(bx_)], 1u);
            asm volatile("s_waitcnt vmcnt(0)" ::: "memory");
        } else {
            XB_SPIN(xb_ld(&bar[XB_XGEN(bx_)]) == gen, bar);
            __builtin_amdgcn_fence(__ATOMIC_ACQUIRE, "agent");
            asm volatile("s_waitcnt vmcnt(0)" ::: "memory");
        }
    }
    __syncthreads();
}

namespace pg8 {
constexpr int BM = 256, BK = 64, HALF = 128, HTB = HALF * BK * 2, NXCD = 8, WGM = 8;
__host__ __device__ __forceinline__ int lds_byte(int r, int c) { const int st = (r >> 4) * 2 + (c >> 5), rr = r & 15, cc = c & 31, ob = rr * 64 + cc * 2; return st * 1024 + (ob ^ (((ob >> 9) & 1) << 5)); }
__host__ __device__ __forceinline__ void stage_rc(int b, int& R_, int& C_) { const int st = b / 1024, sb = b % 1024, swz = sb ^ (((sb >> 9) & 1) << 5); R_ = (st >> 1) * 16 + swz / 64; C_ = (st & 1) * 32 + (swz % 64) / 2; }
__host__ __device__ __forceinline__ int perm32(int rho) { const int n = rho >> 4, i = rho & 15; return 8 * (i >> 2) + 4 * n + (i & 3); }

struct Unit { int pm, pn, seg; unsigned A, B; };
__device__ __forceinline__ const char* sgpr_ptr(const char* p) {
    const unsigned long long v = (unsigned long long)p;
    const unsigned lo = (unsigned)__builtin_amdgcn_readfirstlane((int)(unsigned)v), hi = (unsigned)__builtin_amdgcn_readfirstlane((int)(unsigned)(v >> 32));
    typedef const char __attribute__((address_space(1)))* gp_t;
    return (const char*)(gp_t)(((unsigned long long)hi << 32) | (unsigned long long)lo);
}

__device__ __forceinline__ void tile_order(int L, int nM, int nN, int& pm, int& pn) {
    const int nwg = nM * nN; int wgid = L;
    { const int q = nwg / NXCD, r = nwg % NXCD, xcd = wgid % NXCD, off = wgid / NXCD; wgid = (xcd < r ? xcd * (q + 1) : r * (q + 1) + (xcd - r) * q) + off; }
    const int nig = WGM * nN, gid = wgid / nig, fm = gid * WGM, gsz = (nM - fm) < WGM ? (nM - fm) : WGM;
    pm = fm + ((wgid % nig) % gsz); pn = (wgid % nig) / gsz;
}
struct TileSched {
    int n1M, n1N, n2M, n2N, pn2_0, pm2_x, G, c, nseg;
    unsigned A, B, a_tstep, b_tstep, a_segstep, b_segstep;
    __device__ __forceinline__ bool next(int i, Unit& u) const {
        const int ti = i / nseg, seg = i - ti * nseg;
        const int L = ti * G + c, n1 = n1M * n1N, n2 = n2M * n2N;
        int pm, pn;
        if (L < n1) tile_order(L, n1M, n1N, pm, pn);
        else if (L < n1 + n2) { tile_order(L - n1, n2M, n2N, pm, pn); pm += n1M + pm2_x; pn += pn2_0; }
        else return false;
        pm = __builtin_amdgcn_readfirstlane(pm); pn = __builtin_amdgcn_readfirstlane(pn);
        u.pm = pm; u.pn = pn; u.seg = seg;
        u.A = A + (unsigned)pm * a_tstep + (unsigned)seg * a_segstep; u.B = B + (unsigned)pn * b_tstep + (unsigned)seg * b_segstep;
        return true;
    }
};

struct NoPre {};
constexpr int TB_OFF = 131072;
constexpr int SHB_OFF = 147456;
template <class Epi, class Sched>
__device__ __forceinline__ void gemm_phase(LAS unsigned char* lds, const unsigned char* wsb, const int tid_in, const int K, const int lda, const int ldb, const bool perm, const Sched& S, const Epi& E) {
    __builtin_amdgcn_s_waitcnt(0x0F70);
    int tid = tid_in; asm volatile("" : "+v"(tid));
    const int wid = __builtin_amdgcn_readfirstlane(tid >> 6), lane = tid & 63, wr = wid >> 2, wc = wid & 3, fr = lane & 15, fq = lane >> 4;
    const int nt = K / BK;
    unsigned voffA[2], voffB[2];
#pragma unroll
    for (int i = 0; i < 2; ++i) { int R_, C_; stage_rc(tid * 16 + i * 8192, R_, C_); const int Rb = perm ? ((R_ & ~31) + perm32(R_ & 31)) : R_;
        voffA[i] = (unsigned)(R_ * lda + C_) * 2u; voffB[i] = (unsigned)(Rb * ldb + C_) * 2u; }
    const unsigned kstep = (unsigned)(BK * 2);
    const unsigned hA = (unsigned)HALF * lda * 2, hB = (unsigned)HALF * ldb * 2;
    const unsigned ldsw = (unsigned)wid * 1024u;
    const int aoff = lds_byte(wr * 64 + fr, fq * 8), boff = lds_byte(wc * 32 + fr, fq * 8);
#define PG8_SA(b, h) (((b) * 2 + (h)) * HTB)
#define PG8_SB(b, h) ((4 + (b) * 2 + (h)) * HTB)
#define PG8_STAGE(bufoff, goff, voff) do { _Pragma("unroll") for (int _i = 0; _i < 2; ++_i) \
        __builtin_amdgcn_global_load_lds((const unsigned*)(wsb + (unsigned)((goff) + (voff)[_i])), (LAS unsigned*)(lds + (bufoff) + ldsw + _i * 8192), 16, 0, 0); } while (0)
#define PG8_LDA(dst, b, h) do { _Pragma("unroll") for (int m = 0; m < 4; ++m) _Pragma("unroll") for (int k = 0; k < 2; ++k) dst[m][k] = *(const LAS bf16x8*)(lds + PG8_SA(b, h) + aoff + m * 2048 + k * 1024); } while (0)
#define PG8_LDB(dst, b, h) do { _Pragma("unroll") for (int n = 0; n < 2; ++n) _Pragma("unroll") for (int k = 0; k < 2; ++k) dst[n][k] = *(const LAS bf16x8*)(lds + PG8_SB(b, h) + boff + n * 2048 + k * 1024); } while (0)
#define PG8_MMA(ai, bj, At, Bt) do { __builtin_amdgcn_s_setprio(1); _Pragma("unroll") for (int m = 0; m < 4; ++m) _Pragma("unroll") for (int n = 0; n < 2; ++n) _Pragma("unroll") for (int k = 0; k < 2; ++k) \
        acc[ai][bj][m][n] = __builtin_amdgcn_mfma_f32_16x16x32_bf16(Bt[n][k], At[m][k], acc[ai][bj][m][n], 0, 0, 0); __builtin_amdgcn_s_setprio(0); } while (0)
#define PG8_WAIT_V(n) asm volatile("s_waitcnt vmcnt(" #n ")" ::: "memory")
#define PG8_WAIT_VN(n) asm volatile("s_waitcnt vmcnt(%0)" :: "n"(n) : "memory")
#define PG8_WAIT_L(n) asm volatile("s_waitcnt lgkmcnt(" #n ")" ::: "memory")
#define PG8_BAR __builtin_amdgcn_s_barrier()
#define PG8_SCHED __builtin_amdgcn_sched_barrier(0)
#define PG8_ZERO() do { _Pragma("unroll") for (int a = 0; a < 2; ++a) _Pragma("unroll") for (int b = 0; b < 2; ++b) _Pragma("unroll") for (int m = 0; m < 4; ++m) _Pragma("unroll") for (int n = 0; n < 2; ++n) acc[a][b][m][n] = (f32x4){0.f, 0.f, 0.f, 0.f}; } while (0)
    Unit cur, nxt; int ui = 0;
    if (!S.next(0, cur)) return;
    f32x4 acc[2][2][4][2];
    PG8_ZERO();
    bf16x8 At[4][2], B0[2][2], B1[2][2];
    unsigned cA = cur.A, cB = cur.B;
    E.prefetch(cur, wid, lane, lds + SHB_OFF);
    typename Epi::Pre pre = E.pre(cur, wr, wc, fr, fq);
    PG8_STAGE(PG8_SB(0, 0), cB, voffB); PG8_STAGE(PG8_SB(0, 1), cB + hB, voffB); PG8_STAGE(PG8_SA(0, 0), cA, voffA); PG8_STAGE(PG8_SA(0, 1), cA + hA, voffA);
    if (wr == 1) PG8_BAR;
    PG8_WAIT_V(2); PG8_BAR;
    PG8_STAGE(PG8_SB(1, 0), cB + kstep, voffB); PG8_STAGE(PG8_SA(1, 0), cA + kstep, voffA); PG8_STAGE(PG8_SB(1, 1), cB + hB + kstep, voffB);
    PG8_WAIT_V(6); PG8_BAR;
    for (;;) {
        const bool has_next = S.next(ui + 1, nxt);
        const unsigned nA = has_next ? nxt.A : cA, nB = has_next ? nxt.B : cB;
#define PG8_PASS(WX) do { \
            const bool last = (t == nt - 2); \
            unsigned tk = (unsigned)t * (unsigned)kstep; asm volatile("" : "+s"(tk)); \
            const unsigned a1 = cA + tk + kstep; \
            const unsigned a2 = last ? nA : cA + tk + 2 * kstep, b2 = last ? nB : cB + tk + 2 * kstep; \
            const unsigned a3 = a2 + kstep, b3 = b2 + kstep; \
            PG8_LDB(B0, 0, 0); PG8_LDB(B1, 0, 1); PG8_SCHED; PG8_LDA(At, 0, 0); PG8_STAGE(PG8_SA(1, 1), a1 + hA, voffA); \
            WX; PG8_WAIT_L(0); PG8_BAR; PG8_MMA(0, 0, At, B0); PG8_MMA(0, 1, At, B1); PG8_BAR; PG8_SCHED; \
            PG8_LDA(At, 0, 1); PG8_STAGE(PG8_SB(0, 0), b2, voffB); PG8_STAGE(PG8_SB(0, 1), b2 + hB, voffB); PG8_STAGE(PG8_SA(0, 0), a2, voffA); \
            WX; PG8_WAIT_L(0); PG8_BAR; PG8_MMA(1, 0, At, B0); PG8_MMA(1, 1, At, B1); PG8_BAR; PG8_SCHED; \
            PG8_LDB(B0, 1, 0); PG8_LDB(B1, 1, 1); PG8_SCHED; PG8_LDA(At, 1, 0); PG8_STAGE(PG8_SA(0, 1), a2 + hA, voffA); \
            PG8_WAIT_V(8); PG8_WAIT_L(0); PG8_BAR; PG8_MMA(0, 0, At, B0); PG8_MMA(0, 1, At, B1); PG8_BAR; PG8_SCHED; \
            PG8_LDA(At, 1, 1); PG8_STAGE(PG8_SB(1, 0), b3, voffB); PG8_STAGE(PG8_SB(1, 1), b3 + hB, voffB); PG8_STAGE(PG8_SA(1, 0), a3, voffA); \
            PG8_WAIT_V(8); PG8_WAIT_L(0); PG8_BAR; PG8_MMA(1, 0, At, B0); PG8_MMA(1, 1, At, B1); PG8_BAR; PG8_SCHED; \
        } while (0)
        int t = 0;
        if (Epi::XST > 0 && ui > 0) { PG8_PASS(PG8_WAIT_VN(8 + Epi::XST)); t = 2; }
        for (; t < nt; t += 2) PG8_PASS(PG8_WAIT_V(8));
#undef PG8_PASS
        if (wr == 0) PG8_BAR;
        unsigned zz = 0u; asm volatile("" : "+s"(zz)); const int le = (int)__builtin_amdgcn_mbcnt_hi(~0u, __builtin_amdgcn_mbcnt_lo(~0u, zz));
        if (E(acc, cur, wr, wc, le & 15, le >> 4, lds + TB_OFF + ldsw, lds + SHB_OFF + (ui & 1) * 3072, pre)) PG8_ZERO();
        if (!has_next) break;
        cur = nxt; cA = nA; cB = nB; ++ui;
        E.prefetch(cur, wid, le, lds + SHB_OFF + (ui & 1) * 3072);
        pre = E.pre(cur, wr, wc, le & 15, le >> 4);
        if (wr == 1) PG8_BAR;
    }
    PG8_WAIT_V(0);
    PG8_BAR;
#undef PG8_SA
#undef PG8_SB
#undef PG8_STAGE
#undef PG8_LDA
#undef PG8_LDB
#undef PG8_MMA
#undef PG8_WAIT_V
#undef PG8_WAIT_VN
#undef PG8_WAIT_L
#undef PG8_BAR
#undef PG8_SCHED
#undef PG8_ZERO
}
}

enum { I_x = 0, I_c = 1, I_ctx = 2, I_c_ctx = 3, I_w_ada = 4, I_b_ada = 5, I_g_norm1 = 6, I_g_norm2 = 7, I_w_in = 8, I_b_gate = 9, I_ret_decay = 10, I_ret_gn = 11, I_w_ret_o = 12, I_conv_dw = 13, I_conv_db = 14, I_conv_ln_g = 15, I_conv_ln_b = 16, I_w_conv_o = 17, I_gmlp_ln_g = 18, I_gmlp_ln_b = 19, I_gmlp_ws = 20, I_gmlp_bs = 21, I_w_gmlp_o = 22, I_w_fnet_o = 23, I_w_out = 24, I_w_ffn_up = 25, I_ffn_dw = 26, I_ffn_db = 27, I_w_ffn_down = 28, I_g_final = 29 };
struct KArgs { const float* in[30]; float* out; unsigned char* ws; int ph_lo, ph_hi; };
constexpr int PTAB_OFF = MISC_OFF + 4096;
struct KP {
    float* out; unsigned char* ws; LAS unsigned char* ldsb; LAS unsigned char* ptab; int tid_, bx_;
    __device__ __forceinline__ const float* in(int k) const {
        const LAS unsigned* t = (const LAS unsigned*)ptab + 2 * k;
        const unsigned lo = (unsigned)__builtin_amdgcn_readfirstlane((int)t[0]), hi = (unsigned)__builtin_amdgcn_readfirstlane((int)t[1]);
        typedef const float __attribute__((address_space(1)))* gcfp_t;
        return (const float*)(gcfp_t)(((unsigned long long)hi << 32) | (unsigned long long)lo);
    }
};

struct RowInfo { int mi; size_t xrow0; bool is_ctx; };
__device__ __forceinline__ RowInfo row_info(int g, int pm) {
    RowInfo ri;
    if (pm < NLT) { const int b = g * GB + (pm >> 3); ri.mi = b; ri.xrow0 = (size_t)b * SEQ + (size_t)(pm & 7) * 256; ri.is_ctx = false; }
    else { const int b = pm - NLT; ri.mi = 16; ri.xrow0 = (size_t)b * CTXL; ri.is_ctx = true; }
    return ri;
}

__device__ __forceinline__ unsigned ap_off(int g) { return g == 0 ? (unsigned)OFF_AP : (unsigned)OFF_AP1; }
__device__ __forceinline__ unsigned ssa_off(int g) { return (unsigned)OFF_SS + (unsigned)(g * 2) * (unsigned)(R * 4); }
__device__ __forceinline__ unsigned ssb_off(int g) { return (unsigned)OFF_SS + (unsigned)(g * 2 + 1) * (unsigned)(R * 4); }

constexpr int TB2_DELTA = 153600 - 131072;
__device__ __forceinline__ void st_rows16x2(LAS unsigned char* tb, bf16_t* base, size_t ld, int fr, int fq, u32x4 w0, u32x4 w1) {
    const int wo = 64 * fr + 16 * (fq ^ ((fr >> 2) & 3));
    *(LAS u32x4*)(tb + wo) = w0; *(LAS u32x4*)(tb + TB2_DELTA + wo) = w1;
    const int l2 = fq * 16 + fr, r2 = l2 >> 2, q2 = l2 & 3, ro = 64 * r2 + 16 * (q2 ^ ((r2 >> 2) & 3));
    const u32x4 t0 = *(const LAS u32x4*)(tb + ro), t1 = *(const LAS u32x4*)(tb + TB2_DELTA + ro);
    bf16_t* d = base + (size_t)r2 * ld + 8 * q2;
    *(u32x4*)d = t0; *(u32x4*)(d + 128) = t1;
}
__device__ __forceinline__ void st_rows16(LAS unsigned char* tb, bf16_t* base, size_t ld, int fr, int fq, u32x4 w) {
    *(LAS u32x4*)(tb + 64 * fr + 16 * (fq ^ ((fr >> 2) & 3))) = w;
    const int l2 = fq * 16 + fr, r2 = l2 >> 2, q2 = l2 & 3;
    const u32x4 t = *(const LAS u32x4*)(tb + 64 * r2 + 16 * (q2 ^ ((r2 >> 2) & 3)));
    *(u32x4*)(base + (size_t)r2 * ld + 8 * q2) = t;
}
struct EpiWin {
    typedef pg8::NoPre Pre;
    __device__ __forceinline__ Pre pre(const pg8::Unit&, int, int, int, int) const { return Pre{}; }
    static constexpr bool PERM = true; static constexpr int XST = 16;
    const float* ss; const float* shw; const float* bgate; bf16_t* PM; bf16_t* GT; int g;
    __device__ __forceinline__ void prefetch(const pg8::Unit& u, int wid, int lane, LAS unsigned char* shb) const {
        const int ctile = u.pn * 256;
        if (wid == 0) { const RowInfo ri = row_info(g, u.pm); __builtin_amdgcn_global_load_lds((const unsigned*)(shw + (size_t)ri.mi * NCOLS + ctile + lane * 4), (LAS unsigned*)shb, 16, 0, 0); }
        else if (wid == 1) __builtin_amdgcn_global_load_lds((const unsigned*)(ss + u.pm * 256 + lane * 4), (LAS unsigned*)(shb + 1024), 16, 0, 0);
        else if (wid == 2 && ctile >= PMW) __builtin_amdgcn_global_load_lds((const unsigned*)(bgate + (ctile - PMW) + lane * 4), (LAS unsigned*)(shb + 2048), 16, 0, 0);
    }
    __device__ __forceinline__ bool operator()(f32x4 (&acc)[2][2][4][2], const pg8::Unit& u, int wr, int wc, int fr, int fq, LAS unsigned char* tb, const LAS unsigned char* shb, const Pre&) const {
        const int ctile = u.pn * 256, cb = wc * 32 + 8 * fq;
        const bool gate = ctile >= PMW;
        f32x4 sh[2][2];
#pragma unroll
        for (int bj = 0; bj < 2; ++bj)
#pragma unroll
            for (int n = 0; n < 2; ++n) { sh[bj][n] = *(const LAS f32x4*)(shb + (bj * 128 + cb + 4 * n) * 4);
                if (gate) sh[bj][n] = (sh[bj][n] + *(const LAS f32x4*)(shb + 2048 + (bj * 128 + cb + 4 * n) * 4)) * (-1.44269504089f) - 7.99435343686f; }
        float rsv[8];
#pragma unroll
        for (int q = 0; q < 8; ++q) rsv[q] = __builtin_amdgcn_rsqf(*(const LAS float*)(shb + 1024 + ((q >> 2) * 128 + wr * 64 + (q & 3) * 16 + fr) * 4) * (1.0f / 1024.0f) + EPS);
#pragma unroll
        for (int ai = 0; ai < 2; ++ai)
#pragma unroll
            for (int m = 0; m < 4; ++m) {
                const int r = u.pm * 256 + ai * 128 + wr * 64 + m * 16 + fr;
                const float rs = rsv[ai * 4 + m], rsg = rs * (-1.44269504089f);
                u32x4 wp[2];
#pragma unroll
                for (int bj = 0; bj < 2; ++bj) {
                    if (gate) {
                        const f32x4 e0 = acc[ai][bj][m][0] * rsg + sh[bj][0], e1 = acc[ai][bj][m][1] * rsg + sh[bj][1];
                        u32x2 wq = (u32x2){0u, 0u};
#pragma unroll
                        for (int j = 0; j < 4; ++j) {
                            const float y0 = fast_rcp(__builtin_amdgcn_fmed3f(__builtin_amdgcn_exp2f(e0[j]) + (1.0f / 255.0f), 0.f, 1.f)), y1 = fast_rcp(__builtin_amdgcn_fmed3f(__builtin_amdgcn_exp2f(e1[j]) + (1.0f / 255.0f), 0.f, 1.f));
                            wq.x = __builtin_amdgcn_cvt_pk_u8_f32(y0, j, wq.x); wq.y = __builtin_amdgcn_cvt_pk_u8_f32(y1, j, wq.y); }
                        *(u32x2*)((unsigned char*)GT + ((size_t)(u.pm * 16 + ((ctile - PMW) >> 8)) * 16 + (ai * 4 + m) * 2 + bj) * 4096 + ((wr * 4 + wc) * 64 + fq * 16 + fr) * 8) = wq;
                        continue;
                    }
                    const f32x4 v0 = acc[ai][bj][m][0] * rs + sh[bj][0], v1 = acc[ai][bj][m][1] * rs + sh[bj][1];
                    wp[bj].x = cvt_pk_bf16(v0[0], v0[1]); wp[bj].y = cvt_pk_bf16(v0[2], v0[3]); wp[bj].z = cvt_pk_bf16(v1[0], v1[1]); wp[bj].w = cvt_pk_bf16(v1[2], v1[3]);
                }
                if (!gate) st_rows16x2(tb, PM + (size_t)(r - fr) * PMW + ctile + wc * 32, PMW, fr, fq, wp[0], wp[1]);
            }
        return true;
    }
};
struct EpiUp {
    typedef pg8::NoPre Pre;
    __device__ __forceinline__ Pre pre(const pg8::Unit&, int, int, int, int) const { return Pre{}; }
    static constexpr bool PERM = true; static constexpr int XST = 16;
    const float* ss; const float* shw; bf16_t* UP; int g;
    __device__ __forceinline__ void prefetch(const pg8::Unit& u, int wid, int lane, LAS unsigned char* shb) const {
        if (wid == 0) { const RowInfo ri = row_info(g, u.pm); __builtin_amdgcn_global_load_lds((const unsigned*)(shw + (size_t)ri.mi * UPW + u.pn * 256 + lane * 4), (LAS unsigned*)shb, 16, 0, 0); }
        else if (wid == 1) __builtin_amdgcn_global_load_lds((const unsigned*)(ss + u.pm * 256 + lane * 4), (LAS unsigned*)(shb + 1024), 16, 0, 0);
    }
    __device__ __forceinline__ bool operator()(f32x4 (&acc)[2][2][4][2], const pg8::Unit& u, int wr, int wc, int fr, int fq, LAS unsigned char* tb, const LAS unsigned char* shb, const Pre&) const {
        const int ctile = u.pn * 256, cb = wc * 32 + 8 * fq;
        f32x4 sh[2][2];
#pragma unroll
        for (int bj = 0; bj < 2; ++bj)
#pragma unroll
            for (int n = 0; n < 2; ++n) sh[bj][n] = *(const LAS f32x4*)(shb + (bj * 128 + cb + 4 * n) * 4);
        float rsv[8];
#pragma unroll
        for (int q = 0; q < 8; ++q) rsv[q] = __builtin_amdgcn_rsqf(*(const LAS float*)(shb + 1024 + ((q >> 2) * 128 + wr * 64 + (q & 3) * 16 + fr) * 4) * (1.0f / 1024.0f) + EPS);
#pragma unroll
        for (int ai = 0; ai < 2; ++ai)
#pragma unroll
            for (int m = 0; m < 4; ++m) {
                const int r = u.pm * 256 + ai * 128 + wr * 64 + m * 16 + fr;
                const float rs = rsv[ai * 4 + m];
                u32x4 w[2];
#pragma unroll
                for (int bj = 0; bj < 2; ++bj) {
                    const f32x4 v0 = acc[ai][bj][m][0] * rs + sh[bj][0], v1 = acc[ai][bj][m][1] * rs + sh[bj][1];
                    w[bj].x = cvt_pk_bf16(v0[0], v0[1]); w[bj].y = cvt_pk_bf16(v0[2], v0[3]); w[bj].z = cvt_pk_bf16(v1[0], v1[1]); w[bj].w = cvt_pk_bf16(v1[2], v1[3]);
                }
                st_rows16x2(tb, UP + (size_t)(r - fr) * UPW + ctile + wc * 32, UPW, fr, fq, w[0], w[1]);
            }
        return true;
    }
};
struct EpiResid {
    typedef pg8::NoPre Pre;
    __device__ __forceinline__ Pre pre(const pg8::Unit&, int, int, int, int) const { return Pre{}; }
    static constexpr bool PERM = false; static constexpr int XST = 0;
    const float *xin_lat, *xin_ctx; float *xout_lat, *xout_ctx; const float* ga; const float* Gn; bf16_t* AP; float* ss; int g;
    __device__ __forceinline__ void prefetch(const pg8::Unit& u, int wid, int lane, LAS unsigned char* shb) const {
        if (wid == 0) { const RowInfo ri = row_info(g, u.pm); __builtin_amdgcn_global_load_lds((const unsigned*)(ga + (size_t)ri.mi * 6144 + u.pn * 256 + lane * 4), (LAS unsigned*)shb, 16, 0, 0); }
        else if (wid == 1 && Gn) { const RowInfo ri = row_info(g, u.pm); __builtin_amdgcn_global_load_lds((const unsigned*)(Gn + (size_t)ri.mi * 6144 + u.pn * 256 + lane * 4), (LAS unsigned*)(shb + 1024), 16, 0, 0); }
    }
    __device__ __forceinline__ bool operator()(f32x4 (&acc)[2][2][4][2], const pg8::Unit& u, int wr, int wc, int fr, int fq, LAS unsigned char* tb, const LAS unsigned char* shb, const Pre&) const {
        const RowInfo ri = row_info(g, u.pm);
        const float* xin = ri.is_ctx ? xin_ctx : xin_lat; float* xout = ri.is_ctx ? xout_ctx : xout_lat;
        const int l2 = fq * 16 + fr, r2 = l2 >> 2, q2 = l2 & 3;
        LAS unsigned char* wa = tb + 64 * fr + 16 * (fq ^ ((fr >> 2) & 3));
        const LAS unsigned char* ra = tb + 64 * r2 + 16 * (q2 ^ ((r2 >> 2) & 3));
        const int c0 = u.pn * 256 + wc * 32 + 4 * q2;
        const bool gnp = Gn != nullptr;
        const LAS unsigned char* gl = shb + (wc * 32 + 4 * q2) * 4;
        const size_t xbase = (ri.xrow0 + (size_t)(wr * 64 + r2)) * D + c0;
        const int rbase = u.pm * 256 + wr * 64 + r2;
        f32x4 xc[4], xn_[4];
#pragma unroll
        for (int q = 0; q < 4; ++q) xc[q] = *(const f32x4*)(xin + xbase + (q >> 1) * 128 + (q & 1) * 16);
#pragma unroll
        for (int st = 0; st < 8; ++st) {
            const int ai = st >> 2, m = st & 3;
            if (st < 7) { const int ai2 = (st + 1) >> 2, m2 = (st + 1) & 3; const size_t o2 = xbase + (size_t)(ai2 * 128 + m2 * 16) * D;
#pragma unroll
                for (int q = 0; q < 4; ++q) xn_[q] = *(const f32x4*)(xin + o2 + (q >> 1) * 128 + (q & 1) * 16); }
            asm volatile("" ::: "memory");
            const size_t xo = xbase + (size_t)(ai * 128 + m * 16) * D; const int r = rbase + ai * 128 + m * 16;
            float sq = 0.f;
#pragma unroll
            for (int q = 0; q < 4; ++q) { const int bj = q >> 1, n = q & 1;
                *(LAS f32x4*)wa = acc[ai][bj][m][n];
                const f32x4 at = *(const LAS f32x4*)ra;
                const f32x4 xv = xc[q] + *(const LAS f32x4*)(gl + (bj * 128 + n * 16) * 4) * at;
                *(f32x4*)(xout + xo + bj * 128 + n * 16) = xv;
                sq += (xv[0] * xv[0] + xv[1] * xv[1]) + (xv[2] * xv[2] + xv[3] * xv[3]);
                if (gnp) { const f32x4 a = xv * *(const LAS f32x4*)(gl + 1024 + (bj * 128 + n * 16) * 4); u32x2 w; w.x = cvt_pk_bf16(a[0], a[1]); w.y = cvt_pk_bf16(a[2], a[3]);
                    *(u32x2*)(AP + (size_t)r * D + c0 + bj * 128 + n * 16) = w; } }
            sq += dpp_mov<0xB1>(sq); sq += dpp_mov<0x4E>(sq);
            if (q2 == 0) atomicAdd(ss + r, sq);
            asm volatile("" ::: "memory");
#pragma unroll
            for (int q = 0; q < 4; ++q) xc[q] = xn_[q];
        }
        return true;
    }
};
struct EpiDft {
    typedef pg8::NoPre Pre;
    __device__ __forceinline__ Pre pre(const pg8::Unit&, int, int, int, int) const { return Pre{}; }
    static constexpr bool PERM = true; static constexpr int XST = 0;
    bf16_t* S; int row_base, rows_per_seq; float scale;
    __device__ __forceinline__ void prefetch(const pg8::Unit&, int, int, LAS unsigned char*) const {}
    __device__ __forceinline__ bool operator()(f32x4 (&acc)[2][2][4][2], const pg8::Unit& u, int wr, int wc, int fr, int fq, LAS unsigned char* tb, const LAS unsigned char*, const Pre&) const {
        const int cb = wc * 32 + 8 * fq;
#pragma unroll
        for (int ai = 0; ai < 2; ++ai)
#pragma unroll
            for (int m = 0; m < 4; ++m) {
                const int r = row_base + u.pn * rows_per_seq + u.pm * 256 + ai * 128 + wr * 64 + m * 16 + fr;
#pragma unroll
                for (int bj = 0; bj < 2; ++bj) {
                    const f32x4 v0 = acc[ai][bj][m][0] * scale, v1 = acc[ai][bj][m][1] * scale;
                    u32x4 w; w.x = cvt_pk_bf16(v0[0], v0[1]); w.y = cvt_pk_bf16(v0[2], v0[3]); w.z = cvt_pk_bf16(v1[0], v1[1]); w.w = cvt_pk_bf16(v1[2], v1[3]);
                    st_rows16(tb, S + (size_t)(r - fr) * D + 768 + bj * 128 + wc * 32, D, fr, fq, w);
                }
            }
        return true;
    }
};
struct EpiMerge {
    static constexpr bool PERM = true; static constexpr int NPQ = 4; static constexpr int XST = 2 * NPQ;
    const unsigned char* GT; bf16_t* MG;
    __device__ __forceinline__ void prefetch(const pg8::Unit&, int, int, LAS unsigned char*) const {}
    struct Pre { u32x2 ti[NPQ], tn[NPQ]; };
    __device__ __forceinline__ Pre pre(const pg8::Unit& u, int wr, int wc, int fr, int fq) const { Pre p_;
        const int i = u.seg, thr = ((wr * 4 + wc) * 64 + fq * 16 + fr) * 8;
        const unsigned char* gi = GT + (size_t)(u.pm * 16 + i * 4 + u.pn) * 16 * 4096 + thr;
        const unsigned char* gn = i < 3 ? gi + (size_t)4 * 16 * 4096 : gi;
#pragma unroll
        for (int q = 0; q < NPQ; ++q) { p_.ti[q] = *(const u32x2*)(gi + q * 4096); p_.tn[q] = *(const u32x2*)(gn + q * 4096); }
        return p_; }
    __device__ __forceinline__ bool operator()(f32x4 (&acc)[2][2][4][2], const pg8::Unit& u, int wr, int wc, int fr, int fq, LAS unsigned char* tb, const LAS unsigned char*, const Pre& p_) const {
        __builtin_amdgcn_s_waitcnt(0x0F78);
        const int cb = u.pn * 256 + wc * 32 + 8 * fq, i = u.seg;
        const int thr = ((wr * 4 + wc) * 64 + fq * 16 + fr) * 8;
        const unsigned char* gi = GT + (size_t)(u.pm * 16 + i * 4 + u.pn) * 16 * 4096 + thr;
        const unsigned char* gn = i < 3 ? gi + (size_t)4 * 16 * 4096 : gi;
        u32x2 ti[16], tn[16];
#pragma unroll
        for (int q = 0; q < 16; ++q) { if (q < NPQ) { ti[q] = p_.ti[q]; tn[q] = p_.tn[q]; } else { ti[q] = *(const u32x2*)(gi + q * 4096); tn[q] = *(const u32x2*)(gn + q * 4096); } }
        const unsigned last = i == 3 ? 0xffffffffu : 0u;
#pragma unroll
        for (int q = 0; q < 16; ++q) { const int ai = q >> 3, m = (q >> 1) & 3, bj = q & 1;
            f32x4 fa, fb;
#pragma unroll
            for (int j = 0; j < 4; ++j) {
                fa[j] = (float)((ti[q].x >> (8 * j)) & 0xffu) * fast_rcp((float)(((tn[q].x | last) >> (8 * j)) & 0xffu));
                fb[j] = (float)((ti[q].y >> (8 * j)) & 0xffu) * fast_rcp((float)(((tn[q].y | last) >> (8 * j)) & 0xffu)); }
            acc[ai][bj][m][0] *= fa; acc[ai][bj][m][1] *= fb;
        }
        if (i < 3) return false;
#pragma unroll
        for (int q = 0; q < 16; ++q) { const int ai = q >> 3, m = (q >> 1) & 3, bj = q & 1;
            const f32x4 v0 = acc[ai][bj][m][0], v1 = acc[ai][bj][m][1];
            const int r0 = u.pm * 256 + ai * 128 + wr * 64 + m * 16;
            u32x4 w; w.x = cvt_pk_bf16(v0[0], v0[1]); w.y = cvt_pk_bf16(v0[2], v0[3]); w.z = cvt_pk_bf16(v1[0], v1[1]); w.w = cvt_pk_bf16(v1[2], v1[3]);
            st_rows16(tb, MG + (size_t)r0 * D + u.pn * 256 + wc * 32 + bj * 128, D, fr, fq, w);
        }
        return true;
    }
};

__device__ __forceinline__ void transpose_item(const float* src, int ld_src, int k0, int n0, bf16_t* dst, int ld_dst, int dst_row0, LAS float* scr, int lane) {
    const int kr = lane >> 3, nq = lane & 7;
    f32x4 v[8];
#pragma unroll
    for (int i = 0; i < 8; ++i) v[i] = *(const f32x4*)(src + (size_t)(k0 + i * 8 + kr) * ld_src + n0 + nq * 4);
#pragma unroll
    for (int i = 0; i < 8; ++i) { LAS float* d_ = scr + (i * 8 + kr) * 33 + nq * 4; d_[0] = v[i][0]; d_[1] = v[i][1]; d_[2] = v[i][2]; d_[3] = v[i][3]; }
    asm volatile("s_waitcnt lgkmcnt(0)" ::: "memory");
    const int c = lane & 7;
#pragma unroll
    for (int j = 0; j < 4; ++j) { const int n = (lane >> 3) + 8 * j; const LAS float* s = scr + (8 * c) * 33 + n;
        u32x4 o; o.x = cvt_pk_bf16(s[0 * 33], s[1 * 33]); o.y = cvt_pk_bf16(s[2 * 33], s[3 * 33]); o.z = cvt_pk_bf16(s[4 * 33], s[5 * 33]); o.w = cvt_pk_bf16(s[6 * 33], s[7 * 33]);
        *(u32x4*)(dst + (size_t)(dst_row0 + n) * ld_dst + k0 + 8 * c) = o; }
    asm volatile("s_waitcnt lgkmcnt(0)" ::: "memory");
}

__device__ __forceinline__ void weight_prep(const KP& p, LAS unsigned char* lds, int l_lo, int l_hi, int b0, int nb) {
    int tid = p.tid_; asm volatile("" : "+v"(tid)); const int wave = tid >> 6, lane = tid & 63, G = nb, bx = p.bx_ - b0;
    unsigned char* ws = p.ws;
    if (bx < 0 || bx >= nb) return;
    {
        LAS float* scr = (LAS float*)(lds + wave * 16384);
        const int gw = bx * NWAVES + wave, NGW = G * NWAVES;
        constexpr int I_IN1 = 16 * 64, I_IN2 = 16 * 128, I_O = 4 * 32, I_OUT = 16 * 32, I_UP = 16 * 176, I_DN = 44 * 32;
        constexpr int PER_L = I_IN1 + I_IN2 + 4 * I_O + I_OUT + I_UP + I_DN;
        for (int it = l_lo * PER_L + gw; it < l_hi * PER_L; it += NGW) {
            const int l = it / PER_L; int r = it % PER_L;
            bf16_t* wl = (bf16_t*)(ws + OFF_W + (size_t)l * W_LAYER);
            if (r < I_IN1) { const int kb = r / 64, nb = r % 64; transpose_item(p.in(I_w_in) + (size_t)l * D * IN_COLS, IN_COLS, kb * 64, nb * 32, wl + W_IN / 2, D, nb * 32, scr, lane); continue; } r -= I_IN1;
            if (r < I_IN2) { const int kb = r / 128, nb = r % 128; transpose_item(p.in(I_w_in) + (size_t)l * D * IN_COLS, IN_COLS, kb * 64, 2304 + nb * 32, wl + W_IN / 2, D, PMW + nb * 32, scr, lane); continue; } r -= I_IN2;
            if (r < 4 * I_O) { const int br = r / I_O, rr = r % I_O, kb = rr / 32, nb = rr % 32;
                const float* src = (br == 0 ? p.in(I_w_ret_o) : br == 1 ? p.in(I_w_conv_o) : br == 2 ? p.in(I_w_gmlp_o) : p.in(I_w_fnet_o)) + (size_t)l * 256 * D;
                transpose_item(src, D, kb * 64, nb * 32, wl + W_O / 2 + (size_t)br * 1024 * 256, 256, nb * 32, scr, lane); continue; } r -= 4 * I_O;
            if (r < I_OUT) { const int kb = r / 32, nb = r % 32; transpose_item(p.in(I_w_out) + (size_t)l * D * D, D, kb * 64, nb * 32, wl + W_OUT / 2, D, nb * 32, scr, lane); continue; } r -= I_OUT;
            if (r < I_UP) { const int kb = r / 176, nb = r % 176; transpose_item(p.in(I_w_ffn_up) + (size_t)l * D * UPW, UPW, kb * 64, nb * 32, wl + W_UP / 2, D, nb * 32, scr, lane); continue; } r -= I_UP;
            { const int kb = r / 32, nb = r % 32; transpose_item(p.in(I_w_ffn_down) + (size_t)l * DFF * D, D, kb * 64, nb * 32, wl + W_DN / 2, DFF, nb * 32, scr, lane); }
        }
        __syncthreads();
    }
    {
        LAS float* tile = (LAS float*)lds;
        LAS float* tab = (LAS float*)(lds + 64 * 65 * 4);
        for (int it = l_lo * 64 + bx; it < l_hi * 64; it += G) {
            const int l = it / 64, gq = (it / 16) % 4, kb = it % 16;
            __syncthreads();
            if (tid < 64) { tab[tid] = cos_rev((float)tid * (1.0f / 64.0f)) * 0.125f; tab[64 + tid] = sin_rev((float)tid * (1.0f / 64.0f)) * 0.125f; }
            for (int i = tid; i < 64 * 64; i += NTHREADS) { const int kk = i / 64, cc = i % 64; tile[kk * 65 + cc] = p.in(I_w_in)[((size_t)l * D + kb * 64 + kk) * IN_COLS + 2048 + gq * 64 + cc]; }
            __syncthreads();
            const int which = tid >> 8, nl = (tid & 255) >> 2, kq = tid & 3;
            float acc[16];
#pragma unroll
            for (int j = 0; j < 16; ++j) acc[j] = 0.f;
            for (int cc = 0; cc < 64; ++cc) { const float coef = tab[which * 64 + ((cc * nl) & 63)];
#pragma unroll
                for (int j = 0; j < 16; ++j) acc[j] += coef * tile[(kq * 16 + j) * 65 + cc]; }
            bf16_t* wl = (bf16_t*)(ws + OFF_W + (size_t)l * W_LAYER + W_IN);
            bf16_t* dst = wl + (size_t)(2048 + which * 256 + gq * 64 + nl) * D + kb * 64 + kq * 16;
            *(u32x4*)dst = pack8(acc); *(u32x4*)(dst + 8) = pack8(acc + 8);
        }
        __syncthreads();
    }
}
__device__ __forceinline__ void phase_prep_a(const KP& p, LAS unsigned char* lds) {
    int tid = p.tid_; asm volatile("" : "+v"(tid)); const int wave = tid >> 6, lane = tid & 63, G = NBLK, bx = p.bx_;
    unsigned char* ws = p.ws;
    {
        LAS float* sl = (LAS float*)lds;
        float* adap = (float*)(ws + OFF_ADAP);
        for (int it = bx; it < 2 * 12 * 8; it += G) {
            const int l = it / 96, nch = (it / 8) % 12, kc = it % 8;
            __syncthreads();
            for (int i = tid; i < 17 * 128; i += NTHREADS) { const int mi = i / 128, k = kc * 128 + (i % 128); const float cv = mi < 16 ? p.in(I_c)[mi * D + k] : p.in(I_c_ctx)[k]; sl[i] = siluf_(cv); }
            __syncthreads();
            const int n = nch * 512 + tid;
            float acc[17];
#pragma unroll
            for (int mi = 0; mi < 17; ++mi) acc[mi] = 0.f;
            const float* wp = p.in(I_w_ada) + ((size_t)l * D + kc * 128) * 6144 + n;
#pragma unroll 1
            for (int k0 = 0; k0 < 128; k0 += 16) { float w[16];
#pragma unroll
                for (int k = 0; k < 16; ++k) w[k] = wp[(size_t)(k0 + k) * 6144];
#pragma unroll
                for (int k = 0; k < 16; ++k)
#pragma unroll
                    for (int mi = 0; mi < 17; ++mi) acc[mi] += sl[mi * 128 + k0 + k] * w[k]; }
#pragma unroll
            for (int mi = 0; mi < 17; ++mi) adap[(((size_t)kc * 2 + l) * 17 + mi) * 6144 + n] = acc[mi];
        }
        __syncthreads();
    }
    weight_prep(p, lds, 0, 1, 0, G);
    {
        const size_t gt = (size_t)bx * NTHREADS + tid, GT_ = (size_t)G * NTHREADS;
        float* rc = (float*)(ws + OFF_ROPE); float* rsn = rc + 2304 * 32;
        for (size_t i = gt; i < (size_t)2304 * 32; i += GT_) { const int pos = (int)(i / 32), fi = (int)(i % 32);
            const float inv = exp2f(-(float)fi * (13.287712379549449f / 32.0f));
            const float ang = (float)pos * inv;
            const double rev = (double)ang * 0.15915494309189535; const float fr_ = (float)(rev - floor(rev));
            rc[i] = cos_rev(fr_); rsn[i] = sin_rev(fr_); }
        bf16_t* dm = (bf16_t*)(ws + OFF_DM);
        for (size_t i = gt; i < (size_t)2048 * 256; i += GT_) { const int n = (int)(i / 256), k8 = (int)(i % 256) * 8; float v[8];
#pragma unroll
            for (int j = 0; j < 8; ++j) { const int kk = k8 + j; if (kk <= 1024) v[j] = cos_rev((float)((n * kk) & 2047) * (1.0f / 2048.0f)); else v[j] = -sin_rev((float)((n * (kk - 1024)) & 2047) * (1.0f / 2048.0f)); }
            *(u32x4*)(dm + (size_t)n * 2048 + k8) = pack8(v); }
        bf16_t* dc = (bf16_t*)(ws + OFF_DC);
        for (size_t i = gt; i < (size_t)256 * 32; i += GT_) { const int n = (int)(i / 32), k8 = (int)(i % 32) * 8; float v[8];
#pragma unroll
            for (int j = 0; j < 8; ++j) { const int kk = k8 + j; if (kk <= 128) v[j] = cos_rev((float)((n * kk) & 255) * (1.0f / 256.0f)); else v[j] = -sin_rev((float)((n * (kk - 128)) & 255) * (1.0f / 256.0f)); }
            *(u32x4*)(dc + (size_t)n * 256 + k8) = pack8(v); }
        if (gt < 16) { const float xx = p.in(I_ret_decay)[gt]; ((float*)(ws + OFF_LOGG))[gt] = (float)(-log1p(exp(-(double)xx))); }
    }
}

__device__ __forceinline__ void phase_prep_b(const KP& p) {
    const size_t gt = (size_t)p.bx_ * NTHREADS + p.tid_, GT_ = (size_t)NBLK * NTHREADS;
    const float* adap = (const float*)(p.ws + OFF_ADAP); float* mod = (float*)(p.ws + OFF_MOD);
    for (size_t i = gt; i < (size_t)2 * 17 * 6144; i += GT_) {
        const int l = (int)(i / (17 * 6144)), n = (int)(i % 6144), j = n / 1024, k = n % 1024;
        float v = p.in(I_b_ada)[l * 6144 + n];
#pragma unroll
        for (int kc = 0; kc < 8; ++kc) v += adap[(size_t)kc * 2 * 17 * 6144 + i];
        if (j == 1) v = p.in(I_g_norm1)[l * D + k] * (1.f + v);
        if (j == 4) v = p.in(I_g_norm2)[l * D + k] * (1.f + v);
        mod[i] = v;
    }
}

__device__ __forceinline__ void phase_prep_c(const KP& p, LAS unsigned char* lds, int l_lo, int l_hi, int b0, int nb) {
    int tid = p.tid_; asm volatile("" : "+v"(tid)); const int wave = tid >> 6, lane = tid & 63, G = nb;
    if (p.bx_ < b0 || p.bx_ >= b0 + nb) return;
    LAS unsigned char* shb = lds;
    const int gw = (p.bx_ - b0) * NWAVES + wave, NGW = G * NWAVES;
    const int c = lane & 15, gq = lane >> 4;
    for (int combo = 2 * l_lo; combo < 2 * l_hi; ++combo) {
        const int l = combo >> 1, which = combo & 1;
        const float* mod = (const float*)(p.ws + OFF_MOD) + (size_t)l * 17 * 6144 + (which ? 3 : 0) * 1024;
        __syncthreads();
        for (int i = tid; i < 32 * 128; i += NTHREADS) { const int row = i >> 7, ch = i & 127; float f[8];
#pragma unroll
            for (int j = 0; j < 8; ++j) f[j] = row < 17 ? mod[(size_t)row * 6144 + ch * 8 + j] : 0.f;
            *(LAS u32x4*)(shb + row * 2048 + ((ch ^ (row & 7)) << 4)) = pack8(f); }
        __syncthreads();
        const int ncol = which ? UPW : NCOLS;
        const bf16_t* W = (const bf16_t*)(p.ws + OFF_W + (size_t)l * W_LAYER + (which ? W_UP : W_IN));
        float* dst = (float*)(p.ws + (which ? OFF_SHW2 : OFF_SHW1)) + (size_t)l * 17 * ncol;
        for (int nb16 = gw; nb16 < ncol / 16; nb16 += NGW) {
            const bf16_t* wrow = W + (size_t)(nb16 * 16 + c) * D + 8 * gq;
            const f32x4 z4 = (f32x4){0.f, 0.f, 0.f, 0.f};
            f32x4 acc0 = z4, acc1 = z4;
#pragma unroll 1
            for (int t0 = 0; t0 < 32; t0 += 8) {
                bf16x8 bfr[8];
#pragma unroll
                for (int q = 0; q < 8; ++q) bfr[q] = *(const bf16x8*)(wrow + 32 * (t0 + q));
#pragma unroll
                for (int q = 0; q < 8; ++q) { const int ch = 4 * (t0 + q) + gq;
                    const bf16x8 a0 = *(const LAS bf16x8*)(shb + c * 2048 + ((ch ^ (c & 7)) << 4)), a1 = *(const LAS bf16x8*)(shb + (16 + c) * 2048 + ((ch ^ (c & 7)) << 4));
                    acc0 = mfma16(a0, bfr[q], acc0); acc1 = mfma16(a1, bfr[q], acc1); }
            }
            const int n = nb16 * 16 + c;
#pragma unroll
            for (int r = 0; r < 4; ++r) dst[(size_t)(4 * gq + r) * ncol + n] = acc0[r];
            if (gq == 0) dst[(size_t)16 * ncol + n] = acc1[0];
        }
    }
    __syncthreads();
}

__device__ __forceinline__ void phase_g0(const KP& p, int g, int b0, int nb) {
    int tid = p.tid_; asm volatile("" : "+v"(tid)); const int wave = tid >> 6, lane = tid & 63;
    if (p.bx_ < b0 || p.bx_ >= b0 + nb) return;
    const int gw = (p.bx_ - b0) * NWAVES + wave, NGW = nb * NWAVES;
    const float* mod = (const float*)(p.ws + OFF_MOD);
    bf16_t* AP = (bf16_t*)(p.ws + ap_off(g)); float* ss = (float*)(p.ws + ssa_off(g));
    const int nrows = g == 0 ? R : R_LAT;
    for (int r0 = gw; r0 < nrows; r0 += 2 * NGW) {
        f32x4 v[2][4], gg[2][4]; int rr[2]; bool ok[2];
#pragma unroll
        for (int h = 0; h < 2; ++h) { rr[h] = r0 + h * NGW; ok[h] = rr[h] < nrows; const int r = ok[h] ? rr[h] : r0;
            const RowInfo ri = row_info(g, r >> 8);
            const float* xr = (ri.is_ctx ? p.in(I_ctx) : p.in(I_x)) + (ri.xrow0 + (size_t)(r & 255)) * D;
            const float* G1 = mod + (size_t)ri.mi * 6144 + 1024;
#pragma unroll
            for (int j = 0; j < 4; ++j) { v[h][j] = *(const f32x4*)(xr + j * 256 + lane * 4); gg[h][j] = *(const f32x4*)(G1 + j * 256 + lane * 4); } }
#pragma unroll
        for (int h = 0; h < 2; ++h) { if (!ok[h]) continue; const int r = rr[h];
            float s_ = 0.f;
#pragma unroll
            for (int j = 0; j < 4; ++j) { const f32x4 x = v[h][j];
                s_ += (x[0] * x[0] + x[1] * x[1]) + (x[2] * x[2] + x[3] * x[3]);
                const f32x4 a = x * gg[h][j]; u32x2 w; w.x = cvt_pk_bf16(a[0], a[1]); w.y = cvt_pk_bf16(a[2], a[3]);
                *(u32x2*)(AP + (size_t)r * D + j * 256 + lane * 4) = w; }
            s_ = wave_sum(s_, lane);
            if (lane == 0) ss[r] = s_; }
    }
}

__device__ __forceinline__ void phase_final(const KP& p, int g, int b0, int nb) {
    int tid = p.tid_; asm volatile("" : "+v"(tid)); const int wave = tid >> 6, lane = tid & 63;
    if (p.bx_ < b0 || p.bx_ >= b0 + nb) return;
    const int gw = (p.bx_ - b0) * NWAVES + wave, NGW = nb * NWAVES;
    const float* ss = (const float*)(p.ws + ssa_off(g));
    const f32x4 gf0 = *(const f32x4*)(p.in(I_g_final) + lane * 4), gf1 = *(const f32x4*)(p.in(I_g_final) + 256 + lane * 4), gf2 = *(const f32x4*)(p.in(I_g_final) + 512 + lane * 4), gf3 = *(const f32x4*)(p.in(I_g_final) + 768 + lane * 4);
    for (int r0 = gw; r0 < R_LAT; r0 += 2 * NGW) {
        f32x4 v[2][4]; float sv[2];
#pragma unroll
        for (int h = 0; h < 2; ++h) { const int r = (r0 + h * NGW < R_LAT) ? r0 + h * NGW : r0; sv[h] = ss[r];
            const float* xr = p.out + ((size_t)g * R_LAT + r) * D;
#pragma unroll
            for (int j = 0; j < 4; ++j) v[h][j] = *(const f32x4*)(xr + j * 256 + lane * 4); }
#pragma unroll
        for (int h = 0; h < 2; ++h) { const int r = r0 + h * NGW; if (r >= R_LAT) continue;
            const float rs = __builtin_amdgcn_rsqf(sv[h] * (1.0f / 1024.0f) + EPS);
            float* xr = p.out + ((size_t)g * R_LAT + r) * D;
            *(f32x4*)(xr + lane * 4) = v[h][0] * rs * gf0; *(f32x4*)(xr + 256 + lane * 4) = v[h][1] * rs * gf1;
            *(f32x4*)(xr + 512 + lane * 4) = v[h][2] * rs * gf2; *(f32x4*)(xr + 768 + lane * 4) = v[h][3] * rs * gf3; }
    }
}

struct ChunkInfo { int row0, pos0, h; };
__device__ __forceinline__ ChunkInfo chunk_info(int item) {
    ChunkInfo ci;
    if (item < N_KV_LAT) { const int gb = item >> 6, ch = item & 15; ci.h = (item >> 4) & 3; ci.row0 = gb * SEQ + ch * 128; ci.pos0 = CTXL + ch * 128; }
    else { const int it2 = item - N_KV_LAT, gb = it2 >> 3, ch = it2 & 1; ci.h = (it2 >> 1) & 3; ci.row0 = R_LAT + gb * CTXL + ch * 128; ci.pos0 = ch * 128; }
    return ci;
}
__device__ __forceinline__ void load_chunk_f32(const int tid, const bf16_t* PM, int row0, int col0, LAS float* dst, int st) {
#pragma unroll
    for (int q = 0; q < 2; ++q) { const int idx = tid + q * NTHREADS, row = idx >> 3, cc = idx & 7; float f[8];
        unpack8(*(const u32x4*)(PM + (size_t)(row0 + row) * PMW + col0 + cc * 8), f);
        *(LAS f32x4*)(dst + row * st + cc * 8) = (f32x4){f[0], f[1], f[2], f[3]}; *(LAS f32x4*)(dst + row * st + cc * 8 + 4) = (f32x4){f[4], f[5], f[6], f[7]}; }
}
__device__ __forceinline__ void rotary_lds(const int tid, LAS float* buf, int st, int pos0, const float* rc, const float* rsn, float scale) {
#pragma unroll
    for (int q = 0; q < 8; ++q) { const int pidx = tid + q * NTHREADS, row = pidx >> 5, i = pidx & 31;
        const float c = rc[(pos0 + row) * 32 + i], s = rsn[(pos0 + row) * 32 + i];
        const float t1 = buf[row * st + i], t2 = buf[row * st + i + 32];
        buf[row * st + i] = (t1 * c - t2 * s) * scale; buf[row * st + i + 32] = (t1 * s + t2 * c) * scale; }
}

__device__ __forceinline__ void ret_kv_item(const KP& p, LAS unsigned char* lds, int l, int item) {
    int tid = p.tid_; asm volatile("" : "+v"(tid));
    const bf16_t* PM = (const bf16_t*)(p.ws + OFF_BIG);
    const float* rc = (const float*)(p.ws + OFF_ROPE); const float* rsn = rc + 2304 * 32;
    const float* logg = (const float*)(p.ws + OFF_LOGG) + l * 8;
    LAS unsigned char* KfT = lds;
    LAS unsigned char* KbT = lds + 16384;
    LAS unsigned char* Vt = lds + 32768;
    const ChunkInfo ci = chunk_info(item);
    __syncthreads();
    {
        const int row = tid >> 2, pc = tid & 3, pos = ci.pos0 + row;
        const bf16_t* src = PM + (size_t)(ci.row0 + row) * PMW + ci.h * 64;
        const float lgf = logg[ci.h], lgb = logg[4 + ci.h];
        const float wf = 0.125f * __expf(lgf * (float)(127 - row)), wb = 0.125f * __expf(lgb * (float)row);
        float cs[8], sn[8], t1[8], t2[8];
        { const f32x4 c0 = *(const f32x4*)(rc + pos * 32 + pc * 8), c1 = *(const f32x4*)(rc + pos * 32 + pc * 8 + 4), s0 = *(const f32x4*)(rsn + pos * 32 + pc * 8), s1 = *(const f32x4*)(rsn + pos * 32 + pc * 8 + 4);
#pragma unroll
          for (int j = 0; j < 4; ++j) { cs[j] = c0[j]; cs[4 + j] = c1[j]; sn[j] = s0[j]; sn[4 + j] = s1[j]; } }
        unpack8(*(const u32x4*)(src + 256 + pc * 8), t1); unpack8(*(const u32x4*)(src + 256 + 32 + pc * 8), t2);
        const int jo = (row & 7) * 2, jc = row >> 3;
#pragma unroll
        for (int j = 0; j < 8; ++j) {
            const float o1 = t1[j] * cs[j] - t2[j] * sn[j], o2 = t1[j] * sn[j] + t2[j] * cs[j];
            const int d1 = pc * 8 + j, d2 = 32 + pc * 8 + j;
            *(LAS unsigned short*)(KfT + d1 * 256 + ((jc ^ (d1 & 15)) << 4) + jo) = f2bf(o1 * wf); *(LAS unsigned short*)(KfT + d2 * 256 + ((jc ^ (d2 & 15)) << 4) + jo) = f2bf(o2 * wf);
            *(LAS unsigned short*)(KbT + d1 * 256 + ((jc ^ (d1 & 15)) << 4) + jo) = f2bf(o1 * wb); *(LAS unsigned short*)(KbT + d2 * 256 + ((jc ^ (d2 & 15)) << 4) + jo) = f2bf(o2 * wb);
        }
        const u32x4 v0 = *(const u32x4*)(src + 512 + pc * 16), v1 = *(const u32x4*)(src + 512 + pc * 16 + 8);
        const unsigned vv[8] = {v0.x, v0.y, v0.z, v0.w, v1.x, v1.y, v1.z, v1.w};
#pragma unroll
        for (int e2 = 0; e2 < 8; ++e2)
#pragma unroll
            for (int hh = 0; hh < 2; ++hh) { const int e = pc * 16 + e2 * 2 + hh; const unsigned short val = (unsigned short)(hh ? (vv[e2] >> 16) : (vv[e2] & 0xffffu));
                *(LAS unsigned short*)(Vt + e * 256 + ((jc ^ (e & 15)) << 4) + jo) = val; }
    }
    __syncthreads();
    const int w = __builtin_amdgcn_readfirstlane(tid >> 6), lane = tid & 63, c = lane & 15, gq = lane >> 4;
    const int dir = w >> 2, db = w & 3, d = 16 * db + c;
    LAS unsigned char* KT = dir ? KbT : KfT;
    const f32x4 z4 = (f32x4){0.f, 0.f, 0.f, 0.f};
    f32x4 acc[4] = {z4, z4, z4, z4};
#pragma unroll
    for (int t = 0; t < 4; ++t) {
        const bf16x8 af = *(const LAS bf16x8*)(KT + d * 256 + (((4 * t + gq) ^ (d & 15)) << 4));
#pragma unroll
        for (int eb = 0; eb < 4; ++eb) { const int e = 16 * eb + c;
            const bf16x8 bfr = *(const LAS bf16x8*)(Vt + e * 256 + (((4 * t + gq) ^ (e & 15)) << 4));
            acc[eb] = mfma16(af, bfr, acc[eb]); }
    }
    float* kv = (item < N_KV_LAT ? (float*)(p.ws + OFF_KV) + (size_t)item * 8192 : (float*)(p.ws + OFF_KVC) + (size_t)(l * N_KV_CTX + item - N_KV_LAT) * 8192) + dir * 4096;
#pragma unroll
    for (int eb = 0; eb < 4; ++eb)
#pragma unroll
        for (int r = 0; r < 4; ++r) kv[(16 * db + 4 * gq + r) * 64 + 16 * eb + c] = acc[eb][r];
}

__device__ __forceinline__ void ret_out_item(const KP& p, LAS unsigned char* lds, int g, int l, int item) {
    int tid = p.tid_; asm volatile("" : "+v"(tid));
    const bf16_t* PM = (const bf16_t*)(p.ws + OFF_BIG);
    const float* rc = (const float*)(p.ws + OFF_ROPE); const float* rsn = rc + 2304 * 32;
    const float* logg = (const float*)(p.ws + OFF_LOGG) + l * 8;
    LAS unsigned char* Qb = lds;
    LAS unsigned char* Kb = lds + 16384;
    LAS unsigned char* Vt = lds + 32768;
    LAS unsigned char* SfT = lds + 49152;
    LAS unsigned char* SbT = lds + 57344;
    LAS float* dtab = (LAS float*)(lds + 65536);
    const ChunkInfo ci = chunk_info(item);
    __syncthreads();
    {
        const int row = tid >> 2, pc = tid & 3, pos = ci.pos0 + row;
        const bf16_t* src = PM + (size_t)(ci.row0 + row) * PMW + ci.h * 64;
        float cs[8], sn[8];
        { const f32x4 c0 = *(const f32x4*)(rc + pos * 32 + pc * 8), c1 = *(const f32x4*)(rc + pos * 32 + pc * 8 + 4), s0 = *(const f32x4*)(rsn + pos * 32 + pc * 8), s1 = *(const f32x4*)(rsn + pos * 32 + pc * 8 + 4);
#pragma unroll
          for (int j = 0; j < 4; ++j) { cs[j] = c0[j]; cs[4 + j] = c1[j]; sn[j] = s0[j]; sn[4 + j] = s1[j]; } }
#pragma unroll
        for (int qk = 0; qk < 2; ++qk) {
            float t1[8], t2[8], o1[8], o2[8];
            unpack8(*(const u32x4*)(src + qk * 256 + pc * 8), t1); unpack8(*(const u32x4*)(src + qk * 256 + 32 + pc * 8), t2);
            const float sc = qk ? 0.125f : 1.0f;
#pragma unroll
            for (int j = 0; j < 8; ++j) { o1[j] = (t1[j] * cs[j] - t2[j] * sn[j]) * sc; o2[j] = (t1[j] * sn[j] + t2[j] * cs[j]) * sc; }
            LAS unsigned char* dst = (qk ? Kb : Qb) + row * 128;
            *(LAS u32x4*)(dst + ((pc ^ (row & 7)) << 4)) = pack8(o1);
            *(LAS u32x4*)(dst + (((4 + pc) ^ (row & 7)) << 4)) = pack8(o2);
        }
        {
            const u32x4 v0 = *(const u32x4*)(src + 512 + pc * 16), v1 = *(const u32x4*)(src + 512 + pc * 16 + 8);
            const unsigned vv[8] = {v0.x, v0.y, v0.z, v0.w, v1.x, v1.y, v1.z, v1.w};
#pragma unroll
            for (int e2 = 0; e2 < 8; ++e2)
#pragma unroll
                for (int hh = 0; hh < 2; ++hh) { const int e = pc * 16 + e2 * 2 + hh; const unsigned short val = (unsigned short)(hh ? (vv[e2] >> 16) : (vv[e2] & 0xffffu));
                    *(LAS unsigned short*)(Vt + e * 256 + ((((row >> 2) ^ (2 * (e & 15))) << 3)) + (row & 3) * 2) = val; }
        }
        {
            const int d = tid >> 3, e0 = (tid & 7) * 8;
            const float* KV = (const float*)(p.ws + OFF_KV) + d * 64 + e0;
            const float* KVC = (const float*)(p.ws + OFF_KVC) + (size_t)l * N_KV_CTX * 8192 + d * 64 + e0;
            const f32x4 z = (f32x4){0.f, 0.f, 0.f, 0.f};
            f32x4 fa = z, fb = z, ba = z, bb = z;
            if (item < N_KV_LAT) {
                const int ch = item & 15, lat0 = item - ch, c0 = (g * GB + (item >> 6)) * 8 + ci.h * 2;
                const float l128f = logg[ci.h] * 128.f, l128b = logg[4 + ci.h] * 128.f;
#pragma unroll 1
                for (int t0 = 0; t0 < 20; t0 += 10) {
                    f32x4 xa[10], xb[10]; float wt[10]; bool isf[10];
#pragma unroll
                    for (int q = 0; q < 10; ++q) { const int t = t0 + q; const bool fw = t < ch + 2; isf[q] = fw;
                        const int k = fw ? t - 2 : t - (ch + 2) - 2;
                        const float* x; if (fw) x = k < 0 ? KVC + (size_t)(c0 + k + 2) * 8192 : KV + (size_t)(lat0 + k) * 8192;
                        else x = (k < 0 ? KVC + (size_t)(c0 - 1 - k) * 8192 : KV + (size_t)(lat0 + 15 - k) * 8192) + 4096;
                        const bool valid = t < 19; if (!valid) x = KVC;
                        wt[q] = valid ? (fw ? __expf(l128f * (float)(ch - 1 - k)) : __expf(l128b * (float)(14 - ch - k))) : 0.f;
                        xa[q] = *(const f32x4*)x; xb[q] = *(const f32x4*)(x + 4); }
#pragma unroll
                    for (int q = 0; q < 10; ++q) { if (isf[q]) { fa += xa[q] * wt[q]; fb += xb[q] * wt[q]; } else { ba += xa[q] * wt[q]; bb += xb[q] * wt[q]; } }
                }
            } else {
                const int it2 = item - N_KV_LAT, ch = it2 & 1, c0 = it2 - ch;
                if (ch == 1) { const float* x = KVC + (size_t)c0 * 8192; fa = *(const f32x4*)x; fb = *(const f32x4*)(x + 4); }
                else { const float* x = KVC + (size_t)(c0 + 1) * 8192 + 4096; ba = *(const f32x4*)x; bb = *(const f32x4*)(x + 4); }
            }
#pragma unroll
            for (int dir = 0; dir < 2; ++dir) { const f32x4 a = dir ? ba : fa, b = dir ? bb : fb;
                LAS unsigned char* dstT = dir ? SbT : SfT; const float vals[8] = {a[0], a[1], a[2], a[3], b[0], b[1], b[2], b[3]};
#pragma unroll
                for (int jj = 0; jj < 8; ++jj) { const int e = e0 + jj; *(LAS unsigned short*)(dstT + e * 128 + (((d >> 3) ^ (e & 7)) << 4) + (d & 7) * 2) = f2bf(vals[jj]); } }
        }
        const float lgf = logg[ci.h], lgb = logg[4 + ci.h];
        if (tid <= 256) { const int t = tid - 128; dtab[tid] = t > 0 ? __expf(lgf * (float)t) : (t < 0 ? __expf(lgb * (float)(-t)) : 2.0f); }
    }
    __syncthreads();
    const int w = __builtin_amdgcn_readfirstlane(tid >> 6), lane = tid & 63, c = lane & 15, gq = lane >> 4;
    const int il = 16 * w + c;
    f32x4 g4v[4]; u32x2 grv[4];
    { const float* gn_ = p.in(I_ret_gn) + l * 256 + ci.h * 64; const bf16_t* gsrc_ = PM + (size_t)(ci.row0 + il) * PMW + 768 + ci.h * 64;
#pragma unroll
      for (int eb = 0; eb < 4; ++eb) { g4v[eb] = *(const f32x4*)(gn_ + 16 * eb + 4 * gq); grv[eb] = *(const u32x2*)(gsrc_ + 16 * eb + 4 * gq); } }
    bf16x8 qf[2];
#pragma unroll
    for (int ks = 0; ks < 2; ++ks) qf[ks] = *(const LAS bf16x8*)(Qb + il * 128 + (((4 * ks + gq) ^ (il & 7)) << 4));
    const f32x4 z4 = (f32x4){0.f, 0.f, 0.f, 0.f};
    f32x4 st[8];
#pragma unroll
    for (int jb = 0; jb < 8; ++jb) { const int j = 16 * jb + c;
        const bf16x8 k0 = *(const LAS bf16x8*)(Kb + j * 128 + (((0 + gq) ^ (j & 7)) << 4)), k1 = *(const LAS bf16x8*)(Kb + j * 128 + (((4 + gq) ^ (j & 7)) << 4));
        st[jb] = mfma16(k0, qf[0], z4); st[jb] = mfma16(k1, qf[1], st[jb]); }
#pragma unroll
    for (int jb = 0; jb < 8; ++jb)
#pragma unroll
        for (int r = 0; r < 4; ++r) st[jb][r] *= dtab[128 + il - (16 * jb + 4 * gq + r)];
    f32x4 oT[4], cf[4], cb[4];
#pragma unroll
    for (int eb = 0; eb < 4; ++eb) { oT[eb] = z4; cf[eb] = z4; cb[eb] = z4; }
#pragma unroll
    for (int t = 0; t < 4; ++t) {
        union { u32x4 u; bf16x8 v; } pk;
        pk.u.x = cvt_pk_bf16(st[2 * t][0], st[2 * t][1]); pk.u.y = cvt_pk_bf16(st[2 * t][2], st[2 * t][3]);
        pk.u.z = cvt_pk_bf16(st[2 * t + 1][0], st[2 * t + 1][1]); pk.u.w = cvt_pk_bf16(st[2 * t + 1][2], st[2 * t + 1][3]);
#pragma unroll
        for (int eb = 0; eb < 4; ++eb) { const int e = 16 * eb + c;
            union { u32x4 u; bf16x8 v; } va;
            const u32x2 lo = *(const LAS u32x2*)(Vt + e * 256 + (((8 * t + gq) ^ (2 * (e & 15))) << 3)), hi = *(const LAS u32x2*)(Vt + e * 256 + (((8 * t + 4 + gq) ^ (2 * (e & 15))) << 3));
            va.u.x = lo.x; va.u.y = lo.y; va.u.z = hi.x; va.u.w = hi.y;
            oT[eb] = mfma16(va.v, pk.v, oT[eb]); }
    }
#pragma unroll
    for (int eb = 0; eb < 4; ++eb) { const int e = 16 * eb + c;
#pragma unroll
        for (int ks = 0; ks < 2; ++ks) {
            const bf16x8 af = *(const LAS bf16x8*)(SfT + e * 128 + (((4 * ks + gq) ^ (e & 7)) << 4)), ab = *(const LAS bf16x8*)(SbT + e * 128 + (((4 * ks + gq) ^ (e & 7)) << 4));
            cf[eb] = mfma16(af, qf[ks], cf[eb]); cb[eb] = mfma16(ab, qf[ks], cb[eb]); } }
    const float wqf = dtab[128 + il + 1], wqb = dtab[il];
    float o[16]; float sm = 0.f;
#pragma unroll
    for (int eb = 0; eb < 4; ++eb)
#pragma unroll
        for (int r = 0; r < 4; ++r) { o[eb * 4 + r] = oT[eb][r] + wqf * cf[eb][r] + wqb * cb[eb][r]; sm += o[eb * 4 + r]; }
    sm += shx(sm, 16, lane); sm += shx(sm, 32, lane);
    const float mean = sm * (1.0f / 64.0f);
    float vq = 0.f;
#pragma unroll
    for (int e = 0; e < 16; ++e) { o[e] -= mean; vq += o[e] * o[e]; }
    vq += shx(vq, 16, lane); vq += shx(vq, 32, lane);
    const float rstd = __builtin_amdgcn_rsqf(vq * (1.0f / 64.0f) + EPS);
    bf16_t* S = (bf16_t*)(p.ws + OFF_S) + (size_t)(ci.row0 + il) * D + ci.h * 64;
#pragma unroll
    for (int eb = 0; eb < 4; ++eb) { const int e0 = 16 * eb + 4 * gq;
        const f32x4 g4 = g4v[eb]; const u32x2 gr = grv[eb];
        const float g0 = bf2f(gr.x & 0xffffu), g1 = __uint_as_float(gr.x & 0xffff0000u), g2 = bf2f(gr.y & 0xffffu), g3 = __uint_as_float(gr.y & 0xffff0000u);
        u32x2 wv; wv.x = cvt_pk_bf16(o[eb * 4 + 0] * rstd * g4[0] * siluf_(g0), o[eb * 4 + 1] * rstd * g4[1] * siluf_(g1));
        wv.y = cvt_pk_bf16(o[eb * 4 + 2] * rstd * g4[2] * siluf_(g2), o[eb * 4 + 3] * rstd * g4[3] * siluf_(g3));
        *(u32x2*)(S + e0) = wv; }
}

__device__ __forceinline__ void conf_item(const KP& p, LAS unsigned char* lds, int l, int item) {
    int tid = p.tid_; asm volatile("" : "+v"(tid)); const int wave = tid >> 6, lane = tid & 63;
    const bf16_t* PM = (const bf16_t*)(p.ws + OFF_BIG);
    LAS float* hbuf = (LAS float*)lds;
    LAS float* ybuf = (LAS float*)(lds + 65536);
    int seqrow0, L, n0;
    if (item < R_LAT / 32) { seqrow0 = (item >> 6) * SEQ; L = SEQ; n0 = (item & 63) * 32; }
    else { const int it2 = item - R_LAT / 32; seqrow0 = R_LAT + (it2 >> 3) * CTXL; L = CTXL; n0 = (it2 & 7) * 32; }
    __syncthreads();
    {
        u32x4 a1[4], a2[4]; bool ok[4];
#pragma unroll
        for (int q = 0; q < 4; ++q) { const int idx = tid + q * NTHREADS, hr = idx >> 5, cc = idx & 31, tok = n0 - 15 + hr;
            ok[q] = idx < 62 * 32 && tok >= 0 && tok < L;
            const bf16_t* src = PM + (size_t)(seqrow0 + (ok[q] ? tok : n0)) * PMW + 1024 + cc * 8;
            a1[q] = *(const u32x4*)src; a2[q] = *(const u32x4*)(src + 256); }
#pragma unroll
        for (int q = 0; q < 4; ++q) { const int idx = tid + q * NTHREADS, hr = idx >> 5, cc = idx & 31;
            if (idx < 62 * 32) { float x1[8], x2[8], hv[8]; unpack8(a1[q], x1); unpack8(a2[q], x2);
#pragma unroll
                for (int j = 0; j < 8; ++j) hv[j] = ok[q] ? x1[j] * sigmoidf_(x2[j]) : 0.f;
                *(LAS f32x4*)(hbuf + hr * 256 + cc * 8) = (f32x4){hv[0], hv[1], hv[2], hv[3]}; *(LAS f32x4*)(hbuf + hr * 256 + cc * 8 + 4) = (f32x4){hv[4], hv[5], hv[6], hv[7]}; } }
    }
    __syncthreads();
    { const int c = tid & 255, q = tid >> 8;
      float w[31], xw[46];
#pragma unroll
      for (int j = 0; j < 31; ++j) w[j] = p.in(I_conv_dw)[((size_t)l * 31 + j) * 256 + c];
      const float bias = p.in(I_conv_db)[l * 256 + c];
#pragma unroll
      for (int j = 0; j < 46; ++j) xw[j] = hbuf[(q * 16 + j) * 256 + c];
#pragma unroll
      for (int tt = 0; tt < 16; ++tt) { float y = bias;
#pragma unroll
          for (int j = 0; j < 31; ++j) y += w[j] * xw[tt + j];
          ybuf[(q * 16 + tt) * 256 + c] = y; } }
    __syncthreads();
    { const f32x4 lg = *(const f32x4*)(p.in(I_conv_ln_g) + l * 256 + lane * 4), lb = *(const f32x4*)(p.in(I_conv_ln_b) + l * 256 + lane * 4);
      bf16_t* S = (bf16_t*)(p.ws + OFF_S);
#pragma unroll
      for (int t4 = 0; t4 < 4; ++t4) { const int tt = wave * 4 + t4;
          f32x4 v = *(const LAS f32x4*)(ybuf + tt * 256 + lane * 4);
          const float mean = wave_sum((v[0] + v[1]) + (v[2] + v[3]), lane) * (1.0f / 256.0f);
          v = v - mean;
          const float var = wave_sum((v[0] * v[0] + v[1] * v[1]) + (v[2] * v[2] + v[3] * v[3]), lane) * (1.0f / 256.0f);
          const float rstd = __builtin_amdgcn_rsqf(var + EPS);
          f32x4 y = v * rstd * lg + lb;
#pragma unroll
          for (int j = 0; j < 4; ++j) y[j] = siluf_(y[j]);
          u32x2 w2; w2.x = cvt_pk_bf16(y[0], y[1]); w2.y = cvt_pk_bf16(y[2], y[3]);
          *(u32x2*)(S + (size_t)(seqrow0 + n0 + tt) * D + 256 + lane * 4) = w2; } }
}

__device__ __forceinline__ void gmlp_item(const KP& p, LAS unsigned char* lds, int l, int item) {
    int tid = p.tid_; asm volatile("" : "+v"(tid)); const int wave = __builtin_amdgcn_readfirstlane(tid >> 6), lane = tid & 63;
    const bf16_t* PM = (const bf16_t*)(p.ws + OFF_BIG);
    LAS unsigned char* vT = lds;
    const int row0 = item * 128;
    __syncthreads();
    { const f32x4 lg = *(const f32x4*)(p.in(I_gmlp_ln_g) + l * 256 + lane * 4), lb = *(const f32x4*)(p.in(I_gmlp_ln_b) + l * 256 + lane * 4);
      u32x2 zz[16];
#pragma unroll
      for (int t16 = 0; t16 < 16; ++t16) zz[t16] = *(const u32x2*)(PM + (size_t)(row0 + wave * 16 + t16) * PMW + 1792 + lane * 4);
#pragma unroll
      for (int t16 = 0; t16 < 16; ++t16) { const int tt = wave * 16 + t16;
          f32x4 v = (f32x4){geluf_(bf2f(zz[t16].x & 0xffffu)), geluf_(__uint_as_float(zz[t16].x & 0xffff0000u)), geluf_(bf2f(zz[t16].y & 0xffffu)), geluf_(__uint_as_float(zz[t16].y & 0xffff0000u))};
          const float mean = wave_sum((v[0] + v[1]) + (v[2] + v[3]), lane) * (1.0f / 256.0f);
          v = v - mean;
          const float var = wave_sum((v[0] * v[0] + v[1] * v[1]) + (v[2] * v[2] + v[3] * v[3]), lane) * (1.0f / 256.0f);
          const float rstd = __builtin_amdgcn_rsqf(var + EPS);
          v = v * rstd * lg + lb;
          const int jc = tt >> 3, jo = (tt & 7) * 2;
#pragma unroll
          for (int q = 0; q < 4; ++q) { const int cc = lane * 4 + q; *(LAS unsigned short*)(vT + cc * 256 + ((jc ^ (cc & 15)) << 4) + jo) = f2bf(v[q]); } } }
    __syncthreads();
    const int c = lane & 15, gq = lane >> 4, gw = wave & 3, ih = wave >> 2;
    const float* wsr = p.in(I_gmlp_ws) + (((size_t)l * 4 + gw) * 128 + ih * 64) * 128 + (size_t)c * 128 + 8 * gq;
    const f32x4 z4 = (f32x4){0.f, 0.f, 0.f, 0.f};
    f32x4 acc[4][4];
#pragma unroll
    for (int ib = 0; ib < 4; ++ib)
#pragma unroll
        for (int cb = 0; cb < 4; ++cb) acc[ib][cb] = z4;
    f32x4 wa[4][2], wb[4][2];
#pragma unroll
    for (int ib = 0; ib < 4; ++ib) { wa[ib][0] = *(const f32x4*)(wsr + ib * 16 * 128); wa[ib][1] = *(const f32x4*)(wsr + ib * 16 * 128 + 4); }
#pragma unroll
    for (int t = 0; t < 4; ++t) {
        if (t < 3) {
#pragma unroll
            for (int ib = 0; ib < 4; ++ib) { wb[ib][0] = *(const f32x4*)(wsr + ib * 16 * 128 + 32 * (t + 1)); wb[ib][1] = *(const f32x4*)(wsr + ib * 16 * 128 + 32 * (t + 1) + 4); } }
        bf16x8 bfr[4];
#pragma unroll
        for (int cb = 0; cb < 4; ++cb) { const int cc = 64 * gw + 16 * cb + c; bfr[cb] = *(const LAS bf16x8*)(vT + cc * 256 + (((4 * t + gq) ^ (cc & 15)) << 4)); }
#pragma unroll
        for (int ib = 0; ib < 4; ++ib) {
            union { u32x4 u; bf16x8 v; } af;
            af.u.x = cvt_pk_bf16(wa[ib][0][0], wa[ib][0][1]); af.u.y = cvt_pk_bf16(wa[ib][0][2], wa[ib][0][3]); af.u.z = cvt_pk_bf16(wa[ib][1][0], wa[ib][1][1]); af.u.w = cvt_pk_bf16(wa[ib][1][2], wa[ib][1][3]);
#pragma unroll
            for (int cb = 0; cb < 4; ++cb) acc[ib][cb] = mfma16(af.v, bfr[cb], acc[ib][cb]);
        }
#pragma unroll
        for (int ib = 0; ib < 4; ++ib) { wa[ib][0] = wb[ib][0]; wa[ib][1] = wb[ib][1]; }
    }
    const float* bs = p.in(I_gmlp_bs) + ((size_t)l * 4 + gw) * 128 + ih * 64;
    bf16_t* S = (bf16_t*)(p.ws + OFF_S);
#pragma unroll
    for (int ib = 0; ib < 4; ++ib) {
        unsigned short uu[4][4]; float bsv[4];
#pragma unroll
        for (int r = 0; r < 4; ++r) { const int il = 16 * ib + 4 * gq + r; bsv[r] = bs[il];
#pragma unroll
            for (int cb = 0; cb < 4; ++cb) uu[r][cb] = PM[(size_t)(row0 + ih * 64 + il) * PMW + 1536 + 64 * gw + 16 * cb + c]; }
#pragma unroll
        for (int r = 0; r < 4; ++r) { const int i = ih * 64 + 16 * ib + 4 * gq + r;
#pragma unroll
            for (int cb = 0; cb < 4; ++cb) S[(size_t)(row0 + i) * D + 512 + 64 * gw + 16 * cb + c] = f2bf(geluf_(bf2f(uu[r][cb])) * (acc[ib][cb][r] + bsv[r])); }
    }
}

__device__ __forceinline__ void fnet_t_item(const KP& p, LAS unsigned char* lds, int item) {
    int tid = p.tid_; asm volatile("" : "+v"(tid));
    const bf16_t* PM = (const bf16_t*)(p.ws + OFF_BIG);
    LAS float* T = (LAS float*)lds;
    int seqrow0, L, s_local, cblk, kb; bf16_t* dstbase;
    if (item < GB * 4 * 16) { s_local = item >> 6; cblk = (item >> 4) & 3; kb = item & 15; L = SEQ; seqrow0 = s_local * SEQ; dstbase = (bf16_t*)(p.ws + OFF_PQT); }
    else { const int it2 = item - GB * 4 * 16; s_local = it2 >> 3; cblk = (it2 >> 1) & 3; kb = it2 & 1; L = CTXL; seqrow0 = R_LAT + s_local * CTXL; dstbase = (bf16_t*)(p.ws + OFF_PQTC); }
    __syncthreads();
    for (int idx = tid; idx < 4 * 64 * 8; idx += NTHREADS) { const int which = idx >> 9, r = (idx >> 3) & 63, cc = idx & 7, k = kb * 64 + r;
        const int tok = (which & 1) ? (L - k) : k; const int col = (which < 2 ? 2048 : 2304) + cblk * 64 + cc * 8; float f[8];
        if (tok < L) unpack8(*(const u32x4*)(PM + (size_t)(seqrow0 + tok) * PMW + col), f);
        else {
#pragma unroll
            for (int j = 0; j < 8; ++j) f[j] = 0.f; }
#pragma unroll
        for (int j = 0; j < 8; ++j) T[(which * 64 + r) * 65 + cc * 8 + j] = f[j]; }
    __syncthreads();
    const int c = tid >> 3, kq = tid & 7;
    float pe[8], qo[8];
#pragma unroll
    for (int e = 0; e < 8; ++e) { const int kl = kq * 8 + e; pe[e] = T[(0 * 64 + kl) * 65 + c] + T[(1 * 64 + kl) * 65 + c]; qo[e] = T[(2 * 64 + kl) * 65 + c] - T[(3 * 64 + kl) * 65 + c]; }
    if (kb == 0 && kq == 0) qo[0] = bf2f(PM[(size_t)(seqrow0 + L / 2) * PMW + 2048 + cblk * 64 + c]);
    bf16_t* dst = dstbase + (size_t)(s_local * 256 + cblk * 64 + c) * L;
    *(u32x4*)(dst + kb * 64 + kq * 8) = pack8(pe);
    *(u32x4*)(dst + L / 2 + kb * 64 + kq * 8) = pack8(qo);
}

__device__ __forceinline__ u32x4 ld8p(const bf16_t* p, bool ok) { return ok ? *(const u32x4*)p : (u32x4){0u, 0u, 0u, 0u}; }
__device__ __forceinline__ void fma8(float* y, const u32x4 a, const float* w) { float f[8]; unpack8(a, f);
#pragma unroll
    for (int j = 0; j < 8; ++j) y[j] += f[j] * w[j]; }
__device__ __forceinline__ void phase_ffn_conv(const KP& p, int g, int l, int parts, int b0, int nb, int halves) {
    int tid = p.tid_; asm volatile("" : "+v"(tid));
    if (parts & 1) { float* ssA = (float*)(p.ws + ssa_off(g)); for (int i = p.bx_ * NTHREADS + tid; i < R; i += NBLK * NTHREADS) ssA[i] = 0.f; }
    if (tid >= 352 || p.bx_ < b0 || p.bx_ >= b0 + nb) return;
    bf16_t* UP = (bf16_t*)(p.ws + OFF_BIG);
    const int c8 = tid * 8, G = nb, bx = p.bx_ - b0;
    const float* dw = p.in(I_ffn_dw) + (size_t)l * 9 * DFF + c8; const float* db = p.in(I_ffn_db) + (size_t)l * DFF + c8;
    float w[9][8], bias[8];
#pragma unroll
    for (int k = 0; k < 9; ++k) { const f32x4 w0 = *(const f32x4*)(dw + k * DFF), w1 = *(const f32x4*)(dw + k * DFF + 4);
#pragma unroll
        for (int j = 0; j < 4; ++j) { w[k][j] = w0[j]; w[k][4 + j] = w1[j]; } }
    { const f32x4 b0 = *(const f32x4*)db, b1 = *(const f32x4*)(db + 4);
#pragma unroll
      for (int j = 0; j < 4; ++j) { bias[j] = b0[j]; bias[4 + j] = b1[j]; } }
    if (parts & 2)
    for (int it0 = bx; it0 < GB * 32 * halves; it0 += G) {
        const int rid0 = it0 / halves, hf = it0 - rid0 * halves;
        const int rid = (G == 256 && halves == 1) ? ((rid0 & 7) * 32 + (rid0 >> 3)) : rid0;
        const int gb = rid >> 5, gr = rid & 31;
        const int c_lo = hf * (64 / halves), c_hi = c_lo + 64 / halves;
        const bool up = gr > 0, dn = gr < 31;
        const bf16_t* a1 = UP + (size_t)(gb * SEQ + gr * 64 + c_lo) * UPW + c8;
        const bf16_t* a0 = a1 - (size_t)64 * UPW; const bf16_t* a2 = a1 + (size_t)64 * UPW;
        const bool lf = c_lo > 0;
        u32x4 L0 = ld8p(a0 - UPW, up && lf), L1 = ld8p(a1 - UPW, lf), L2 = ld8p(a2 - UPW, dn && lf), M0 = ld8p(a0, up), M1 = ld8p(a1, true), M2 = ld8p(a2, dn);
        u32x4 R0 = ld8p(a0 + UPW, up), R1 = ld8p(a1 + UPW, true), R2 = ld8p(a2 + UPW, dn);
        bf16_t* hp = UP + (size_t)(gb * SEQ + gr * 64 + c_lo) * UPW + DFF + c8;
        u32x4 bq = *(const u32x4*)hp;
#pragma unroll 1
        for (int gc = c_lo; gc < c_hi; ++gc) {
            const bool nt2 = gc < 62; const size_t o = (size_t)(gc - c_lo + 2) * UPW;
            const u32x4 N0 = ld8p(a0 + o, up && nt2), N1 = ld8p(a1 + o, nt2), N2 = ld8p(a2 + o, dn && nt2);
            const u32x4 bn = ld8p(hp + UPW, gc < 63);
            float y[8];
#pragma unroll
            for (int j = 0; j < 8; ++j) y[j] = bias[j];
            fma8(y, L0, w[0]); fma8(y, M0, w[1]); fma8(y, R0, w[2]);
            fma8(y, L1, w[3]); fma8(y, M1, w[4]); fma8(y, R1, w[5]);
            fma8(y, L2, w[6]); fma8(y, M2, w[7]); fma8(y, R2, w[8]);
            float bv[8]; unpack8(bq, bv);
#pragma unroll
            for (int j = 0; j < 8; ++j) y[j] = siluf_(y[j]) * bv[j];
            *(u32x4*)hp = pack8(y);
            L0 = M0; L1 = M1; L2 = M2; M0 = R0; M1 = R1; M2 = R2; R0 = N0; R1 = N1; R2 = N2; bq = bn; hp += UPW;
        }
    }
    if (parts & 4) {
        for (int it = bx; it < R_CTX / 8; it += G) {
            const int s_ = it >> 5, t0 = (it & 31) * 8;
            const bf16_t* a = UP + (size_t)(R_LAT + s_ * CTXL + t0) * UPW + c8;
            u32x4 Lq = ld8p(a - UPW, t0 > 0), Mq = ld8p(a, true);
#pragma unroll 1
            for (int t = 0; t < 8; ++t) {
                const u32x4 Rq = ld8p(a + (size_t)(t + 1) * UPW, t0 + t + 1 < CTXL);
                bf16_t* hp = UP + (size_t)(R_LAT + s_ * CTXL + t0 + t) * UPW + DFF + c8;
                const u32x4 bq = *(const u32x4*)hp;
                float y[8];
#pragma unroll
                for (int j = 0; j < 8; ++j) y[j] = bias[j];
                fma8(y, Lq, w[3]); fma8(y, Mq, w[4]); fma8(y, Rq, w[5]);
                float bv[8]; unpack8(bq, bv);
#pragma unroll
                for (int j = 0; j < 8; ++j) y[j] = siluf_(y[j]) * bv[j];
                *(u32x4*)hp = pack8(y);
                Lq = Mq; Mq = Rq;
            }
        }
    }
}

#ifndef DUP_LP
#define DUP_LP 0
#endif

__device__ __forceinline__ unsigned wl_off(int l) { return (unsigned)OFF_W + (unsigned)l * (unsigned)W_LAYER; }
__device__ __forceinline__ unsigned mod_off(int l) { return (unsigned)OFF_MOD + (unsigned)l * (unsigned)(17 * 6144 * 4); }

__device__ __forceinline__ void ph_l1(const KP& p, LAS unsigned char* lds, int g, int l) {
    unsigned char* ws = p.ws; const bool ctx_full = (g == 0 && l == 0);
    pg8::TileSched S{}; S.G = NBLK; S.c = p.bx_; S.nseg = 1;
    S.n1M = NLT; S.n1N = NCOLS / 256; S.n2M = g == 0 ? NCT : 0; S.n2N = ctx_full ? NCOLS / 256 : 2; S.pn2_0 = ctx_full ? 0 : 1;
    S.A = ap_off(g); S.B = (unsigned)(wl_off(l) + (unsigned)W_IN); S.a_tstep = (unsigned)256 * D * 2; S.b_tstep = (unsigned)256 * D * 2;
    EpiWin E{(const float*)(ws + ssa_off(g)), (const float*)(ws + (unsigned)OFF_SHW1 + (unsigned)l * (unsigned)(17 * NCOLS * 4)), p.in(I_b_gate) + (size_t)l * GTW, (bf16_t*)(ws + OFF_BIG), (bf16_t*)(ws + OFF_GT), g};
    pg8::gemm_phase(lds, p.ws, p.tid_, D, D, D, true, S, E);
}
__device__ __forceinline__ void ph_l2(const KP& p, LAS unsigned char* lds, int g, int l) {
    const bool ctx_full = (g == 0 && l == 0); const int G = NBLK;
    const int n_kv = g == 0 ? N_KV : N_KV_LAT, n_conf = (ctx_full ? R : R_LAT) / 32, n_gm = (ctx_full ? R : R_LAT) / 128, n_fn = GB * 4 * 16 + (ctx_full ? NB * 4 * 2 : 0);
    const int total = n_kv + n_conf + n_gm + n_fn;
    { float* ssB = (float*)(p.ws + ssb_off(g)); for (int i = p.bx_ * NTHREADS + p.tid_; i < R; i += G * NTHREADS) ssB[i] = 0.f; }
    const int bx = p.bx_, n_small = total - n_gm, nb2 = G - n_gm, head = (nb2 > 0 && 7 * nb2 < n_small) ? 7 * nb2 : 0;
#define L2_SMALL(t_) do { int t = (t_); if (t < n_kv) ret_kv_item(p, lds, l, t); else if ((t -= n_kv) < n_fn) fnet_t_item(p, lds, t); else conf_item(p, lds, l, t - n_fn); } while (0)
    if (bx < n_gm) gmlp_item(p, lds, l, bx);
    else if (head) { for (int r7 = 0; r7 < 7; ++r7) L2_SMALL(r7 * nb2 + (bx - n_gm)); }
    for (int t2 = head + bx; t2 < n_small; t2 += G) L2_SMALL(t2);
#undef L2_SMALL
    __syncthreads();
}
__device__ __forceinline__ void ph_l3(const KP& p, LAS unsigned char* lds, int g, int l) {
    unsigned char* ws = p.ws; const bool ctx_full = (g == 0 && l == 0); const int G = NBLK, bx = p.bx_;
    const int nd = 64 + (ctx_full ? NB : 0);
    if (bx < nd) {
        const bool isc = bx >= 64;
        const int Kd = isc ? CTXL : SEQ;
        pg8::TileSched S{}; S.G = G; S.nseg = 1;
        S.n1M = isc ? 1 : 8; S.n1N = isc ? NB : GB; S.c = isc ? bx - 64 : bx;
        S.A = (unsigned)((isc ? OFF_DC : OFF_DM)); S.B = (unsigned)((isc ? OFF_PQTC : OFF_PQT)); S.a_tstep = (unsigned)256 * Kd * 2; S.b_tstep = (unsigned)256 * Kd * 2;
        EpiDft E{(bf16_t*)(ws + OFF_S), isc ? R_LAT : 0, Kd, isc ? 0.0625f : 0.02209708691207961f};
        pg8::gemm_phase(lds, p.ws, p.tid_, Kd, Kd, Kd, true, S, E);
    } else {
        const int n = ctx_full ? N_KV : N_KV_LAT;
        for (int it = bx - nd; it < n; it += G - nd) ret_out_item(p, lds, g, l, it);
        __syncthreads();
    }
}
__device__ __forceinline__ void ph_l5(const KP& p, LAS unsigned char* lds, int g, int l) {
    unsigned char* ws = p.ws; const bool ctx_full = (g == 0 && l == 0);
    pg8::TileSched S{}; S.G = NBLK; S.c = p.bx_; S.nseg = 4;
    S.n1M = NLT; S.n1N = 4; S.n2M = ctx_full ? NCT : 0; S.n2N = 4;
    S.A = (unsigned)(OFF_S); S.B = (unsigned)(wl_off(l) + (unsigned)W_O); S.a_tstep = (unsigned)256 * D * 2; S.b_tstep = (unsigned)256 * 256 * 2; S.a_segstep = (unsigned)256 * 2; S.b_segstep = (unsigned)1024 * 256 * 2;
    EpiMerge E{(const unsigned char*)(ws + OFF_GT), (bf16_t*)(ws + OFF_BIG)};
    pg8::gemm_phase(lds, p.ws, p.tid_, 256, D, 256, true, S, E);
}
__device__ __forceinline__ void ph_l6(const KP& p, LAS unsigned char* lds, int g, int l) {
    unsigned char* ws = p.ws; const bool ctx_full = (g == 0 && l == 0);
    pg8::TileSched S{}; S.G = NBLK; S.c = p.bx_; S.nseg = 1;
    S.n1M = NLT; S.n1N = 4; S.n2M = ctx_full ? NCT : 0; S.n2N = 4;
    S.A = (unsigned)(OFF_BIG); S.B = (unsigned)(wl_off(l) + (unsigned)W_OUT); S.a_tstep = (unsigned)256 * D * 2; S.b_tstep = (unsigned)256 * D * 2;
    EpiResid E{l == 0 ? p.in(I_x) : (const float*)p.out, l == 0 ? p.in(I_ctx) : (const float*)(ws + OFF_XC), p.out, (float*)(ws + OFF_XC),
               (const float*)(ws + mod_off(l) + 2 * 4096), (const float*)(ws + mod_off(l) + 4 * 4096), (bf16_t*)(ws + ap_off(g)), (float*)(ws + ssb_off(g)), g};
    pg8::gemm_phase(lds, p.ws, p.tid_, D, D, D, false, S, E);
}
__device__ __forceinline__ void ph_l7(const KP& p, LAS unsigned char* lds, int g, int l) {
    unsigned char* ws = p.ws; const bool ctx_full = (g == 0 && l == 0);
    pg8::TileSched S{}; S.G = NBLK; S.c = p.bx_; S.nseg = 1;
    S.n1M = NLT; S.n1N = UPW / 256; S.n2M = ctx_full ? NCT : 0; S.n2N = UPW / 256;
    S.A = ap_off(g); S.B = (unsigned)(wl_off(l) + (unsigned)W_UP); S.a_tstep = (unsigned)256 * D * 2; S.b_tstep = (unsigned)256 * D * 2;
    EpiUp E{(const float*)(ws + ssb_off(g)), (const float*)(ws + (unsigned)OFF_SHW2 + (unsigned)l * (unsigned)(17 * UPW * 4)), (bf16_t*)(ws + OFF_BIG), g};
    pg8::gemm_phase(lds, p.ws, p.tid_, D, D, D, true, S, E);
}
__device__ __forceinline__ void ph_l9(const KP& p, LAS unsigned char* lds, int g, int l, int which = 0) {
    unsigned char* ws = p.ws; const bool ctx_full = (g == 0 && l == 0);
    pg8::TileSched S{}; S.G = NBLK; S.c = p.bx_; S.nseg = 1;
    S.n1M = which == 2 ? 0 : NLT; S.n1N = 4; S.n2M = (ctx_full && which != 1) ? NCT : 0; S.n2N = 4;
    if (which == 2) S.pm2_x = NLT;
    S.A = (unsigned)OFF_BIG + (unsigned)DFF * 2u; S.B = (unsigned)(wl_off(l) + (unsigned)W_DN); S.a_tstep = (unsigned)256 * UPW * 2; S.b_tstep = (unsigned)256 * DFF * 2;
    EpiResid E{p.out, (const float*)(ws + OFF_XC), p.out, (float*)(ws + OFF_XC), (const float*)(ws + mod_off(l) + 5 * 4096),
               l == 0 ? (const float*)(ws + mod_off(1) + 4096) : nullptr, (bf16_t*)(ws + ap_off(g)), (float*)(ws + ssa_off(g)), g};
    pg8::gemm_phase(lds, p.ws, p.tid_, DFF, UPW, DFF, false, S, E);
}

__global__ void __launch_bounds__(NTHREADS) mega(KArgs a) {
    extern __shared__ __attribute__((aligned(16))) unsigned char lds_raw[];
    LAS unsigned char* lds = (LAS unsigned char*)lds_raw;
    volatile LAS unsigned* misc = (volatile LAS unsigned*)(lds + MISC_OFF);
    if (threadIdx.x < 64) misc[threadIdx.x] = 0u;
    if (threadIdx.x < 30) { const unsigned long long v = (unsigned long long)a.in[threadIdx.x]; LAS unsigned* t = (LAS unsigned*)(lds + PTAB_OFF) + 2 * threadIdx.x; t[0] = (unsigned)v; t[1] = (unsigned)(v >> 32); }
    __syncthreads();
    const int wid_s = __builtin_amdgcn_readfirstlane((int)(threadIdx.x >> 6));
    cg::grid_group grid = cg::this_grid();
    XcdBarrier xb = xcd_barrier_post((unsigned*)(a.ws + OFF_BAR), misc + 8);
    grid.sync();
#define MK_Q() KP q; { int w_ = wid_s, b_ = blockIdx.x; unsigned z_ = 0u; asm volatile("" : "+s"(w_), "+s"(b_), "+s"(z_)); int t_ = (w_ << 6) | (int)__builtin_amdgcn_mbcnt_hi(~0u, __builtin_amdgcn_mbcnt_lo(~0u, z_)); asm volatile("" : "+v"(t_)); q.tid_ = t_; q.bx_ = b_; q.ws = a.ws + z_; q.out = a.out + z_; q.ldsb = lds; q.ptab = lds + PTAB_OFF + z_; }
#define PHASE(call) do { MK_Q(); call; xcd_barrier(xb); } while (0)
    PHASE(phase_prep_a(q, lds));
    PHASE(phase_prep_b(q));
    PHASE(phase_prep_c(q, lds, 0, 1, 0, NBLK); phase_g0(q, 0, 0, NBLK));
    for (int g = 0; g < NG; ++g) {
        for (int l = 0; l < 2; ++l) {
            { MK_Q(); ph_l1(q, lds, g, l); }
            PHASE(if (g == 0 && l == 0) weight_prep(q, lds, 1, 2, 32, NBLK - 32);
                  if (g == 1 && l == 0) phase_final(q, 0, 128, NBLK - 128));
            if (DUP_LP == 1) PHASE(ph_l1(q, lds, g, l));
            PHASE(ph_l2(q, lds, g, l));
            if (DUP_LP == 2) PHASE(ph_l2(q, lds, g, l));
            PHASE(ph_l3(q, lds, g, l));
            if (DUP_LP == 3) PHASE(ph_l3(q, lds, g, l));
            PHASE(ph_l5(q, lds, g, l); if (g == 0 && l == 0) phase_prep_c(q, lds, 1, 2, 64, NBLK - 64));
            if (DUP_LP == 5) PHASE(ph_l5(q, lds, g, l));
            PHASE(ph_l6(q, lds, g, l); if (g == 0 && l == 0) phase_g0(q, 1, 64, NBLK - 64));
            PHASE(ph_l7(q, lds, g, l));
            if (DUP_LP == 7) PHASE(ph_l7(q, lds, g, l));
            if (g == 0 && l == 0) {
                PHASE(phase_ffn_conv(q, g, l, 1 | 4, 0, NBLK, 1));
                PHASE(ph_l9(q, lds, g, l, 2); phase_ffn_conv(q, g, l, 2, 64, NBLK - 64, 4));
                PHASE(ph_l9(q, lds, g, l, 1));
            } else {
                PHASE(phase_ffn_conv(q, g, l, 1 | 2, 0, NBLK, 1));
                PHASE(ph_l9(q, lds, g, l));
            }
        }
        if (g == NG - 1) { MK_Q(); phase_final(q, g, 0, NBLK); }
    }
#undef PHASE
#undef MK_Q
}

extern "C" void kernel_launch(void* const* d_in, const int* in_sizes, int n_in, void* d_out, int out_size, void* d_ws, size_t ws_size, hipStream_t stream) {
    static int grid = 0;
    if (grid == 0) {
        int dev = 0, cus = 0, per_cu = 0;
        (void)hipGetDevice(&dev);
        (void)hipDeviceGetAttribute(&cus, hipDeviceAttributeMultiprocessorCount, dev);
        (void)hipFuncSetAttribute((const void*)mega, hipFuncAttributeMaxDynamicSharedMemorySize, LDS_BYTES);
        (void)hipOccupancyMaxActiveBlocksPerMultiprocessor(&per_cu, (const void*)mega, NTHREADS, LDS_BYTES);
        grid = NBLK;
        if (n_in != 30 || ws_size < WS_END || per_cu < 1 || cus * per_cu < NBLK) { fprintf(stderr, "kernel_launch: unexpected n_in %d / ws %zu (need %zu) / per_cu %d\n", n_in, ws_size, (size_t)WS_END, per_cu); }
    }
    (void)hipMemsetAsync(d_ws, 0, 16384, stream);
    KArgs a{};
    for (int i = 0; i < 30; ++i) a.in[i] = (const float*)d_in[i];
    a.out = (float*)d_out; a.ws = (unsigned char*)d_ws;
    void* args[] = {&a};
    hipError_t e = hipLaunchCooperativeKernel((const void*)mega, dim3(grid), dim3(NTHREADS), args, LDS_BYTES, stream);
    if (e != hipSuccess) fprintf(stderr, "cooperative launch failed: %s (grid %d)\n", hipGetErrorString(e), grid);
}
```

```cpp
#include <hip/hip_runtime.h>
#include <hip/hip_cooperative_groups.h>
#include <cstdio>
#include <cstdint>
namespace cg = cooperative_groups;

#define LAS __attribute__((address_space(3)))
typedef unsigned short bf16_t;
typedef short bf16x8 __attribute__((ext_vector_type(8)));
typedef float f32x4 __attribute__((ext_vector_type(4)));
typedef float f32x2 __attribute__((ext_vector_type(2)));
typedef unsigned u32x4 __attribute__((ext_vector_type(4)));
typedef unsigned u32x2 __attribute__((ext_vector_type(2)));

#ifndef ONE_LAUNCH
#define ONE_LAUNCH 1
#endif

constexpr int NTHREADS = 512, NWAVES = 8;
constexpr int NBLK = 256;
constexpr int D = 1024, NB = 16, SEQ = 2048, CTXL = 256, DFF = 2816;
constexpr int NCOLS = 6656;
constexpr int PMW = 2560, GTW = 4096, UPW = 5632;
constexpr int IN_COLS = 6400;
constexpr float EPS = 1e-6f;
constexpr int NG = 2, GB = 8;
constexpr int R_LAT = GB * SEQ, R_CTX = NB * CTXL, R = R_LAT + R_CTX;
constexpr int NLT = R_LAT / 256, NCT = R_CTX / 256;
constexpr int N_KV_LAT = GB * 4 * 16, N_KV_CTX = NB * 4 * 2, N_KV = N_KV_LAT + N_KV_CTX;

constexpr size_t al256(size_t x) { return (x + 255) & ~(size_t)255; }
constexpr size_t OFF_BAR = 0;
constexpr size_t OFF_ADAP = 65536;
constexpr size_t OFF_MOD = OFF_ADAP + al256((size_t)8 * 2 * 17 * 6144 * 4);
constexpr size_t OFF_SHW1 = OFF_MOD + al256((size_t)2 * 17 * 6144 * 4);
constexpr size_t OFF_SHW2 = OFF_SHW1 + al256((size_t)2 * 17 * NCOLS * 4);
constexpr size_t OFF_ROPE = OFF_SHW2 + al256((size_t)2 * 17 * UPW * 4);
constexpr size_t OFF_LOGG = OFF_ROPE + al256((size_t)2 * 2304 * 32 * 4);
constexpr size_t OFF_DM = OFF_LOGG + 256;
constexpr size_t OFF_DC = OFF_DM + (size_t)2048 * 2048 * 2;
constexpr size_t OFF_W = OFF_DC + (size_t)256 * 256 * 2;
constexpr size_t W_IN = 0, W_O = W_IN + (size_t)NCOLS * 1024 * 2, W_OUT = W_O + (size_t)4 * 1024 * 256 * 2, W_UP = W_OUT + (size_t)1024 * 1024 * 2,
                 W_DN = W_UP + (size_t)UPW * 1024 * 2, W_LAYER = W_DN + (size_t)1024 * DFF * 2;
constexpr size_t OFF_XC = OFF_W + 2 * W_LAYER;
constexpr size_t OFF_AP = OFF_XC + (size_t)NB * CTXL * D * 4;
constexpr size_t OFF_AP1 = OFF_AP + (size_t)R * D * 2;
constexpr size_t OFF_SS = OFF_AP1 + (size_t)R_LAT * D * 2;
constexpr size_t OFF_S = OFF_SS + (size_t)R * 16 * 4;
constexpr size_t OFF_KV = OFF_S + (size_t)R * D * 2;
constexpr size_t OFF_KVC = OFF_KV + (size_t)N_KV_LAT * 2 * 4096 * 4;
constexpr size_t OFF_PQT = OFF_KVC + (size_t)2 * N_KV_CTX * 2 * 4096 * 4;
constexpr size_t OFF_PQTC = OFF_PQT + (size_t)GB * 256 * 2048 * 2;
constexpr size_t OFF_BIG = OFF_PQTC + (size_t)NB * 256 * 256 * 2;
constexpr size_t OFF_GT = OFF_BIG + (size_t)R * PMW * 2;
constexpr size_t WS_END = OFF_BIG + ((size_t)R * PMW * 2 + (size_t)R * GTW > (size_t)R * UPW * 2 ? (size_t)R * PMW * 2 + (size_t)R * GTW : (size_t)R * UPW * 2);
static_assert(WS_END <= (size_t)512 * 1024 * 1024, "workspace map exceeds 512 MiB");
static_assert((size_t)R * UPW * 2 <= WS_END - OFF_BIG, "UP overlay");

constexpr int SCR_BYTES = 139264;
constexpr int MISC_OFF = SCR_BYTES;
constexpr int LDS_BYTES = 161792;

__device__ __forceinline__ float bf2f(unsigned v) { return __uint_as_float(v << 16); }
__device__ __forceinline__ unsigned cvt_pk_bf16(float lo, float hi) { unsigned r; asm volatile("v_cvt_pk_bf16_f32 %0, %1, %2" : "=v"(r) : "v"(lo), "v"(hi)); return r; }
__device__ __forceinline__ bf16_t f2bf(float f) { return (bf16_t)(cvt_pk_bf16(f, 0.f) & 0xffffu); }
__device__ __forceinline__ void unpack8(const u32x4 w, float* f) {
    f[0] = bf2f(w.x & 0xffffu); f[1] = __uint_as_float(w.x & 0xffff0000u); f[2] = bf2f(w.y & 0xffffu); f[3] = __uint_as_float(w.y & 0xffff0000u);
    f[4] = bf2f(w.z & 0xffffu); f[5] = __uint_as_float(w.z & 0xffff0000u); f[6] = bf2f(w.w & 0xffffu); f[7] = __uint_as_float(w.w & 0xffff0000u);
}
__device__ __forceinline__ u32x4 pack8(const float* f) { u32x4 w; w.x = cvt_pk_bf16(f[0], f[1]); w.y = cvt_pk_bf16(f[2], f[3]); w.z = cvt_pk_bf16(f[4], f[5]); w.w = cvt_pk_bf16(f[6], f[7]); return w; }
__device__ __forceinline__ float shx(float v, int m, int lane) { return __int_as_float(__builtin_amdgcn_ds_bpermute((lane ^ m) << 2, __float_as_int(v))); }
template <int CTRL> __device__ __forceinline__ float dpp_mov(float v) { return __int_as_float(__builtin_amdgcn_update_dpp(0, __float_as_int(v), CTRL, 0xF, 0xF, false)); }
__device__ __forceinline__ float wave_sum(float v, int  ) {
    v += dpp_mov<0xB1>(v); v += dpp_mov<0x4E>(v); v += dpp_mov<0x141>(v); v += dpp_mov<0x140>(v);
    const int vi = __float_as_int(v);
    const float s0 = __int_as_float(__builtin_amdgcn_readlane(vi, 0)), s1 = __int_as_float(__builtin_amdgcn_readlane(vi, 16)), s2 = __int_as_float(__builtin_amdgcn_readlane(vi, 32)), s3 = __int_as_float(__builtin_amdgcn_readlane(vi, 48));
    return (s0 + s1) + (s2 + s3);
}
__device__ __forceinline__ float fast_rcp(float x) { return __builtin_amdgcn_rcpf(x); }
__device__ __forceinline__ float sigmoidf_(float x) { return fast_rcp(1.f + __expf(-x)); }
__device__ __forceinline__ float siluf_(float x) { return x * sigmoidf_(x); }
__device__ __forceinline__ float geluf_(float v) {
    const float av = fabsf(v), d = av * 0.2316418882f + 1.0f;
    const float t = fast_rcp(d);
    float q = t * 0.5307027145f + (-0.7265760135f); q = q * t + 0.7107068705f; q = q * t + (-0.142248368f); q = q * t + 0.127414796f; q = q * t;
    const float e = __builtin_amdgcn_exp2f((v * v) * (-0.72134752044f));
    const float m = v * (q * e);
    return v < 0.f ? m : v - m;
}
__device__ __forceinline__ f32x4 mfma16(bf16x8 a, bf16x8 b, f32x4 c) { return __builtin_amdgcn_mfma_f32_16x16x32_bf16(a, b, c, 0, 0, 0); }
__device__ __forceinline__ float sin_rev(float r) { return __builtin_amdgcn_sinf(r); }
__device__ __forceinline__ float cos_rev(float r) { return __builtin_amdgcn_cosf(r); }

#define XB_TMO      128
#define XB_XCNT(j)  (256  + 64 * (j))
#define XB_XSUB(j)  (1280 + 64 * (j))
#define XB_XGEN(j)  (2304 + 64 * (j))
#define XB_TOP      3328
#define XB_TOPGEN   3392
#define XCD_BAR_WORDS 3456
#define XB_SPIN_CAP (1u << 20)
__device__ __forceinline__ unsigned xb_ld(unsigned* p)              { return __hip_atomic_load(p, __ATOMIC_RELAXED, __HIP_MEMORY_SCOPE_AGENT); }
__device__ __forceinline__ unsigned xb_add(unsigned* p, unsigned v) { return __hip_atomic_fetch_add(p, v, __ATOMIC_RELAXED, __HIP_MEMORY_SCOPE_AGENT); }
__device__ __forceinline__ unsigned xb_xcc_id() { return (unsigned)__builtin_amdgcn_s_getreg((3 << 11) | 20) & 0xFu; }
#define XB_SPIN(cond, bar) do { unsigned _sp = 0; while (cond) { __builtin_amdgcn_s_sleep(1); \
    if ((++_sp & 255u) == 0u) { if (xb_ld(&(bar)[XB_TMO])) break; if (_sp > XB_SPIN_CAP) { atomicAdd(&(bar)[XB_TMO], 1u); break; } } } } while (0)
struct XcdBarrier { unsigned* bar; unsigned x; volatile LAS unsigned* st; };
__device__ __forceinline__ XcdBarrier xcd_barrier_post(unsigned* bar, volatile LAS unsigned* st) {
    XcdBarrier b; b.bar = bar; b.x = xb_xcc_id(); b.st = st;
    if (threadIdx.x == 0) (void)xb_add(&bar[XB_XCNT(b.x)], 1u);
    return b;
}
__device__ __forceinline__ void xcd_barrier_complete(unsigned* bar, unsigned x, unsigned& nloc, unsigned& nx) {
    const unsigned G = NBLK;
    unsigned sum, cnt, mine, sp = 0u;
    for (;;) {
        sum = 0u; cnt = 0u; mine = 0u;
#pragma unroll
        for (unsigned j = 0; j < 16; ++j) { const unsigned c = xb_ld(&bar[XB_XCNT(j)]); sum += c; cnt += (c > 0u) ? 1u : 0u; mine = (j == x) ? c : mine; }
        if (sum == G) break;
        __builtin_amdgcn_s_sleep(1);
        if ((++sp & 255u) == 0u) { if (xb_ld(&bar[XB_TMO])) break; if (sp > XB_SPIN_CAP) { atomicAdd(&bar[XB_TMO], 1u); break; } }
    }
    nloc = mine > 0u ? mine : 1u; nx = cnt > 0u ? cnt : 1u;
}
__device__ __forceinline__ void xcd_barrier(const XcdBarrier& b) {
    asm volatile("s_waitcnt vmcnt(0)" ::: "memory");
    __syncthreads();
    if (threadIdx.x == 0) {
        unsigned* bar = b.bar; unsigned bx_ = b.x; asm volatile("" : "+s"(bx_));
        __builtin_amdgcn_s_waitcnt(0);
        unsigned nloc = b.st[0], nx = b.st[1];
        if (nloc == 0u) { xcd_barrier_complete(bar, bx_, nloc, nx); b.st[0] = nloc; b.st[1] = nx; }
        const unsigned old = xb_add(&bar[XB_XSUB(bx_)], 1u);
        const unsigned gen = old / nloc;
        if (old + 1u == (gen + 1u) * nloc) {
            __builtin_amdgcn_fence(__ATOMIC_RELEASE, "agent");
            asm volatile("s_waitcnt vmcnt(0)" ::: "memory");
            const unsigned og = xb_add(&bar[XB_TOP], 1u);
            const unsigned tg = og / nx;
            if (og + 1u == (tg + 1u) * nx) xb_add(&bar[XB_TOPGEN], 1u);
            else XB_SPIN(xb_ld(&bar[XB_TOPGEN]) == tg, bar);
            __builtin_amdgcn_fence(__ATOMIC_ACQUIRE, "agent");
            xb_add(&bar[XB_XGEN(bx_)], 1u);
            asm volatile("s_waitcnt vmcnt(0)" ::: "memory");
        } else {
            XB_SPIN(xb_ld(&bar[XB_XGEN(bx_)]) == gen, bar);
            __builtin_amdgcn_fence(__ATOMIC_ACQUIRE, "agent");
            asm volatile("s_waitcnt vmcnt(0)" ::: "memory");
        }
    }
    __syncthreads();
}

namespace pg8 {
constexpr int BM = 256, BK = 64, HALF = 128, HTB = HALF * BK * 2, NXCD = 8, WGM = 8;
__host__ __device__ __forceinline__ int lds_byte(int r, int c) { const int st = (r >> 4) * 2 + (c >> 5), rr = r & 15, cc = c & 31, ob = rr * 64 + cc * 2; return st * 1024 + (ob ^ (((ob >> 9) & 1) << 5)); }
__host__ __device__ __forceinline__ void stage_rc(int b, int& R_, int& C_) { const int st = b / 1024, sb = b % 1024, swz = sb ^ (((sb >> 9) & 1) << 5); R_ = (st >> 1) * 16 + swz / 64; C_ = (st & 1) * 32 + (swz % 64) / 2; }
__host__ __device__ __forceinline__ int perm32(int rho) { const int n = rho >> 4, i = rho & 15; return 8 * (i >> 2) + 4 * n + (i & 3); }

struct Unit { int pm, pn, seg; unsigned A, B; };
__device__ __forceinline__ const char* sgpr_ptr(const char* p) {
    const unsigned long long v = (unsigned long long)p;
    const unsigned lo = (unsigned)__builtin_amdgcn_readfirstlane((int)(unsigned)v), hi = (unsigned)__builtin_amdgcn_readfirstlane((int)(unsigned)(v >> 32));
    typedef const char __attribute__((address_space(1)))* gp_t;
    return (const char*)(gp_t)(((unsigned long long)hi << 32) | (unsigned long long)lo);
}

__device__ __forceinline__ void tile_order(int L, int nM, int nN, int& pm, int& pn) {
    const int nwg = nM * nN; int wgid = L;
    { const int q = nwg / NXCD, r = nwg % NXCD, xcd = wgid % NXCD, off = wgid / NXCD; wgid = (xcd < r ? xcd * (q + 1) : r * (q + 1) + (xcd - r) * q) + off; }
    const int nig = WGM * nN, gid = wgid / nig, fm = gid * WGM, gsz = (nM - fm) < WGM ? (nM - fm) : WGM;
    pm = fm + ((wgid % nig) % gsz); pn = (wgid % nig) / gsz;
}
struct TileSched {
    int n1M, n1N, n2M, n2N, pn2_0, pm2_x, G, c, nseg;
    unsigned A, B, a_tstep, b_tstep, a_segstep, b_segstep;
    __device__ __forceinline__ bool next(int i, Unit& u) const {
        const int ti = i / nseg, seg = i - ti * nseg;
        const int L = ti * G + c, n1 = n1M * n1N, n2 = n2M * n2N;
        int pm, pn;
        if (L < n1) tile_order(L, n1M, n1N, pm, pn);
        else if (L < n1 + n2) { tile_order(L - n1, n2M, n2N, pm, pn); pm += n1M + pm2_x; pn += pn2_0; }
        else return false;
        pm = __builtin_amdgcn_readfirstlane(pm); pn = __builtin_amdgcn_readfirstlane(pn);
        u.pm = pm; u.pn = pn; u.seg = seg;
        u.A = A + (unsigned)pm * a_tstep + (unsigned)seg * a_segstep; u.B = B + (unsigned)pn * b_tstep + (unsigned)seg * b_segstep;
        return true;
    }
};

struct NoPre {};
constexpr int TB_OFF = 131072;
constexpr int SHB_OFF = 147456;
template <class Epi, class Sched>
__device__ __forceinline__ void gemm_phase(LAS unsigned char* lds, const unsigned char* wsb, const int tid_in, const int K, const int lda, const int ldb, const bool perm, const Sched& S, const Epi& E) {
    __builtin_amdgcn_s_waitcnt(0x0F70);
    int tid = tid_in; asm volatile("" : "+v"(tid));
    const int wid = __builtin_amdgcn_readfirstlane(tid >> 6), lane = tid & 63, wr = wid >> 2, wc = wid & 3, fr = lane & 15, fq = lane >> 4;
    const int nt = K / BK;
    unsigned voffA[2], voffB[2];
#pragma unroll
    for (int i = 0; i < 2; ++i) { int R_, C_; stage_rc(tid * 16 + i * 8192, R_, C_); const int Rb = perm ? ((R_ & ~31) + perm32(R_ & 31)) : R_;
        voffA[i] = (unsigned)(R_ * lda + C_) * 2u; voffB[i] = (unsigned)(Rb * ldb + C_) * 2u; }
    const unsigned kstep = (unsigned)(BK * 2);
    const unsigned hA = (unsigned)HALF * lda * 2, hB = (unsigned)HALF * ldb * 2;
    const unsigned ldsw = (unsigned)wid * 1024u;
    const int aoff = lds_byte(wr * 64 + fr, fq * 8), boff = lds_byte(wc * 32 + fr, fq * 8);
#define PG8_SA(b, h) (((b) * 2 + (h)) * HTB)
#define PG8_SB(b, h) ((4 + (b) * 2 + (h)) * HTB)
#define PG8_STAGE(bufoff, goff, voff) do { _Pragma("unroll") for (int _i = 0; _i < 2; ++_i) \
        __builtin_amdgcn_global_load_lds((const unsigned*)(wsb + (unsigned)((goff) + (voff)[_i])), (LAS unsigned*)(lds + (bufoff) + ldsw + _i * 8192), 16, 0, 0); } while (0)
#define PG8_LDA(dst, b, h) do { _Pragma("unroll") for (int m = 0; m < 4; ++m) _Pragma("unroll") for (int k = 0; k < 2; ++k) dst[m][k] = *(const LAS bf16x8*)(lds + PG8_SA(b, h) + aoff + m * 2048 + k * 1024); } while (0)
#define PG8_LDB(dst, b, h) do { _Pragma("unroll") for (int n = 0; n < 2; ++n) _Pragma("unroll") for (int k = 0; k < 2; ++k) dst[n][k] = *(const LAS bf16x8*)(lds + PG8_SB(b, h) + boff + n * 2048 + k * 1024); } while (0)
#define PG8_MMA(ai, bj, At, Bt) do { __builtin_amdgcn_s_setprio(1); _Pragma("unroll") for (int m = 0; m < 4; ++m) _Pragma("unroll") for (int n = 0; n < 2; ++n) _Pragma("unroll") for (int k = 0; k < 2; ++k) \
        acc[ai][bj][m][n] = __builtin_amdgcn_mfma_f32_16x16x32_bf16(Bt[n][k], At[m][k], acc[ai][bj][m][n], 0, 0, 0); __builtin_amdgcn_s_setprio(0); } while (0)
#define PG8_WAIT_V(n) asm volatile("s_waitcnt vmcnt(" #n ")" ::: "memory")
#define PG8_WAIT_VN(n) asm volatile("s_waitcnt vmcnt(%0)" :: "n"(n) : "memory")
#define PG8_WAIT_L(n) asm volatile("s_waitcnt lgkmcnt(" #n ")" ::: "memory")
#define PG8_BAR __builtin_amdgcn_s_barrier()
#define PG8_SCHED __builtin_amdgcn_sched_barrier(0)
#define PG8_ZERO() do { _Pragma("unroll") for (int a = 0; a < 2; ++a) _Pragma("unroll") for (int b = 0; b < 2; ++b) _Pragma("unroll") for (int m = 0; m < 4; ++m) _Pragma("unroll") for (int n = 0; n < 2; ++n) acc[a][b][m][n] = (f32x4){0.f, 0.f, 0.f, 0.f}; } while (0)
    Unit cur, nxt; int ui = 0;
    if (!S.next(0, cur)) return;
    f32x4 acc[2][2][4][2];
    PG8_ZERO();
    bf16x8 At[4][2], B0[2][2], B1[2][2];
    unsigned cA = cur.A, cB = cur.B;
    E.prefetch(cur, wid, lane, lds + SHB_OFF);
    typename Epi::Pre pre = E.pre(cur, wr, wc, fr, fq);
    PG8_STAGE(PG8_SB(0, 0), cB, voffB); PG8_STAGE(PG8_SB(0, 1), cB + hB, voffB); PG8_STAGE(PG8_SA(0, 0), cA, voffA); PG8_STAGE(PG8_SA(0, 1), cA + hA, voffA);
    if (wr == 1) PG8_BAR;
    PG8_WAIT_V(2); PG8_BAR;
    PG8_STAGE(PG8_SB(1, 0), cB + kstep, voffB); PG8_STAGE(PG8_SA(1, 0), cA + kstep, voffA); PG8_STAGE(PG8_SB(1, 1), cB + hB + kstep, voffB);
    PG8_WAIT_V(6); PG8_BAR;
    for (;;) {
        const bool has_next = S.next(ui + 1, nxt);
        const unsigned nA = has_next ? nxt.A : cA, nB = has_next ? nxt.B : cB;
#define PG8_PASS(WX) do { \
            const bool last = (t == nt - 2); \
            unsigned tk = (unsigned)t * (unsigned)kstep; asm volatile("" : "+s"(tk)); \
            const unsigned a1 = cA + tk + kstep; \
            const unsigned a2 = last ? nA : cA + tk + 2 * kstep, b2 = last ? nB : cB + tk + 2 * kstep; \
            const unsigned a3 = a2 + kstep, b3 = b2 + kstep; \
            PG8_LDB(B0, 0, 0); PG8_LDB(B1, 0, 1); PG8_SCHED; PG8_LDA(At, 0, 0); PG8_STAGE(PG8_SA(1, 1), a1 + hA, voffA); \
            WX; PG8_WAIT_L(0); PG8_BAR; PG8_MMA(0, 0, At, B0); PG8_MMA(0, 1, At, B1); PG8_BAR; PG8_SCHED; \
            PG8_LDA(At, 0, 1); PG8_STAGE(PG8_SB(0, 0), b2, voffB); PG8_STAGE(PG8_SB(0, 1), b2 + hB, voffB); PG8_STAGE(PG8_SA(0, 0), a2, voffA); \
            WX; PG8_WAIT_L(0); PG8_BAR; PG8_MMA(1, 0, At, B0); PG8_MMA(1, 1, At, B1); PG8_BAR; PG8_SCHED; \
            PG8_LDB(B0, 1, 0); PG8_LDB(B1, 1, 1); PG8_SCHED; PG8_LDA(At, 1, 0); PG8_STAGE(PG8_SA(0, 1), a2 + hA, voffA); \
            PG8_WAIT_V(8); PG8_WAIT_L(0); PG8_BAR; PG8_MMA(0, 0, At, B0); PG8_MMA(0, 1, At, B1); PG8_BAR; PG8_SCHED; \
            PG8_LDA(At, 1, 1); PG8_STAGE(PG8_SB(1, 0), b3, voffB); PG8_STAGE(PG8_SB(1, 1), b3 + hB, voffB); PG8_STAGE(PG8_SA(1, 0), a3, voffA); \
            PG8_WAIT_V(8); PG8_WAIT_L(0); PG8_BAR; PG8_MMA(1, 0, At, B0); PG8_MMA(1, 1, At, B1); PG8_BAR; PG8_SCHED; \
        } while (0)
        int t = 0;
        if (Epi::XST > 0 && ui > 0) { PG8_PASS(PG8_WAIT_VN(8 + Epi::XST)); t = 2; }
        for (; t < nt; t += 2) PG8_PASS(PG8_WAIT_V(8));
#undef PG8_PASS
        if (wr == 0) PG8_BAR;
        unsigned zz = 0u; asm volatile("" : "+s"(zz)); const int le = (int)__builtin_amdgcn_mbcnt_hi(~0u, __builtin_amdgcn_mbcnt_lo(~0u, zz));
        if (E(acc, cur, wr, wc, le & 15, le >> 4, lds + TB_OFF + ldsw, lds + SHB_OFF + (ui & 1) * 3072, pre)) PG8_ZERO();
        if (!has_next) break;
        cur = nxt; cA = nA; cB = nB; ++ui;
        E.prefetch(cur, wid, le, lds + SHB_OFF + (ui & 1) * 3072);
        pre = E.pre(cur, wr, wc, le & 15, le >> 4);
        if (wr == 1) PG8_BAR;
    }
    PG8_WAIT_V(0);
    PG8_BAR;
#undef PG8_SA
#undef PG8_SB
#undef PG8_STAGE
#undef PG8_LDA
#undef PG8_LDB
#undef PG8_MMA
#undef PG8_WAIT_V
#undef PG8_WAIT_VN
#undef PG8_WAIT_L
#undef PG8_BAR
#undef PG8_SCHED
#undef PG8_ZERO
}
}

enum { I_x = 0, I_c = 1, I_ctx = 2, I_c_ctx = 3, I_w_ada = 4, I_b_ada = 5, I_g_norm1 = 6, I_g_norm2 = 7, I_w_in = 8, I_b_gate = 9, I_ret_decay = 10, I_ret_gn = 11, I_w_ret_o = 12, I_conv_dw = 13, I_conv_db = 14, I_conv_ln_g = 15, I_conv_ln_b = 16, I_w_conv_o = 17, I_gmlp_ln_g = 18, I_gmlp_ln_b = 19, I_gmlp_ws = 20, I_gmlp_bs = 21, I_w_gmlp_o = 22, I_w_fnet_o = 23, I_w_out = 24, I_w_ffn_up = 25, I_ffn_dw = 26, I_ffn_db = 27, I_w_ffn_down = 28, I_g_final = 29 };
struct KArgs { const float* in[30]; float* out; unsigned char* ws; int ph_lo, ph_hi; };
constexpr int PTAB_OFF = MISC_OFF + 4096;
struct KP {
    float* out; unsigned char* ws; LAS unsigned char* ldsb; LAS unsigned char* ptab; int tid_, bx_;
    __device__ __forceinline__ const float* in(int k) const {
        const LAS unsigned* t = (const LAS unsigned*)ptab + 2 * k;
        const unsigned lo = (unsigned)__builtin_amdgcn_readfirstlane((int)t[0]), hi = (unsigned)__builtin_amdgcn_readfirstlane((int)t[1]);
        typedef const float __attribute__((address_space(1)))* gcfp_t;
        return (const float*)(gcfp_t)(((unsigned long long)hi << 32) | (unsigned long long)lo);
    }
};

struct RowInfo { int mi; size_t xrow0; bool is_ctx; };
__device__ __forceinline__ RowInfo row_info(int g, int pm) {
    RowInfo ri;
    if (pm < NLT) { const int b = g * GB + (pm >> 3); ri.mi = b; ri.xrow0 = (size_t)b * SEQ + (size_t)(pm & 7) * 256; ri.is_ctx = false; }
    else { const int b = pm - NLT; ri.mi = 16; ri.xrow0 = (size_t)b * CTXL; ri.is_ctx = true; }
    return ri;
}

__device__ __forceinline__ unsigned ap_off(int g) { return g == 0 ? (unsigned)OFF_AP : (unsigned)OFF_AP1; }
__device__ __forceinline__ unsigned ssa_off(int g) { return (unsigned)OFF_SS + (unsigned)(g * 2) * (unsigned)(R * 4); }
__device__ __forceinline__ unsigned ssb_off(int g) { return (unsigned)OFF_SS + (unsigned)(g * 2 + 1) * (unsigned)(R * 4); }

constexpr int TB2_DELTA = 153600 - 131072;
__device__ __forceinline__ void st_rows16x2(LAS unsigned char* tb, bf16_t* base, size_t ld, int fr, int fq, u32x4 w0, u32x4 w1) {
    const int wo = 64 * fr + 16 * (fq ^ ((fr >> 2) & 3));
    *(LAS u32x4*)(tb + wo) = w0; *(LAS u32x4*)(tb + TB2_DELTA + wo) = w1;
    const int l2 = fq * 16 + fr, r2 = l2 >> 2, q2 = l2 & 3, ro = 64 * r2 + 16 * (q2 ^ ((r2 >> 2) & 3));
    const u32x4 t0 = *(const LAS u32x4*)(tb + ro), t1 = *(const LAS u32x4*)(tb + TB2_DELTA + ro);
    bf16_t* d = base + (size_t)r2 * ld + 8 * q2;
    *(u32x4*)d = t0; *(u32x4*)(d + 128) = t1;
}
__device__ __forceinline__ void st_rows16(LAS unsigned char* tb, bf16_t* base, size_t ld, int fr, int fq, u32x4 w) {
    *(LAS u32x4*)(tb + 64 * fr + 16 * (fq ^ ((fr >> 2) & 3))) = w;
    const int l2 = fq * 16 + fr, r2 = l2 >> 2, q2 = l2 & 3;
    const u32x4 t = *(const LAS u32x4*)(tb + 64 * r2 + 16 * (q2 ^ ((r2 >> 2) & 3)));
    *(u32x4*)(base + (size_t)r2 * ld + 8 * q2) = t;
}
struct EpiWin {
    typedef pg8::NoPre Pre;
    __device__ __forceinline__ Pre pre(const pg8::Unit&, int, int, int, int) const { return Pre{}; }
    static constexpr bool PERM = true; static constexpr int XST = 16;
    const float* ss; const float* shw; const float* bgate; bf16_t* PM; bf16_t* GT; int g;
    __device__ __forceinline__ void prefetch(const pg8::Unit& u, int wid, int lane, LAS unsigned char* shb) const {
        const int ctile = u.pn * 256;
        if (wid == 0) { const RowInfo ri = row_info(g, u.pm); __builtin_amdgcn_global_load_lds((const unsigned*)(shw + (size_t)ri.mi * NCOLS + ctile + lane * 4), (LAS unsigned*)shb, 16, 0, 0); }
        else if (wid == 1) __builtin_amdgcn_global_load_lds((const unsigned*)(ss + u.pm * 256 + lane * 4), (LAS unsigned*)(shb + 1024), 16, 0, 0);
        else if (wid == 2 && ctile >= PMW) __builtin_amdgcn_global_load_lds((const unsigned*)(bgate + (ctile - PMW) + lane * 4), (LAS unsigned*)(shb + 2048), 16, 0, 0);
    }
    __device__ __forceinline__ bool operator()(f32x4 (&acc)[2][2][4][2], const pg8::Unit& u, int wr, int wc, int fr, int fq, LAS unsigned char* tb, const LAS unsigned char* shb, const Pre&) const {
        const int ctile = u.pn * 256, cb = wc * 32 + 8 * fq;
        const bool gate = ctile >= PMW;
        f32x4 sh[2][2];
#pragma unroll
        for (int bj = 0; bj < 2; ++bj)
#pragma unroll
            for (int n = 0; n < 2; ++n) { sh[bj][n] = *(const LAS f32x4*)(shb + (bj * 128 + cb + 4 * n) * 4);
                if (gate) sh[bj][n] = (sh[bj][n] + *(const LAS f32x4*)(shb + 2048 + (bj * 128 + cb + 4 * n) * 4)) * (-1.44269504089f) - 7.99435343686f; }
        float rsv[8];
#pragma unroll
        for (int q = 0; q < 8; ++q) rsv[q] = __builtin_amdgcn_rsqf(*(const LAS float*)(shb + 1024 + ((q >> 2) * 128 + wr * 64 + (q & 3) * 16 + fr) * 4) * (1.0f / 1024.0f) + EPS);
        if (gate) {
            typedef float f32x2_ __attribute__((ext_vector_type(2)));
            unsigned char* gt = (unsigned char*)GT + (size_t)(u.pm * 16 + ((ctile - PMW) >> 8)) * 16 * 4096 + ((wr * 4 + wc) * 64 + fq * 16 + fr) * 8;
#pragma unroll
            for (int ai = 0; ai < 2; ++ai)
#pragma unroll
                for (int m = 0; m < 4; ++m) {
                    const float rsg = rsv[ai * 4 + m] * (-1.44269504089f);
                    const f32x2_ rg2 = (f32x2_){rsg, rsg};
#pragma unroll
                    for (int bj = 0; bj < 2; ++bj) {
                        u32x2 wq = (u32x2){0u, 0u};
#pragma unroll
                        for (int n = 0; n < 2; ++n) { const f32x4 a_ = acc[ai][bj][m][n], s_ = sh[bj][n];
                            const f32x2_ p0 = __builtin_elementwise_fma((f32x2_){a_[0], a_[1]}, rg2, (f32x2_){s_[0], s_[1]}), p1 = __builtin_elementwise_fma((f32x2_){a_[2], a_[3]}, rg2, (f32x2_){s_[2], s_[3]});
                            const float e_[4] = {p0[0], p0[1], p1[0], p1[1]};
                            unsigned w_ = 0u;
#pragma unroll
                            for (int j = 0; j < 4; ++j) w_ = __builtin_amdgcn_cvt_pk_u8_f32(fast_rcp(__builtin_amdgcn_fmed3f(__builtin_amdgcn_exp2f(e_[j]) + (1.0f / 255.0f), 0.f, 1.f)), j, w_);
                            if (n == 0) wq.x = w_; else wq.y = w_; }
                        *(u32x2*)(gt + ((ai * 4 + m) * 2 + bj) * 4096) = wq;
                    }
                }
            return true;
        }
#pragma unroll
        for (int ai = 0; ai < 2; ++ai)
#pragma unroll
            for (int m = 0; m < 4; ++m) {
                const int r0 = u.pm * 256 + ai * 128 + wr * 64 + m * 16;
                const float rs = rsv[ai * 4 + m];
                u32x4 wp[2];
#pragma unroll
                for (int bj = 0; bj < 2; ++bj) {
                    const f32x4 v0 = acc[ai][bj][m][0] * rs + sh[bj][0], v1 = acc[ai][bj][m][1] * rs + sh[bj][1];
                    wp[bj].x = cvt_pk_bf16(v0[0], v0[1]); wp[bj].y = cvt_pk_bf16(v0[2], v0[3]); wp[bj].z = cvt_pk_bf16(v1[0], v1[1]); wp[bj].w = cvt_pk_bf16(v1[2], v1[3]);
                }
                st_rows16x2(tb, PM + (size_t)r0 * PMW + ctile + wc * 32, PMW, fr, fq, wp[0], wp[1]);
            }
        return true;
    }
};
struct EpiUp {
    typedef pg8::NoPre Pre;
    __device__ __forceinline__ Pre pre(const pg8::Unit&, int, int, int, int) const { return Pre{}; }
    static constexpr bool PERM = true; static constexpr int XST = 16;
    const float* ss; const float* shw; bf16_t* UP; int g;
    __device__ __forceinline__ void prefetch(const pg8::Unit& u, int wid, int lane, LAS unsigned char* shb) const {
        if (wid == 0) { const RowInfo ri = row_info(g, u.pm); __builtin_amdgcn_global_load_lds((const unsigned*)(shw + (size_t)ri.mi * UPW + u.pn * 256 + lane * 4), (LAS unsigned*)shb, 16, 0, 0); }
        else if (wid == 1) __builtin_amdgcn_global_load_lds((const unsigned*)(ss + u.pm * 256 + lane * 4), (LAS unsigned*)(shb + 1024), 16, 0, 0);
    }
    __device__ __forceinline__ bool operator()(f32x4 (&acc)[2][2][4][2], const pg8::Unit& u, int wr, int wc, int fr, int fq, LAS unsigned char* tb, const LAS unsigned char* shb, const Pre&) const {
        const int ctile = u.pn * 256, cb = wc * 32 + 8 * fq;
        f32x4 sh[2][2];
#pragma unroll
        for (int bj = 0; bj < 2; ++bj)
#pragma unroll
            for (int n = 0; n < 2; ++n) sh[bj][n] = *(const LAS f32x4*)(shb + (bj * 128 + cb + 4 * n) * 4);
        float rsv[8];
#pragma unroll
        for (int q = 0; q < 8; ++q) rsv[q] = __builtin_amdgcn_rsqf(*(const LAS float*)(shb + 1024 + ((q >> 2) * 128 + wr * 64 + (q & 3) * 16 + fr) * 4) * (1.0f / 1024.0f) + EPS);
#pragma unroll
        for (int ai = 0; ai < 2; ++ai)
#pragma unroll
            for (int m = 0; m < 4; ++m) {
                const int r = u.pm * 256 + ai * 128 + wr * 64 + m * 16 + fr;
                const float rs = rsv[ai * 4 + m];
                u32x4 w[2];
#pragma unroll
                for (int bj = 0; bj < 2; ++bj) {
                    const f32x4 v0 = acc[ai][bj][m][0] * rs + sh[bj][0], v1 = acc[ai][bj][m][1] * rs + sh[bj][1];
                    w[bj].x = cvt_pk_bf16(v0[0], v0[1]); w[bj].y = cvt_pk_bf16(v0[2], v0[3]); w[bj].z = cvt_pk_bf16(v1[0], v1[1]); w[bj].w = cvt_pk_bf16(v1[2], v1[3]);
                }
                st_rows16x2(tb, UP + (size_t)(r - fr) * UPW + ctile + wc * 32, UPW, fr, fq, w[0], w[1]);
            }
        return true;
    }
};
struct EpiResid {
    typedef pg8::NoPre Pre;
    __device__ __forceinline__ Pre pre(const pg8::Unit&, int, int, int, int) const { return Pre{}; }
    static constexpr bool PERM = false; static constexpr int XST = 0;
    const float *xin_lat, *xin_ctx; float *xout_lat, *xout_ctx; const float* ga; const float* Gn; bf16_t* AP; float* ss; int g;
    __device__ __forceinline__ void prefetch(const pg8::Unit& u, int wid, int lane, LAS unsigned char* shb) const {
        if (wid == 0) { const RowInfo ri = row_info(g, u.pm); __builtin_amdgcn_global_load_lds((const unsigned*)(ga + (size_t)ri.mi * 6144 + u.pn * 256 + lane * 4), (LAS unsigned*)shb, 16, 0, 0); }
        else if (wid == 1 && Gn) { const RowInfo ri = row_info(g, u.pm); __builtin_amdgcn_global_load_lds((const unsigned*)(Gn + (size_t)ri.mi * 6144 + u.pn * 256 + lane * 4), (LAS unsigned*)(shb + 1024), 16, 0, 0); }
    }
    __device__ __forceinline__ bool operator()(f32x4 (&acc)[2][2][4][2], const pg8::Unit& u, int wr, int wc, int fr, int fq, LAS unsigned char* tb, const LAS unsigned char* shb, const Pre&) const {
        const RowInfo ri = row_info(g, u.pm);
        const float* xin = ri.is_ctx ? xin_ctx : xin_lat; float* xout = ri.is_ctx ? xout_ctx : xout_lat;
        const int l2 = fq * 16 + fr, r2 = l2 >> 2, q2 = l2 & 3;
        LAS unsigned char* wa = tb + 64 * fr + 16 * (fq ^ ((fr >> 2) & 3));
        const LAS unsigned char* ra = tb + 64 * r2 + 16 * (q2 ^ ((r2 >> 2) & 3));
        const int c0 = u.pn * 256 + wc * 32 + 4 * q2;
        const bool gnp = Gn != nullptr;
        const LAS unsigned char* gl = shb + (wc * 32 + 4 * q2) * 4;
        const size_t xbase = (ri.xrow0 + (size_t)(wr * 64 + r2)) * D + c0;
        const int rbase = u.pm * 256 + wr * 64 + r2;
        f32x4 xc[4], xn_[4];
#pragma unroll
        for (int q = 0; q < 4; ++q) xc[q] = *(const f32x4*)(xin + xbase + (q >> 1) * 128 + (q & 1) * 16);
#pragma unroll
        for (int st = 0; st < 8; ++st) {
            const int ai = st >> 2, m = st & 3;
            if (st < 7) { const int ai2 = (st + 1) >> 2, m2 = (st + 1) & 3; const size_t o2 = xbase + (size_t)(ai2 * 128 + m2 * 16) * D;
#pragma unroll
                for (int q = 0; q < 4; ++q) xn_[q] = *(const f32x4*)(xin + o2 + (q >> 1) * 128 + (q & 1) * 16); }
            asm volatile("" ::: "memory");
            const size_t xo = xbase + (size_t)(ai * 128 + m * 16) * D; const int r = rbase + ai * 128 + m * 16;
            float sq = 0.f;
#pragma unroll
            for (int q = 0; q < 4; ++q) { const int bj = q >> 1, n = q & 1;
                *(LAS f32x4*)wa = acc[ai][bj][m][n];
                const f32x4 at = *(const LAS f32x4*)ra;
                const f32x4 xv = xc[q] + *(const LAS f32x4*)(gl + (bj * 128 + n * 16) * 4) * at;
                *(f32x4*)(xout + xo + bj * 128 + n * 16) = xv;
                sq += (xv[0] * xv[0] + xv[1] * xv[1]) + (xv[2] * xv[2] + xv[3] * xv[3]);
                if (gnp) { const f32x4 a = xv * *(const LAS f32x4*)(gl + 1024 + (bj * 128 + n * 16) * 4); u32x2 w; w.x = cvt_pk_bf16(a[0], a[1]); w.y = cvt_pk_bf16(a[2], a[3]);
                    *(u32x2*)(AP + (size_t)r * D + c0 + bj * 128 + n * 16) = w; } }
            sq += dpp_mov<0xB1>(sq); sq += dpp_mov<0x4E>(sq);
            if (q2 == 0) atomicAdd(ss + r, sq);
            asm volatile("" ::: "memory");
#pragma unroll
            for (int q = 0; q < 4; ++q) xc[q] = xn_[q];
        }
        return true;
    }
};
struct EpiDft {
    typedef pg8::NoPre Pre;
    __device__ __forceinline__ Pre pre(const pg8::Unit&, int, int, int, int) const { return Pre{}; }
    static constexpr bool PERM = true; static constexpr int XST = 0;
    bf16_t* S; int row_base, rows_per_seq; float scale;
    __device__ __forceinline__ void prefetch(const pg8::Unit&, int, int, LAS unsigned char*) const {}
    __device__ __forceinline__ bool operator()(f32x4 (&acc)[2][2][4][2], const pg8::Unit& u, int wr, int wc, int fr, int fq, LAS unsigned char* tb, const LAS unsigned char*, const Pre&) const {
        const int cb = wc * 32 + 8 * fq;
#pragma unroll
        for (int ai = 0; ai < 2; ++ai)
#pragma unroll
            for (int m = 0; m < 4; ++m) {
                const int r = row_base + u.pn * rows_per_seq + u.pm * 256 + ai * 128 + wr * 64 + m * 16 + fr;
#pragma unroll
                for (int bj = 0; bj < 2; ++bj) {
                    const f32x4 v0 = acc[ai][bj][m][0] * scale, v1 = acc[ai][bj][m][1] * scale;
                    u32x4 w; w.x = cvt_pk_bf16(v0[0], v0[1]); w.y = cvt_pk_bf16(v0[2], v0[3]); w.z = cvt_pk_bf16(v1[0], v1[1]); w.w = cvt_pk_bf16(v1[2], v1[3]);
                    st_rows16(tb, S + (size_t)(r - fr) * D + 768 + bj * 128 + wc * 32, D, fr, fq, w);
                }
            }
        return true;
    }
};
struct EpiMerge {
    static constexpr bool PERM = true; static constexpr int NPQ = 4; static constexpr int XST = 2 * NPQ;
    const unsigned char* GT; bf16_t* MG;
    __device__ __forceinline__ void prefetch(const pg8::Unit&, int, int, LAS unsigned char*) const {}
    struct Pre { u32x2 ti[NPQ], tn[NPQ]; };
    __device__ __forceinline__ Pre pre(const pg8::Unit& u, int wr, int wc, int fr, int fq) const { Pre p_;
        const int i = u.seg, thr = ((wr * 4 + wc) * 64 + fq * 16 + fr) * 8;
        const unsigned char* gi = GT + (size_t)(u.pm * 16 + i * 4 + u.pn) * 16 * 4096 + thr;
        const unsigned char* gn = i < 3 ? gi + (size_t)4 * 16 * 4096 : gi;
#pragma unroll
        for (int q = 0; q < NPQ; ++q) { p_.ti[q] = *(const u32x2*)(gi + q * 4096); p_.tn[q] = *(const u32x2*)(gn + q * 4096); }
        return p_; }
    __device__ __forceinline__ bool operator()(f32x4 (&acc)[2][2][4][2], const pg8::Unit& u, int wr, int wc, int fr, int fq, LAS unsigned char* tb, const LAS unsigned char*, const Pre& p_) const {
        __builtin_amdgcn_s_waitcnt(0x0F78);
        const int cb = u.pn * 256 + wc * 32 + 8 * fq, i = u.seg;
        const int thr = ((wr * 4 + wc) * 64 + fq * 16 + fr) * 8;
        const unsigned char* gi = GT + (size_t)(u.pm * 16 + i * 4 + u.pn) * 16 * 4096 + thr;
        const unsigned char* gn = i < 3 ? gi + (size_t)4 * 16 * 4096 : gi;
        u32x2 ti[16], tn[16];
#pragma unroll
        for (int q = 0; q < 16; ++q) { if (q < NPQ) { ti[q] = p_.ti[q]; tn[q] = p_.tn[q]; } else { ti[q] = *(const u32x2*)(gi + q * 4096); tn[q] = *(const u32x2*)(gn + q * 4096); } }
        const unsigned last = i == 3 ? 0xffffffffu : 0u;
#pragma unroll
        for (int q = 0; q < 16; ++q) { const int ai = q >> 3, m = (q >> 1) & 3, bj = q & 1;
            f32x4 fa, fb;
#pragma unroll
            for (int j = 0; j < 4; ++j) {
                fa[j] = (float)((ti[q].x >> (8 * j)) & 0xffu) * fast_rcp((float)(((tn[q].x | last) >> (8 * j)) & 0xffu));
                fb[j] = (float)((ti[q].y >> (8 * j)) & 0xffu) * fast_rcp((float)(((tn[q].y | last) >> (8 * j)) & 0xffu)); }
            acc[ai][bj][m][0] *= fa; acc[ai][bj][m][1] *= fb;
        }
        if (i < 3) return false;
#pragma unroll
        for (int q = 0; q < 16; ++q) { const int ai = q >> 3, m = (q >> 1) & 3, bj = q & 1;
            const f32x4 v0 = acc[ai][bj][m][0], v1 = acc[ai][bj][m][1];
            const int r0 = u.pm * 256 + ai * 128 + wr * 64 + m * 16;
            u32x4 w; w.x = cvt_pk_bf16(v0[0], v0[1]); w.y = cvt_pk_bf16(v0[2], v0[3]); w.z = cvt_pk_bf16(v1[0], v1[1]); w.w = cvt_pk_bf16(v1[2], v1[3]);
            st_rows16(tb, MG + (size_t)r0 * D + u.pn * 256 + wc * 32 + bj * 128, D, fr, fq, w);
        }
        return true;
    }
};

__device__ __forceinline__ void transpose_item(const float* src, int ld_src, int k0, int n0, bf16_t* dst, int ld_dst, int dst_row0, LAS float* scr, int lane) {
    const int kr = lane >> 3, nq = lane & 7;
    f32x4 v[8];
#pragma unroll
    for (int i = 0; i < 8; ++i) v[i] = *(const f32x4*)(src + (size_t)(k0 + i * 8 + kr) * ld_src + n0 + nq * 4);
#pragma unroll
    for (int i = 0; i < 8; ++i) { LAS float* d_ = scr + (i * 8 + kr) * 33 + nq * 4; d_[0] = v[i][0]; d_[1] = v[i][1]; d_[2] = v[i][2]; d_[3] = v[i][3]; }
    asm volatile("s_waitcnt lgkmcnt(0)" ::: "memory");
    const int c = lane & 7;
#pragma unroll
    for (int j = 0; j < 4; ++j) { const int n = (lane >> 3) + 8 * j; const LAS float* s = scr + (8 * c) * 33 + n;
        u32x4 o; o.x = cvt_pk_bf16(s[0 * 33], s[1 * 33]); o.y = cvt_pk_bf16(s[2 * 33], s[3 * 33]); o.z = cvt_pk_bf16(s[4 * 33], s[5 * 33]); o.w = cvt_pk_bf16(s[6 * 33], s[7 * 33]);
        *(u32x4*)(dst + (size_t)(dst_row0 + n) * ld_dst + k0 + 8 * c) = o; }
    asm volatile("s_waitcnt lgkmcnt(0)" ::: "memory");
}

__device__ __forceinline__ void weight_prep(const KP& p, LAS unsigned char* lds, int l_lo, int l_hi, int b0, int nb) {
    int tid = p.tid_; asm volatile("" : "+v"(tid)); const int wave = tid >> 6, lane = tid & 63, G = nb, bx = p.bx_ - b0;
    unsigned char* ws = p.ws;
    if (bx < 0 || bx >= nb) return;
    {
        LAS float* scr = (LAS float*)(lds + wave * 16384);
        const int gw = bx * NWAVES + wave, NGW = G * NWAVES;
        constexpr int I_IN1 = 16 * 64, I_IN2 = 16 * 128, I_O = 4 * 32, I_OUT = 16 * 32, I_UP = 16 * 176, I_DN = 44 * 32;
        constexpr int PER_L = I_IN1 + I_IN2 + 4 * I_O + I_OUT + I_UP + I_DN;
        for (int it = l_lo * PER_L + gw; it < l_hi * PER_L; it += NGW) {
            const int l = it / PER_L; int r = it % PER_L;
            bf16_t* wl = (bf16_t*)(ws + OFF_W + (size_t)l * W_LAYER);
            if (r < I_IN1) { const int kb = r / 64, nb = r % 64; transpose_item(p.in(I_w_in) + (size_t)l * D * IN_COLS, IN_COLS, kb * 64, nb * 32, wl + W_IN / 2, D, nb * 32, scr, lane); continue; } r -= I_IN1;
            if (r < I_IN2) { const int kb = r / 128, nb = r % 128; transpose_item(p.in(I_w_in) + (size_t)l * D * IN_COLS, IN_COLS, kb * 64, 2304 + nb * 32, wl + W_IN / 2, D, PMW + nb * 32, scr, lane); continue; } r -= I_IN2;
            if (r < 4 * I_O) { const int br = r / I_O, rr = r % I_O, kb = rr / 32, nb = rr % 32;
                const float* src = (br == 0 ? p.in(I_w_ret_o) : br == 1 ? p.in(I_w_conv_o) : br == 2 ? p.in(I_w_gmlp_o) : p.in(I_w_fnet_o)) + (size_t)l * 256 * D;
                transpose_item(src, D, kb * 64, nb * 32, wl + W_O / 2 + (size_t)br * 1024 * 256, 256, nb * 32, scr, lane); continue; } r -= 4 * I_O;
            if (r < I_OUT) { const int kb = r / 32, nb = r % 32; transpose_item(p.in(I_w_out) + (size_t)l * D * D, D, kb * 64, nb * 32, wl + W_OUT / 2, D, nb * 32, scr, lane); continue; } r -= I_OUT;
            if (r < I_UP) { const int kb = r / 176, nb = r % 176; transpose_item(p.in(I_w_ffn_up) + (size_t)l * D * UPW, UPW, kb * 64, nb * 32, wl + W_UP / 2, D, nb * 32, scr, lane); continue; } r -= I_UP;
            { const int kb = r / 32, nb = r % 32; transpose_item(p.in(I_w_ffn_down) + (size_t)l * DFF * D, D, kb * 64, nb * 32, wl + W_DN / 2, DFF, nb * 32, scr, lane); }
        }
        __syncthreads();
    }
    {
        LAS float* tile = (LAS float*)lds;
        LAS float* tab = (LAS float*)(lds + 64 * 65 * 4);
        for (int it = l_lo * 64 + bx; it < l_hi * 64; it += G) {
            const int l = it / 64, gq = (it / 16) % 4, kb = it % 16;
            __syncthreads();
            if (tid < 64) { tab[tid] = cos_rev((float)tid * (1.0f / 64.0f)) * 0.125f; tab[64 + tid] = sin_rev((float)tid * (1.0f / 64.0f)) * 0.125f; }
            for (int i = tid; i < 64 * 64; i += NTHREADS) { const int kk = i / 64, cc = i % 64; tile[kk * 65 + cc] = p.in(I_w_in)[((size_t)l * D + kb * 64 + kk) * IN_COLS + 2048 + gq * 64 + cc]; }
            __syncthreads();
            const int which = tid >> 8, nl = (tid & 255) >> 2, kq = tid & 3;
            float acc[16];
#pragma unroll
            for (int j = 0; j < 16; ++j) acc[j] = 0.f;
            for (int cc = 0; cc < 64; ++cc) { const float coef = tab[which * 64 + ((cc * nl) & 63)];
#pragma unroll
                for (int j = 0; j < 16; ++j) acc[j] += coef * tile[(kq * 16 + j) * 65 + cc]; }
            bf16_t* wl = (bf16_t*)(ws + OFF_W + (size_t)l * W_LAYER + W_IN);
            bf16_t* dst = wl + (size_t)(2048 + which * 256 + gq * 64 + nl) * D + kb * 64 + kq * 16;
            *(u32x4*)dst = pack8(acc); *(u32x4*)(dst + 8) = pack8(acc + 8);
        }
        __syncthreads();
    }
}
__device__ __forceinline__ void phase_prep_a(const KP& p, LAS unsigned char* lds) {
    int tid = p.tid_; asm volatile("" : "+v"(tid)); const int wave = tid >> 6, lane = tid & 63, G = NBLK, bx = p.bx_;
    unsigned char* ws = p.ws;
    {
        LAS float* sl = (LAS float*)lds;
        float* adap = (float*)(ws + OFF_ADAP);
        for (int it = bx; it < 2 * 12 * 8; it += G) {
            const int l = it / 96, nch = (it / 8) % 12, kc = it % 8;
            __syncthreads();
            for (int i = tid; i < 17 * 128; i += NTHREADS) { const int mi = i / 128, k = kc * 128 + (i % 128); const float cv = mi < 16 ? p.in(I_c)[mi * D + k] : p.in(I_c_ctx)[k]; sl[i] = siluf_(cv); }
            __syncthreads();
            const int n = nch * 512 + tid;
            float acc[17];
#pragma unroll
            for (int mi = 0; mi < 17; ++mi) acc[mi] = 0.f;
            const float* wp = p.in(I_w_ada) + ((size_t)l * D + kc * 128) * 6144 + n;
#pragma unroll 1
            for (int k0 = 0; k0 < 128; k0 += 16) { float w[16];
#pragma unroll
                for (int k = 0; k < 16; ++k) w[k] = wp[(size_t)(k0 + k) * 6144];
#pragma unroll
                for (int k = 0; k < 16; ++k)
#pragma unroll
                    for (int mi = 0; mi < 17; ++mi) acc[mi] += sl[mi * 128 + k0 + k] * w[k]; }
#pragma unroll
            for (int mi = 0; mi < 17; ++mi) adap[(((size_t)kc * 2 + l) * 17 + mi) * 6144 + n] = acc[mi];
        }
        __syncthreads();
    }
    weight_prep(p, lds, 0, 1, 0, G);
    {
        const size_t gt = (size_t)bx * NTHREADS + tid, GT_ = (size_t)G * NTHREADS;
        float* rc = (float*)(ws + OFF_ROPE); float* rsn = rc + 2304 * 32;
        for (size_t i = gt; i < (size_t)2304 * 32; i += GT_) { const int pos = (int)(i / 32), fi = (int)(i % 32);
            const float inv = exp2f(-(float)fi * (13.287712379549449f / 32.0f));
            const float ang = (float)pos * inv;
            const double rev = (double)ang * 0.15915494309189535; const float fr_ = (float)(rev - floor(rev));
            rc[i] = cos_rev(fr_); rsn[i] = sin_rev(fr_); }
        bf16_t* dm = (bf16_t*)(ws + OFF_DM);
        for (size_t i = gt; i < (size_t)2048 * 256; i += GT_) { const int n = (int)(i / 256), k8 = (int)(i % 256) * 8; float v[8];
#pragma unroll
            for (int j = 0; j < 8; ++j) { const int kk = k8 + j; if (kk <= 1024) v[j] = cos_rev((float)((n * kk) & 2047) * (1.0f / 2048.0f)); else v[j] = -sin_rev((float)((n * (kk - 1024)) & 2047) * (1.0f / 2048.0f)); }
            *(u32x4*)(dm + (size_t)n * 2048 + k8) = pack8(v); }
        bf16_t* dc = (bf16_t*)(ws + OFF_DC);
        for (size_t i = gt; i < (size_t)256 * 32; i += GT_) { const int n = (int)(i / 32), k8 = (int)(i % 32) * 8; float v[8];
#pragma unroll
            for (int j = 0; j < 8; ++j) { const int kk = k8 + j; if (kk <= 128) v[j] = cos_rev((float)((n * kk) & 255) * (1.0f / 256.0f)); else v[j] = -sin_rev((float)((n * (kk - 128)) & 255) * (1.0f / 256.0f)); }
            *(u32x4*)(dc + (size_t)n * 256 + k8) = pack8(v); }
        if (gt < 16) { const float xx = p.in(I_ret_decay)[gt]; ((float*)(ws + OFF_LOGG))[gt] = (float)(-log1p(exp(-(double)xx))); }
    }
}

__device__ __forceinline__ void phase_prep_b(const KP& p) {
    const size_t gt = (size_t)p.bx_ * NTHREADS + p.tid_, GT_ = (size_t)NBLK * NTHREADS;
    const float* adap = (const float*)(p.ws + OFF_ADAP); float* mod = (float*)(p.ws + OFF_MOD);
    for (size_t i = gt; i < (size_t)2 * 17 * 6144; i += GT_) {
        const int l = (int)(i / (17 * 6144)), n = (int)(i % 6144), j = n / 1024, k = n % 1024;
        float v = p.in(I_b_ada)[l * 6144 + n];
#pragma unroll
        for (int kc = 0; kc < 8; ++kc) v += adap[(size_t)kc * 2 * 17 * 6144 + i];
        if (j == 1) v = p.in(I_g_norm1)[l * D + k] * (1.f + v);
        if (j == 4) v = p.in(I_g_norm2)[l * D + k] * (1.f + v);
        mod[i] = v;
    }
}

__device__ __forceinline__ void phase_prep_c(const KP& p, LAS unsigned char* lds, int l_lo, int l_hi, int b0, int nb) {
    int tid = p.tid_; asm volatile("" : "+v"(tid)); const int wave = tid >> 6, lane = tid & 63, G = nb;
    if (p.bx_ < b0 || p.bx_ >= b0 + nb) return;
    LAS unsigned char* shb = lds;
    const int gw = (p.bx_ - b0) * NWAVES + wave, NGW = G * NWAVES;
    const int c = lane & 15, gq = lane >> 4;
    for (int combo = 2 * l_lo; combo < 2 * l_hi; ++combo) {
        const int l = combo >> 1, which = combo & 1;
        const float* mod = (const float*)(p.ws + OFF_MOD) + (size_t)l * 17 * 6144 + (which ? 3 : 0) * 1024;
        __syncthreads();
        for (int i = tid; i < 32 * 128; i += NTHREADS) { const int row = i >> 7, ch = i & 127; float f[8];
#pragma unroll
            for (int j = 0; j < 8; ++j) f[j] = row < 17 ? mod[(size_t)row * 6144 + ch * 8 + j] : 0.f;
            *(LAS u32x4*)(shb + row * 2048 + ((ch ^ (row & 7)) << 4)) = pack8(f); }
        __syncthreads();
        const int ncol = which ? UPW : NCOLS;
        const bf16_t* W = (const bf16_t*)(p.ws + OFF_W + (size_t)l * W_LAYER + (which ? W_UP : W_IN));
        float* dst = (float*)(p.ws + (which ? OFF_SHW2 : OFF_SHW1)) + (size_t)l * 17 * ncol;
        for (int nb16 = gw; nb16 < ncol / 16; nb16 += NGW) {
            const bf16_t* wrow = W + (size_t)(nb16 * 16 + c) * D + 8 * gq;
            const f32x4 z4 = (f32x4){0.f, 0.f, 0.f, 0.f};
            f32x4 acc0 = z4, acc1 = z4;
#pragma unroll 1
            for (int t0 = 0; t0 < 32; t0 += 8) {
                bf16x8 bfr[8];
#pragma unroll
                for (int q = 0; q < 8; ++q) bfr[q] = *(const bf16x8*)(wrow + 32 * (t0 + q));
#pragma unroll
                for (int q = 0; q < 8; ++q) { const int ch = 4 * (t0 + q) + gq;
                    const bf16x8 a0 = *(const LAS bf16x8*)(shb + c * 2048 + ((ch ^ (c & 7)) << 4)), a1 = *(const LAS bf16x8*)(shb + (16 + c) * 2048 + ((ch ^ (c & 7)) << 4));
                    acc0 = mfma16(a0, bfr[q], acc0); acc1 = mfma16(a1, bfr[q], acc1); }
            }
            const int n = nb16 * 16 + c;
#pragma unroll
            for (int r = 0; r < 4; ++r) dst[(size_t)(4 * gq + r) * ncol + n] = acc0[r];
            if (gq == 0) dst[(size_t)16 * ncol + n] = acc1[0];
        }
    }
    __syncthreads();
}

__device__ __forceinline__ void phase_g0(const KP& p, int g, int b0, int nb) {
    int tid = p.tid_; asm volatile("" : "+v"(tid)); const int wave = tid >> 6, lane = tid & 63;
    if (p.bx_ < b0 || p.bx_ >= b0 + nb) return;
    const int gw = (p.bx_ - b0) * NWAVES + wave, NGW = nb * NWAVES;
    const float* mod = (const float*)(p.ws + OFF_MOD);
    bf16_t* AP = (bf16_t*)(p.ws + ap_off(g)); float* ss = (float*)(p.ws + ssa_off(g));
    const int nrows = g == 0 ? R : R_LAT;
    for (int r0 = gw; r0 < nrows; r0 += 2 * NGW) {
        f32x4 v[2][4], gg[2][4]; int rr[2]; bool ok[2];
#pragma unroll
        for (int h = 0; h < 2; ++h) { rr[h] = r0 + h * NGW; ok[h] = rr[h] < nrows; const int r = ok[h] ? rr[h] : r0;
            const RowInfo ri = row_info(g, r >> 8);
            const float* xr = (ri.is_ctx ? p.in(I_ctx) : p.in(I_x)) + (ri.xrow0 + (size_t)(r & 255)) * D;
            const float* G1 = mod + (size_t)ri.mi * 6144 + 1024;
#pragma unroll
            for (int j = 0; j < 4; ++j) { v[h][j] = *(const f32x4*)(xr + j * 256 + lane * 4); gg[h][j] = *(const f32x4*)(G1 + j * 256 + lane * 4); } }
#pragma unroll
        for (int h = 0; h < 2; ++h) { if (!ok[h]) continue; const int r = rr[h];
            float s_ = 0.f;
#pragma unroll
            for (int j = 0; j < 4; ++j) { const f32x4 x = v[h][j];
                s_ += (x[0] * x[0] + x[1] * x[1]) + (x[2] * x[2] + x[3] * x[3]);
                const f32x4 a = x * gg[h][j]; u32x2 w; w.x = cvt_pk_bf16(a[0], a[1]); w.y = cvt_pk_bf16(a[2], a[3]);
                *(u32x2*)(AP + (size_t)r * D + j * 256 + lane * 4) = w; }
            s_ = wave_sum(s_, lane);
            if (lane == 0) ss[r] = s_; }
    }
}

__device__ __forceinline__ void phase_final(const KP& p, int g, int b0, int nb) {
    int tid = p.tid_; asm volatile("" : "+v"(tid)); const int wave = tid >> 6, lane = tid & 63;
    if (p.bx_ < b0 || p.bx_ >= b0 + nb) return;
    const int gw = (p.bx_ - b0) * NWAVES + wave, NGW = nb * NWAVES;
    const float* ss = (const float*)(p.ws + ssa_off(g));
    const f32x4 gf0 = *(const f32x4*)(p.in(I_g_final) + lane * 4), gf1 = *(const f32x4*)(p.in(I_g_final) + 256 + lane * 4), gf2 = *(const f32x4*)(p.in(I_g_final) + 512 + lane * 4), gf3 = *(const f32x4*)(p.in(I_g_final) + 768 + lane * 4);
    for (int r0 = gw; r0 < R_LAT; r0 += 2 * NGW) {
        f32x4 v[2][4]; float sv[2];
#pragma unroll
        for (int h = 0; h < 2; ++h) { const int r = (r0 + h * NGW < R_LAT) ? r0 + h * NGW : r0; sv[h] = ss[r];
            const float* xr = p.out + ((size_t)g * R_LAT + r) * D;
#pragma unroll
            for (int j = 0; j < 4; ++j) v[h][j] = *(const f32x4*)(xr + j * 256 + lane * 4); }
#pragma unroll
        for (int h = 0; h < 2; ++h) { const int r = r0 + h * NGW; if (r >= R_LAT) continue;
            const float rs = __builtin_amdgcn_rsqf(sv[h] * (1.0f / 1024.0f) + EPS);
            float* xr = p.out + ((size_t)g * R_LAT + r) * D;
            *(f32x4*)(xr + lane * 4) = v[h][0] * rs * gf0; *(f32x4*)(xr + 256 + lane * 4) = v[h][1] * rs * gf1;
            *(f32x4*)(xr + 512 + lane * 4) = v[h][2] * rs * gf2; *(f32x4*)(xr + 768 + lane * 4) = v[h][3] * rs * gf3; }
    }
}

struct ChunkInfo { int row0, pos0, h; };
__device__ __forceinline__ ChunkInfo chunk_info(int item) {
    ChunkInfo ci;
    if (item < N_KV_LAT) { const int gb = item >> 6, ch = item & 15; ci.h = (item >> 4) & 3; ci.row0 = gb * SEQ + ch * 128; ci.pos0 = CTXL + ch * 128; }
    else { const int it2 = item - N_KV_LAT, gb = it2 >> 3, ch = it2 & 1; ci.h = (it2 >> 1) & 3; ci.row0 = R_LAT + gb * CTXL + ch * 128; ci.pos0 = ch * 128; }
    return ci;
}
__device__ __forceinline__ void load_chunk_f32(const int tid, const bf16_t* PM, int row0, int col0, LAS float* dst, int st) {
#pragma unroll
    for (int q = 0; q < 2; ++q) { const int idx = tid + q * NTHREADS, row = idx >> 3, cc = idx & 7; float f[8];
        unpack8(*(const u32x4*)(PM + (size_t)(row0 + row) * PMW + col0 + cc * 8), f);
        *(LAS f32x4*)(dst + row * st + cc * 8) = (f32x4){f[0], f[1], f[2], f[3]}; *(LAS f32x4*)(dst + row * st + cc * 8 + 4) = (f32x4){f[4], f[5], f[6], f[7]}; }
}
__device__ __forceinline__ void rotary_lds(const int tid, LAS float* buf, int st, int pos0, const float* rc, const float* rsn, float scale) {
#pragma unroll
    for (int q = 0; q < 8; ++q) { const int pidx = tid + q * NTHREADS, row = pidx >> 5, i = pidx & 31;
        const float c = rc[(pos0 + row) * 32 + i], s = rsn[(pos0 + row) * 32 + i];
        const float t1 = buf[row * st + i], t2 = buf[row * st + i + 32];
        buf[row * st + i] = (t1 * c - t2 * s) * scale; buf[row * st + i + 32] = (t1 * s + t2 * c) * scale; }
}

__device__ __forceinline__ void ret_kv_item(const KP& p, LAS unsigned char* lds, int l, int item) {
    int tid = p.tid_; asm volatile("" : "+v"(tid));
    const bf16_t* PM = (const bf16_t*)(p.ws + OFF_BIG);
    const float* rc = (const float*)(p.ws + OFF_ROPE); const float* rsn = rc + 2304 * 32;
    const float* logg = (const float*)(p.ws + OFF_LOGG) + l * 8;
    LAS unsigned char* KfT = lds;
    LAS unsigned char* KbT = lds + 16384;
    LAS unsigned char* Vt = lds + 32768;
    const ChunkInfo ci = chunk_info(item);
    __syncthreads();
    {
        const int row = tid >> 2, pc = tid & 3, pos = ci.pos0 + row;
        const bf16_t* src = PM + (size_t)(ci.row0 + row) * PMW + ci.h * 64;
        const float lgf = logg[ci.h], lgb = logg[4 + ci.h];
        const float wf = 0.125f * __expf(lgf * (float)(127 - row)), wb = 0.125f * __expf(lgb * (float)row);
        float cs[8], sn[8], t1[8], t2[8];
        { const f32x4 c0 = *(const f32x4*)(rc + pos * 32 + pc * 8), c1 = *(const f32x4*)(rc + pos * 32 + pc * 8 + 4), s0 = *(const f32x4*)(rsn + pos * 32 + pc * 8), s1 = *(const f32x4*)(rsn + pos * 32 + pc * 8 + 4);
#pragma unroll
          for (int j = 0; j < 4; ++j) { cs[j] = c0[j]; cs[4 + j] = c1[j]; sn[j] = s0[j]; sn[4 + j] = s1[j]; } }
        unpack8(*(const u32x4*)(src + 256 + pc * 8), t1); unpack8(*(const u32x4*)(src + 256 + 32 + pc * 8), t2);
        const int jo = (row & 7) * 2, jc = row >> 3;
#pragma unroll
        for (int j = 0; j < 8; ++j) {
            const float o1 = t1[j] * cs[j] - t2[j] * sn[j], o2 = t1[j] * sn[j] + t2[j] * cs[j];
            const int d1 = pc * 8 + j, d2 = 32 + pc * 8 + j;
            *(LAS unsigned short*)(KfT + d1 * 256 + ((jc ^ (d1 & 15)) << 4) + jo) = f2bf(o1 * wf); *(LAS unsigned short*)(KfT + d2 * 256 + ((jc ^ (d2 & 15)) << 4) + jo) = f2bf(o2 * wf);
            *(LAS unsigned short*)(KbT + d1 * 256 + ((jc ^ (d1 & 15)) << 4) + jo) = f2bf(o1 * wb); *(LAS unsigned short*)(KbT + d2 * 256 + ((jc ^ (d2 & 15)) << 4) + jo) = f2bf(o2 * wb);
        }
        const u32x4 v0 = *(const u32x4*)(src + 512 + pc * 16), v1 = *(const u32x4*)(src + 512 + pc * 16 + 8);
        const unsigned vv[8] = {v0.x, v0.y, v0.z, v0.w, v1.x, v1.y, v1.z, v1.w};
#pragma unroll
        for (int e2 = 0; e2 < 8; ++e2)
#pragma unroll
            for (int hh = 0; hh < 2; ++hh) { const int e = pc * 16 + e2 * 2 + hh; const unsigned short val = (unsigned short)(hh ? (vv[e2] >> 16) : (vv[e2] & 0xffffu));
                *(LAS unsigned short*)(Vt + e * 256 + ((jc ^ (e & 15)) << 4) + jo) = val; }
    }
    __syncthreads();
    const int w = __builtin_amdgcn_readfirstlane(tid >> 6), lane = tid & 63, c = lane & 15, gq = lane >> 4;
    const int dir = w >> 2, db = w & 3, d = 16 * db + c;
    LAS unsigned char* KT = dir ? KbT : KfT;
    const f32x4 z4 = (f32x4){0.f, 0.f, 0.f, 0.f};
    f32x4 acc[4] = {z4, z4, z4, z4};
#pragma unroll
    for (int t = 0; t < 4; ++t) {
        const bf16x8 af = *(const LAS bf16x8*)(KT + d * 256 + (((4 * t + gq) ^ (d & 15)) << 4));
#pragma unroll
        for (int eb = 0; eb < 4; ++eb) { const int e = 16 * eb + c;
            const bf16x8 bfr = *(const LAS bf16x8*)(Vt + e * 256 + (((4 * t + gq) ^ (e & 15)) << 4));
            acc[eb] = mfma16(af, bfr, acc[eb]); }
    }
    float* kv = (item < N_KV_LAT ? (float*)(p.ws + OFF_KV) + (size_t)item * 8192 : (float*)(p.ws + OFF_KVC) + (size_t)(l * N_KV_CTX + item - N_KV_LAT) * 8192) + dir * 4096;
#pragma unroll
    for (int eb = 0; eb < 4; ++eb)
#pragma unroll
        for (int r = 0; r < 4; ++r) kv[(16 * db + 4 * gq + r) * 64 + 16 * eb + c] = acc[eb][r];
}

__device__ __forceinline__ void ret_out_item(const KP& p, LAS unsigned char* lds, int g, int l, int item) {
    int tid = p.tid_; asm volatile("" : "+v"(tid));
    const bf16_t* PM = (const bf16_t*)(p.ws + OFF_BIG);
    const float* rc = (const float*)(p.ws + OFF_ROPE); const float* rsn = rc + 2304 * 32;
    const float* logg = (const float*)(p.ws + OFF_LOGG) + l * 8;
    LAS unsigned char* Qb = lds;
    LAS unsigned char* Kb = lds + 16384;
    LAS unsigned char* Vt = lds + 32768;
    LAS unsigned char* SfT = lds + 49152;
    LAS unsigned char* SbT = lds + 57344;
    LAS float* dtab = (LAS float*)(lds + 65536);
    const ChunkInfo ci = chunk_info(item);
    __syncthreads();
    {
        const int row = tid >> 2, pc = tid & 3, pos = ci.pos0 + row;
        const bf16_t* src = PM + (size_t)(ci.row0 + row) * PMW + ci.h * 64;
        float cs[8], sn[8];
        { const f32x4 c0 = *(const f32x4*)(rc + pos * 32 + pc * 8), c1 = *(const f32x4*)(rc + pos * 32 + pc * 8 + 4), s0 = *(const f32x4*)(rsn + pos * 32 + pc * 8), s1 = *(const f32x4*)(rsn + pos * 32 + pc * 8 + 4);
#pragma unroll
          for (int j = 0; j < 4; ++j) { cs[j] = c0[j]; cs[4 + j] = c1[j]; sn[j] = s0[j]; sn[4 + j] = s1[j]; } }
#pragma unroll
        for (int qk = 0; qk < 2; ++qk) {
            float t1[8], t2[8], o1[8], o2[8];
            unpack8(*(const u32x4*)(src + qk * 256 + pc * 8), t1); unpack8(*(const u32x4*)(src + qk * 256 + 32 + pc * 8), t2);
            const float sc = qk ? 0.125f : 1.0f;
#pragma unroll
            for (int j = 0; j < 8; ++j) { o1[j] = (t1[j] * cs[j] - t2[j] * sn[j]) * sc; o2[j] = (t1[j] * sn[j] + t2[j] * cs[j]) * sc; }
            LAS unsigned char* dst = (qk ? Kb : Qb) + row * 128;
            *(LAS u32x4*)(dst + ((pc ^ (row & 7)) << 4)) = pack8(o1);
            *(LAS u32x4*)(dst + (((4 + pc) ^ (row & 7)) << 4)) = pack8(o2);
        }
        {
            const u32x4 v0 = *(const u32x4*)(src + 512 + pc * 16), v1 = *(const u32x4*)(src + 512 + pc * 16 + 8);
            const unsigned vv[8] = {v0.x, v0.y, v0.z, v0.w, v1.x, v1.y, v1.z, v1.w};
#pragma unroll
            for (int e2 = 0; e2 < 8; ++e2)
#pragma unroll
                for (int hh = 0; hh < 2; ++hh) { const int e = pc * 16 + e2 * 2 + hh; const unsigned short val = (unsigned short)(hh ? (vv[e2] >> 16) : (vv[e2] & 0xffffu));
                    *(LAS unsigned short*)(Vt + e * 256 + ((((row >> 2) ^ (2 * (e & 15))) << 3)) + (row & 3) * 2) = val; }
        }
        {
            const int d = tid >> 3, e0 = (tid & 7) * 8;
            const float* KV = (const float*)(p.ws + OFF_KV) + d * 64 + e0;
            const float* KVC = (const float*)(p.ws + OFF_KVC) + (size_t)l * N_KV_CTX * 8192 + d * 64 + e0;
            const f32x4 z = (f32x4){0.f, 0.f, 0.f, 0.f};
            f32x4 fa = z, fb = z, ba = z, bb = z;
            if (item < N_KV_LAT) {
                const int ch = item & 15, lat0 = item - ch, c0 = (g * GB + (item >> 6)) * 8 + ci.h * 2;
                const float l128f = logg[ci.h] * 128.f, l128b = logg[4 + ci.h] * 128.f;
#pragma unroll 1
                for (int t0 = 0; t0 < 20; t0 += 10) {
                    f32x4 xa[10], xb[10]; float wt[10]; bool isf[10];
#pragma unroll
                    for (int q = 0; q < 10; ++q) { const int t = t0 + q; const bool fw = t < ch + 2; isf[q] = fw;
                        const int k = fw ? t - 2 : t - (ch + 2) - 2;
                        const float* x; if (fw) x = k < 0 ? KVC + (size_t)(c0 + k + 2) * 8192 : KV + (size_t)(lat0 + k) * 8192;
                        else x = (k < 0 ? KVC + (size_t)(c0 - 1 - k) * 8192 : KV + (size_t)(lat0 + 15 - k) * 8192) + 4096;
                        const bool valid = t < 19; if (!valid) x = KVC;
                        wt[q] = valid ? (fw ? __expf(l128f * (float)(ch - 1 - k)) : __expf(l128b * (float)(14 - ch - k))) : 0.f;
                        xa[q] = *(const f32x4*)x; xb[q] = *(const f32x4*)(x + 4); }
#pragma unroll
                    for (int q = 0; q < 10; ++q) { if (isf[q]) { fa += xa[q] * wt[q]; fb += xb[q] * wt[q]; } else { ba += xa[q] * wt[q]; bb += xb[q] * wt[q]; } }
                }
            } else {
                const int it2 = item - N_KV_LAT, ch = it2 & 1, c0 = it2 - ch;
                if (ch == 1) { const float* x = KVC + (size_t)c0 * 8192; fa = *(const f32x4*)x; fb = *(const f32x4*)(x + 4); }
                else { const float* x = KVC + (size_t)(c0 + 1) * 8192 + 4096; ba = *(const f32x4*)x; bb = *(const f32x4*)(x + 4); }
            }
#pragma unroll
            for (int dir = 0; dir < 2; ++dir) { const f32x4 a = dir ? ba : fa, b = dir ? bb : fb;
                LAS unsigned char* dstT = dir ? SbT : SfT; const float vals[8] = {a[0], a[1], a[2], a[3], b[0], b[1], b[2], b[3]};
#pragma unroll
                for (int jj = 0; jj < 8; ++jj) { const int e = e0 + jj; *(LAS unsigned short*)(dstT + e * 128 + (((d >> 3) ^ (e & 7)) << 4) + (d & 7) * 2) = f2bf(vals[jj]); } }
        }
        const float lgf = logg[ci.h], lgb = logg[4 + ci.h];
        if (tid <= 256) { const int t = tid - 128; dtab[tid] = t > 0 ? __expf(lgf * (float)t) : (t < 0 ? __expf(lgb * (float)(-t)) : 2.0f); }
    }
    __syncthreads();
    const int w = __builtin_amdgcn_readfirstlane(tid >> 6), lane = tid & 63, c = lane & 15, gq = lane >> 4;
    const int il = 16 * w + c;
    f32x4 g4v[4]; u32x2 grv[4];
    { const float* gn_ = p.in(I_ret_gn) + l * 256 + ci.h * 64; const bf16_t* gsrc_ = PM + (size_t)(ci.row0 + il) * PMW + 768 + ci.h * 64;
#pragma unroll
      for (int eb = 0; eb < 4; ++eb) { g4v[eb] = *(const f32x4*)(gn_ + 16 * eb + 4 * gq); grv[eb] = *(const u32x2*)(gsrc_ + 16 * eb + 4 * gq); } }
    bf16x8 qf[2];
#pragma unroll
    for (int ks = 0; ks < 2; ++ks) qf[ks] = *(const LAS bf16x8*)(Qb + il * 128 + (((4 * ks + gq) ^ (il & 7)) << 4));
    const f32x4 z4 = (f32x4){0.f, 0.f, 0.f, 0.f};
    f32x4 st[8];
#pragma unroll
    for (int jb = 0; jb < 8; ++jb) { const int j = 16 * jb + c;
        const bf16x8 k0 = *(const LAS bf16x8*)(Kb + j * 128 + (((0 + gq) ^ (j & 7)) << 4)), k1 = *(const LAS bf16x8*)(Kb + j * 128 + (((4 + gq) ^ (j & 7)) << 4));
        st[jb] = mfma16(k0, qf[0], z4); st[jb] = mfma16(k1, qf[1], st[jb]); }
#pragma unroll
    for (int jb = 0; jb < 8; ++jb)
#pragma unroll
        for (int r = 0; r < 4; ++r) st[jb][r] *= dtab[128 + il - (16 * jb + 4 * gq + r)];
    f32x4 oT[4], cf[4], cb[4];
#pragma unroll
    for (int eb = 0; eb < 4; ++eb) { oT[eb] = z4; cf[eb] = z4; cb[eb] = z4; }
#pragma unroll
    for (int t = 0; t < 4; ++t) {
        union { u32x4 u; bf16x8 v; } pk;
        pk.u.x = cvt_pk_bf16(st[2 * t][0], st[2 * t][1]); pk.u.y = cvt_pk_bf16(st[2 * t][2], st[2 * t][3]);
        pk.u.z = cvt_pk_bf16(st[2 * t + 1][0], st[2 * t + 1][1]); pk.u.w = cvt_pk_bf16(st[2 * t + 1][2], st[2 * t + 1][3]);
#pragma unroll
        for (int eb = 0; eb < 4; ++eb) { const int e = 16 * eb + c;
            union { u32x4 u; bf16x8 v; } va;
            const u32x2 lo = *(const LAS u32x2*)(Vt + e * 256 + (((8 * t + gq) ^ (2 * (e & 15))) << 3)), hi = *(const LAS u32x2*)(Vt + e * 256 + (((8 * t + 4 + gq) ^ (2 * (e & 15))) << 3));
            va.u.x = lo.x; va.u.y = lo.y; va.u.z = hi.x; va.u.w = hi.y;
            oT[eb] = mfma16(va.v, pk.v, oT[eb]); }
    }
#pragma unroll
    for (int eb = 0; eb < 4; ++eb) { const int e = 16 * eb + c;
#pragma unroll
        for (int ks = 0; ks < 2; ++ks) {
            const bf16x8 af = *(const LAS bf16x8*)(SfT + e * 128 + (((4 * ks + gq) ^ (e & 7)) << 4)), ab = *(const LAS bf16x8*)(SbT + e * 128 + (((4 * ks + gq) ^ (e & 7)) << 4));
            cf[eb] = mfma16(af, qf[ks], cf[eb]); cb[eb] = mfma16(ab, qf[ks], cb[eb]); } }
    const float wqf = dtab[128 + il + 1], wqb = dtab[il];
    float o[16]; float sm = 0.f;
#pragma unroll
    for (int eb = 0; eb < 4; ++eb)
#pragma unroll
        for (int r = 0; r < 4; ++r) { o[eb * 4 + r] = oT[eb][r] + wqf * cf[eb][r] + wqb * cb[eb][r]; sm += o[eb * 4 + r]; }
    sm += shx(sm, 16, lane); sm += shx(sm, 32, lane);
    const float mean = sm * (1.0f / 64.0f);
    float vq = 0.f;
#pragma unroll
    for (int e = 0; e < 16; ++e) { o[e] -= mean; vq += o[e] * o[e]; }
    vq += shx(vq, 16, lane); vq += shx(vq, 32, lane);
    const float rstd = __builtin_amdgcn_rsqf(vq * (1.0f / 64.0f) + EPS);
    bf16_t* S = (bf16_t*)(p.ws + OFF_S) + (size_t)(ci.row0 + il) * D + ci.h * 64;
#pragma unroll
    for (int eb = 0; eb < 4; ++eb) { const int e0 = 16 * eb + 4 * gq;
        const f32x4 g4 = g4v[eb]; const u32x2 gr = grv[eb];
        const float g0 = bf2f(gr.x & 0xffffu), g1 = __uint_as_float(gr.x & 0xffff0000u), g2 = bf2f(gr.y & 0xffffu), g3 = __uint_as_float(gr.y & 0xffff0000u);
        u32x2 wv; wv.x = cvt_pk_bf16(o[eb * 4 + 0] * rstd * g4[0] * siluf_(g0), o[eb * 4 + 1] * rstd * g4[1] * siluf_(g1));
        wv.y = cvt_pk_bf16(o[eb * 4 + 2] * rstd * g4[2] * siluf_(g2), o[eb * 4 + 3] * rstd * g4[3] * siluf_(g3));
        *(u32x2*)(S + e0) = wv; }
}

__device__ __forceinline__ void conf_item(const KP& p, LAS unsigned char* lds, int l, int item) {
    int tid = p.tid_; asm volatile("" : "+v"(tid)); const int wave = tid >> 6, lane = tid & 63;
    const bf16_t* PM = (const bf16_t*)(p.ws + OFF_BIG);
    LAS float* hbuf = (LAS float*)lds;
    LAS float* ybuf = (LAS float*)(lds + 65536);
    int seqrow0, L, n0;
    if (item < R_LAT / 32) { seqrow0 = (item >> 6) * SEQ; L = SEQ; n0 = (item & 63) * 32; }
    else { const int it2 = item - R_LAT / 32; seqrow0 = R_LAT + (it2 >> 3) * CTXL; L = CTXL; n0 = (it2 & 7) * 32; }
    __syncthreads();
    {
        u32x4 a1[4], a2[4]; bool ok[4];
#pragma unroll
        for (int q = 0; q < 4; ++q) { const int idx = tid + q * NTHREADS, hr = idx >> 5, cc = idx & 31, tok = n0 - 15 + hr;
            ok[q] = idx < 62 * 32 && tok >= 0 && tok < L;
            const bf16_t* src = PM + (size_t)(seqrow0 + (ok[q] ? tok : n0)) * PMW + 1024 + cc * 8;
            a1[q] = *(const u32x4*)src; a2[q] = *(const u32x4*)(src + 256); }
#pragma unroll
        for (int q = 0; q < 4; ++q) { const int idx = tid + q * NTHREADS, hr = idx >> 5, cc = idx & 31;
            if (idx < 62 * 32) { float x1[8], x2[8], hv[8]; unpack8(a1[q], x1); unpack8(a2[q], x2);
#pragma unroll
                for (int j = 0; j < 8; ++j) hv[j] = ok[q] ? x1[j] * sigmoidf_(x2[j]) : 0.f;
                *(LAS f32x4*)(hbuf + hr * 256 + cc * 8) = (f32x4){hv[0], hv[1], hv[2], hv[3]}; *(LAS f32x4*)(hbuf + hr * 256 + cc * 8 + 4) = (f32x4){hv[4], hv[5], hv[6], hv[7]}; } }
    }
    __syncthreads();
    { const int c = tid & 255, q = tid >> 8;
      float w[31], xw[46];
#pragma unroll
      for (int j = 0; j < 31; ++j) w[j] = p.in(I_conv_dw)[((size_t)l * 31 + j) * 256 + c];
      const float bias = p.in(I_conv_db)[l * 256 + c];
#pragma unroll
      for (int j = 0; j < 46; ++j) xw[j] = hbuf[(q * 16 + j) * 256 + c];
#pragma unroll
      for (int tt = 0; tt < 16; ++tt) { float y = bias;
#pragma unroll
          for (int j = 0; j < 31; ++j) y += w[j] * xw[tt + j];
          ybuf[(q * 16 + tt) * 256 + c] = y; } }
    __syncthreads();
    { const f32x4 lg = *(const f32x4*)(p.in(I_conv_ln_g) + l * 256 + lane * 4), lb = *(const f32x4*)(p.in(I_conv_ln_b) + l * 256 + lane * 4);
      bf16_t* S = (bf16_t*)(p.ws + OFF_S);
#pragma unroll
      for (int t4 = 0; t4 < 4; ++t4) { const int tt = wave * 4 + t4;
          f32x4 v = *(const LAS f32x4*)(ybuf + tt * 256 + lane * 4);
          const float mean = wave_sum((v[0] + v[1]) + (v[2] + v[3]), lane) * (1.0f / 256.0f);
          v = v - mean;
          const float var = wave_sum((v[0] * v[0] + v[1] * v[1]) + (v[2] * v[2] + v[3] * v[3]), lane) * (1.0f / 256.0f);
          const float rstd = __builtin_amdgcn_rsqf(var + EPS);
          f32x4 y = v * rstd * lg + lb;
#pragma unroll
          for (int j = 0; j < 4; ++j) y[j] = siluf_(y[j]);
          u32x2 w2; w2.x = cvt_pk_bf16(y[0], y[1]); w2.y = cvt_pk_bf16(y[2], y[3]);
          *(u32x2*)(S + (size_t)(seqrow0 + n0 + tt) * D + 256 + lane * 4) = w2; } }
}

__device__ __forceinline__ void gmlp_item(const KP& p, LAS unsigned char* lds, int l, int item) {
    int tid = p.tid_; asm volatile("" : "+v"(tid)); const int wave = __builtin_amdgcn_readfirstlane(tid >> 6), lane = tid & 63;
    const bf16_t* PM = (const bf16_t*)(p.ws + OFF_BIG);
    LAS unsigned char* vT = lds;
    const int row0 = item * 128;
    __syncthreads();
    { const f32x4 lg = *(const f32x4*)(p.in(I_gmlp_ln_g) + l * 256 + lane * 4), lb = *(const f32x4*)(p.in(I_gmlp_ln_b) + l * 256 + lane * 4);
      u32x2 zz[16];
#pragma unroll
      for (int t16 = 0; t16 < 16; ++t16) zz[t16] = *(const u32x2*)(PM + (size_t)(row0 + wave * 16 + t16) * PMW + 1792 + lane * 4);
#pragma unroll
      for (int t16 = 0; t16 < 16; ++t16) { const int tt = wave * 16 + t16;
          f32x4 v = (f32x4){geluf_(bf2f(zz[t16].x & 0xffffu)), geluf_(__uint_as_float(zz[t16].x & 0xffff0000u)), geluf_(bf2f(zz[t16].y & 0xffffu)), geluf_(__uint_as_float(zz[t16].y & 0xffff0000u))};
          const float mean = wave_sum((v[0] + v[1]) + (v[2] + v[3]), lane) * (1.0f / 256.0f);
          v = v - mean;
          const float var = wave_sum((v[0] * v[0] + v[1] * v[1]) + (v[2] * v[2] + v[3] * v[3]), lane) * (1.0f / 256.0f);
          const float rstd = __builtin_amdgcn_rsqf(var + EPS);
          v = v * rstd * lg + lb;
          const int jc = tt >> 3, jo = (tt & 7) * 2;
#pragma unroll
          for (int q = 0; q < 4; ++q) { const int cc = lane * 4 + q; *(LAS unsigned short*)(vT + cc * 256 + ((jc ^ (cc & 15)) << 4) + jo) = f2bf(v[q]); } } }
    __syncthreads();
    const int c = lane & 15, gq = lane >> 4, gw = wave & 3, ih = wave >> 2;
    const float* wsr = p.in(I_gmlp_ws) + (((size_t)l * 4 + gw) * 128 + ih * 64) * 128 + (size_t)c * 128 + 8 * gq;
    const f32x4 z4 = (f32x4){0.f, 0.f, 0.f, 0.f};
    f32x4 acc[4][4];
#pragma unroll
    for (int ib = 0; ib < 4; ++ib)
#pragma unroll
        for (int cb = 0; cb < 4; ++cb) acc[ib][cb] = z4;
    f32x4 wa[4][2], wb[4][2];
#pragma unroll
    for (int ib = 0; ib < 4; ++ib) { wa[ib][0] = *(const f32x4*)(wsr + ib * 16 * 128); wa[ib][1] = *(const f32x4*)(wsr + ib * 16 * 128 + 4); }
#pragma unroll
    for (int t = 0; t < 4; ++t) {
        if (t < 3) {
#pragma unroll
            for (int ib = 0; ib < 4; ++ib) { wb[ib][0] = *(const f32x4*)(wsr + ib * 16 * 128 + 32 * (t + 1)); wb[ib][1] = *(const f32x4*)(wsr + ib * 16 * 128 + 32 * (t + 1) + 4); } }
        bf16x8 bfr[4];
#pragma unroll
        for (int cb = 0; cb < 4; ++cb) { const int cc = 64 * gw + 16 * cb + c; bfr[cb] = *(const LAS bf16x8*)(vT + cc * 256 + (((4 * t + gq) ^ (cc & 15)) << 4)); }
#pragma unroll
        for (int ib = 0; ib < 4; ++ib) {
            union { u32x4 u; bf16x8 v; } af;
            af.u.x = cvt_pk_bf16(wa[ib][0][0], wa[ib][0][1]); af.u.y = cvt_pk_bf16(wa[ib][0][2], wa[ib][0][3]); af.u.z = cvt_pk_bf16(wa[ib][1][0], wa[ib][1][1]); af.u.w = cvt_pk_bf16(wa[ib][1][2], wa[ib][1][3]);
#pragma unroll
            for (int cb = 0; cb < 4; ++cb) acc[ib][cb] = mfma16(af.v, bfr[cb], acc[ib][cb]);
        }
#pragma unroll
        for (int ib = 0; ib < 4; ++ib) { wa[ib][0] = wb[ib][0]; wa[ib][1] = wb[ib][1]; }
    }
    const float* bs = p.in(I_gmlp_bs) + ((size_t)l * 4 + gw) * 128 + ih * 64;
    bf16_t* S = (bf16_t*)(p.ws + OFF_S);
#pragma unroll
    for (int ib = 0; ib < 4; ++ib) {
        unsigned short uu[4][4]; float bsv[4];
#pragma unroll
        for (int r = 0; r < 4; ++r) { const int il = 16 * ib + 4 * gq + r; bsv[r] = bs[il];
#pragma unroll
            for (int cb = 0; cb < 4; ++cb) uu[r][cb] = PM[(size_t)(row0 + ih * 64 + il) * PMW + 1536 + 64 * gw + 16 * cb + c]; }
#pragma unroll
        for (int r = 0; r < 4; ++r) { const int i = ih * 64 + 16 * ib + 4 * gq + r;
#pragma unroll
            for (int cb = 0; cb < 4; ++cb) S[(size_t)(row0 + i) * D + 512 + 64 * gw + 16 * cb + c] = f2bf(geluf_(bf2f(uu[r][cb])) * (acc[ib][cb][r] + bsv[r])); }
    }
}

__device__ __forceinline__ void fnet_t_item(const KP& p, LAS unsigned char* lds, int item) {
    int tid = p.tid_; asm volatile("" : "+v"(tid));
    const bf16_t* PM = (const bf16_t*)(p.ws + OFF_BIG);
    LAS float* T = (LAS float*)lds;
    int seqrow0, L, s_local, cblk, kb; bf16_t* dstbase;
    if (item < GB * 4 * 16) { s_local = item >> 6; cblk = (item >> 4) & 3; kb = item & 15; L = SEQ; seqrow0 = s_local * SEQ; dstbase = (bf16_t*)(p.ws + OFF_PQT); }
    else { const int it2 = item - GB * 4 * 16; s_local = it2 >> 3; cblk = (it2 >> 1) & 3; kb = it2 & 1; L = CTXL; seqrow0 = R_LAT + s_local * CTXL; dstbase = (bf16_t*)(p.ws + OFF_PQTC); }
    __syncthreads();
    for (int idx = tid; idx < 4 * 64 * 8; idx += NTHREADS) { const int which = idx >> 9, r = (idx >> 3) & 63, cc = idx & 7, k = kb * 64 + r;
        const int tok = (which & 1) ? (L - k) : k; const int col = (which < 2 ? 2048 : 2304) + cblk * 64 + cc * 8; float f[8];
        if (tok < L) unpack8(*(const u32x4*)(PM + (size_t)(seqrow0 + tok) * PMW + col), f);
        else {
#pragma unroll
            for (int j = 0; j < 8; ++j) f[j] = 0.f; }
#pragma unroll
        for (int j = 0; j < 8; ++j) T[(which * 64 + r) * 65 + cc * 8 + j] = f[j]; }
    __syncthreads();
    const int c = tid >> 3, kq = tid & 7;
    float pe[8], qo[8];
#pragma unroll
    for (int e = 0; e < 8; ++e) { const int kl = kq * 8 + e; pe[e] = T[(0 * 64 + kl) * 65 + c] + T[(1 * 64 + kl) * 65 + c]; qo[e] = T[(2 * 64 + kl) * 65 + c] - T[(3 * 64 + kl) * 65 + c]; }
    if (kb == 0 && kq == 0) qo[0] = bf2f(PM[(size_t)(seqrow0 + L / 2) * PMW + 2048 + cblk * 64 + c]);
    bf16_t* dst = dstbase + (size_t)(s_local * 256 + cblk * 64 + c) * L;
    *(u32x4*)(dst + kb * 64 + kq * 8) = pack8(pe);
    *(u32x4*)(dst + L / 2 + kb * 64 + kq * 8) = pack8(qo);
}

__device__ __forceinline__ u32x4 ld8p(const bf16_t* p, bool ok) { return ok ? *(const u32x4*)p : (u32x4){0u, 0u, 0u, 0u}; }
__device__ __forceinline__ void fma8(float* y, const u32x4 a, const float* w) { float f[8]; unpack8(a, f);
#pragma unroll
    for (int j = 0; j < 8; ++j) y[j] += f[j] * w[j]; }
__device__ __forceinline__ void phase_ffn_conv(const KP& p, int g, int l, int parts, int b0, int nb, int halves) {
    int tid = p.tid_; asm volatile("" : "+v"(tid));
    if (parts & 1) { float* ssA = (float*)(p.ws + ssa_off(g)); for (int i = p.bx_ * NTHREADS + tid; i < R; i += NBLK * NTHREADS) ssA[i] = 0.f; }
    if (tid >= 352 || p.bx_ < b0 || p.bx_ >= b0 + nb) return;
    bf16_t* UP = (bf16_t*)(p.ws + OFF_BIG);
    const int c8 = tid * 8, G = nb, bx = p.bx_ - b0;
    const float* dw = p.in(I_ffn_dw) + (size_t)l * 9 * DFF + c8; const float* db = p.in(I_ffn_db) + (size_t)l * DFF + c8;
    float w[9][8], bias[8];
#pragma unroll
    for (int k = 0; k < 9; ++k) { const f32x4 w0 = *(const f32x4*)(dw + k * DFF), w1 = *(const f32x4*)(dw + k * DFF + 4);
#pragma unroll
        for (int j = 0; j < 4; ++j) { w[k][j] = w0[j]; w[k][4 + j] = w1[j]; } }
    { const f32x4 b0 = *(const f32x4*)db, b1 = *(const f32x4*)(db + 4);
#pragma unroll
      for (int j = 0; j < 4; ++j) { bias[j] = b0[j]; bias[4 + j] = b1[j]; } }
    if (parts & 2)
    for (int it0 = bx; it0 < GB * 32 * halves; it0 += G) {
        const int rid0 = it0 / halves, hf = it0 - rid0 * halves;
        const int rid = (G == 256 && halves == 1) ? ((rid0 & 7) * 32 + (rid0 >> 3)) : rid0;
        const int gb = rid >> 5, gr = rid & 31;
        const int c_lo = hf * (64 / halves), c_hi = c_lo + 64 / halves;
        const bool up = gr > 0, dn = gr < 31;
        const bf16_t* a1 = UP + (size_t)(gb * SEQ + gr * 64 + c_lo) * UPW + c8;
        const bf16_t* a0 = a1 - (size_t)64 * UPW; const bf16_t* a2 = a1 + (size_t)64 * UPW;
        const bool lf = c_lo > 0;
        u32x4 L0 = ld8p(a0 - UPW, up && lf), L1 = ld8p(a1 - UPW, lf), L2 = ld8p(a2 - UPW, dn && lf), M0 = ld8p(a0, up), M1 = ld8p(a1, true), M2 = ld8p(a2, dn);
        u32x4 R0 = ld8p(a0 + UPW, up), R1 = ld8p(a1 + UPW, true), R2 = ld8p(a2 + UPW, dn);
        bf16_t* hp = UP + (size_t)(gb * SEQ + gr * 64 + c_lo) * UPW + DFF + c8;
        u32x4 bq = *(const u32x4*)hp;
#pragma unroll 1
        for (int gc = c_lo; gc < c_hi; ++gc) {
            const bool nt2 = gc < 62; const size_t o = (size_t)(gc - c_lo + 2) * UPW;
            const u32x4 N0 = ld8p(a0 + o, up && nt2), N1 = ld8p(a1 + o, nt2), N2 = ld8p(a2 + o, dn && nt2);
            const u32x4 bn = ld8p(hp + UPW, gc < 63);
            float y[8];
#pragma unroll
            for (int j = 0; j < 8; ++j) y[j] = bias[j];
            fma8(y, L0, w[0]); fma8(y, M0, w[1]); fma8(y, R0, w[2]);
            fma8(y, L1, w[3]); fma8(y, M1, w[4]); fma8(y, R1, w[5]);
            fma8(y, L2, w[6]); fma8(y, M2, w[7]); fma8(y, R2, w[8]);
            float bv[8]; unpack8(bq, bv);
#pragma unroll
            for (int j = 0; j < 8; ++j) y[j] = siluf_(y[j]) * bv[j];
            *(u32x4*)hp = pack8(y);
            L0 = M0; L1 = M1; L2 = M2; M0 = R0; M1 = R1; M2 = R2; R0 = N0; R1 = N1; R2 = N2; bq = bn; hp += UPW;
        }
    }
    if (parts & 4) {
        for (int it = bx; it < R_CTX / 8; it += G) {
            const int s_ = it >> 5, t0 = (it & 31) * 8;
            const bf16_t* a = UP + (size_t)(R_LAT + s_ * CTXL + t0) * UPW + c8;
            u32x4 Lq = ld8p(a - UPW, t0 > 0), Mq = ld8p(a, true);
#pragma unroll 1
            for (int t = 0; t < 8; ++t) {
                const u32x4 Rq = ld8p(a + (size_t)(t + 1) * UPW, t0 + t + 1 < CTXL);
                bf16_t* hp = UP + (size_t)(R_LAT + s_ * CTXL + t0 + t) * UPW + DFF + c8;
                const u32x4 bq = *(const u32x4*)hp;
                float y[8];
#pragma unroll
                for (int j = 0; j < 8; ++j) y[j] = bias[j];
                fma8(y, Lq, w[3]); fma8(y, Mq, w[4]); fma8(y, Rq, w[5]);
                float bv[8]; unpack8(bq, bv);
#pragma unroll
                for (int j = 0; j < 8; ++j) y[j] = siluf_(y[j]) * bv[j];
                *(u32x4*)hp = pack8(y);
                Lq = Mq; Mq = Rq;
            }
        }
    }
}

#ifndef DUP_LP
#define DUP_LP 0
#endif

__device__ __forceinline__ unsigned wl_off(int l) { return (unsigned)OFF_W + (unsigned)l * (unsigned)W_LAYER; }
__device__ __forceinline__ unsigned mod_off(int l) { return (unsigned)OFF_MOD + (unsigned)l * (unsigned)(17 * 6144 * 4); }

__device__ __forceinline__ void ph_l1(const KP& p, LAS unsigned char* lds, int g, int l) {
    unsigned char* ws = p.ws; const bool ctx_full = (g == 0 && l == 0);
    pg8::TileSched S{}; S.G = NBLK; S.c = p.bx_; S.nseg = 1;
    S.n1M = NLT; S.n1N = NCOLS / 256; S.n2M = g == 0 ? NCT : 0; S.n2N = ctx_full ? NCOLS / 256 : 2; S.pn2_0 = ctx_full ? 0 : 1;
    S.A = ap_off(g); S.B = (unsigned)(wl_off(l) + (unsigned)W_IN); S.a_tstep = (unsigned)256 * D * 2; S.b_tstep = (unsigned)256 * D * 2;
    EpiWin E{(const float*)(ws + ssa_off(g)), (const float*)(ws + (unsigned)OFF_SHW1 + (unsigned)l * (unsigned)(17 * NCOLS * 4)), p.in(I_b_gate) + (size_t)l * GTW, (bf16_t*)(ws + OFF_BIG), (bf16_t*)(ws + OFF_GT), g};
    pg8::gemm_phase(lds, p.ws, p.tid_, D, D, D, true, S, E);
}
__device__ __forceinline__ void ph_l2(const KP& p, LAS unsigned char* lds, int g, int l) {
    const bool ctx_full = (g == 0 && l == 0); const int G = NBLK;
    const int n_kv = g == 0 ? N_KV : N_KV_LAT, n_conf = (ctx_full ? R : R_LAT) / 32, n_gm = (ctx_full ? R : R_LAT) / 128, n_fn = GB * 4 * 16 + (ctx_full ? NB * 4 * 2 : 0);
    const int total = n_kv + n_conf + n_gm + n_fn;
    { float* ssB = (float*)(p.ws + ssb_off(g)); for (int i = p.bx_ * NTHREADS + p.tid_; i < R; i += G * NTHREADS) ssB[i] = 0.f; }
    const int bx = p.bx_, n_small = total - n_gm, nb2 = G - n_gm, head = (nb2 > 0 && 7 * nb2 < n_small) ? 7 * nb2 : 0;
#define L2_SMALL(t_) do { int t = (t_); if (t < n_kv) ret_kv_item(p, lds, l, t); else if ((t -= n_kv) < n_fn) fnet_t_item(p, lds, t); else conf_item(p, lds, l, t - n_fn); } while (0)
    if (bx < n_gm) gmlp_item(p, lds, l, bx);
    else if (head) { for (int r7 = 0; r7 < 7; ++r7) L2_SMALL(r7 * nb2 + (bx - n_gm)); }
    for (int t2 = head + bx; t2 < n_small; t2 += G) L2_SMALL(t2);
#undef L2_SMALL
    __syncthreads();
}
__device__ __forceinline__ void ph_l3(const KP& p, LAS unsigned char* lds, int g, int l) {
    unsigned char* ws = p.ws; const bool ctx_full = (g == 0 && l == 0); const int G = NBLK, bx = p.bx_;
    const int nd = 64 + (ctx_full ? NB : 0);
    if (bx < nd) {
        const bool isc = bx >= 64;
        const int Kd = isc ? CTXL : SEQ;
        pg8::TileSched S{}; S.G = G; S.nseg = 1;
        S.n1M = isc ? 1 : 8; S.n1N = isc ? NB : GB; S.c = isc ? bx - 64 : bx;
        S.A = (unsigned)((isc ? OFF_DC : OFF_DM)); S.B = (unsigned)((isc ? OFF_PQTC : OFF_PQT)); S.a_tstep = (unsigned)256 * Kd * 2; S.b_tstep = (unsigned)256 * Kd * 2;
        EpiDft E{(bf16_t*)(ws + OFF_S), isc ? R_LAT : 0, Kd, isc ? 0.0625f : 0.02209708691207961f};
        pg8::gemm_phase(lds, p.ws, p.tid_, Kd, Kd, Kd, true, S, E);
    } else {
        const int n = ctx_full ? N_KV : N_KV_LAT;
        for (int it = bx - nd; it < n; it += G - nd) ret_out_item(p, lds, g, l, it);
        __syncthreads();
    }
}
__device__ __forceinline__ void ph_l5(const KP& p, LAS unsigned char* lds, int g, int l) {
    unsigned char* ws = p.ws; const bool ctx_full = (g == 0 && l == 0);
    pg8::TileSched S{}; S.G = NBLK; S.c = p.bx_; S.nseg = 4;
    S.n1M = NLT; S.n1N = 4; S.n2M = ctx_full ? NCT : 0; S.n2N = 4;
    S.A = (unsigned)(OFF_S); S.B = (unsigned)(wl_off(l) + (unsigned)W_O); S.a_tstep = (unsigned)256 * D * 2; S.b_tstep = (unsigned)256 * 256 * 2; S.a_segstep = (unsigned)256 * 2; S.b_segstep = (unsigned)1024 * 256 * 2;
    EpiMerge E{(const unsigned char*)(ws + OFF_GT), (bf16_t*)(ws + OFF_BIG)};
    pg8::gemm_phase(lds, p.ws, p.tid_, 256, D, 256, true, S, E);
}
__device__ __forceinline__ void ph_l6(const KP& p, LAS unsigned char* lds, int g, int l) {
    unsigned char* ws = p.ws; const bool ctx_full = (g == 0 && l == 0);
    pg8::TileSched S{}; S.G = NBLK; S.c = p.bx_; S.nseg = 1;
    S.n1M = NLT; S.n1N = 4; S.n2M = ctx_full ? NCT : 0; S.n2N = 4;
    S.A = (unsigned)(OFF_BIG); S.B = (unsigned)(wl_off(l) + (unsigned)W_OUT); S.a_tstep = (unsigned)256 * D * 2; S.b_tstep = (unsigned)256 * D * 2;
    EpiResid E{l == 0 ? p.in(I_x) : (const float*)p.out, l == 0 ? p.in(I_ctx) : (const float*)(ws + OFF_XC), p.out, (float*)(ws + OFF_XC),
               (const float*)(ws + mod_off(l) + 2 * 4096), (const float*)(ws + mod_off(l) + 4 * 4096), (bf16_t*)(ws + ap_off(g)), (float*)(ws + ssb_off(g)), g};
    pg8::gemm_phase(lds, p.ws, p.tid_, D, D, D, false, S, E);
}
__device__ __forceinline__ void ph_l7(const KP& p, LAS unsigned char* lds, int g, int l) {
    unsigned char* ws = p.ws; const bool ctx_full = (g == 0 && l == 0);
    pg8::TileSched S{}; S.G = NBLK; S.c = p.bx_; S.nseg = 1;
    S.n1M = NLT; S.n1N = UPW / 256; S.n2M = ctx_full ? NCT : 0; S.n2N = UPW / 256;
    S.A = ap_off(g); S.B = (unsigned)(wl_off(l) + (unsigned)W_UP); S.a_tstep = (unsigned)256 * D * 2; S.b_tstep = (unsigned)256 * D * 2;
    EpiUp E{(const float*)(ws + ssb_off(g)), (const float*)(ws + (unsigned)OFF_SHW2 + (unsigned)l * (unsigned)(17 * UPW * 4)), (bf16_t*)(ws + OFF_BIG), g};
    pg8::gemm_phase(lds, p.ws, p.tid_, D, D, D, true, S, E);
}
__device__ __forceinline__ void ph_l9(const KP& p, LAS unsigned char* lds, int g, int l, int which = 0) {
    unsigned char* ws = p.ws; const bool ctx_full = (g == 0 && l == 0);
    pg8::TileSched S{}; S.G = NBLK; S.c = p.bx_; S.nseg = 1;
    S.n1M = which == 2 ? 0 : NLT; S.n1N = 4; S.n2M = (ctx_full && which != 1) ? NCT : 0; S.n2N = 4;
    if (which == 2) S.pm2_x = NLT;
    S.A = (unsigned)OFF_BIG + (unsigned)DFF * 2u; S.B = (unsigned)(wl_off(l) + (unsigned)W_DN); S.a_tstep = (unsigned)256 * UPW * 2; S.b_tstep = (unsigned)256 * DFF * 2;
    EpiResid E{p.out, (const float*)(ws + OFF_XC), p.out, (float*)(ws + OFF_XC), (const float*)(ws + mod_off(l) + 5 * 4096),
               l == 0 ? (const float*)(ws + mod_off(1) + 4096) : nullptr, (bf16_t*)(ws + ap_off(g)), (float*)(ws + ssa_off(g)), g};
    pg8::gemm_phase(lds, p.ws, p.tid_, DFF, UPW, DFF, false, S, E);
}

__global__ void __launch_bounds__(NTHREADS) mega(KArgs a) {
    extern __shared__ __attribute__((aligned(16))) unsigned char lds_raw[];
    LAS unsigned char* lds = (LAS unsigned char*)lds_raw;
    volatile LAS unsigned* misc = (volatile LAS unsigned*)(lds + MISC_OFF);
    if (threadIdx.x < 64) misc[threadIdx.x] = 0u;
    if (threadIdx.x < 30) { const unsigned long long v = (unsigned long long)a.in[threadIdx.x]; LAS unsigned* t = (LAS unsigned*)(lds + PTAB_OFF) + 2 * threadIdx.x; t[0] = (unsigned)v; t[1] = (unsigned)(v >> 32); }
    __syncthreads();
    const int wid_s = __builtin_amdgcn_readfirstlane((int)(threadIdx.x >> 6));
    cg::grid_group grid = cg::this_grid();
    XcdBarrier xb = xcd_barrier_post((unsigned*)(a.ws + OFF_BAR), misc + 8);
    grid.sync();
#define MK_Q() KP q; { int w_ = wid_s, b_ = blockIdx.x; unsigned z_ = 0u; asm volatile("" : "+s"(w_), "+s"(b_), "+s"(z_)); int t_ = (w_ << 6) | (int)__builtin_amdgcn_mbcnt_hi(~0u, __builtin_amdgcn_mbcnt_lo(~0u, z_)); asm volatile("" : "+v"(t_)); q.tid_ = t_; q.bx_ = b_; q.ws = a.ws + z_; q.out = a.out + z_; q.ldsb = lds; q.ptab = lds + PTAB_OFF + z_; }
#define PHASE(call) do { MK_Q(); call; xcd_barrier(xb); } while (0)
    PHASE(phase_prep_a(q, lds));
    PHASE(phase_prep_b(q));
    PHASE(phase_prep_c(q, lds, 0, 1, 0, NBLK); phase_g0(q, 0, 0, NBLK));
    for (int g = 0; g < NG; ++g) {
        for (int l = 0; l < 2; ++l) {
            { MK_Q(); ph_l1(q, lds, g, l); }
            PHASE(if (g == 0 && l == 0) weight_prep(q, lds, 1, 2, 32, NBLK - 32);
                  if (g == 1 && l == 0) phase_final(q, 0, 128, NBLK - 128));
            if (DUP_LP == 1) PHASE(ph_l1(q, lds, g, l));
            PHASE(ph_l2(q, lds, g, l));
            if (DUP_LP == 2) PHASE(ph_l2(q, lds, g, l));
            PHASE(ph_l3(q, lds, g, l));
            if (DUP_LP == 3) PHASE(ph_l3(q, lds, g, l));
            PHASE(ph_l5(q, lds, g, l); if (g == 0 && l == 0) phase_prep_c(q, lds, 1, 2, 64, NBLK - 64));
            if (DUP_LP == 5) PHASE(ph_l5(q, lds, g, l));
            PHASE(ph_l6(q, lds, g, l); if (g == 0 && l == 0) phase_g0(q, 1, 64, NBLK - 64));
            PHASE(ph_l7(q, lds, g, l));
            if (DUP_LP == 7) PHASE(ph_l7(q, lds, g, l));
            if (g == 0 && l == 0) {
                PHASE(phase_ffn_conv(q, g, l, 1 | 4, 0, NBLK, 1));
                PHASE(ph_l9(q, lds, g, l, 2); phase_ffn_conv(q, g, l, 2, 64, NBLK - 64, 4));
                PHASE(ph_l9(q, lds, g, l, 1));
            } else {
                PHASE(phase_ffn_conv(q, g, l, 1 | 2, 0, NBLK, 1));
                PHASE(ph_l9(q, lds, g, l));
            }
        }
        if (g == NG - 1) { MK_Q(); phase_final(q, g, 0, NBLK); }
    }
#undef PHASE
#undef MK_Q
}

extern "C" void kernel_launch(void* const* d_in, const int* in_sizes, int n_in, void* d_out, int out_size, void* d_ws, size_t ws_size, hipStream_t stream) {
    static int grid = 0;
    if (grid == 0) {
        int dev = 0, cus = 0, per_cu = 0;
        (void)hipGetDevice(&dev);
        (void)hipDeviceGetAttribute(&cus, hipDeviceAttributeMultiprocessorCount, dev);
        (void)hipFuncSetAttribute((const void*)mega, hipFuncAttributeMaxDynamicSharedMemorySize, LDS_BYTES);
        (void)hipOccupancyMaxActiveBlocksPerMultiprocessor(&per_cu, (const void*)mega, NTHREADS, LDS_BYTES);
        grid = NBLK;
        if (n_in != 30 || ws_size < WS_END || per_cu < 1 || cus * per_cu < NBLK) { fprintf(stderr, "kernel_launch: unexpected n_in %d / ws %zu (need %zu) / per_cu %d\n", n_in, ws_size, (size_t)WS_END, per_cu); }
    }
    (void)hipMemsetAsync(d_ws, 0, 16384, stream);
    KArgs a{};
    for (int i = 0; i < 30; ++i) a.in[i] = (const float*)d_in[i];
    a.out = (float*)d_out; a.ws = (unsigned char*)d_ws;
    void* args[] = {&a};
    hipError_t e = hipLaunchCooperativeKernel((const void*)mega, dim3(grid), dim3(NTHREADS), args, LDS_BYTES, stream);
    if (e != hipSuccess) fprintf(stderr, "cooperative launch failed: %s (grid %d)\n", hipGetErrorString(e), grid);
}
```

```cpp
#include <hip/hip_runtime.h>
#include <hip/hip_cooperative_groups.h>
#include <cstdio>
#include <cstdint>
namespace cg = cooperative_groups;

#define LAS __attribute__((address_space(3)))
typedef unsigned short bf16_t;
typedef short bf16x8 __attribute__((ext_vector_type(8)));
typedef float f32x4 __attribute__((ext_vector_type(4)));
typedef float f32x2 __attribute__((ext_vector_type(2)));
typedef unsigned u32x4 __attribute__((ext_vector_type(4)));
typedef unsigned u32x2 __attribute__((ext_vector_type(2)));

#ifndef ONE_LAUNCH
#define ONE_LAUNCH 1
#endif

constexpr int NTHREADS = 512, NWAVES = 8;
constexpr int NBLK = 256;
constexpr int D = 1024, NB = 16, SEQ = 2048, CTXL = 256, DFF = 2816;
constexpr int NCOLS = 6656;
constexpr int PMW = 2560, GTW = 4096, UPW = 5632;
constexpr int IN_COLS = 6400;
constexpr float EPS = 1e-6f;
constexpr int NG = 2, GB = 8;
constexpr int R_LAT = GB * SEQ, R_CTX = NB * CTXL, R = R_LAT + R_CTX;
constexpr int NLT = R_LAT / 256, NCT = R_CTX / 256;
constexpr int N_KV_LAT = GB * 4 * 16, N_KV_CTX = NB * 4 * 2, N_KV = N_KV_LAT + N_KV_CTX;

constexpr size_t al256(size_t x) { return (x + 255) & ~(size_t)255; }
constexpr size_t OFF_BAR = 0;
constexpr size_t OFF_ADAP = 65536;
constexpr size_t OFF_MOD = OFF_ADAP + al256((size_t)8 * 2 * 17 * 6144 * 4);
constexpr size_t OFF_SHW1 = OFF_MOD + al256((size_t)2 * 17 * 6144 * 4);
constexpr size_t OFF_SHW2 = OFF_SHW1 + al256((size_t)2 * 17 * NCOLS * 4);
constexpr size_t OFF_ROPE = OFF_SHW2 + al256((size_t)2 * 17 * UPW * 4);
constexpr size_t OFF_LOGG = OFF_ROPE + al256((size_t)2 * 2304 * 32 * 4);
constexpr size_t OFF_DM = OFF_LOGG + 256;
constexpr size_t OFF_DC = OFF_DM + (size_t)2048 * 2048 * 2;
constexpr size_t OFF_W = OFF_DC + (size_t)256 * 256 * 2;
constexpr size_t W_IN = 0, W_O = W_IN + (size_t)NCOLS * 1024 * 2, W_OUT = W_O + (size_t)4 * 1024 * 256 * 2, W_UP = W_OUT + (size_t)1024 * 1024 * 2,
                 W_DN = W_UP + (size_t)UPW * 1024 * 2, W_LAYER = W_DN + (size_t)1024 * DFF * 2;
constexpr size_t OFF_XC = OFF_W + 2 * W_LAYER;
constexpr size_t OFF_AP = OFF_XC + (size_t)NB * CTXL * D * 4;
constexpr size_t OFF_AP1 = OFF_AP + (size_t)R * D * 2;
constexpr size_t OFF_SS = OFF_AP1 + (size_t)R_LAT * D * 2;
constexpr size_t OFF_S = OFF_SS + (size_t)R * 16 * 4;
constexpr size_t OFF_KV = OFF_S + (size_t)R * D * 2;
constexpr size_t OFF_KVC = OFF_KV + (size_t)N_KV_LAT * 2 * 4096 * 4;
constexpr size_t OFF_PQT = OFF_KVC + (size_t)2 * N_KV_CTX * 2 * 4096 * 4;
constexpr size_t OFF_PQTC = OFF_PQT + (size_t)GB * 256 * 2048 * 2;
constexpr size_t OFF_BIG = OFF_PQTC + (size_t)NB * 256 * 256 * 2;
constexpr size_t OFF_GT = OFF_BIG + (size_t)R * PMW * 2;
constexpr size_t WS_END = OFF_BIG + ((size_t)R * PMW * 2 + (size_t)R * GTW > (size_t)R * UPW * 2 ? (size_t)R * PMW * 2 + (size_t)R * GTW : (size_t)R * UPW * 2);
static_assert(WS_END <= (size_t)512 * 1024 * 1024, "workspace map exceeds 512 MiB");
static_assert((size_t)R * UPW * 2 <= WS_END - OFF_BIG, "UP overlay");

constexpr int SCR_BYTES = 139264;
constexpr int MISC_OFF = SCR_BYTES;
constexpr int LDS_BYTES = 161792;

__device__ __forceinline__ float bf2f(unsigned v) { return __uint_as_float(v << 16); }
__device__ __forceinline__ unsigned cvt_pk_bf16(float lo, float hi) { unsigned r; asm volatile("v_cvt_pk_bf16_f32 %0, %1, %2" : "=v"(r) : "v"(lo), "v"(hi)); return r; }
__device__ __forceinline__ bf16_t f2bf(float f) { return (bf16_t)(cvt_pk_bf16(f, 0.f) & 0xffffu); }
__device__ __forceinline__ void unpack8(const u32x4 w, float* f) {
    f[0] = bf2f(w.x & 0xffffu); f[1] = __uint_as_float(w.x & 0xffff0000u); f[2] = bf2f(w.y & 0xffffu); f[3] = __uint_as_float(w.y & 0xffff0000u);
    f[4] = bf2f(w.z & 0xffffu); f[5] = __uint_as_float(w.z & 0xffff0000u); f[6] = bf2f(w.w & 0xffffu); f[7] = __uint_as_float(w.w & 0xffff0000u);
}
__device__ __forceinline__ u32x4 pack8(const float* f) { u32x4 w; w.x = cvt_pk_bf16(f[0], f[1]); w.y = cvt_pk_bf16(f[2], f[3]); w.z = cvt_pk_bf16(f[4], f[5]); w.w = cvt_pk_bf16(f[6], f[7]); return w; }
__device__ __forceinline__ float shx(float v, int m, int lane) { return __int_as_float(__builtin_amdgcn_ds_bpermute((lane ^ m) << 2, __float_as_int(v))); }
template <int CTRL> __device__ __forceinline__ float dpp_mov(float v) { return __int_as_float(__builtin_amdgcn_update_dpp(0, __float_as_int(v), CTRL, 0xF, 0xF, false)); }
__device__ __forceinline__ float wave_sum(float v, int  ) {
    v += dpp_mov<0xB1>(v); v += dpp_mov<0x4E>(v); v += dpp_mov<0x141>(v); v += dpp_mov<0x140>(v);
    const int vi = __float_as_int(v);
    const float s0 = __int_as_float(__builtin_amdgcn_readlane(vi, 0)), s1 = __int_as_float(__builtin_amdgcn_readlane(vi, 16)), s2 = __int_as_float(__builtin_amdgcn_readlane(vi, 32)), s3 = __int_as_float(__builtin_amdgcn_readlane(vi, 48));
    return (s0 + s1) + (s2 + s3);
}
__device__ __forceinline__ float fast_rcp(float x) { return __builtin_amdgcn_rcpf(x); }
__device__ __forceinline__ float sigmoidf_(float x) { return fast_rcp(1.f + __expf(-x)); }
__device__ __forceinline__ float siluf_(float x) { return x * sigmoidf_(x); }
__device__ __forceinline__ float geluf_(float v) {
    const float av = fabsf(v), d = av * 0.2316418882f + 1.0f;
    const float t = fast_rcp(d);
    float q = t * 0.5307027145f + (-0.7265760135f); q = q * t + 0.7107068705f; q = q * t + (-0.142248368f); q = q * t + 0.127414796f; q = q * t;
    const float e = __builtin_amdgcn_exp2f((v * v) * (-0.72134752044f));
    const float m = v * (q * e);
    return v < 0.f ? m : v - m;
}
__device__ __forceinline__ f32x4 mfma16(bf16x8 a, bf16x8 b, f32x4 c) { return __builtin_amdgcn_mfma_f32_16x16x32_bf16(a, b, c, 0, 0, 0); }
__device__ __forceinline__ float sin_rev(float r) { return __builtin_amdgcn_sinf(r); }
__device__ __forceinline__ float cos_rev(float r) { return __builtin_amdgcn_cosf(r); }

#define XB_TMO      128
#define XB_XCNT(j)  (256  + 64 * (j))
#define XB_XSUB(j)  (1280 + 64 * (j))
#define XB_XGEN(j)  (2304 + 64 * (j))
#define XB_TOP      3328
#define XB_TOPGEN   3392
#define XCD_BAR_WORDS 3456
#define XB_SPIN_CAP (1u << 20)
__device__ __forceinline__ unsigned xb_ld(unsigned* p)              { return __hip_atomic_load(p, __ATOMIC_RELAXED, __HIP_MEMORY_SCOPE_AGENT); }
__device__ __forceinline__ unsigned xb_add(unsigned* p, unsigned v) { return __hip_atomic_fetch_add(p, v, __ATOMIC_RELAXED, __HIP_MEMORY_SCOPE_AGENT); }
__device__ __forceinline__ unsigned xb_xcc_id() { return (unsigned)__builtin_amdgcn_s_getreg((3 << 11) | 20) & 0xFu; }
#define XB_SPIN(cond, bar) do { unsigned _sp = 0; while (cond) { __builtin_amdgcn_s_sleep(1); \
    if ((++_sp & 255u) == 0u) { if (xb_ld(&(bar)[XB_TMO])) break; if (_sp > XB_SPIN_CAP) { atomicAdd(&(bar)[XB_TMO], 1u); break; } } } } while (0)
struct XcdBarrier { unsigned* bar; unsigned x; volatile LAS unsigned* st; };
__device__ __forceinline__ XcdBarrier xcd_barrier_post(unsigned* bar, volatile LAS unsigned* st) {
    XcdBarrier b; b.bar = bar; b.x = xb_xcc_id(); b.st = st;
    if (threadIdx.x == 0) (void)xb_add(&bar[XB_XCNT(b.x)], 1u);
    return b;
}
__device__ __forceinline__ void xcd_barrier_complete(unsigned* bar, unsigned x, unsigned& nloc, unsigned& nx) {
    const unsigned G = NBLK;
    unsigned sum, cnt, mine, sp = 0u;
    for (;;) {
        sum = 0u; cnt = 0u; mine = 0u;
#pragma unroll
        for (unsigned j = 0; j < 16; ++j) { const unsigned c = xb_ld(&bar[XB_XCNT(j)]); sum += c; cnt += (c > 0u) ? 1u : 0u; mine = (j == x) ? c : mine; }
        if (sum == G) break;
        __builtin_amdgcn_s_sleep(1);
        if ((++sp & 255u) == 0u) { if (xb_ld(&bar[XB_TMO])) break; if (sp > XB_SPIN_CAP) { atomicAdd(&bar[XB_TMO], 1u); break; } }
    }
    nloc = mine > 0u ? mine : 1u; nx = cnt > 0u ? cnt : 1u;
}
__device__ __forceinline__ void xcd_barrier(const XcdBarrier& b) {
    asm volatile("s_waitcnt vmcnt(0)" ::: "memory");
    __syncthreads();
    if (threadIdx.x == 0) {
        unsigned* bar = b.bar; unsigned bx_ = b.x; asm volatile("" : "+s"(bx_));
        __builtin_amdgcn_s_waitcnt(0);
        unsigned nloc = b.st[0], nx = b.st[1];
        if (nloc == 0u) { xcd_barrier_complete(bar, bx_, nloc, nx); b.st[0] = nloc; b.st[1] = nx; }
        const unsigned old = xb_add(&bar[XB_XSUB(bx_)], 1u);
        const unsigned gen = old / nloc;
        if (old + 1u == (gen + 1u) * nloc) {
            __builtin_amdgcn_fence(__ATOMIC_RELEASE, "agent");
            asm volatile("s_waitcnt vmcnt(0)" ::: "memory");
            const unsigned og = xb_add(&bar[XB_TOP], 1u);
            const unsigned tg = og / nx;
            if (og + 1u == (tg + 1u) * nx) xb_add(&bar[XB_TOPGEN], 1u);
            else XB_SPIN(xb_ld(&bar[XB_TOPGEN]) == tg, bar);
            __builtin_amdgcn_fence(__ATOMIC_ACQUIRE, "agent");
            xb_add(&bar[XB_XGEN(bx_)], 1u);
            asm volatile("s_waitcnt vmcnt(0)" ::: "memory");
        } else {
            XB_SPIN(xb_ld(&bar[XB_XGEN(bx_)]) == gen, bar);
            __builtin_amdgcn_fence(__ATOMIC_ACQUIRE, "agent");
            asm volatile("s_waitcnt vmcnt(0)" ::: "memory");
        }
    }
    __syncthreads();
}

namespace pg8 {
constexpr int BM = 256, BK = 64, HALF = 128, HTB = HALF * BK * 2, NXCD = 8, WGM = 8;
__host__ __device__ __forceinline__ int lds_byte(int r, int c) { const int st = (r >> 4) * 2 + (c >> 5), rr = r & 15, cc = c & 31, ob = rr * 64 + cc * 2; return st * 1024 + (ob ^ (((ob >> 9) & 1) << 5)); }
__host__ __device__ __forceinline__ void stage_rc(int b, int& R_, int& C_) { const int st = b / 1024, sb = b % 1024, swz = sb ^ (((sb >> 9) & 1) << 5); R_ = (st >> 1) * 16 + swz / 64; C_ = (st & 1) * 32 + (swz % 64) / 2; }
__host__ __device__ __forceinline__ int perm32(int rho) { const int n = rho >> 4, i = rho & 15; return 8 * (i >> 2) + 4 * n + (i & 3); }

struct Unit { int pm, pn, seg; unsigned A, B; };
__device__ __forceinline__ const char* sgpr_ptr(const char* p) {
    const unsigned long long v = (unsigned long long)p;
    const unsigned lo = (unsigned)__builtin_amdgcn_readfirstlane((int)(unsigned)v), hi = (unsigned)__builtin_amdgcn_readfirstlane((int)(unsigned)(v >> 32));
    typedef const char __attribute__((address_space(1)))* gp_t;
    return (const char*)(gp_t)(((unsigned long long)hi << 32) | (unsigned long long)lo);
}

__device__ __forceinline__ void tile_order(int L, int nM, int nN, int& pm, int& pn) {
    const int nwg = nM * nN; int wgid = L;
    { const int q = nwg / NXCD, r = nwg % NXCD, xcd = wgid % NXCD, off = wgid / NXCD; wgid = (xcd < r ? xcd * (q + 1) : r * (q + 1) + (xcd - r) * q) + off; }
    const int nig = WGM * nN, gid = wgid / nig, fm = gid * WGM, gsz = (nM - fm) < WGM ? (nM - fm) : WGM;
    pm = fm + ((wgid % nig) % gsz); pn = (wgid % nig) / gsz;
}
struct TileSched {
    int n1M, n1N, n2M, n2N, pn2_0, pm2_x, G, c, nseg;
    unsigned A, B, a_tstep, b_tstep, a_segstep, b_segstep;
    __device__ __forceinline__ bool next(int i, Unit& u) const {
        const int ti = i / nseg, seg = i - ti * nseg;
        const int L = ti * G + c, n1 = n1M * n1N, n2 = n2M * n2N;
        int pm, pn;
        if (L < n1) tile_order(L, n1M, n1N, pm, pn);
        else if (L < n1 + n2) { tile_order(L - n1, n2M, n2N, pm, pn); pm += n1M + pm2_x; pn += pn2_0; }
        else return false;
        pm = __builtin_amdgcn_readfirstlane(pm); pn = __builtin_amdgcn_readfirstlane(pn);
        u.pm = pm; u.pn = pn; u.seg = seg;
        u.A = A + (unsigned)pm * a_tstep + (unsigned)seg * a_segstep; u.B = B + (unsigned)pn * b_tstep + (unsigned)seg * b_segstep;
        return true;
    }
};

struct NoPre {};
constexpr int TB_OFF = 131072;
constexpr int SHB_OFF = 147456;
template <class Epi, class Sched>
__device__ __forceinline__ void gemm_phase(LAS unsigned char* lds, const unsigned char* wsb, const int tid_in, const int K, const int lda, const int ldb, const bool perm, const Sched& S, const Epi& E) {
    __builtin_amdgcn_s_waitcnt(0x0F70);
    int tid = tid_in; asm volatile("" : "+v"(tid));
    const int wid = __builtin_amdgcn_readfirstlane(tid >> 6), lane = tid & 63, wr = wid >> 2, wc = wid & 3, fr = lane & 15, fq = lane >> 4;
    const int nt = K / BK;
    unsigned voffA[2], voffB[2];
#pragma unroll
    for (int i = 0; i < 2; ++i) { int R_, C_; stage_rc(tid * 16 + i * 8192, R_, C_); const int Rb = perm ? ((R_ & ~31) + perm32(R_ & 31)) : R_;
        voffA[i] = (unsigned)(R_ * lda + C_) * 2u; voffB[i] = (unsigned)(Rb * ldb + C_) * 2u; }
    const unsigned kstep = (unsigned)(BK * 2);
    const unsigned hA = (unsigned)HALF * lda * 2, hB = (unsigned)HALF * ldb * 2;
    const unsigned ldsw = (unsigned)wid * 1024u;
    const int aoff = lds_byte(wr * 64 + fr, fq * 8), boff = lds_byte(wc * 32 + fr, fq * 8);
#define PG8_SA(b, h) (((b) * 2 + (h)) * HTB)
#define PG8_SB(b, h) ((4 + (b) * 2 + (h)) * HTB)
#define PG8_STAGE(bufoff, goff, voff) do { _Pragma("unroll") for (int _i = 0; _i < 2; ++_i) \
        __builtin_amdgcn_global_load_lds((const unsigned*)(wsb + (unsigned)((goff) + (voff)[_i])), (LAS unsigned*)(lds + (bufoff) + ldsw + _i * 8192), 16, 0, 0); } while (0)
#define PG8_LDA(dst, b, h) do { _Pragma("unroll") for (int m = 0; m < 4; ++m) _Pragma("unroll") for (int k = 0; k < 2; ++k) dst[m][k] = *(const LAS bf16x8*)(lds + PG8_SA(b, h) + aoff + m * 2048 + k * 1024); } while (0)
#define PG8_LDB(dst, b, h) do { _Pragma("unroll") for (int n = 0; n < 2; ++n) _Pragma("unroll") for (int k = 0; k < 2; ++k) dst[n][k] = *(const LAS bf16x8*)(lds + PG8_SB(b, h) + boff + n * 2048 + k * 1024); } while (0)
#define PG8_MMA(ai, bj, At, Bt) do { __builtin_amdgcn_s_setprio(1); _Pragma("unroll") for (int m = 0; m < 4; ++m) _Pragma("unroll") for (int n = 0; n < 2; ++n) _Pragma("unroll") for (int k = 0; k < 2; ++k) \
        acc[ai][bj][m][n] = __builtin_amdgcn_mfma_f32_16x16x32_bf16(Bt[n][k], At[m][k], acc[ai][bj][m][n], 0, 0, 0); __builtin_amdgcn_s_setprio(0); } while (0)
#define PG8_MMA0(ai, bj, At, Bt) do { __builtin_amdgcn_s_setprio(1); _Pragma("unroll") for (int m = 0; m < 4; ++m) _Pragma("unroll") for (int n = 0; n < 2; ++n) { \
        acc[ai][bj][m][n] = __builtin_amdgcn_mfma_f32_16x16x32_bf16(Bt[n][0], At[m][0], (f32x4){0.f, 0.f, 0.f, 0.f}, 0, 0, 0); \
        acc[ai][bj][m][n] = __builtin_amdgcn_mfma_f32_16x16x32_bf16(Bt[n][1], At[m][1], acc[ai][bj][m][n], 0, 0, 0); } __builtin_amdgcn_s_setprio(0); } while (0)
#define PG8_WAIT_V(n) asm volatile("s_waitcnt vmcnt(" #n ")" ::: "memory")
#define PG8_WAIT_VN(n) asm volatile("s_waitcnt vmcnt(%0)" :: "n"(n) : "memory")
#define PG8_WAIT_L(n) asm volatile("s_waitcnt lgkmcnt(" #n ")" ::: "memory")
#define PG8_BAR __builtin_amdgcn_s_barrier()
#define PG8_SCHED __builtin_amdgcn_sched_barrier(0)
#define PG8_ZERO() do { _Pragma("unroll") for (int a = 0; a < 2; ++a) _Pragma("unroll") for (int b = 0; b < 2; ++b) _Pragma("unroll") for (int m = 0; m < 4; ++m) _Pragma("unroll") for (int n = 0; n < 2; ++n) acc[a][b][m][n] = (f32x4){0.f, 0.f, 0.f, 0.f}; } while (0)
    Unit cur, nxt; int ui = 0;
    if (!S.next(0, cur)) return;
    f32x4 acc[2][2][4][2];
    if (!Epi::ZC) PG8_ZERO();
    bf16x8 At[4][2], B0[2][2], B1[2][2];
    unsigned cA = cur.A, cB = cur.B;
    E.prefetch(cur, wid, lane, lds + SHB_OFF);
    typename Epi::Pre pre = E.pre(cur, wr, wc, fr, fq);
    PG8_STAGE(PG8_SB(0, 0), cB, voffB); PG8_STAGE(PG8_SB(0, 1), cB + hB, voffB); PG8_STAGE(PG8_SA(0, 0), cA, voffA); PG8_STAGE(PG8_SA(0, 1), cA + hA, voffA);
    if (wr == 1) PG8_BAR;
    PG8_WAIT_V(2); PG8_BAR;
    PG8_STAGE(PG8_SB(1, 0), cB + kstep, voffB); PG8_STAGE(PG8_SA(1, 0), cA + kstep, voffA); PG8_STAGE(PG8_SB(1, 1), cB + hB + kstep, voffB);
    PG8_WAIT_V(6); PG8_BAR;
    for (;;) {
        const bool has_next = S.next(ui + 1, nxt);
        const unsigned nA = has_next ? nxt.A : cA, nB = has_next ? nxt.B : cB;
#define PG8_PASS(WX, MM) do { \
            const bool last = (t == nt - 2); \
            unsigned tk = (unsigned)t * (unsigned)kstep; asm volatile("" : "+s"(tk)); \
            const unsigned a1 = cA + tk + kstep; \
            const unsigned a2 = last ? nA : cA + tk + 2 * kstep, b2 = last ? nB : cB + tk + 2 * kstep; \
            const unsigned a3 = a2 + kstep, b3 = b2 + kstep; \
            PG8_LDB(B0, 0, 0); PG8_LDB(B1, 0, 1); PG8_SCHED; PG8_LDA(At, 0, 0); PG8_STAGE(PG8_SA(1, 1), a1 + hA, voffA); \
            WX; PG8_WAIT_L(0); PG8_BAR; MM(0, 0, At, B0); MM(0, 1, At, B1); PG8_BAR; PG8_SCHED; \
            PG8_LDA(At, 0, 1); PG8_STAGE(PG8_SB(0, 0), b2, voffB); PG8_STAGE(PG8_SB(0, 1), b2 + hB, voffB); PG8_STAGE(PG8_SA(0, 0), a2, voffA); \
            WX; PG8_WAIT_L(0); PG8_BAR; MM(1, 0, At, B0); MM(1, 1, At, B1); PG8_BAR; PG8_SCHED; \
            PG8_LDB(B0, 1, 0); PG8_LDB(B1, 1, 1); PG8_SCHED; PG8_LDA(At, 1, 0); PG8_STAGE(PG8_SA(0, 1), a2 + hA, voffA); \
            PG8_WAIT_V(8); PG8_WAIT_L(0); PG8_BAR; PG8_MMA(0, 0, At, B0); PG8_MMA(0, 1, At, B1); PG8_BAR; PG8_SCHED; \
            PG8_LDA(At, 1, 1); PG8_STAGE(PG8_SB(1, 0), b3, voffB); PG8_STAGE(PG8_SB(1, 1), b3 + hB, voffB); PG8_STAGE(PG8_SA(1, 0), a3, voffA); \
            PG8_WAIT_V(8); PG8_WAIT_L(0); PG8_BAR; PG8_MMA(1, 0, At, B0); PG8_MMA(1, 1, At, B1); PG8_BAR; PG8_SCHED; \
        } while (0)
        int t = 0;
        if (Epi::ZC) {
            if (Epi::XST > 0 && ui > 0) PG8_PASS(PG8_WAIT_VN(8 + Epi::XST), PG8_MMA0); else PG8_PASS(PG8_WAIT_V(8), PG8_MMA0);
            t = 2;
        } else if (Epi::XST > 0 && ui > 0) { PG8_PASS(PG8_WAIT_VN(8 + Epi::XST), PG8_MMA); t = 2; }
        for (; t < nt; t += 2) PG8_PASS(PG8_WAIT_V(8), PG8_MMA);
#undef PG8_PASS
        if (wr == 0) PG8_BAR;
        unsigned zz = 0u; asm volatile("" : "+s"(zz)); const int le = (int)__builtin_amdgcn_mbcnt_hi(~0u, __builtin_amdgcn_mbcnt_lo(~0u, zz));
        if (E(acc, cur, wr, wc, le & 15, le >> 4, lds + TB_OFF + ldsw, lds + SHB_OFF + (ui & 1) * 3072, pre)) { if (!Epi::ZC) PG8_ZERO(); }
        if (!has_next) break;
        cur = nxt; cA = nA; cB = nB; ++ui;
        E.prefetch(cur, wid, le, lds + SHB_OFF + (ui & 1) * 3072);
        pre = E.pre(cur, wr, wc, le & 15, le >> 4);
        if (wr == 1) PG8_BAR;
    }
    PG8_WAIT_V(0);
    PG8_BAR;
#undef PG8_SA
#undef PG8_SB
#undef PG8_STAGE
#undef PG8_LDA
#undef PG8_LDB
#undef PG8_MMA
#undef PG8_MMA0
#undef PG8_WAIT_V
#undef PG8_WAIT_VN
#undef PG8_WAIT_L
#undef PG8_BAR
#undef PG8_SCHED
#undef PG8_ZERO
}
}

enum { I_x = 0, I_c = 1, I_ctx = 2, I_c_ctx = 3, I_w_ada = 4, I_b_ada = 5, I_g_norm1 = 6, I_g_norm2 = 7, I_w_in = 8, I_b_gate = 9, I_ret_decay = 10, I_ret_gn = 11, I_w_ret_o = 12, I_conv_dw = 13, I_conv_db = 14, I_conv_ln_g = 15, I_conv_ln_b = 16, I_w_conv_o = 17, I_gmlp_ln_g = 18, I_gmlp_ln_b = 19, I_gmlp_ws = 20, I_gmlp_bs = 21, I_w_gmlp_o = 22, I_w_fnet_o = 23, I_w_out = 24, I_w_ffn_up = 25, I_ffn_dw = 26, I_ffn_db = 27, I_w_ffn_down = 28, I_g_final = 29 };
struct KArgs { const float* in[30]; float* out; unsigned char* ws; int ph_lo, ph_hi; };
constexpr int PTAB_OFF = MISC_OFF + 4096;
struct KP {
    float* out; unsigned char* ws; LAS unsigned char* ldsb; LAS unsigned char* ptab; int tid_, bx_;
    __device__ __forceinline__ const float* in(int k) const {
        const LAS unsigned* t = (const LAS unsigned*)ptab + 2 * k;
        const unsigned lo = (unsigned)__builtin_amdgcn_readfirstlane((int)t[0]), hi = (unsigned)__builtin_amdgcn_readfirstlane((int)t[1]);
        typedef const float __attribute__((address_space(1)))* gcfp_t;
        return (const float*)(gcfp_t)(((unsigned long long)hi << 32) | (unsigned long long)lo);
    }
};

struct RowInfo { int mi; size_t xrow0; bool is_ctx; };
__device__ __forceinline__ RowInfo row_info(int g, int pm) {
    RowInfo ri;
    if (pm < NLT) { const int b = g * GB + (pm >> 3); ri.mi = b; ri.xrow0 = (size_t)b * SEQ + (size_t)(pm & 7) * 256; ri.is_ctx = false; }
    else { const int b = pm - NLT; ri.mi = 16; ri.xrow0 = (size_t)b * CTXL; ri.is_ctx = true; }
    return ri;
}

__device__ __forceinline__ unsigned ap_off(int g) { return g == 0 ? (unsigned)OFF_AP : (unsigned)OFF_AP1; }
__device__ __forceinline__ unsigned ssa_off(int g) { return (unsigned)OFF_SS + (unsigned)(g * 2) * (unsigned)(R * 4); }
__device__ __forceinline__ unsigned ssb_off(int g) { return (unsigned)OFF_SS + (unsigned)(g * 2 + 1) * (unsigned)(R * 4); }

constexpr int TB2_DELTA = 153600 - 131072;
__device__ __forceinline__ void st_rows16x2(LAS unsigned char* tb, bf16_t* base, size_t ld, int fr, int fq, u32x4 w0, u32x4 w1) {
    const int wo = 64 * fr + 16 * (fq ^ ((fr >> 2) & 3));
    *(LAS u32x4*)(tb + wo) = w0; *(LAS u32x4*)(tb + TB2_DELTA + wo) = w1;
    const int l2 = fq * 16 + fr, r2 = l2 >> 2, q2 = l2 & 3, ro = 64 * r2 + 16 * (q2 ^ ((r2 >> 2) & 3));
    const u32x4 t0 = *(const LAS u32x4*)(tb + ro), t1 = *(const LAS u32x4*)(tb + TB2_DELTA + ro);
    bf16_t* d = base + (size_t)r2 * ld + 8 * q2;
    *(u32x4*)d = t0; *(u32x4*)(d + 128) = t1;
}
__device__ __forceinline__ void st_rows16(LAS unsigned char* tb, bf16_t* base, size_t ld, int fr, int fq, u32x4 w) {
    *(LAS u32x4*)(tb + 64 * fr + 16 * (fq ^ ((fr >> 2) & 3))) = w;
    const int l2 = fq * 16 + fr, r2 = l2 >> 2, q2 = l2 & 3;
    const u32x4 t = *(const LAS u32x4*)(tb + 64 * r2 + 16 * (q2 ^ ((r2 >> 2) & 3)));
    *(u32x4*)(base + (size_t)r2 * ld + 8 * q2) = t;
}
struct EpiWin {
    typedef pg8::NoPre Pre; static constexpr bool ZC = true;
    __device__ __forceinline__ Pre pre(const pg8::Unit&, int, int, int, int) const { return Pre{}; }
    static constexpr bool PERM = true; static constexpr int XST = 16;
    const float* ss; const float* shw; const float* bgate; bf16_t* PM; bf16_t* GT; int g;
    __device__ __forceinline__ void prefetch(const pg8::Unit& u, int wid, int lane, LAS unsigned char* shb) const {
        const int ctile = u.pn * 256;
        if (wid == 0) { const RowInfo ri = row_info(g, u.pm); __builtin_amdgcn_global_load_lds((const unsigned*)(shw + (size_t)ri.mi * NCOLS + ctile + lane * 4), (LAS unsigned*)shb, 16, 0, 0); }
        else if (wid == 1) __builtin_amdgcn_global_load_lds((const unsigned*)(ss + u.pm * 256 + lane * 4), (LAS unsigned*)(shb + 1024), 16, 0, 0);
        else if (wid == 2 && ctile >= PMW) __builtin_amdgcn_global_load_lds((const unsigned*)(bgate + (ctile - PMW) + lane * 4), (LAS unsigned*)(shb + 2048), 16, 0, 0);
    }
    __device__ __forceinline__ bool operator()(f32x4 (&acc)[2][2][4][2], const pg8::Unit& u, int wr, int wc, int fr, int fq, LAS unsigned char* tb, const LAS unsigned char* shb, const Pre&) const {
        const int ctile = u.pn * 256, cb = wc * 32 + 8 * fq;
        const bool gate = ctile >= PMW;
        f32x4 sh[2][2];
#pragma unroll
        for (int bj = 0; bj < 2; ++bj)
#pragma unroll
            for (int n = 0; n < 2; ++n) { sh[bj][n] = *(const LAS f32x4*)(shb + (bj * 128 + cb + 4 * n) * 4);
                if (gate) sh[bj][n] = (sh[bj][n] + *(const LAS f32x4*)(shb + 2048 + (bj * 128 + cb + 4 * n) * 4)) * (-1.44269504089f) - 7.99435343686f; }
        float rsv[8];
#pragma unroll
        for (int q = 0; q < 8; ++q) rsv[q] = __builtin_amdgcn_rsqf(*(const LAS float*)(shb + 1024 + ((q >> 2) * 128 + wr * 64 + (q & 3) * 16 + fr) * 4) * (1.0f / 1024.0f) + EPS);
        if (gate) {
            typedef float f32x2_ __attribute__((ext_vector_type(2)));
            unsigned char* gt = (unsigned char*)GT + (size_t)(u.pm * 16 + ((ctile - PMW) >> 8)) * 16 * 4096 + ((wr * 4 + wc) * 64 + fq * 16 + fr) * 8;
#pragma unroll
            for (int ai = 0; ai < 2; ++ai)
#pragma unroll
                for (int m = 0; m < 4; ++m) {
                    const float rsg = rsv[ai * 4 + m] * (-1.44269504089f);
                    const f32x2_ rg2 = (f32x2_){rsg, rsg};
#pragma unroll
                    for (int bj = 0; bj < 2; ++bj) {
                        u32x2 wq = (u32x2){0u, 0u};
#pragma unroll
                        for (int n = 0; n < 2; ++n) { const f32x4 a_ = acc[ai][bj][m][n], s_ = sh[bj][n];
                            const f32x2_ p0 = __builtin_elementwise_fma((f32x2_){a_[0], a_[1]}, rg2, (f32x2_){s_[0], s_[1]}), p1 = __builtin_elementwise_fma((f32x2_){a_[2], a_[3]}, rg2, (f32x2_){s_[2], s_[3]});
                            const float e_[4] = {p0[0], p0[1], p1[0], p1[1]};
                            unsigned w_ = 0u;
#pragma unroll
                            for (int j = 0; j < 4; ++j) w_ = __builtin_amdgcn_cvt_pk_u8_f32(fast_rcp(__builtin_amdgcn_fmed3f(__builtin_amdgcn_exp2f(e_[j]) + (1.0f / 255.0f), 0.f, 1.f)), j, w_);
                            if (n == 0) wq.x = w_; else wq.y = w_; }
                        *(u32x2*)(gt + ((ai * 4 + m) * 2 + bj) * 4096) = wq;
                    }
                }
            return true;
        }
#pragma unroll
        for (int ai = 0; ai < 2; ++ai)
#pragma unroll
            for (int m = 0; m < 4; ++m) {
                const int r0 = u.pm * 256 + ai * 128 + wr * 64 + m * 16;
                const float rs = rsv[ai * 4 + m];
                u32x4 wp[2];
#pragma unroll
                for (int bj = 0; bj < 2; ++bj) {
                    const f32x4 v0 = acc[ai][bj][m][0] * rs + sh[bj][0], v1 = acc[ai][bj][m][1] * rs + sh[bj][1];
                    wp[bj].x = cvt_pk_bf16(v0[0], v0[1]); wp[bj].y = cvt_pk_bf16(v0[2], v0[3]); wp[bj].z = cvt_pk_bf16(v1[0], v1[1]); wp[bj].w = cvt_pk_bf16(v1[2], v1[3]);
                }
                st_rows16x2(tb, PM + (size_t)r0 * PMW + ctile + wc * 32, PMW, fr, fq, wp[0], wp[1]);
            }
        return true;
    }
};
struct EpiUp {
    typedef pg8::NoPre Pre; static constexpr bool ZC = true;
    __device__ __forceinline__ Pre pre(const pg8::Unit&, int, int, int, int) const { return Pre{}; }
    static constexpr bool PERM = true; static constexpr int XST = 16;
    const float* ss; const float* shw; bf16_t* UP; int g;
    __device__ __forceinline__ void prefetch(const pg8::Unit& u, int wid, int lane, LAS unsigned char* shb) const {
        if (wid == 0) { const RowInfo ri = row_info(g, u.pm); __builtin_amdgcn_global_load_lds((const unsigned*)(shw + (size_t)ri.mi * UPW + u.pn * 256 + lane * 4), (LAS unsigned*)shb, 16, 0, 0); }
        else if (wid == 1) __builtin_amdgcn_global_load_lds((const unsigned*)(ss + u.pm * 256 + lane * 4), (LAS unsigned*)(shb + 1024), 16, 0, 0);
    }
    __device__ __forceinline__ bool operator()(f32x4 (&acc)[2][2][4][2], const pg8::Unit& u, int wr, int wc, int fr, int fq, LAS unsigned char* tb, const LAS unsigned char* shb, const Pre&) const {
        const int ctile = u.pn * 256, cb = wc * 32 + 8 * fq;
        f32x4 sh[2][2];
#pragma unroll
        for (int bj = 0; bj < 2; ++bj)
#pragma unroll
            for (int n = 0; n < 2; ++n) sh[bj][n] = *(const LAS f32x4*)(shb + (bj * 128 + cb + 4 * n) * 4);
        float rsv[8];
#pragma unroll
        for (int q = 0; q < 8; ++q) rsv[q] = __builtin_amdgcn_rsqf(*(const LAS float*)(shb + 1024 + ((q >> 2) * 128 + wr * 64 + (q & 3) * 16 + fr) * 4) * (1.0f / 1024.0f) + EPS);
#pragma unroll
        for (int ai = 0; ai < 2; ++ai)
#pragma unroll
            for (int m = 0; m < 4; ++m) {
                const int r = u.pm * 256 + ai * 128 + wr * 64 + m * 16 + fr;
                const float rs = rsv[ai * 4 + m];
                u32x4 w[2];
#pragma unroll
                for (int bj = 0; bj < 2; ++bj) {
                    const f32x4 v0 = acc[ai][bj][m][0] * rs + sh[bj][0], v1 = acc[ai][bj][m][1] * rs + sh[bj][1];
                    w[bj].x = cvt_pk_bf16(v0[0], v0[1]); w[bj].y = cvt_pk_bf16(v0[2], v0[3]); w[bj].z = cvt_pk_bf16(v1[0], v1[1]); w[bj].w = cvt_pk_bf16(v1[2], v1[3]);
                }
                st_rows16x2(tb, UP + (size_t)(r - fr) * UPW + ctile + wc * 32, UPW, fr, fq, w[0], w[1]);
            }
        return true;
    }
};
struct EpiResid {
    typedef pg8::NoPre Pre; static constexpr bool ZC = true;
    __device__ __forceinline__ Pre pre(const pg8::Unit&, int, int, int, int) const { return Pre{}; }
    static constexpr bool PERM = false; static constexpr int XST = 0;
    const float *xin_lat, *xin_ctx; float *xout_lat, *xout_ctx; const float* ga; const float* Gn; bf16_t* AP; float* ss; int g;
    __device__ __forceinline__ void prefetch(const pg8::Unit& u, int wid, int lane, LAS unsigned char* shb) const {
        if (wid == 0) { const RowInfo ri = row_info(g, u.pm); __builtin_amdgcn_global_load_lds((const unsigned*)(ga + (size_t)ri.mi * 6144 + u.pn * 256 + lane * 4), (LAS unsigned*)shb, 16, 0, 0); }
        else if (wid == 1 && Gn) { const RowInfo ri = row_info(g, u.pm); __builtin_amdgcn_global_load_lds((const unsigned*)(Gn + (size_t)ri.mi * 6144 + u.pn * 256 + lane * 4), (LAS unsigned*)(shb + 1024), 16, 0, 0); }
    }
    __device__ __forceinline__ bool operator()(f32x4 (&acc)[2][2][4][2], const pg8::Unit& u, int wr, int wc, int fr, int fq, LAS unsigned char* tb, const LAS unsigned char* shb, const Pre&) const {
        const RowInfo ri = row_info(g, u.pm);
        const float* xin = ri.is_ctx ? xin_ctx : xin_lat; float* xout = ri.is_ctx ? xout_ctx : xout_lat;
        const int l2 = fq * 16 + fr, r2 = l2 >> 2, q2 = l2 & 3;
        LAS unsigned char* wa = tb + 64 * fr + 16 * (fq ^ ((fr >> 2) & 3));
        const LAS unsigned char* ra = tb + 64 * r2 + 16 * (q2 ^ ((r2 >> 2) & 3));
        const int c0 = u.pn * 256 + wc * 32 + 4 * q2;
        const bool gnp = Gn != nullptr;
        const LAS unsigned char* gl = shb + (wc * 32 + 4 * q2) * 4;
        const size_t xbase = (ri.xrow0 + (size_t)(wr * 64 + r2)) * D + c0;
        const int rbase = u.pm * 256 + wr * 64 + r2;
        f32x4 xc[4], xn_[4];
#pragma unroll
        for (int q = 0; q < 4; ++q) xc[q] = *(const f32x4*)(xin + xbase + (q >> 1) * 128 + (q & 1) * 16);
#pragma unroll
        for (int st = 0; st < 8; ++st) {
            const int ai = st >> 2, m = st & 3;
            if (st < 7) { const int ai2 = (st + 1) >> 2, m2 = (st + 1) & 3; const size_t o2 = xbase + (size_t)(ai2 * 128 + m2 * 16) * D;
#pragma unroll
                for (int q = 0; q < 4; ++q) xn_[q] = *(const f32x4*)(xin + o2 + (q >> 1) * 128 + (q & 1) * 16); }
            asm volatile("" ::: "memory");
            const size_t xo = xbase + (size_t)(ai * 128 + m * 16) * D; const int r = rbase + ai * 128 + m * 16;
            float sq = 0.f;
#pragma unroll
            for (int q = 0; q < 4; ++q) { const int bj = q >> 1, n = q & 1;
                *(LAS f32x4*)wa = acc[ai][bj][m][n];
                const f32x4 at = *(const LAS f32x4*)ra;
                const f32x4 xv = xc[q] + *(const LAS f32x4*)(gl + (bj * 128 + n * 16) * 4) * at;
                *(f32x4*)(xout + xo + bj * 128 + n * 16) = xv;
                sq += (xv[0] * xv[0] + xv[1] * xv[1]) + (xv[2] * xv[2] + xv[3] * xv[3]);
                if (gnp) { const f32x4 a = xv * *(const LAS f32x4*)(gl + 1024 + (bj * 128 + n * 16) * 4); u32x2 w; w.x = cvt_pk_bf16(a[0], a[1]); w.y = cvt_pk_bf16(a[2], a[3]);
                    *(u32x2*)(AP + (size_t)r * D + c0 + bj * 128 + n * 16) = w; } }
            sq += dpp_mov<0xB1>(sq); sq += dpp_mov<0x4E>(sq);
            if (q2 == 0) atomicAdd(ss + r, sq);
            asm volatile("" ::: "memory");
#pragma unroll
            for (int q = 0; q < 4; ++q) xc[q] = xn_[q];
        }
        return true;
    }
};
struct EpiDft {
    typedef pg8::NoPre Pre; static constexpr bool ZC = true;
    __device__ __forceinline__ Pre pre(const pg8::Unit&, int, int, int, int) const { return Pre{}; }
    static constexpr bool PERM = true; static constexpr int XST = 0;
    bf16_t* S; int row_base, rows_per_seq; float scale;
    __device__ __forceinline__ void prefetch(const pg8::Unit&, int, int, LAS unsigned char*) const {}
    __device__ __forceinline__ bool operator()(f32x4 (&acc)[2][2][4][2], const pg8::Unit& u, int wr, int wc, int fr, int fq, LAS unsigned char* tb, const LAS unsigned char*, const Pre&) const {
        const int cb = wc * 32 + 8 * fq;
#pragma unroll
        for (int ai = 0; ai < 2; ++ai)
#pragma unroll
            for (int m = 0; m < 4; ++m) {
                const int r = row_base + u.pn * rows_per_seq + u.pm * 256 + ai * 128 + wr * 64 + m * 16 + fr;
#pragma unroll
                for (int bj = 0; bj < 2; ++bj) {
                    const f32x4 v0 = acc[ai][bj][m][0] * scale, v1 = acc[ai][bj][m][1] * scale;
                    u32x4 w; w.x = cvt_pk_bf16(v0[0], v0[1]); w.y = cvt_pk_bf16(v0[2], v0[3]); w.z = cvt_pk_bf16(v1[0], v1[1]); w.w = cvt_pk_bf16(v1[2], v1[3]);
                    st_rows16(tb, S + (size_t)(r - fr) * D + 768 + bj * 128 + wc * 32, D, fr, fq, w);
                }
            }
        return true;
    }
};
struct EpiMerge {
    static constexpr bool ZC = false;
    static constexpr bool PERM = true; static constexpr int NPQ = 4; static constexpr int XST = 2 * NPQ;
    const unsigned char* GT; bf16_t* MG;
    __device__ __forceinline__ void prefetch(const pg8::Unit&, int, int, LAS unsigned char*) const {}
    struct Pre { u32x2 ti[NPQ], tn[NPQ]; };
    __device__ __forceinline__ Pre pre(const pg8::Unit& u, int wr, int wc, int fr, int fq) const { Pre p_;
        const int i = u.seg, thr = ((wr * 4 + wc) * 64 + fq * 16 + fr) * 8;
        const unsigned char* gi = GT + (size_t)(u.pm * 16 + i * 4 + u.pn) * 16 * 4096 + thr;
        const unsigned char* gn = i < 3 ? gi + (size_t)4 * 16 * 4096 : gi;
#pragma unroll
        for (int q = 0; q < NPQ; ++q) { p_.ti[q] = *(const u32x2*)(gi + q * 4096); p_.tn[q] = *(const u32x2*)(gn + q * 4096); }
        return p_; }
    __device__ __forceinline__ bool operator()(f32x4 (&acc)[2][2][4][2], const pg8::Unit& u, int wr, int wc, int fr, int fq, LAS unsigned char* tb, const LAS unsigned char*, const Pre& p_) const {
        __builtin_amdgcn_s_waitcnt(0x0F78);
        const int cb = u.pn * 256 + wc * 32 + 8 * fq, i = u.seg;
        const int thr = ((wr * 4 + wc) * 64 + fq * 16 + fr) * 8;
        const unsigned char* gi = GT + (size_t)(u.pm * 16 + i * 4 + u.pn) * 16 * 4096 + thr;
        const unsigned char* gn = i < 3 ? gi + (size_t)4 * 16 * 4096 : gi;
        u32x2 ti[16], tn[16];
#pragma unroll
        for (int q = 0; q < 16; ++q) { if (q < NPQ) { ti[q] = p_.ti[q]; tn[q] = p_.tn[q]; } else { ti[q] = *(const u32x2*)(gi + q * 4096); tn[q] = *(const u32x2*)(gn + q * 4096); } }
        const unsigned last = i == 3 ? 0xffffffffu : 0u;
#pragma unroll
        for (int q = 0; q < 16; ++q) { const int ai = q >> 3, m = (q >> 1) & 3, bj = q & 1;
            f32x4 fa, fb;
#pragma unroll
            for (int j = 0; j < 4; ++j) {
                fa[j] = (float)((ti[q].x >> (8 * j)) & 0xffu) * fast_rcp((float)(((tn[q].x | last) >> (8 * j)) & 0xffu));
                fb[j] = (float)((ti[q].y >> (8 * j)) & 0xffu) * fast_rcp((float)(((tn[q].y | last) >> (8 * j)) & 0xffu)); }
            acc[ai][bj][m][0] *= fa; acc[ai][bj][m][1] *= fb;
        }
        if (i < 3) return false;
#pragma unroll
        for (int q = 0; q < 16; ++q) { const int ai = q >> 3, m = (q >> 1) & 3, bj = q & 1;
            const f32x4 v0 = acc[ai][bj][m][0], v1 = acc[ai][bj][m][1];
            const int r0 = u.pm * 256 + ai * 128 + wr * 64 + m * 16;
            u32x4 w; w.x = cvt_pk_bf16(v0[0], v0[1]); w.y = cvt_pk_bf16(v0[2], v0[3]); w.z = cvt_pk_bf16(v1[0], v1[1]); w.w = cvt_pk_bf16(v1[2], v1[3]);
            st_rows16(tb, MG + (size_t)r0 * D + u.pn * 256 + wc * 32 + bj * 128, D, fr, fq, w);
        }
        return true;
    }
};

__device__ __forceinline__ void transpose_item(const float* src, int ld_src, int k0, int n0, bf16_t* dst, int ld_dst, int dst_row0, LAS float* scr, int lane) {
    const int kr = lane >> 3, nq = lane & 7;
    f32x4 v[8];
#pragma unroll
    for (int i = 0; i < 8; ++i) v[i] = *(const f32x4*)(src + (size_t)(k0 + i * 8 + kr) * ld_src + n0 + nq * 4);
#pragma unroll
    for (int i = 0; i < 8; ++i) { LAS float* d_ = scr + (i * 8 + kr) * 33 + nq * 4; d_[0] = v[i][0]; d_[1] = v[i][1]; d_[2] = v[i][2]; d_[3] = v[i][3]; }
    asm volatile("s_waitcnt lgkmcnt(0)" ::: "memory");
    const int c = lane & 7;
#pragma unroll
    for (int j = 0; j < 4; ++j) { const int n = (lane >> 3) + 8 * j; const LAS float* s = scr + (8 * c) * 33 + n;
        u32x4 o; o.x = cvt_pk_bf16(s[0 * 33], s[1 * 33]); o.y = cvt_pk_bf16(s[2 * 33], s[3 * 33]); o.z = cvt_pk_bf16(s[4 * 33], s[5 * 33]); o.w = cvt_pk_bf16(s[6 * 33], s[7 * 33]);
        *(u32x4*)(dst + (size_t)(dst_row0 + n) * ld_dst + k0 + 8 * c) = o; }
    asm volatile("s_waitcnt lgkmcnt(0)" ::: "memory");
}

__device__ __forceinline__ void weight_prep(const KP& p, LAS unsigned char* lds, int l_lo, int l_hi, int b0, int nb) {
    int tid = p.tid_; asm volatile("" : "+v"(tid)); const int wave = tid >> 6, lane = tid & 63, G = nb, bx = p.bx_ - b0;
    unsigned char* ws = p.ws;
    if (bx < 0 || bx >= nb) return;
    {
        LAS float* scr = (LAS float*)(lds + wave * 16384);
        const int gw = bx * NWAVES + wave, NGW = G * NWAVES;
        constexpr int I_IN1 = 16 * 64, I_IN2 = 16 * 128, I_O = 4 * 32, I_OUT = 16 * 32, I_UP = 16 * 176, I_DN = 44 * 32;
        constexpr int PER_L = I_IN1 + I_IN2 + 4 * I_O + I_OUT + I_UP + I_DN;
        for (int it = l_lo * PER_L + gw; it < l_hi * PER_L; it += NGW) {
            const int l = it / PER_L; int r = it % PER_L;
            bf16_t* wl = (bf16_t*)(ws + OFF_W + (size_t)l * W_LAYER);
            if (r < I_IN1) { const int kb = r / 64, nb = r % 64; transpose_item(p.in(I_w_in) + (size_t)l * D * IN_COLS, IN_COLS, kb * 64, nb * 32, wl + W_IN / 2, D, nb * 32, scr, lane); continue; } r -= I_IN1;
            if (r < I_IN2) { const int kb = r / 128, nb = r % 128; transpose_item(p.in(I_w_in) + (size_t)l * D * IN_COLS, IN_COLS, kb * 64, 2304 + nb * 32, wl + W_IN / 2, D, PMW + nb * 32, scr, lane); continue; } r -= I_IN2;
            if (r < 4 * I_O) { const int br = r / I_O, rr = r % I_O, kb = rr / 32, nb = rr % 32;
                const float* src = (br == 0 ? p.in(I_w_ret_o) : br == 1 ? p.in(I_w_conv_o) : br == 2 ? p.in(I_w_gmlp_o) : p.in(I_w_fnet_o)) + (size_t)l * 256 * D;
                transpose_item(src, D, kb * 64, nb * 32, wl + W_O / 2 + (size_t)br * 1024 * 256, 256, nb * 32, scr, lane); continue; } r -= 4 * I_O;
            if (r < I_OUT) { const int kb = r / 32, nb = r % 32; transpose_item(p.in(I_w_out) + (size_t)l * D * D, D, kb * 64, nb * 32, wl + W_OUT / 2, D, nb * 32, scr, lane); continue; } r -= I_OUT;
            if (r < I_UP) { const int kb = r / 176, nb = r % 176; transpose_item(p.in(I_w_ffn_up) + (size_t)l * D * UPW, UPW, kb * 64, nb * 32, wl + W_UP / 2, D, nb * 32, scr, lane); continue; } r -= I_UP;
            { const int kb = r / 32, nb = r % 32; transpose_item(p.in(I_w_ffn_down) + (size_t)l * DFF * D, D, kb * 64, nb * 32, wl + W_DN / 2, DFF, nb * 32, scr, lane); }
        }
        __syncthreads();
    }
    {
        LAS float* tile = (LAS float*)lds;
        LAS float* tab = (LAS float*)(lds + 64 * 65 * 4);
        for (int it = l_lo * 64 + bx; it < l_hi * 64; it += G) {
            const int l = it / 64, gq = (it / 16) % 4, kb = it % 16;
            __syncthreads();
            if (tid < 64) { tab[tid] = cos_rev((float)tid * (1.0f / 64.0f)) * 0.125f; tab[64 + tid] = sin_rev((float)tid * (1.0f / 64.0f)) * 0.125f; }
            for (int i = tid; i < 64 * 64; i += NTHREADS) { const int kk = i / 64, cc = i % 64; tile[kk * 65 + cc] = p.in(I_w_in)[((size_t)l * D + kb * 64 + kk) * IN_COLS + 2048 + gq * 64 + cc]; }
            __syncthreads();
            const int which = tid >> 8, nl = (tid & 255) >> 2, kq = tid & 3;
            float acc[16];
#pragma unroll
            for (int j = 0; j < 16; ++j) acc[j] = 0.f;
            for (int cc = 0; cc < 64; ++cc) { const float coef = tab[which * 64 + ((cc * nl) & 63)];
#pragma unroll
                for (int j = 0; j < 16; ++j) acc[j] += coef * tile[(kq * 16 + j) * 65 + cc]; }
            bf16_t* wl = (bf16_t*)(ws + OFF_W + (size_t)l * W_LAYER + W_IN);
            bf16_t* dst = wl + (size_t)(2048 + which * 256 + gq * 64 + nl) * D + kb * 64 + kq * 16;
            *(u32x4*)dst = pack8(acc); *(u32x4*)(dst + 8) = pack8(acc + 8);
        }
        __syncthreads();
    }
}
__device__ __forceinline__ void phase_prep_a(const KP& p, LAS unsigned char* lds) {
    int tid = p.tid_; asm volatile("" : "+v"(tid)); const int wave = tid >> 6, lane = tid & 63, G = NBLK, bx = p.bx_;
    unsigned char* ws = p.ws;
    {
        LAS float* sl = (LAS float*)lds;
        float* adap = (float*)(ws + OFF_ADAP);
        for (int it = bx; it < 2 * 12 * 8; it += G) {
            const int l = it / 96, nch = (it / 8) % 12, kc = it % 8;
            __syncthreads();
            for (int i = tid; i < 17 * 128; i += NTHREADS) { const int mi = i / 128, k = kc * 128 + (i % 128); const float cv = mi < 16 ? p.in(I_c)[mi * D + k] : p.in(I_c_ctx)[k]; sl[i] = siluf_(cv); }
            __syncthreads();
            const int n = nch * 512 + tid;
            float acc[17];
#pragma unroll
            for (int mi = 0; mi < 17; ++mi) acc[mi] = 0.f;
            const float* wp = p.in(I_w_ada) + ((size_t)l * D + kc * 128) * 6144 + n;
#pragma unroll 1
            for (int k0 = 0; k0 < 128; k0 += 16) { float w[16];
#pragma unroll
                for (int k = 0; k < 16; ++k) w[k] = wp[(size_t)(k0 + k) * 6144];
#pragma unroll
                for (int k = 0; k < 16; ++k)
#pragma unroll
                    for (int mi = 0; mi < 17; ++mi) acc[mi] += sl[mi * 128 + k0 + k] * w[k]; }
#pragma unroll
            for (int mi = 0; mi < 17; ++mi) adap[(((size_t)kc * 2 + l) * 17 + mi) * 6144 + n] = acc[mi];
        }
        __syncthreads();
    }
    weight_prep(p, lds, 0, 1, 0, G);
    {
        const size_t gt = (size_t)bx * NTHREADS + tid, GT_ = (size_t)G * NTHREADS;
        float* rc = (float*)(ws + OFF_ROPE); float* rsn = rc + 2304 * 32;
        for (size_t i = gt; i < (size_t)2304 * 32; i += GT_) { const int pos = (int)(i / 32), fi = (int)(i % 32);
            const float inv = exp2f(-(float)fi * (13.287712379549449f / 32.0f));
            const float ang = (float)pos * inv;
            const double rev = (double)ang * 0.15915494309189535; const float fr_ = (float)(rev - floor(rev));
            rc[i] = cos_rev(fr_); rsn[i] = sin_rev(fr_); }
        bf16_t* dm = (bf16_t*)(ws + OFF_DM);
        for (size_t i = gt; i < (size_t)2048 * 256; i += GT_) { const int n = (int)(i / 256), k8 = (int)(i % 256) * 8; float v[8];
#pragma unroll
            for (int j = 0; j < 8; ++j) { const int kk = k8 + j; if (kk <= 1024) v[j] = cos_rev((float)((n * kk) & 2047) * (1.0f / 2048.0f)); else v[j] = -sin_rev((float)((n * (kk - 1024)) & 2047) * (1.0f / 2048.0f)); }
            *(u32x4*)(dm + (size_t)n * 2048 + k8) = pack8(v); }
        bf16_t* dc = (bf16_t*)(ws + OFF_DC);
        for (size_t i = gt; i < (size_t)256 * 32; i += GT_) { const int n = (int)(i / 32), k8 = (int)(i % 32) * 8; float v[8];
#pragma unroll
            for (int j = 0; j < 8; ++j) { const int kk = k8 + j; if (kk <= 128) v[j] = cos_rev((float)((n * kk) & 255) * (1.0f / 256.0f)); else v[j] = -sin_rev((float)((n * (kk - 128)) & 255) * (1.0f / 256.0f)); }
            *(u32x4*)(dc + (size_t)n * 256 + k8) = pack8(v); }
        if (gt < 16) { const float xx = p.in(I_ret_decay)[gt]; ((float*)(ws + OFF_LOGG))[gt] = (float)(-log1p(exp(-(double)xx))); }
    }
}

__device__ __forceinline__ void phase_prep_b(const KP& p) {
    const size_t gt = (size_t)p.bx_ * NTHREADS + p.tid_, GT_ = (size_t)NBLK * NTHREADS;
    const float* adap = (const float*)(p.ws + OFF_ADAP); float* mod = (float*)(p.ws + OFF_MOD);
    for (size_t i = gt; i < (size_t)2 * 17 * 6144; i += GT_) {
        const int l = (int)(i / (17 * 6144)), n = (int)(i % 6144), j = n / 1024, k = n % 1024;
        float v = p.in(I_b_ada)[l * 6144 + n];
#pragma unroll
        for (int kc = 0; kc < 8; ++kc) v += adap[(size_t)kc * 2 * 17 * 6144 + i];
        if (j == 1) v = p.in(I_g_norm1)[l * D + k] * (1.f + v);
        if (j == 4) v = p.in(I_g_norm2)[l * D + k] * (1.f + v);
        mod[i] = v;
    }
}

__device__ __forceinline__ void phase_prep_c(const KP& p, LAS unsigned char* lds, int l_lo, int l_hi, int b0, int nb) {
    int tid = p.tid_; asm volatile("" : "+v"(tid)); const int wave = tid >> 6, lane = tid & 63, G = nb;
    if (p.bx_ < b0 || p.bx_ >= b0 + nb) return;
    LAS unsigned char* shb = lds;
    const int gw = (p.bx_ - b0) * NWAVES + wave, NGW = G * NWAVES;
    const int c = lane & 15, gq = lane >> 4;
    for (int combo = 2 * l_lo; combo < 2 * l_hi; ++combo) {
        const int l = combo >> 1, which = combo & 1;
        const float* mod = (const float*)(p.ws + OFF_MOD) + (size_t)l * 17 * 6144 + (which ? 3 : 0) * 1024;
        __syncthreads();
        for (int i = tid; i < 32 * 128; i += NTHREADS) { const int row = i >> 7, ch = i & 127; float f[8];
#pragma unroll
            for (int j = 0; j < 8; ++j) f[j] = row < 17 ? mod[(size_t)row * 6144 + ch * 8 + j] : 0.f;
            *(LAS u32x4*)(shb + row * 2048 + ((ch ^ (row & 7)) << 4)) = pack8(f); }
        __syncthreads();
        const int ncol = which ? UPW : NCOLS;
        const bf16_t* W = (const bf16_t*)(p.ws + OFF_W + (size_t)l * W_LAYER + (which ? W_UP : W_IN));
        float* dst = (float*)(p.ws + (which ? OFF_SHW2 : OFF_SHW1)) + (size_t)l * 17 * ncol;
        for (int nb16 = gw; nb16 < ncol / 16; nb16 += NGW) {
            const bf16_t* wrow = W + (size_t)(nb16 * 16 + c) * D + 8 * gq;
            const f32x4 z4 = (f32x4){0.f, 0.f, 0.f, 0.f};
            f32x4 acc0 = z4, acc1 = z4;
#pragma unroll 1
            for (int t0 = 0; t0 < 32; t0 += 8) {
                bf16x8 bfr[8];
#pragma unroll
                for (int q = 0; q < 8; ++q) bfr[q] = *(const bf16x8*)(wrow + 32 * (t0 + q));
#pragma unroll
                for (int q = 0; q < 8; ++q) { const int ch = 4 * (t0 + q) + gq;
                    const bf16x8 a0 = *(const LAS bf16x8*)(shb + c * 2048 + ((ch ^ (c & 7)) << 4)), a1 = *(const LAS bf16x8*)(shb + (16 + c) * 2048 + ((ch ^ (c & 7)) << 4));
                    acc0 = mfma16(a0, bfr[q], acc0); acc1 = mfma16(a1, bfr[q], acc1); }
            }
            const int n = nb16 * 16 + c;
#pragma unroll
            for (int r = 0; r < 4; ++r) dst[(size_t)(4 * gq + r) * ncol + n] = acc0[r];
            if (gq == 0) dst[(size_t)16 * ncol + n] = acc1[0];
        }
    }
    __syncthreads();
}

__device__ __forceinline__ void phase_g0(const KP& p, int g, int b0, int nb) {
    int tid = p.tid_; asm volatile("" : "+v"(tid)); const int wave = tid >> 6, lane = tid & 63;
    if (p.bx_ < b0 || p.bx_ >= b0 + nb) return;
    const int gw = (p.bx_ - b0) * NWAVES + wave, NGW = nb * NWAVES;
    const float* mod = (const float*)(p.ws + OFF_MOD);
    bf16_t* AP = (bf16_t*)(p.ws + ap_off(g)); float* ss = (float*)(p.ws + ssa_off(g));
    const int nrows = g == 0 ? R : R_LAT;
    for (int r0 = gw; r0 < nrows; r0 += 2 * NGW) {
        f32x4 v[2][4], gg[2][4]; int rr[2]; bool ok[2];
#pragma unroll
        for (int h = 0; h < 2; ++h) { rr[h] = r0 + h * NGW; ok[h] = rr[h] < nrows; const int r = ok[h] ? rr[h] : r0;
            const RowInfo ri = row_info(g, r >> 8);
            const float* xr = (ri.is_ctx ? p.in(I_ctx) : p.in(I_x)) + (ri.xrow0 + (size_t)(r & 255)) * D;
            const float* G1 = mod + (size_t)ri.mi * 6144 + 1024;
#pragma unroll
            for (int j = 0; j < 4; ++j) { v[h][j] = *(const f32x4*)(xr + j * 256 + lane * 4); gg[h][j] = *(const f32x4*)(G1 + j * 256 + lane * 4); } }
#pragma unroll
        for (int h = 0; h < 2; ++h) { if (!ok[h]) continue; const int r = rr[h];
            float s_ = 0.f;
#pragma unroll
            for (int j = 0; j < 4; ++j) { const f32x4 x = v[h][j];
                s_ += (x[0] * x[0] + x[1] * x[1]) + (x[2] * x[2] + x[3] * x[3]);
                const f32x4 a = x * gg[h][j]; u32x2 w; w.x = cvt_pk_bf16(a[0], a[1]); w.y = cvt_pk_bf16(a[2], a[3]);
                *(u32x2*)(AP + (size_t)r * D + j * 256 + lane * 4) = w; }
            s_ = wave_sum(s_, lane);
            if (lane == 0) ss[r] = s_; }
    }
}

__device__ __forceinline__ void phase_final(const KP& p, int g, int b0, int nb) {
    int tid = p.tid_; asm volatile("" : "+v"(tid)); const int wave = tid >> 6, lane = tid & 63;
    if (p.bx_ < b0 || p.bx_ >= b0 + nb) return;
    const int gw = (p.bx_ - b0) * NWAVES + wave, NGW = nb * NWAVES;
    const float* ss = (const float*)(p.ws + ssa_off(g));
    const f32x4 gf0 = *(const f32x4*)(p.in(I_g_final) + lane * 4), gf1 = *(const f32x4*)(p.in(I_g_final) + 256 + lane * 4), gf2 = *(const f32x4*)(p.in(I_g_final) + 512 + lane * 4), gf3 = *(const f32x4*)(p.in(I_g_final) + 768 + lane * 4);
    for (int r0 = gw; r0 < R_LAT; r0 += 2 * NGW) {
        f32x4 v[2][4]; float sv[2];
#pragma unroll
        for (int h = 0; h < 2; ++h) { const int r = (r0 + h * NGW < R_LAT) ? r0 + h * NGW : r0; sv[h] = ss[r];
            const float* xr = p.out + ((size_t)g * R_LAT + r) * D;
#pragma unroll
            for (int j = 0; j < 4; ++j) v[h][j] = *(const f32x4*)(xr + j * 256 + lane * 4); }
#pragma unroll
        for (int h = 0; h < 2; ++h) { const int r = r0 + h * NGW; if (r >= R_LAT) continue;
            const float rs = __builtin_amdgcn_rsqf(sv[h] * (1.0f / 1024.0f) + EPS);
            float* xr = p.out + ((size_t)g * R_LAT + r) * D;
            *(f32x4*)(xr + lane * 4) = v[h][0] * rs * gf0; *(f32x4*)(xr + 256 + lane * 4) = v[h][1] * rs * gf1;
            *(f32x4*)(xr + 512 + lane * 4) = v[h][2] * rs * gf2; *(f32x4*)(xr + 768 + lane * 4) = v[h][3] * rs * gf3; }
    }
}

struct ChunkInfo { int row0, pos0, h; };
__device__ __forceinline__ ChunkInfo chunk_info(int item) {
    ChunkInfo ci;
    if (item < N_KV_LAT) { const int gb = item >> 6, ch = item & 15; ci.h = (item >> 4) & 3; ci.row0 = gb * SEQ + ch * 128; ci.pos0 = CTXL + ch * 128; }
    else { const int it2 = item - N_KV_LAT, gb = it2 >> 3, ch = it2 & 1; ci.h = (it2 >> 1) & 3; ci.row0 = R_LAT + gb * CTXL + ch * 128; ci.pos0 = ch * 128; }
    return ci;
}
__device__ __forceinline__ void load_chunk_f32(const int tid, const bf16_t* PM, int row0, int col0, LAS float* dst, int st) {
#pragma unroll
    for (int q = 0; q < 2; ++q) { const int idx = tid + q * NTHREADS, row = idx >> 3, cc = idx & 7; float f[8];
        unpack8(*(const u32x4*)(PM + (size_t)(row0 + row) * PMW + col0 + cc * 8), f);
        *(LAS f32x4*)(dst + row * st + cc * 8) = (f32x4){f[0], f[1], f[2], f[3]}; *(LAS f32x4*)(dst + row * st + cc * 8 + 4) = (f32x4){f[4], f[5], f[6], f[7]}; }
}
__device__ __forceinline__ void rotary_lds(const int tid, LAS float* buf, int st, int pos0, const float* rc, const float* rsn, float scale) {
#pragma unroll
    for (int q = 0; q < 8; ++q) { const int pidx = tid + q * NTHREADS, row = pidx >> 5, i = pidx & 31;
        const float c = rc[(pos0 + row) * 32 + i], s = rsn[(pos0 + row) * 32 + i];
        const float t1 = buf[row * st + i], t2 = buf[row * st + i + 32];
        buf[row * st + i] = (t1 * c - t2 * s) * scale; buf[row * st + i + 32] = (t1 * s + t2 * c) * scale; }
}

__device__ __forceinline__ void ret_kv_item(const KP& p, LAS unsigned char* lds, int l, int item) {
    int tid = p.tid_; asm volatile("" : "+v"(tid));
    const bf16_t* PM = (const bf16_t*)(p.ws + OFF_BIG);
    const float* rc = (const float*)(p.ws + OFF_ROPE); const float* rsn = rc + 2304 * 32;
    const float* logg = (const float*)(p.ws + OFF_LOGG) + l * 8;
    LAS unsigned char* KfT = lds;
    LAS unsigned char* KbT = lds + 16384;
    LAS unsigned char* Vt = lds + 32768;
    const ChunkInfo ci = chunk_info(item);
    __syncthreads();
    {
        const int row = tid >> 2, pc = tid & 3, pos = ci.pos0 + row;
        const bf16_t* src = PM + (size_t)(ci.row0 + row) * PMW + ci.h * 64;
        const float lgf = logg[ci.h], lgb = logg[4 + ci.h];
        const float wf = 0.125f * __expf(lgf * (float)(127 - row)), wb = 0.125f * __expf(lgb * (float)row);
        float cs[8], sn[8], t1[8], t2[8];
        { const f32x4 c0 = *(const f32x4*)(rc + pos * 32 + pc * 8), c1 = *(const f32x4*)(rc + pos * 32 + pc * 8 + 4), s0 = *(const f32x4*)(rsn + pos * 32 + pc * 8), s1 = *(const f32x4*)(rsn + pos * 32 + pc * 8 + 4);
#pragma unroll
          for (int j = 0; j < 4; ++j) { cs[j] = c0[j]; cs[4 + j] = c1[j]; sn[j] = s0[j]; sn[4 + j] = s1[j]; } }
        unpack8(*(const u32x4*)(src + 256 + pc * 8), t1); unpack8(*(const u32x4*)(src + 256 + 32 + pc * 8), t2);
        const int jo = (row & 7) * 2, jc = row >> 3;
#pragma unroll
        for (int j = 0; j < 8; ++j) {
            const float o1 = t1[j] * cs[j] - t2[j] * sn[j], o2 = t1[j] * sn[j] + t2[j] * cs[j];
            const int d1 = pc * 8 + j, d2 = 32 + pc * 8 + j;
            *(LAS unsigned short*)(KfT + d1 * 256 + ((jc ^ (d1 & 15)) << 4) + jo) = f2bf(o1 * wf); *(LAS unsigned short*)(KfT + d2 * 256 + ((jc ^ (d2 & 15)) << 4) + jo) = f2bf(o2 * wf);
            *(LAS unsigned short*)(KbT + d1 * 256 + ((jc ^ (d1 & 15)) << 4) + jo) = f2bf(o1 * wb); *(LAS unsigned short*)(KbT + d2 * 256 + ((jc ^ (d2 & 15)) << 4) + jo) = f2bf(o2 * wb);
        }
        const u32x4 v0 = *(const u32x4*)(src + 512 + pc * 16), v1 = *(const u32x4*)(src + 512 + pc * 16 + 8);
        const unsigned vv[8] = {v0.x, v0.y, v0.z, v0.w, v1.x, v1.y, v1.z, v1.w};
#pragma unroll
        for (int e2 = 0; e2 < 8; ++e2)
#pragma unroll
            for (int hh = 0; hh < 2; ++hh) { const int e = pc * 16 + e2 * 2 + hh; const unsigned short val = (unsigned short)(hh ? (vv[e2] >> 16) : (vv[e2] & 0xffffu));
                *(LAS unsigned short*)(Vt + e * 256 + ((jc ^ (e & 15)) << 4) + jo) = val; }
    }
    __syncthreads();
    const int w = __builtin_amdgcn_readfirstlane(tid >> 6), lane = tid & 63, c = lane & 15, gq = lane >> 4;
    const int dir = w >> 2, db = w & 3, d = 16 * db + c;
    LAS unsigned char* KT = dir ? KbT : KfT;
    const f32x4 z4 = (f32x4){0.f, 0.f, 0.f, 0.f};
    f32x4 acc[4] = {z4, z4, z4, z4};
#pragma unroll
    for (int t = 0; t < 4; ++t) {
        const bf16x8 af = *(const LAS bf16x8*)(KT + d * 256 + (((4 * t + gq) ^ (d & 15)) << 4));
#pragma unroll
        for (int eb = 0; eb < 4; ++eb) { const int e = 16 * eb + c;
            const bf16x8 bfr = *(const LAS bf16x8*)(Vt + e * 256 + (((4 * t + gq) ^ (e & 15)) << 4));
            acc[eb] = mfma16(af, bfr, acc[eb]); }
    }
    float* kv = (item < N_KV_LAT ? (float*)(p.ws + OFF_KV) + (size_t)item * 8192 : (float*)(p.ws + OFF_KVC) + (size_t)(l * N_KV_CTX + item - N_KV_LAT) * 8192) + dir * 4096;
#pragma unroll
    for (int eb = 0; eb < 4; ++eb)
#pragma unroll
        for (int r = 0; r < 4; ++r) kv[(16 * db + 4 * gq + r) * 64 + 16 * eb + c] = acc[eb][r];
}

__device__ __forceinline__ void ret_out_item(const KP& p, LAS unsigned char* lds, int g, int l, int item) {
    int tid = p.tid_; asm volatile("" : "+v"(tid));
    const bf16_t* PM = (const bf16_t*)(p.ws + OFF_BIG);
    const float* rc = (const float*)(p.ws + OFF_ROPE); const float* rsn = rc + 2304 * 32;
    const float* logg = (const float*)(p.ws + OFF_LOGG) + l * 8;
    LAS unsigned char* Qb = lds;
    LAS unsigned char* Kb = lds + 16384;
    LAS unsigned char* Vt = lds + 32768;
    LAS unsigned char* SfT = lds + 49152;
    LAS unsigned char* SbT = lds + 57344;
    LAS float* dtab = (LAS float*)(lds + 65536);
    const ChunkInfo ci = chunk_info(item);
    __syncthreads();
    {
        const int row = tid >> 2, pc = tid & 3, pos = ci.pos0 + row;
        const bf16_t* src = PM + (size_t)(ci.row0 + row) * PMW + ci.h * 64;
        float cs[8], sn[8];
        { const f32x4 c0 = *(const f32x4*)(rc + pos * 32 + pc * 8), c1 = *(const f32x4*)(rc + pos * 32 + pc * 8 + 4), s0 = *(const f32x4*)(rsn + pos * 32 + pc * 8), s1 = *(const f32x4*)(rsn + pos * 32 + pc * 8 + 4);
#pragma unroll
          for (int j = 0; j < 4; ++j) { cs[j] = c0[j]; cs[4 + j] = c1[j]; sn[j] = s0[j]; sn[4 + j] = s1[j]; } }
#pragma unroll
        for (int qk = 0; qk < 2; ++qk) {
            float t1[8], t2[8], o1[8], o2[8];
            unpack8(*(const u32x4*)(src + qk * 256 + pc * 8), t1); unpack8(*(const u32x4*)(src + qk * 256 + 32 + pc * 8), t2);
            const float sc = qk ? 0.125f : 1.0f;
#pragma unroll
            for (int j = 0; j < 8; ++j) { o1[j] = (t1[j] * cs[j] - t2[j] * sn[j]) * sc; o2[j] = (t1[j] * sn[j] + t2[j] * cs[j]) * sc; }
            LAS unsigned char* dst = (qk ? Kb : Qb) + row * 128;
            *(LAS u32x4*)(dst + ((pc ^ (row & 7)) << 4)) = pack8(o1);
            *(LAS u32x4*)(dst + (((4 + pc) ^ (row & 7)) << 4)) = pack8(o2);
        }
        {
            const u32x4 v0 = *(const u32x4*)(src + 512 + pc * 16), v1 = *(const u32x4*)(src + 512 + pc * 16 + 8);
            const unsigned vv[8] = {v0.x, v0.y, v0.z, v0.w, v1.x, v1.y, v1.z, v1.w};
#pragma unroll
            for (int e2 = 0; e2 < 8; ++e2)
#pragma unroll
                for (int hh = 0; hh < 2; ++hh) { const int e = pc * 16 + e2 * 2 + hh; const unsigned short val = (unsigned short)(hh ? (vv[e2] >> 16) : (vv[e2] & 0xffffu));
                    *(LAS unsigned short*)(Vt + e * 256 + ((((row >> 2) ^ (2 * (e & 15))) << 3)) + (row & 3) * 2) = val; }
        }
        {
            const int d = tid >> 3, e0 = (tid & 7) * 8;
            const float* KV = (const float*)(p.ws + OFF_KV) + d * 64 + e0;
            const float* KVC = (const float*)(p.ws + OFF_KVC) + (size_t)l * N_KV_CTX * 8192 + d * 64 + e0;
            const f32x4 z = (f32x4){0.f, 0.f, 0.f, 0.f};
            f32x4 fa = z, fb = z, ba = z, bb = z;
            if (item < N_KV_LAT) {
                const int ch = item & 15, lat0 = item - ch, c0 = (g * GB + (item >> 6)) * 8 + ci.h * 2;
                const float l128f = logg[ci.h] * 128.f, l128b = logg[4 + ci.h] * 128.f;
#pragma unroll 1
                for (int t0 = 0; t0 < 20; t0 += 10) {
                    f32x4 xa[10], xb[10]; float wt[10]; bool isf[10];
#pragma unroll
                    for (int q = 0; q < 10; ++q) { const int t = t0 + q; const bool fw = t < ch + 2; isf[q] = fw;
                        const int k = fw ? t - 2 : t - (ch + 2) - 2;
                        const float* x; if (fw) x = k < 0 ? KVC + (size_t)(c0 + k + 2) * 8192 : KV + (size_t)(lat0 + k) * 8192;
                        else x = (k < 0 ? KVC + (size_t)(c0 - 1 - k) * 8192 : KV + (size_t)(lat0 + 15 - k) * 8192) + 4096;
                        const bool valid = t < 19; if (!valid) x = KVC;
                        wt[q] = valid ? (fw ? __expf(l128f * (float)(ch - 1 - k)) : __expf(l128b * (float)(14 - ch - k))) : 0.f;
                        xa[q] = *(const f32x4*)x; xb[q] = *(const f32x4*)(x + 4); }
#pragma unroll
                    for (int q = 0; q < 10; ++q) { if (isf[q]) { fa += xa[q] * wt[q]; fb += xb[q] * wt[q]; } else { ba += xa[q] * wt[q]; bb += xb[q] * wt[q]; } }
                }
            } else {
                const int it2 = item - N_KV_LAT, ch = it2 & 1, c0 = it2 - ch;
                if (ch == 1) { const float* x = KVC + (size_t)c0 * 8192; fa = *(const f32x4*)x; fb = *(const f32x4*)(x + 4); }
                else { const float* x = KVC + (size_t)(c0 + 1) * 8192 + 4096; ba = *(const f32x4*)x; bb = *(const f32x4*)(x + 4); }
            }
#pragma unroll
            for (int dir = 0; dir < 2; ++dir) { const f32x4 a = dir ? ba : fa, b = dir ? bb : fb;
                LAS unsigned char* dstT = dir ? SbT : SfT; const float vals[8] = {a[0], a[1], a[2], a[3], b[0], b[1], b[2], b[3]};
#pragma unroll
                for (int jj = 0; jj < 8; ++jj) { const int e = e0 + jj; *(LAS unsigned short*)(dstT + e * 128 + (((d >> 3) ^ (e & 7)) << 4) + (d & 7) * 2) = f2bf(vals[jj]); } }
        }
        const float lgf = logg[ci.h], lgb = logg[4 + ci.h];
        if (tid <= 256) { const int t = tid - 128; dtab[tid] = t > 0 ? __expf(lgf * (float)t) : (t < 0 ? __expf(lgb * (float)(-t)) : 2.0f); }
    }
    __syncthreads();
    const int w = __builtin_amdgcn_readfirstlane(tid >> 6), lane = tid & 63, c = lane & 15, gq = lane >> 4;
    const int il = 16 * w + c;
    f32x4 g4v[4]; u32x2 grv[4];
    { const float* gn_ = p.in(I_ret_gn) + l * 256 + ci.h * 64; const bf16_t* gsrc_ = PM + (size_t)(ci.row0 + il) * PMW + 768 + ci.h * 64;
#pragma unroll
      for (int eb = 0; eb < 4; ++eb) { g4v[eb] = *(const f32x4*)(gn_ + 16 * eb + 4 * gq); grv[eb] = *(const u32x2*)(gsrc_ + 16 * eb + 4 * gq); } }
    bf16x8 qf[2];
#pragma unroll
    for (int ks = 0; ks < 2; ++ks) qf[ks] = *(const LAS bf16x8*)(Qb + il * 128 + (((4 * ks + gq) ^ (il & 7)) << 4));
    const f32x4 z4 = (f32x4){0.f, 0.f, 0.f, 0.f};
    f32x4 st[8];
#pragma unroll
    for (int jb = 0; jb < 8; ++jb) { const int j = 16 * jb + c;
        const bf16x8 k0 = *(const LAS bf16x8*)(Kb + j * 128 + (((0 + gq) ^ (j & 7)) << 4)), k1 = *(const LAS bf16x8*)(Kb + j * 128 + (((4 + gq) ^ (j & 7)) << 4));
        st[jb] = mfma16(k0, qf[0], z4); st[jb] = mfma16(k1, qf[1], st[jb]); }
#pragma unroll
    for (int jb = 0; jb < 8; ++jb)
#pragma unroll
        for (int r = 0; r < 4; ++r) st[jb][r] *= dtab[128 + il - (16 * jb + 4 * gq + r)];
    f32x4 oT[4], cf[4], cb[4];
#pragma unroll
    for (int eb = 0; eb < 4; ++eb) { oT[eb] = z4; cf[eb] = z4; cb[eb] = z4; }
#pragma unroll
    for (int t = 0; t < 4; ++t) {
        union { u32x4 u; bf16x8 v; } pk;
        pk.u.x = cvt_pk_bf16(st[2 * t][0], st[2 * t][1]); pk.u.y = cvt_pk_bf16(st[2 * t][2], st[2 * t][3]);
        pk.u.z = cvt_pk_bf16(st[2 * t + 1][0], st[2 * t + 1][1]); pk.u.w = cvt_pk_bf16(st[2 * t + 1][2], st[2 * t + 1][3]);
#pragma unroll
        for (int eb = 0; eb < 4; ++eb) { const int e = 16 * eb + c;
            union { u32x4 u; bf16x8 v; } va;
            const u32x2 lo = *(const LAS u32x2*)(Vt + e * 256 + (((8 * t + gq) ^ (2 * (e & 15))) << 3)), hi = *(const LAS u32x2*)(Vt + e * 256 + (((8 * t + 4 + gq) ^ (2 * (e & 15))) << 3));
            va.u.x = lo.x; va.u.y = lo.y; va.u.z = hi.x; va.u.w = hi.y;
            oT[eb] = mfma16(va.v, pk.v, oT[eb]); }
    }
#pragma unroll
    for (int eb = 0; eb < 4; ++eb) { const int e = 16 * eb + c;
#pragma unroll
        for (int ks = 0; ks < 2; ++ks) {
            const bf16x8 af = *(const LAS bf16x8*)(SfT + e * 128 + (((4 * ks + gq) ^ (e & 7)) << 4)), ab = *(const LAS bf16x8*)(SbT + e * 128 + (((4 * ks + gq) ^ (e & 7)) << 4));
            cf[eb] = mfma16(af, qf[ks], cf[eb]); cb[eb] = mfma16(ab, qf[ks], cb[eb]); } }
    const float wqf = dtab[128 + il + 1], wqb = dtab[il];
    float o[16]; float sm = 0.f;
#pragma unroll
    for (int eb = 0; eb < 4; ++eb)
#pragma unroll
        for (int r = 0; r < 4; ++r) { o[eb * 4 + r] = oT[eb][r] + wqf * cf[eb][r] + wqb * cb[eb][r]; sm += o[eb * 4 + r]; }
    sm += shx(sm, 16, lane); sm += shx(sm, 32, lane);
    const float mean = sm * (1.0f / 64.0f);
    float vq = 0.f;
#pragma unroll
    for (int e = 0; e < 16; ++e) { o[e] -= mean; vq += o[e] * o[e]; }
    vq += shx(vq, 16, lane); vq += shx(vq, 32, lane);
    const float rstd = __builtin_amdgcn_rsqf(vq * (1.0f / 64.0f) + EPS);
    bf16_t* S = (bf16_t*)(p.ws + OFF_S) + (size_t)(ci.row0 + il) * D + ci.h * 64;
#pragma unroll
    for (int eb = 0; eb < 4; ++eb) { const int e0 = 16 * eb + 4 * gq;
        const f32x4 g4 = g4v[eb]; const u32x2 gr = grv[eb];
        const float g0 = bf2f(gr.x & 0xffffu), g1 = __uint_as_float(gr.x & 0xffff0000u), g2 = bf2f(gr.y & 0xffffu), g3 = __uint_as_float(gr.y & 0xffff0000u);
        u32x2 wv; wv.x = cvt_pk_bf16(o[eb * 4 + 0] * rstd * g4[0] * siluf_(g0), o[eb * 4 + 1] * rstd * g4[1] * siluf_(g1));
        wv.y = cvt_pk_bf16(o[eb * 4 + 2] * rstd * g4[2] * siluf_(g2), o[eb * 4 + 3] * rstd * g4[3] * siluf_(g3));
        *(u32x2*)(S + e0) = wv; }
}

__device__ __forceinline__ void conf_item(const KP& p, LAS unsigned char* lds, int l, int item) {
    int tid = p.tid_; asm volatile("" : "+v"(tid)); const int wave = tid >> 6, lane = tid & 63;
    const bf16_t* PM = (const bf16_t*)(p.ws + OFF_BIG);
    LAS float* hbuf = (LAS float*)lds;
    LAS float* ybuf = (LAS float*)(lds + 65536);
    int seqrow0, L, n0;
    if (item < R_LAT / 32) { seqrow0 = (item >> 6) * SEQ; L = SEQ; n0 = (item & 63) * 32; }
    else { const int it2 = item - R_LAT / 32; seqrow0 = R_LAT + (it2 >> 3) * CTXL; L = CTXL; n0 = (it2 & 7) * 32; }
    __syncthreads();
    {
        u32x4 a1[4], a2[4]; bool ok[4];
#pragma unroll
        for (int q = 0; q < 4; ++q) { const int idx = tid + q * NTHREADS, hr = idx >> 5, cc = idx & 31, tok = n0 - 15 + hr;
            ok[q] = idx < 62 * 32 && tok >= 0 && tok < L;
            const bf16_t* src = PM + (size_t)(seqrow0 + (ok[q] ? tok : n0)) * PMW + 1024 + cc * 8;
            a1[q] = *(const u32x4*)src; a2[q] = *(const u32x4*)(src + 256); }
#pragma unroll
        for (int q = 0; q < 4; ++q) { const int idx = tid + q * NTHREADS, hr = idx >> 5, cc = idx & 31;
            if (idx < 62 * 32) { float x1[8], x2[8], hv[8]; unpack8(a1[q], x1); unpack8(a2[q], x2);
#pragma unroll
                for (int j = 0; j < 8; ++j) hv[j] = ok[q] ? x1[j] * sigmoidf_(x2[j]) : 0.f;
                *(LAS f32x4*)(hbuf + hr * 256 + cc * 8) = (f32x4){hv[0], hv[1], hv[2], hv[3]}; *(LAS f32x4*)(hbuf + hr * 256 + cc * 8 + 4) = (f32x4){hv[4], hv[5], hv[6], hv[7]}; } }
    }
    __syncthreads();
    { const int c = tid & 255, q = tid >> 8;
      float w[31], xw[46];
#pragma unroll
      for (int j = 0; j < 31; ++j) w[j] = p.in(I_conv_dw)[((size_t)l * 31 + j) * 256 + c];
      const float bias = p.in(I_conv_db)[l * 256 + c];
#pragma unroll
      for (int j = 0; j < 46; ++j) xw[j] = hbuf[(q * 16 + j) * 256 + c];
#pragma unroll
      for (int tt = 0; tt < 16; ++tt) { float y = bias;
#pragma unroll
          for (int j = 0; j < 31; ++j) y += w[j] * xw[tt + j];
          ybuf[(q * 16 + tt) * 256 + c] = y; } }
    __syncthreads();
    { const f32x4 lg = *(const f32x4*)(p.in(I_conv_ln_g) + l * 256 + lane * 4), lb = *(const f32x4*)(p.in(I_conv_ln_b) + l * 256 + lane * 4);
      bf16_t* S = (bf16_t*)(p.ws + OFF_S);
#pragma unroll
      for (int t4 = 0; t4 < 4; ++t4) { const int tt = wave * 4 + t4;
          f32x4 v = *(const LAS f32x4*)(ybuf + tt * 256 + lane * 4);
          const float mean = wave_sum((v[0] + v[1]) + (v[2] + v[3]), lane) * (1.0f / 256.0f);
          v = v - mean;
          const float var = wave_sum((v[0] * v[0] + v[1] * v[1]) + (v[2] * v[2] + v[3] * v[3]), lane) * (1.0f / 256.0f);
          const float rstd = __builtin_amdgcn_rsqf(var + EPS);
          f32x4 y = v * rstd * lg + lb;
#pragma unroll
          for (int j = 0; j < 4; ++j) y[j] = siluf_(y[j]);
          u32x2 w2; w2.x = cvt_pk_bf16(y[0], y[1]); w2.y = cvt_pk_bf16(y[2], y[3]);
          *(u32x2*)(S + (size_t)(seqrow0 + n0 + tt) * D + 256 + lane * 4) = w2; } }
}

__device__ __forceinline__ void gmlp_item(const KP& p, LAS unsigned char* lds, int l, int item) {
    int tid = p.tid_; asm volatile("" : "+v"(tid)); const int wave = __builtin_amdgcn_readfirstlane(tid >> 6), lane = tid & 63;
    const bf16_t* PM = (const bf16_t*)(p.ws + OFF_BIG);
    LAS unsigned char* vT = lds;
    const int row0 = item * 128;
    __syncthreads();
    { const f32x4 lg = *(const f32x4*)(p.in(I_gmlp_ln_g) + l * 256 + lane * 4), lb = *(const f32x4*)(p.in(I_gmlp_ln_b) + l * 256 + lane * 4);
      u32x2 zz[16];
#pragma unroll
      for (int t16 = 0; t16 < 16; ++t16) zz[t16] = *(const u32x2*)(PM + (size_t)(row0 + wave * 16 + t16) * PMW + 1792 + lane * 4);
#pragma unroll
      for (int t16 = 0; t16 < 16; ++t16) { const int tt = wave * 16 + t16;
          f32x4 v = (f32x4){geluf_(bf2f(zz[t16].x & 0xffffu)), geluf_(__uint_as_float(zz[t16].x & 0xffff0000u)), geluf_(bf2f(zz[t16].y & 0xffffu)), geluf_(__uint_as_float(zz[t16].y & 0xffff0000u))};
          const float mean = wave_sum((v[0] + v[1]) + (v[2] + v[3]), lane) * (1.0f / 256.0f);
          v = v - mean;
          const float var = wave_sum((v[0] * v[0] + v[1] * v[1]) + (v[2] * v[2] + v[3] * v[3]), lane) * (1.0f / 256.0f);
          const float rstd = __builtin_amdgcn_rsqf(var + EPS);
          v = v * rstd * lg + lb;
          const int jc = tt >> 3, jo = (tt & 7) * 2;
#pragma unroll
          for (int q = 0; q < 4; ++q) { const int cc = lane * 4 + q; *(LAS unsigned short*)(vT + cc * 256 + ((jc ^ (cc & 15)) << 4) + jo) = f2bf(v[q]); } } }
    __syncthreads();
    const int c = lane & 15, gq = lane >> 4, gw = wave & 3, ih = wave >> 2;
    const float* wsr = p.in(I_gmlp_ws) + (((size_t)l * 4 + gw) * 128 + ih * 64) * 128 + (size_t)c * 128 + 8 * gq;
    const f32x4 z4 = (f32x4){0.f, 0.f, 0.f, 0.f};
    f32x4 acc[4][4];
#pragma unroll
    for (int ib = 0; ib < 4; ++ib)
#pragma unroll
        for (int cb = 0; cb < 4; ++cb) acc[ib][cb] = z4;
    f32x4 wa[4][2], wb[4][2];
#pragma unroll
    for (int ib = 0; ib < 4; ++ib) { wa[ib][0] = *(const f32x4*)(wsr + ib * 16 * 128); wa[ib][1] = *(const f32x4*)(wsr + ib * 16 * 128 + 4); }
#pragma unroll
    for (int t = 0; t < 4; ++t) {
        if (t < 3) {
#pragma unroll
            for (int ib = 0; ib < 4; ++ib) { wb[ib][0] = *(const f32x4*)(wsr + ib * 16 * 128 + 32 * (t + 1)); wb[ib][1] = *(const f32x4*)(wsr + ib * 16 * 128 + 32 * (t + 1) + 4); } }
        bf16x8 bfr[4];
#pragma unroll
        for (int cb = 0; cb < 4; ++cb) { const int cc = 64 * gw + 16 * cb + c; bfr[cb] = *(const LAS bf16x8*)(vT + cc * 256 + (((4 * t + gq) ^ (cc & 15)) << 4)); }
#pragma unroll
        for (int ib = 0; ib < 4; ++ib) {
            union { u32x4 u; bf16x8 v; } af;
            af.u.x = cvt_pk_bf16(wa[ib][0][0], wa[ib][0][1]); af.u.y = cvt_pk_bf16(wa[ib][0][2], wa[ib][0][3]); af.u.z = cvt_pk_bf16(wa[ib][1][0], wa[ib][1][1]); af.u.w = cvt_pk_bf16(wa[ib][1][2], wa[ib][1][3]);
#pragma unroll
            for (int cb = 0; cb < 4; ++cb) acc[ib][cb] = mfma16(af.v, bfr[cb], acc[ib][cb]);
        }
#pragma unroll
        for (int ib = 0; ib < 4; ++ib) { wa[ib][0] = wb[ib][0]; wa[ib][1] = wb[ib][1]; }
    }
    const float* bs = p.in(I_gmlp_bs) + ((size_t)l * 4 + gw) * 128 + ih * 64;
    bf16_t* S = (bf16_t*)(p.ws + OFF_S);
#pragma unroll
    for (int ib = 0; ib < 4; ++ib) {
        unsigned short uu[4][4]; float bsv[4];
#pragma unroll
        for (int r = 0; r < 4; ++r) { const int il = 16 * ib + 4 * gq + r; bsv[r] = bs[il];
#pragma unroll
            for (int cb = 0; cb < 4; ++cb) uu[r][cb] = PM[(size_t)(row0 + ih * 64 + il) * PMW + 1536 + 64 * gw + 16 * cb + c]; }
#pragma unroll
        for (int r = 0; r < 4; ++r) { const int i = ih * 64 + 16 * ib + 4 * gq + r;
#pragma unroll
            for (int cb = 0; cb < 4; ++cb) S[(size_t)(row0 + i) * D + 512 + 64 * gw + 16 * cb + c] = f2bf(geluf_(bf2f(uu[r][cb])) * (acc[ib][cb][r] + bsv[r])); }
    }
}

__device__ __forceinline__ void fnet_t_item(const KP& p, LAS unsigned char* lds, int item) {
    int tid = p.tid_; asm volatile("" : "+v"(tid));
    const bf16_t* PM = (const bf16_t*)(p.ws + OFF_BIG);
    LAS float* T = (LAS float*)lds;
    int seqrow0, L, s_local, cblk, kb; bf16_t* dstbase;
    if (item < GB * 4 * 16) { s_local = item >> 6; cblk = (item >> 4) & 3; kb = item & 15; L = SEQ; seqrow0 = s_local * SEQ; dstbase = (bf16_t*)(p.ws + OFF_PQT); }
    else { const int it2 = item - GB * 4 * 16; s_local = it2 >> 3; cblk = (it2 >> 1) & 3; kb = it2 & 1; L = CTXL; seqrow0 = R_LAT + s_local * CTXL; dstbase = (bf16_t*)(p.ws + OFF_PQTC); }
    __syncthreads();
    for (int idx = tid; idx < 4 * 64 * 8; idx += NTHREADS) { const int which = idx >> 9, r = (idx >> 3) & 63, cc = idx & 7, k = kb * 64 + r;
        const int tok = (which & 1) ? (L - k) : k; const int col = (which < 2 ? 2048 : 2304) + cblk * 64 + cc * 8; float f[8];
        if (tok < L) unpack8(*(const u32x4*)(PM + (size_t)(seqrow0 + tok) * PMW + col), f);
        else {
#pragma unroll
            for (int j = 0; j < 8; ++j) f[j] = 0.f; }
#pragma unroll
        for (int j = 0; j < 8; ++j) T[(which * 64 + r) * 65 + cc * 8 + j] = f[j]; }
    __syncthreads();
    const int c = tid >> 3, kq = tid & 7;
    float pe[8], qo[8];
#pragma unroll
    for (int e = 0; e < 8; ++e) { const int kl = kq * 8 + e; pe[e] = T[(0 * 64 + kl) * 65 + c] + T[(1 * 64 + kl) * 65 + c]; qo[e] = T[(2 * 64 + kl) * 65 + c] - T[(3 * 64 + kl) * 65 + c]; }
    if (kb == 0 && kq == 0) qo[0] = bf2f(PM[(size_t)(seqrow0 + L / 2) * PMW + 2048 + cblk * 64 + c]);
    bf16_t* dst = dstbase + (size_t)(s_local * 256 + cblk * 64 + c) * L;
    *(u32x4*)(dst + kb * 64 + kq * 8) = pack8(pe);
    *(u32x4*)(dst + L / 2 + kb * 64 + kq * 8) = pack8(qo);
}

__device__ __forceinline__ u32x4 ld8p(const bf16_t* p, bool ok) { return ok ? *(const u32x4*)p : (u32x4){0u, 0u, 0u, 0u}; }
__device__ __forceinline__ void fma8(float* y, const u32x4 a, const float* w) { float f[8]; unpack8(a, f);
#pragma unroll
    for (int j = 0; j < 8; ++j) y[j] += f[j] * w[j]; }
__device__ __forceinline__ void phase_ffn_conv(const KP& p, int g, int l, int parts, int b0, int nb, int halves) {
    int tid = p.tid_; asm volatile("" : "+v"(tid));
    if (parts & 1) { float* ssA = (float*)(p.ws + ssa_off(g)); for (int i = p.bx_ * NTHREADS + tid; i < R; i += NBLK * NTHREADS) ssA[i] = 0.f; }
    if (tid >= 352 || p.bx_ < b0 || p.bx_ >= b0 + nb) return;
    bf16_t* UP = (bf16_t*)(p.ws + OFF_BIG);
    const int c8 = tid * 8, G = nb, bx = p.bx_ - b0;
    const float* dw = p.in(I_ffn_dw) + (size_t)l * 9 * DFF + c8; const float* db = p.in(I_ffn_db) + (size_t)l * DFF + c8;
    float w[9][8], bias[8];
#pragma unroll
    for (int k = 0; k < 9; ++k) { const f32x4 w0 = *(const f32x4*)(dw + k * DFF), w1 = *(const f32x4*)(dw + k * DFF + 4);
#pragma unroll
        for (int j = 0; j < 4; ++j) { w[k][j] = w0[j]; w[k][4 + j] = w1[j]; } }
    { const f32x4 b0 = *(const f32x4*)db, b1 = *(const f32x4*)(db + 4);
#pragma unroll
      for (int j = 0; j < 4; ++j) { bias[j] = b0[j]; bias[4 + j] = b1[j]; } }
    if (parts & 2)
    for (int it0 = bx; it0 < GB * 32 * halves; it0 += G) {
        const int rid0 = it0 / halves, hf = it0 - rid0 * halves;
        const int rid = (G == 256 && halves == 1) ? ((rid0 & 7) * 32 + (rid0 >> 3)) : rid0;
        const int gb = rid >> 5, gr = rid & 31;
        const int c_lo = hf * (64 / halves), c_hi = c_lo + 64 / halves;
        const bool up = gr > 0, dn = gr < 31;
        const bf16_t* a1 = UP + (size_t)(gb * SEQ + gr * 64 + c_lo) * UPW + c8;
        const bf16_t* a0 = a1 - (size_t)64 * UPW; const bf16_t* a2 = a1 + (size_t)64 * UPW;
        const bool lf = c_lo > 0;
        u32x4 L0 = ld8p(a0 - UPW, up && lf), L1 = ld8p(a1 - UPW, lf), L2 = ld8p(a2 - UPW, dn && lf), M0 = ld8p(a0, up), M1 = ld8p(a1, true), M2 = ld8p(a2, dn);
        u32x4 R0 = ld8p(a0 + UPW, up), R1 = ld8p(a1 + UPW, true), R2 = ld8p(a2 + UPW, dn);
        bf16_t* hp = UP + (size_t)(gb * SEQ + gr * 64 + c_lo) * UPW + DFF + c8;
        u32x4 bq = *(const u32x4*)hp;
#pragma unroll 1
        for (int gc = c_lo; gc < c_hi; ++gc) {
            const bool nt2 = gc < 62; const size_t o = (size_t)(gc - c_lo + 2) * UPW;
            const u32x4 N0 = ld8p(a0 + o, up && nt2), N1 = ld8p(a1 + o, nt2), N2 = ld8p(a2 + o, dn && nt2);
            const u32x4 bn = ld8p(hp + UPW, gc < 63);
            float y[8];
#pragma unroll
            for (int j = 0; j < 8; ++j) y[j] = bias[j];
            fma8(y, L0, w[0]); fma8(y, M0, w[1]); fma8(y, R0, w[2]);
            fma8(y, L1, w[3]); fma8(y, M1, w[4]); fma8(y, R1, w[5]);
            fma8(y, L2, w[6]); fma8(y, M2, w[7]); fma8(y, R2, w[8]);
            float bv[8]; unpack8(bq, bv);
#pragma unroll
            for (int j = 0; j < 8; ++j) y[j] = siluf_(y[j]) * bv[j];
            *(u32x4*)hp = pack8(y);
            L0 = M0; L1 = M1; L2 = M2; M0 = R0; M1 = R1; M2 = R2; R0 = N0; R1 = N1; R2 = N2; bq = bn; hp += UPW;
        }
    }
    if (parts & 4) {
        for (int it = bx; it < R_CTX / 8; it += G) {
            const int s_ = it >> 5, t0 = (it & 31) * 8;
            const bf16_t* a = UP + (size_t)(R_LAT + s_ * CTXL + t0) * UPW + c8;
            u32x4 Lq = ld8p(a - UPW, t0 > 0), Mq = ld8p(a, true);
#pragma unroll 1
            for (int t = 0; t < 8; ++t) {
                const u32x4 Rq = ld8p(a + (size_t)(t + 1) * UPW, t0 + t + 1 < CTXL);
                bf16_t* hp = UP + (size_t)(R_LAT + s_ * CTXL + t0 + t) * UPW + DFF + c8;
                const u32x4 bq = *(const u32x4*)hp;
                float y[8];
#pragma unroll
                for (int j = 0; j < 8; ++j) y[j] = bias[j];
                fma8(y, Lq, w[3]); fma8(y, Mq, w[4]); fma8(y, Rq, w[5]);
                float bv[8]; unpack8(bq, bv);
#pragma unroll
                for (int j = 0; j < 8; ++j) y[j] = siluf_(y[j]) * bv[j];
                *(u32x4*)hp = pack8(y);
                Lq = Mq; Mq = Rq;
            }
        }
    }
}

#ifndef DUP_LP
#define DUP_LP 0
#endif

__device__ __forceinline__ unsigned wl_off(int l) { return (unsigned)OFF_W + (unsigned)l * (unsigned)W_LAYER; }
__device__ __forceinline__ unsigned mod_off(int l) { return (unsigned)OFF_MOD + (unsigned)l * (unsigned)(17 * 6144 * 4); }

__device__ __forceinline__ void ph_l1(const KP& p, LAS unsigned char* lds, int g, int l) {
    unsigned char* ws = p.ws; const bool ctx_full = (g == 0 && l == 0);
    pg8::TileSched S{}; S.G = NBLK; S.c = p.bx_; S.nseg = 1;
    S.n1M = NLT; S.n1N = NCOLS / 256; S.n2M = g == 0 ? NCT : 0; S.n2N = ctx_full ? NCOLS / 256 : 2; S.pn2_0 = ctx_full ? 0 : 1;
    S.A = ap_off(g); S.B = (unsigned)(wl_off(l) + (unsigned)W_IN); S.a_tstep = (unsigned)256 * D * 2; S.b_tstep = (unsigned)256 * D * 2;
    EpiWin E{(const float*)(ws + ssa_off(g)), (const float*)(ws + (unsigned)OFF_SHW1 + (unsigned)l * (unsigned)(17 * NCOLS * 4)), p.in(I_b_gate) + (size_t)l * GTW, (bf16_t*)(ws + OFF_BIG), (bf16_t*)(ws + OFF_GT), g};
    pg8::gemm_phase(lds, p.ws, p.tid_, D, D, D, true, S, E);
}
__device__ __forceinline__ void ph_l2(const KP& p, LAS unsigned char* lds, int g, int l) {
    const bool ctx_full = (g == 0 && l == 0); const int G = NBLK;
    const int n_kv = g == 0 ? N_KV : N_KV_LAT, n_conf = (ctx_full ? R : R_LAT) / 32, n_gm = (ctx_full ? R : R_LAT) / 128, n_fn = GB * 4 * 16 + (ctx_full ? NB * 4 * 2 : 0);
    const int total = n_kv + n_conf + n_gm + n_fn;
    { float* ssB = (float*)(p.ws + ssb_off(g)); for (int i = p.bx_ * NTHREADS + p.tid_; i < R; i += G * NTHREADS) ssB[i] = 0.f; }
    const int bx = p.bx_, n_small = total - n_gm, nb2 = G - n_gm, head = (nb2 > 0 && 7 * nb2 < n_small) ? 7 * nb2 : 0;
#define L2_SMALL(t_) do { int t = (t_); if (t < n_kv) ret_kv_item(p, lds, l, t); else if ((t -= n_kv) < n_fn) fnet_t_item(p, lds, t); else conf_item(p, lds, l, t - n_fn); } while (0)
    if (bx < n_gm) gmlp_item(p, lds, l, bx);
    else if (head) { for (int r7 = 0; r7 < 7; ++r7) L2_SMALL(r7 * nb2 + (bx - n_gm)); }
    for (int t2 = head + bx; t2 < n_small; t2 += G) L2_SMALL(t2);
#undef L2_SMALL
    __syncthreads();
}
__device__ __forceinline__ void ph_l3(const KP& p, LAS unsigned char* lds, int g, int l) {
    unsigned char* ws = p.ws; const bool ctx_full = (g == 0 && l == 0); const int G = NBLK, bx = p.bx_;
    const int nd = 64 + (ctx_full ? NB : 0);
    if (bx < nd) {
        const bool isc = bx >= 64;
        const int Kd = isc ? CTXL : SEQ;
        pg8::TileSched S{}; S.G = G; S.nseg = 1;
        S.n1M = isc ? 1 : 8; S.n1N = isc ? NB : GB; S.c = isc ? bx - 64 : bx;
        S.A = (unsigned)((isc ? OFF_DC : OFF_DM)); S.B = (unsigned)((isc ? OFF_PQTC : OFF_PQT)); S.a_tstep = (unsigned)256 * Kd * 2; S.b_tstep = (unsigned)256 * Kd * 2;
        EpiDft E{(bf16_t*)(ws + OFF_S), isc ? R_LAT : 0, Kd, isc ? 0.0625f : 0.02209708691207961f};
        pg8::gemm_phase(lds, p.ws, p.tid_, Kd, Kd, Kd, true, S, E);
    } else {
        const int n = ctx_full ? N_KV : N_KV_LAT;
        for (int it = bx - nd; it < n; it += G - nd) ret_out_item(p, lds, g, l, it);
        __syncthreads();
    }
}
__device__ __forceinline__ void ph_l5(const KP& p, LAS unsigned char* lds, int g, int l) {
    unsigned char* ws = p.ws; const bool ctx_full = (g == 0 && l == 0);
    pg8::TileSched S{}; S.G = NBLK; S.c = p.bx_; S.nseg = 4;
    S.n1M = NLT; S.n1N = 4; S.n2M = ctx_full ? NCT : 0; S.n2N = 4;
    S.A = (unsigned)(OFF_S); S.B = (unsigned)(wl_off(l) + (unsigned)W_O); S.a_tstep = (unsigned)256 * D * 2; S.b_tstep = (unsigned)256 * 256 * 2; S.a_segstep = (unsigned)256 * 2; S.b_segstep = (unsigned)1024 * 256 * 2;
    EpiMerge E{(const unsigned char*)(ws + OFF_GT), (bf16_t*)(ws + OFF_BIG)};
    pg8::gemm_phase(lds, p.ws, p.tid_, 256, D, 256, true, S, E);
}
__device__ __forceinline__ void ph_l6(const KP& p, LAS unsigned char* lds, int g, int l) {
    unsigned char* ws = p.ws; const bool ctx_full = (g == 0 && l == 0);
    pg8::TileSched S{}; S.G = NBLK; S.c = p.bx_; S.nseg = 1;
    S.n1M = NLT; S.n1N = 4; S.n2M = ctx_full ? NCT : 0; S.n2N = 4;
    S.A = (unsigned)(OFF_BIG); S.B = (unsigned)(wl_off(l) + (unsigned)W_OUT); S.a_tstep = (unsigned)256 * D * 2; S.b_tstep = (unsigned)256 * D * 2;
    EpiResid E{l == 0 ? p.in(I_x) : (const float*)p.out, l == 0 ? p.in(I_ctx) : (const float*)(ws + OFF_XC), p.out, (float*)(ws + OFF_XC),
               (const float*)(ws + mod_off(l) + 2 * 4096), (const float*)(ws + mod_off(l) + 4 * 4096), (bf16_t*)(ws + ap_off(g)), (float*)(ws + ssb_off(g)), g};
    pg8::gemm_phase(lds, p.ws, p.tid_, D, D, D, false, S, E);
}
__device__ __forceinline__ void ph_l7(const KP& p, LAS unsigned char* lds, int g, int l) {
    unsigned char* ws = p.ws; const bool ctx_full = (g == 0 && l == 0);
    pg8::TileSched S{}; S.G = NBLK; S.c = p.bx_; S.nseg = 1;
    S.n1M = NLT; S.n1N = UPW / 256; S.n2M = ctx_full ? NCT : 0; S.n2N = UPW / 256;
    S.A = ap_off(g); S.B = (unsigned)(wl_off(l) + (unsigned)W_UP); S.a_tstep = (unsigned)256 * D * 2; S.b_tstep = (unsigned)256 * D * 2;
    EpiUp E{(const float*)(ws + ssb_off(g)), (const float*)(ws + (unsigned)OFF_SHW2 + (unsigned)l * (unsigned)(17 * UPW * 4)), (bf16_t*)(ws + OFF_BIG), g};
    pg8::gemm_phase(lds, p.ws, p.tid_, D, D, D, true, S, E);
}
__device__ __forceinline__ void ph_l9(const KP& p, LAS unsigned char* lds, int g, int l, int which = 0) {
    unsigned char* ws = p.ws; const bool ctx_full = (g == 0 && l == 0);
    pg8::TileSched S{}; S.G = NBLK; S.c = p.bx_; S.nseg = 1;
    S.n1M = which == 2 ? 0 : NLT; S.n1N = 4; S.n2M = (ctx_full && which != 1) ? NCT : 0; S.n2N = 4;
    if (which == 2) S.pm2_x = NLT;
    S.A = (unsigned)OFF_BIG + (unsigned)DFF * 2u; S.B = (unsigned)(wl_off(l) + (unsigned)W_DN); S.a_tstep = (unsigned)256 * UPW * 2; S.b_tstep = (unsigned)256 * DFF * 2;
    EpiResid E{p.out, (const float*)(ws + OFF_XC), p.out, (float*)(ws + OFF_XC), (const float*)(ws + mod_off(l) + 5 * 4096),
               l == 0 ? (const float*)(ws + mod_off(1) + 4096) : nullptr, (bf16_t*)(ws + ap_off(g)), (float*)(ws + ssa_off(g)), g};
    pg8::gemm_phase(lds, p.ws, p.tid_, DFF, UPW, DFF, false, S, E);
}

__global__ void __launch_bounds__(NTHREADS) mega(KArgs a) {
    extern __shared__ __attribute__((aligned(16))) unsigned char lds_raw[];
    LAS unsigned char* lds = (LAS unsigned char*)lds_raw;
    volatile LAS unsigned* misc = (volatile LAS unsigned*)(lds + MISC_OFF);
    if (threadIdx.x < 64) misc[threadIdx.x] = 0u;
    if (threadIdx.x < 30) { const unsigned long long v = (unsigned long long)a.in[threadIdx.x]; LAS unsigned* t = (LAS unsigned*)(lds + PTAB_OFF) + 2 * threadIdx.x; t[0] = (unsigned)v; t[1] = (unsigned)(v >> 32); }
    __syncthreads();
    const int wid_s = __builtin_amdgcn_readfirstlane((int)(threadIdx.x >> 6));
    cg::grid_group grid = cg::this_grid();
    XcdBarrier xb = xcd_barrier_post((unsigned*)(a.ws + OFF_BAR), misc + 8);
    grid.sync();
#define MK_Q() KP q; { int w_ = wid_s, b_ = blockIdx.x; unsigned z_ = 0u; asm volatile("" : "+s"(w_), "+s"(b_), "+s"(z_)); int t_ = (w_ << 6) | (int)__builtin_amdgcn_mbcnt_hi(~0u, __builtin_amdgcn_mbcnt_lo(~0u, z_)); asm volatile("" : "+v"(t_)); q.tid_ = t_; q.bx_ = b_; q.ws = a.ws + z_; q.out = a.out + z_; q.ldsb = lds; q.ptab = lds + PTAB_OFF + z_; }
#define PHASE(call) do { MK_Q(); call; xcd_barrier(xb); } while (0)
    PHASE(phase_prep_a(q, lds));
    PHASE(phase_prep_b(q));
    PHASE(phase_prep_c(q, lds, 0, 1, 0, NBLK); phase_g0(q, 0, 0, NBLK));
    for (int g = 0; g < NG; ++g) {
        for (int l = 0; l < 2; ++l) {
            { MK_Q(); ph_l1(q, lds, g, l); }
            PHASE(if (g == 0 && l == 0) weight_prep(q, lds, 1, 2, 32, NBLK - 32);
                  if (g == 1 && l == 0) phase_final(q, 0, 128, NBLK - 128));
            if (DUP_LP == 1) PHASE(ph_l1(q, lds, g, l));
            PHASE(ph_l2(q, lds, g, l));
            if (DUP_LP == 2) PHASE(ph_l2(q, lds, g, l));
            PHASE(ph_l3(q, lds, g, l));
            if (DUP_LP == 3) PHASE(ph_l3(q, lds, g, l));
            PHASE(ph_l5(q, lds, g, l); if (g == 0 && l == 0) phase_prep_c(q, lds, 1, 2, 64, NBLK - 64));
            if (DUP_LP == 5) PHASE(ph_l5(q, lds, g, l));
            PHASE(ph_l6(q, lds, g, l); if (g == 0 && l == 0) phase_g0(q, 1, 64, NBLK - 64));
            PHASE(ph_l7(q, lds, g, l));
            if (DUP_LP == 7) PHASE(ph_l7(q, lds, g, l));
            if (g == 0 && l == 0) {
                PHASE(phase_ffn_conv(q, g, l, 1 | 4, 0, NBLK, 1));
                PHASE(ph_l9(q, lds, g, l, 2); phase_ffn_conv(q, g, l, 2, 64, NBLK - 64, 4));
                PHASE(ph_l9(q, lds, g, l, 1));
            } else {
                PHASE(phase_ffn_conv(q, g, l, 1 | 2, 0, NBLK, 1));
                PHASE(ph_l9(q, lds, g, l));
            }
        }
        if (g == NG - 1) { MK_Q(); phase_final(q, g, 0, NBLK); }
    }
#undef PHASE
#undef MK_Q
}

extern "C" void kernel_launch(void* const* d_in, const int* in_sizes, int n_in, void* d_out, int out_size, void* d_ws, size_t ws_size, hipStream_t stream) {
    static int grid = 0;
    if (grid == 0) {
        int dev = 0, cus = 0, per_cu = 0;
        (void)hipGetDevice(&dev);
        (void)hipDeviceGetAttribute(&cus, hipDeviceAttributeMultiprocessorCount, dev);
        (void)hipFuncSetAttribute((const void*)mega, hipFuncAttributeMaxDynamicSharedMemorySize, LDS_BYTES);
        (void)hipOccupancyMaxActiveBlocksPerMultiprocessor(&per_cu, (const void*)mega, NTHREADS, LDS_BYTES);
        grid = NBLK;
        if (n_in != 30 || ws_size < WS_END || per_cu < 1 || cus * per_cu < NBLK) { fprintf(stderr, "kernel_launch: unexpected n_in %d / ws %zu (need %zu) / per_cu %d\n", n_in, ws_size, (size_t)WS_END, per_cu); }
    }
    (void)hipMemsetAsync(d_ws, 0, 16384, stream);
    KArgs a{};
    for (int i = 0; i < 30; ++i) a.in[i] = (const float*)d_in[i];
    a.out = (float*)d_out; a.ws = (unsigned char*)d_ws;
    void* args[] = {&a};
    hipError_t e = hipLaunchCooperativeKernel((const void*)mega, dim3(grid), dim3(NTHREADS), args, LDS_BYTES, stream);
    if (e != hipSuccess) fprintf(stderr, "cooperative launch failed: %s (grid %d)\n", hipGetErrorString(e), grid);
}
```

```cpp
#include <hip/hip_runtime.h>
#include <hip/hip_cooperative_groups.h>
#include <cstdio>
#include <cstdint>
namespace cg = cooperative_groups;

#define LAS __attribute__((address_space(3)))
typedef unsigned short bf16_t;
typedef short bf16x8 __attribute__((ext_vector_type(8)));
typedef float f32x4 __attribute__((ext_vector_type(4)));
typedef float f32x2 __attribute__((ext_vector_type(2)));
typedef unsigned u32x4 __attribute__((ext_vector_type(4)));
typedef unsigned u32x2 __attribute__((ext_vector_type(2)));

#ifndef ONE_LAUNCH
#define ONE_LAUNCH 1
#endif

constexpr int NTHREADS = 512, NWAVES = 8;
constexpr int NBLK = 256;
constexpr int D = 1024, NB = 16, SEQ = 2048, CTXL = 256, DFF = 2816;
constexpr int NCOLS = 6656;
constexpr int PMW = 2560, GTW = 4096, UPW = 5632;
constexpr int IN_COLS = 6400;
constexpr float EPS = 1e-6f;
constexpr int NG = 2, GB = 8;
constexpr int R_LAT = GB * SEQ, R_CTX = NB * CTXL, R = R_LAT + R_CTX;
constexpr int NLT = R_LAT / 256, NCT = R_CTX / 256;
constexpr int N_KV_LAT = GB * 4 * 16, N_KV_CTX = NB * 4 * 2, N_KV = N_KV_LAT + N_KV_CTX;

constexpr size_t al256(size_t x) { return (x + 255) & ~(size_t)255; }
constexpr size_t OFF_BAR = 0;
constexpr size_t OFF_ADAP = 65536;
constexpr size_t OFF_MOD = OFF_ADAP + al256((size_t)8 * 2 * 17 * 6144 * 4);
constexpr size_t OFF_SHW1 = OFF_MOD + al256((size_t)2 * 17 * 6144 * 4);
constexpr size_t OFF_SHW2 = OFF_SHW1 + al256((size_t)2 * 17 * NCOLS * 4);
constexpr size_t OFF_ROPE = OFF_SHW2 + al256((size_t)2 * 17 * UPW * 4);
constexpr size_t OFF_LOGG = OFF_ROPE + al256((size_t)2 * 2304 * 32 * 4);
constexpr size_t OFF_DM = OFF_LOGG + 256;
constexpr size_t OFF_DC = OFF_DM + (size_t)2048 * 2048 * 2;
constexpr size_t OFF_W = OFF_DC + (size_t)256 * 256 * 2;
constexpr size_t W_IN = 0, W_O = W_IN + (size_t)NCOLS * 1024 * 2, W_OUT = W_O + (size_t)4 * 1024 * 256 * 2, W_UP = W_OUT + (size_t)1024 * 1024 * 2,
                 W_DN = W_UP + (size_t)UPW * 1024 * 2, W_LAYER = W_DN + (size_t)1024 * DFF * 2;
constexpr size_t OFF_XC = OFF_W + 2 * W_LAYER;
constexpr size_t OFF_AP = OFF_XC + (size_t)NB * CTXL * D * 4;
constexpr size_t OFF_AP1 = OFF_AP + (size_t)R * D * 2;
constexpr size_t OFF_SS = OFF_AP1 + (size_t)R_LAT * D * 2;
constexpr size_t OFF_S = OFF_SS + (size_t)R * 16 * 4;
constexpr size_t OFF_KV = OFF_S + (size_t)R * D * 2;
constexpr size_t OFF_KVC = OFF_KV + (size_t)N_KV_LAT * 2 * 4096 * 4;
constexpr size_t OFF_PQT = OFF_KVC + (size_t)2 * N_KV_CTX * 2 * 4096 * 4;
constexpr size_t OFF_PQTC = OFF_PQT + (size_t)GB * 256 * 2048 * 2;
constexpr size_t OFF_BIG = OFF_PQTC + (size_t)NB * 256 * 256 * 2;
constexpr size_t OFF_GT = OFF_BIG + (size_t)R * PMW * 2;
constexpr size_t WS_END = OFF_BIG + ((size_t)R * PMW * 2 + (size_t)R * GTW > (size_t)R * UPW * 2 ? (size_t)R * PMW * 2 + (size_t)R * GTW : (size_t)R * UPW * 2);
static_assert(WS_END <= (size_t)512 * 1024 * 1024, "workspace map exceeds 512 MiB");
static_assert((size_t)R * UPW * 2 <= WS_END - OFF_BIG, "UP overlay");

constexpr int SCR_BYTES = 139264;
constexpr int MISC_OFF = SCR_BYTES;
constexpr int LDS_BYTES = 161792;

__device__ __forceinline__ float bf2f(unsigned v) { return __uint_as_float(v << 16); }
__device__ __forceinline__ unsigned cvt_pk_bf16(float lo, float hi) { unsigned r; asm volatile("v_cvt_pk_bf16_f32 %0, %1, %2" : "=v"(r) : "v"(lo), "v"(hi)); return r; }
__device__ __forceinline__ bf16_t f2bf(float f) { return (bf16_t)(cvt_pk_bf16(f, 0.f) & 0xffffu); }
__device__ __forceinline__ void unpack8(const u32x4 w, float* f) {
    f[0] = bf2f(w.x & 0xffffu); f[1] = __uint_as_float(w.x & 0xffff0000u); f[2] = bf2f(w.y & 0xffffu); f[3] = __uint_as_float(w.y & 0xffff0000u);
    f[4] = bf2f(w.z & 0xffffu); f[5] = __uint_as_float(w.z & 0xffff0000u); f[6] = bf2f(w.w & 0xffffu); f[7] = __uint_as_float(w.w & 0xffff0000u);
}
__device__ __forceinline__ u32x4 pack8(const float* f) { u32x4 w; w.x = cvt_pk_bf16(f[0], f[1]); w.y = cvt_pk_bf16(f[2], f[3]); w.z = cvt_pk_bf16(f[4], f[5]); w.w = cvt_pk_bf16(f[6], f[7]); return w; }
__device__ __forceinline__ float shx(float v, int m, int lane) { return __int_as_float(__builtin_amdgcn_ds_bpermute((lane ^ m) << 2, __float_as_int(v))); }
template <int CTRL> __device__ __forceinline__ float dpp_mov(float v) { return __int_as_float(__builtin_amdgcn_update_dpp(0, __float_as_int(v), CTRL, 0xF, 0xF, false)); }
__device__ __forceinline__ float wave_sum(float v, int  ) {
    v += dpp_mov<0xB1>(v); v += dpp_mov<0x4E>(v); v += dpp_mov<0x141>(v); v += dpp_mov<0x140>(v);
    const int vi = __float_as_int(v);
    const float s0 = __int_as_float(__builtin_amdgcn_readlane(vi, 0)), s1 = __int_as_float(__builtin_amdgcn_readlane(vi, 16)), s2 = __int_as_float(__builtin_amdgcn_readlane(vi, 32)), s3 = __int_as_float(__builtin_amdgcn_readlane(vi, 48));
    return (s0 + s1) + (s2 + s3);
}
__device__ __forceinline__ float fast_rcp(float x) { return __builtin_amdgcn_rcpf(x); }
__device__ __forceinline__ float sigmoidf_(float x) { return fast_rcp(1.f + __expf(-x)); }
__device__ __forceinline__ float siluf_(float x) { return x * sigmoidf_(x); }
__device__ __forceinline__ float geluf_(float v) {
    const float av = fabsf(v), d = av * 0.2316418882f + 1.0f;
    const float t = fast_rcp(d);
    float q = t * 0.5307027145f + (-0.7265760135f); q = q * t + 0.7107068705f; q = q * t + (-0.142248368f); q = q * t + 0.127414796f; q = q * t;
    const float e = __builtin_amdgcn_exp2f((v * v) * (-0.72134752044f));
    const float m = v * (q * e);
    return v < 0.f ? m : v - m;
}
__device__ __forceinline__ f32x4 mfma16(bf16x8 a, bf16x8 b, f32x4 c) { return __builtin_amdgcn_mfma_f32_16x16x32_bf16(a, b, c, 0, 0, 0); }
__device__ __forceinline__ float sin_rev(float r) { return __builtin_amdgcn_sinf(r); }
__device__ __forceinline__ float cos_rev(float r) { return __builtin_amdgcn_cosf(r); }

#define XB_TMO      128
#define XB_XCNT(j)  (256  + 64 * (j))
#define XB_XSUB(j)  (1280 + 64 * (j))
#define XB_XGEN(j)  (2304 + 64 * (j))
#define XB_TOP      3328
#define XB_TOPGEN   3392
#define XCD_BAR_WORDS 3456
#define XB_SPIN_CAP (1u << 20)
__device__ __forceinline__ unsigned xb_ld(unsigned* p)              { return __hip_atomic_load(p, __ATOMIC_RELAXED, __HIP_MEMORY_SCOPE_AGENT); }
__device__ __forceinline__ unsigned xb_add(unsigned* p, unsigned v) { return __hip_atomic_fetch_add(p, v, __ATOMIC_RELAXED, __HIP_MEMORY_SCOPE_AGENT); }
__device__ __forceinline__ unsigned xb_xcc_id() { return (unsigned)__builtin_amdgcn_s_getreg((3 << 11) | 20) & 0xFu; }
#define XB_SPIN(cond, bar) do { unsigned _sp = 0; while (cond) { __builtin_amdgcn_s_sleep(1); \
    if ((++_sp & 255u) == 0u) { if (xb_ld(&(bar)[XB_TMO])) break; if (_sp > XB_SPIN_CAP) { atomicAdd(&(bar)[XB_TMO], 1u); break; } } } } while (0)
struct XcdBarrier { unsigned* bar; unsigned x; volatile LAS unsigned* st; };
__device__ __forceinline__ XcdBarrier xcd_barrier_post(unsigned* bar, volatile LAS unsigned* st) {
    XcdBarrier b; b.bar = bar; b.x = xb_xcc_id(); b.st = st;
    if (threadIdx.x == 0) (void)xb_add(&bar[XB_XCNT(b.x)], 1u);
    return b;
}
__device__ __forceinline__ void xcd_barrier_complete(unsigned* bar, unsigned x, unsigned& nloc, unsigned& nx) {
    const unsigned G = NBLK;
    unsigned sum, cnt, mine, sp = 0u;
    for (;;) {
        sum = 0u; cnt = 0u; mine = 0u;
#pragma unroll
        for (unsigned j = 0; j < 16; ++j) { const unsigned c = xb_ld(&bar[XB_XCNT(j)]); sum += c; cnt += (c > 0u) ? 1u : 0u; mine = (j == x) ? c : mine; }
        if (sum == G) break;
        __builtin_amdgcn_s_sleep(1);
        if ((++sp & 255u) == 0u) { if (xb_ld(&bar[XB_TMO])) break; if (sp > XB_SPIN_CAP) { atomicAdd(&bar[XB_TMO], 1u); break; } }
    }
    nloc = mine > 0u ? mine : 1u; nx = cnt > 0u ? cnt : 1u;
}
__device__ __forceinline__ void xcd_barrier(const XcdBarrier& b) {
    asm volatile("s_waitcnt vmcnt(0)" ::: "memory");
    __syncthreads();
    if (threadIdx.x == 0) {
        unsigned* bar = b.bar; unsigned bx_ = b.x; asm volatile("" : "+s"(bx_));
        __builtin_amdgcn_s_waitcnt(0);
        unsigned nloc = b.st[0], nx = b.st[1];
        if (nloc == 0u) { xcd_barrier_complete(bar, bx_, nloc, nx); b.st[0] = nloc; b.st[1] = nx; }
        const unsigned old = xb_add(&bar[XB_XSUB(bx_)], 1u);
        const unsigned gen = old / nloc;
        if (old + 1u == (gen + 1u) * nloc) {
            __builtin_amdgcn_fence(__ATOMIC_RELEASE, "agent");
            asm volatile("s_waitcnt vmcnt(0)" ::: "memory");
            const unsigned og = xb_add(&bar[XB_TOP], 1u);
            const unsigned tg = og / nx;
            if (og + 1u == (tg + 1u) * nx) xb_add(&bar[XB_TOPGEN], 1u);
            else XB_SPIN(xb_ld(&bar[XB_TOPGEN]) == tg, bar);
            __builtin_amdgcn_fence(__ATOMIC_ACQUIRE, "agent");
            xb_add(&bar[XB_XGEN(bx_)], 1u);
            asm volatile("s_waitcnt vmcnt(0)" ::: "memory");
        } else {
            XB_SPIN(xb_ld(&bar[XB_XGEN(bx_)]) == gen, bar);
            __builtin_amdgcn_fence(__ATOMIC_ACQUIRE, "agent");
            asm volatile("s_waitcnt vmcnt(0)" ::: "memory");
        }
    }
    __syncthreads();
}

namespace pg8 {
constexpr int BM = 256, BK = 64, HALF = 128, HTB = HALF * BK * 2, NXCD = 8, WGM = 8;
__host__ __device__ __forceinline__ int lds_byte(int r, int c) { const int st = (r >> 4) * 2 + (c >> 5), rr = r & 15, cc = c & 31, ob = rr * 64 + cc * 2; return st * 1024 + (ob ^ (((ob >> 9) & 1) << 5)); }
__host__ __device__ __forceinline__ void stage_rc(int b, int& R_, int& C_) { const int st = b / 1024, sb = b % 1024, swz = sb ^ (((sb >> 9) & 1) << 5); R_ = (st >> 1) * 16 + swz / 64; C_ = (st & 1) * 32 + (swz % 64) / 2; }
__host__ __device__ __forceinline__ int perm32(int rho) { const int n = rho >> 4, i = rho & 15; return 8 * (i >> 2) + 4 * n + (i & 3); }

struct Unit { int pm, pn, seg; unsigned A, B; };
__device__ __forceinline__ const char* sgpr_ptr(const char* p) {
    const unsigned long long v = (unsigned long long)p;
    const unsigned lo = (unsigned)__builtin_amdgcn_readfirstlane((int)(unsigned)v), hi = (unsigned)__builtin_amdgcn_readfirstlane((int)(unsigned)(v >> 32));
    typedef const char __attribute__((address_space(1)))* gp_t;
    return (const char*)(gp_t)(((unsigned long long)hi << 32) | (unsigned long long)lo);
}

__device__ __forceinline__ void tile_order(int L, int nM, int nN, int& pm, int& pn) {
    const int nwg = nM * nN; int wgid = L;
    { const int q = nwg / NXCD, r = nwg % NXCD, xcd = wgid % NXCD, off = wgid / NXCD; wgid = (xcd < r ? xcd * (q + 1) : r * (q + 1) + (xcd - r) * q) + off; }
    const int nig = WGM * nN, gid = wgid / nig, fm = gid * WGM, gsz = (nM - fm) < WGM ? (nM - fm) : WGM;
    pm = fm + ((wgid % nig) % gsz); pn = (wgid % nig) / gsz;
}
struct TileSched {
    int n1M, n1N, n2M, n2N, pn2_0, pm2_x, G, c, nseg;
    unsigned A, B, a_tstep, b_tstep, a_segstep, b_segstep;
    __device__ __forceinline__ bool next(int i, Unit& u) const {
        const int ti = i / nseg, seg = i - ti * nseg;
        const int L = ti * G + c, n1 = n1M * n1N, n2 = n2M * n2N;
        int pm, pn;
        if (L < n1) tile_order(L, n1M, n1N, pm, pn);
        else if (L < n1 + n2) { tile_order(L - n1, n2M, n2N, pm, pn); pm += n1M + pm2_x; pn += pn2_0; }
        else return false;
        pm = __builtin_amdgcn_readfirstlane(pm); pn = __builtin_amdgcn_readfirstlane(pn);
        u.pm = pm; u.pn = pn; u.seg = seg;
        u.A = A + (unsigned)pm * a_tstep + (unsigned)seg * a_segstep; u.B = B + (unsigned)pn * b_tstep + (unsigned)seg * b_segstep;
        return true;
    }
};

struct NoPre {};
constexpr int TB_OFF = 131072;
constexpr int SHB_OFF = 147456;
template <class Epi, class Sched>
__device__ __forceinline__ void gemm_phase(LAS unsigned char* lds, const unsigned char* wsb, const int tid_in, const int K, const int lda, const int ldb, const bool perm, const Sched& S, const Epi& E) {
    __builtin_amdgcn_s_waitcnt(0x0F70);
    int tid = tid_in; asm volatile("" : "+v"(tid));
    const int wid = __builtin_amdgcn_readfirstlane(tid >> 6), lane = tid & 63, wr = wid >> 2, wc = wid & 3, fr = lane & 15, fq = lane >> 4;
    const int nt = K / BK;
    unsigned voffA[2], voffB[2];
#pragma unroll
    for (int i = 0; i < 2; ++i) { int R_, C_; stage_rc(tid * 16 + i * 8192, R_, C_); const int Rb = perm ? ((R_ & ~31) + perm32(R_ & 31)) : R_;
        voffA[i] = (unsigned)(R_ * lda + C_) * 2u; voffB[i] = (unsigned)(Rb * ldb + C_) * 2u; }
    const unsigned kstep = (unsigned)(BK * 2);
    const unsigned hA = (unsigned)HALF * lda * 2, hB = (unsigned)HALF * ldb * 2;
    const unsigned ldsw = (unsigned)wid * 1024u;
    const int aoff = lds_byte(wr * 64 + fr, fq * 8), boff = lds_byte(wc * 32 + fr, fq * 8);
#define PG8_SA(b, h) (((b) * 2 + (h)) * HTB)
#define PG8_SB(b, h) ((4 + (b) * 2 + (h)) * HTB)
#define PG8_STAGE(bufoff, goff, voff) do { _Pragma("unroll") for (int _i = 0; _i < 2; ++_i) \
        __builtin_amdgcn_global_load_lds((const unsigned*)(wsb + (unsigned)((goff) + (voff)[_i])), (LAS unsigned*)(lds + (bufoff) + ldsw + _i * 8192), 16, 0, 0); } while (0)
#define PG8_LDA(dst, b, h) do { _Pragma("unroll") for (int m = 0; m < 4; ++m) _Pragma("unroll") for (int k = 0; k < 2; ++k) dst[m][k] = *(const LAS bf16x8*)(lds + PG8_SA(b, h) + aoff + m * 2048 + k * 1024); } while (0)
#define PG8_LDB(dst, b, h) do { _Pragma("unroll") for (int n = 0; n < 2; ++n) _Pragma("unroll") for (int k = 0; k < 2; ++k) dst[n][k] = *(const LAS bf16x8*)(lds + PG8_SB(b, h) + boff + n * 2048 + k * 1024); } while (0)
#define PG8_MMA(ai, bj, At, Bt) do { __builtin_amdgcn_s_setprio(1); _Pragma("unroll") for (int m = 0; m < 4; ++m) _Pragma("unroll") for (int n = 0; n < 2; ++n) _Pragma("unroll") for (int k = 0; k < 2; ++k) \
        acc[ai][bj][m][n] = __builtin_amdgcn_mfma_f32_16x16x32_bf16(Bt[n][k], At[m][k], acc[ai][bj][m][n], 0, 0, 0); __builtin_amdgcn_s_setprio(0); } while (0)
#define PG8_MMA0(ai, bj, At, Bt) do { __builtin_amdgcn_s_setprio(1); _Pragma("unroll") for (int m = 0; m < 4; ++m) _Pragma("unroll") for (int n = 0; n < 2; ++n) { \
        acc[ai][bj][m][n] = __builtin_amdgcn_mfma_f32_16x16x32_bf16(Bt[n][0], At[m][0], (f32x4){0.f, 0.f, 0.f, 0.f}, 0, 0, 0); \
        acc[ai][bj][m][n] = __builtin_amdgcn_mfma_f32_16x16x32_bf16(Bt[n][1], At[m][1], acc[ai][bj][m][n], 0, 0, 0); } __builtin_amdgcn_s_setprio(0); } while (0)
#define PG8_WAIT_V(n) asm volatile("s_waitcnt vmcnt(" #n ")" ::: "memory")
#define PG8_WAIT_VN(n) asm volatile("s_waitcnt vmcnt(%0)" :: "n"(n) : "memory")
#define PG8_WAIT_L(n) asm volatile("s_waitcnt lgkmcnt(" #n ")" ::: "memory")
#define PG8_BAR __builtin_amdgcn_s_barrier()
#define PG8_SCHED __builtin_amdgcn_sched_barrier(0)
#define PG8_ZERO() do { _Pragma("unroll") for (int a = 0; a < 2; ++a) _Pragma("unroll") for (int b = 0; b < 2; ++b) _Pragma("unroll") for (int m = 0; m < 4; ++m) _Pragma("unroll") for (int n = 0; n < 2; ++n) acc[a][b][m][n] = (f32x4){0.f, 0.f, 0.f, 0.f}; } while (0)
    Unit cur, nxt; int ui = 0;
    if (!S.next(0, cur)) return;
    f32x4 acc[2][2][4][2];
    if (!Epi::ZC) PG8_ZERO();
    bf16x8 At[4][2], B0[2][2], B1[2][2];
    unsigned cA = cur.A, cB = cur.B;
    E.prefetch(cur, wid, lane, lds + SHB_OFF);
    typename Epi::Pre pre = E.pre(cur, wr, wc, fr, fq);
    PG8_STAGE(PG8_SB(0, 0), cB, voffB); PG8_STAGE(PG8_SB(0, 1), cB + hB, voffB); PG8_STAGE(PG8_SA(0, 0), cA, voffA); PG8_STAGE(PG8_SA(0, 1), cA + hA, voffA);
    if (wr == 1) PG8_BAR;
    PG8_WAIT_V(2); PG8_BAR;
    PG8_STAGE(PG8_SB(1, 0), cB + kstep, voffB); PG8_STAGE(PG8_SA(1, 0), cA + kstep, voffA); PG8_STAGE(PG8_SB(1, 1), cB + hB + kstep, voffB);
    PG8_WAIT_V(6); PG8_BAR;
    for (;;) {
        const bool has_next = S.next(ui + 1, nxt);
        const unsigned nA = has_next ? nxt.A : cA, nB = has_next ? nxt.B : cB;
#define PG8_PASS(WX, MM) do { \
            const bool last = (t == nt - 2); \
            unsigned tk = (unsigned)t * (unsigned)kstep; asm volatile("" : "+s"(tk)); \
            const unsigned a1 = cA + tk + kstep; \
            const unsigned a2 = last ? nA : cA + tk + 2 * kstep, b2 = last ? nB : cB + tk + 2 * kstep; \
            const unsigned a3 = a2 + kstep, b3 = b2 + kstep; \
            PG8_LDB(B0, 0, 0); PG8_LDB(B1, 0, 1); PG8_SCHED; PG8_LDA(At, 0, 0); PG8_STAGE(PG8_SA(1, 1), a1 + hA, voffA); \
            WX; PG8_WAIT_L(0); PG8_BAR; MM(0, 0, At, B0); MM(0, 1, At, B1); PG8_BAR; PG8_SCHED; \
            PG8_LDA(At, 0, 1); PG8_STAGE(PG8_SB(0, 0), b2, voffB); PG8_STAGE(PG8_SB(0, 1), b2 + hB, voffB); PG8_STAGE(PG8_SA(0, 0), a2, voffA); \
            WX; PG8_WAIT_L(0); PG8_BAR; MM(1, 0, At, B0); MM(1, 1, At, B1); PG8_BAR; PG8_SCHED; \
            PG8_LDB(B0, 1, 0); PG8_LDB(B1, 1, 1); PG8_SCHED; PG8_LDA(At, 1, 0); PG8_STAGE(PG8_SA(0, 1), a2 + hA, voffA); \
            PG8_WAIT_V(8); PG8_WAIT_L(0); PG8_BAR; PG8_MMA(0, 0, At, B0); PG8_MMA(0, 1, At, B1); PG8_BAR; PG8_SCHED; \
            PG8_LDA(At, 1, 1); PG8_STAGE(PG8_SB(1, 0), b3, voffB); PG8_STAGE(PG8_SB(1, 1), b3 + hB, voffB); PG8_STAGE(PG8_SA(1, 0), a3, voffA); \
            PG8_WAIT_V(8); PG8_WAIT_L(0); PG8_BAR; PG8_MMA(1, 0, At, B0); PG8_MMA(1, 1, At, B1); PG8_BAR; PG8_SCHED; \
        } while (0)
        int t = 0;
        if (Epi::ZC) {
            if (Epi::XST > 0 && ui > 0) PG8_PASS(PG8_WAIT_VN(8 + Epi::XST), PG8_MMA0); else PG8_PASS(PG8_WAIT_V(8), PG8_MMA0);
            t = 2;
        } else if (Epi::XST > 0 && ui > 0) { PG8_PASS(PG8_WAIT_VN(8 + Epi::XST), PG8_MMA); t = 2; }
        for (; t < nt; t += 2) PG8_PASS(PG8_WAIT_V(8), PG8_MMA);
#undef PG8_PASS
        if (wr == 0) PG8_BAR;
        unsigned zz = 0u; asm volatile("" : "+s"(zz)); const int le = (int)__builtin_amdgcn_mbcnt_hi(~0u, __builtin_amdgcn_mbcnt_lo(~0u, zz));
        if (E(acc, cur, wr, wc, le & 15, le >> 4, lds + TB_OFF + ldsw, lds + SHB_OFF + (ui & 1) * 3072, pre)) { if (!Epi::ZC) PG8_ZERO(); }
        if (!has_next) break;
        cur = nxt; cA = nA; cB = nB; ++ui;
        E.prefetch(cur, wid, le, lds + SHB_OFF + (ui & 1) * 3072);
        pre = E.pre(cur, wr, wc, le & 15, le >> 4);
        if (wr == 1) PG8_BAR;
    }
    PG8_WAIT_V(0);
    PG8_BAR;
#undef PG8_SA
#undef PG8_SB
#undef PG8_STAGE
#undef PG8_LDA
#undef PG8_LDB
#undef PG8_MMA
#undef PG8_MMA0
#undef PG8_WAIT_V
#undef PG8_WAIT_VN
#undef PG8_WAIT_L
#undef PG8_BAR
#undef PG8_SCHED
#undef PG8_ZERO
}
}

enum { I_x = 0, I_c = 1, I_ctx = 2, I_c_ctx = 3, I_w_ada = 4, I_b_ada = 5, I_g_norm1 = 6, I_g_norm2 = 7, I_w_in = 8, I_b_gate = 9, I_ret_decay = 10, I_ret_gn = 11, I_w_ret_o = 12, I_conv_dw = 13, I_conv_db = 14, I_conv_ln_g = 15, I_conv_ln_b = 16, I_w_conv_o = 17, I_gmlp_ln_g = 18, I_gmlp_ln_b = 19, I_gmlp_ws = 20, I_gmlp_bs = 21, I_w_gmlp_o = 22, I_w_fnet_o = 23, I_w_out = 24, I_w_ffn_up = 25, I_ffn_dw = 26, I_ffn_db = 27, I_w_ffn_down = 28, I_g_final = 29 };
struct KArgs { const float* in[30]; float* out; unsigned char* ws; int ph_lo, ph_hi; };
constexpr int PTAB_OFF = MISC_OFF + 4096;
struct KP {
    float* out; unsigned char* ws; LAS unsigned char* ldsb; LAS unsigned char* ptab; int tid_, bx_;
    __device__ __forceinline__ const float* in(int k) const {
        const LAS unsigned* t = (const LAS unsigned*)ptab + 2 * k;
        const unsigned lo = (unsigned)__builtin_amdgcn_readfirstlane((int)t[0]), hi = (unsigned)__builtin_amdgcn_readfirstlane((int)t[1]);
        typedef const float __attribute__((address_space(1)))* gcfp_t;
        return (const float*)(gcfp_t)(((unsigned long long)hi << 32) | (unsigned long long)lo);
    }
};

struct RowInfo { int mi; size_t xrow0; bool is_ctx; };
__device__ __forceinline__ RowInfo row_info(int g, int pm) {
    RowInfo ri;
    if (pm < NLT) { const int b = g * GB + (pm >> 3); ri.mi = b; ri.xrow0 = (size_t)b * SEQ + (size_t)(pm & 7) * 256; ri.is_ctx = false; }
    else { const int b = pm - NLT; ri.mi = 16; ri.xrow0 = (size_t)b * CTXL; ri.is_ctx = true; }
    return ri;
}

__device__ __forceinline__ unsigned ap_off(int g) { return g == 0 ? (unsigned)OFF_AP : (unsigned)OFF_AP1; }
__device__ __forceinline__ unsigned ssa_off(int g) { return (unsigned)OFF_SS + (unsigned)(g * 2) * (unsigned)(R * 4); }
__device__ __forceinline__ unsigned ssb_off(int g) { return (unsigned)OFF_SS + (unsigned)(g * 2 + 1) * (unsigned)(R * 4); }

constexpr int TB2_DELTA = 153600 - 131072;
__device__ __forceinline__ void st_rows16x2(LAS unsigned char* tb, bf16_t* base, size_t ld, int fr, int fq, u32x4 w0, u32x4 w1) {
    const int wo = 64 * fr + 16 * (fq ^ ((fr >> 2) & 3));
    *(LAS u32x4*)(tb + wo) = w0; *(LAS u32x4*)(tb + TB2_DELTA + wo) = w1;
    const int l2 = fq * 16 + fr, r2 = l2 >> 2, q2 = l2 & 3, ro = 64 * r2 + 16 * (q2 ^ ((r2 >> 2) & 3));
    const u32x4 t0 = *(const LAS u32x4*)(tb + ro), t1 = *(const LAS u32x4*)(tb + TB2_DELTA + ro);
    bf16_t* d = base + (size_t)r2 * ld + 8 * q2;
    *(u32x4*)d = t0; *(u32x4*)(d + 128) = t1;
}
__device__ __forceinline__ void st_rows16(LAS unsigned char* tb, bf16_t* base, size_t ld, int fr, int fq, u32x4 w) {
    *(LAS u32x4*)(tb + 64 * fr + 16 * (fq ^ ((fr >> 2) & 3))) = w;
    const int l2 = fq * 16 + fr, r2 = l2 >> 2, q2 = l2 & 3;
    const u32x4 t = *(const LAS u32x4*)(tb + 64 * r2 + 16 * (q2 ^ ((r2 >> 2) & 3)));
    *(u32x4*)(base + (size_t)r2 * ld + 8 * q2) = t;
}
struct EpiWin {
    typedef pg8::NoPre Pre; static constexpr bool ZC = true;
    __device__ __forceinline__ Pre pre(const pg8::Unit&, int, int, int, int) const { return Pre{}; }
    static constexpr bool PERM = true; static constexpr int XST = 16;
    const float* ss; const float* shw; const float* bgate; bf16_t* PM; bf16_t* GT; int g;
    __device__ __forceinline__ void prefetch(const pg8::Unit& u, int wid, int lane, LAS unsigned char* shb) const {
        const int ctile = u.pn * 256;
        if (wid == 0) { const RowInfo ri = row_info(g, u.pm); __builtin_amdgcn_global_load_lds((const unsigned*)(shw + (size_t)ri.mi * NCOLS + ctile + lane * 4), (LAS unsigned*)shb, 16, 0, 0); }
        else if (wid == 1) __builtin_amdgcn_global_load_lds((const unsigned*)(ss + u.pm * 256 + lane * 4), (LAS unsigned*)(shb + 1024), 16, 0, 0);
        else if (wid == 2 && ctile >= PMW) __builtin_amdgcn_global_load_lds((const unsigned*)(bgate + (ctile - PMW) + lane * 4), (LAS unsigned*)(shb + 2048), 16, 0, 0);
    }
    __device__ __forceinline__ bool operator()(f32x4 (&acc)[2][2][4][2], const pg8::Unit& u, int wr, int wc, int fr, int fq, LAS unsigned char* tb, const LAS unsigned char* shb, const Pre&) const {
        const int ctile = u.pn * 256, cb = wc * 32 + 8 * fq;
        const bool gate = ctile >= PMW;
        f32x4 sh[2][2];
#pragma unroll
        for (int bj = 0; bj < 2; ++bj)
#pragma unroll
            for (int n = 0; n < 2; ++n) { sh[bj][n] = *(const LAS f32x4*)(shb + (bj * 128 + cb + 4 * n) * 4);
                if (gate) sh[bj][n] = (sh[bj][n] + *(const LAS f32x4*)(shb + 2048 + (bj * 128 + cb + 4 * n) * 4)) * (-1.44269504089f) - 7.99435343686f; }
        float rsv[8];
#pragma unroll
        for (int q = 0; q < 8; ++q) rsv[q] = __builtin_amdgcn_rsqf(*(const LAS float*)(shb + 1024 + ((q >> 2) * 128 + wr * 64 + (q & 3) * 16 + fr) * 4) * (1.0f / 1024.0f) + EPS);
        if (gate) {
            typedef float f32x2_ __attribute__((ext_vector_type(2)));
            unsigned char* gt = (unsigned char*)GT + (size_t)(u.pm * 16 + ((ctile - PMW) >> 8)) * 16 * 4096 + ((wr * 4 + wc) * 64 + fq * 16 + fr) * 8;
#pragma unroll
            for (int ai = 0; ai < 2; ++ai)
#pragma unroll
                for (int m = 0; m < 4; ++m) {
                    const float rsg = rsv[ai * 4 + m] * (-1.44269504089f);
                    const f32x2_ rg2 = (f32x2_){rsg, rsg};
#pragma unroll
                    for (int bj = 0; bj < 2; ++bj) {
                        u32x2 wq = (u32x2){0u, 0u};
#pragma unroll
                        for (int n = 0; n < 2; ++n) { const f32x4 a_ = acc[ai][bj][m][n], s_ = sh[bj][n];
                            const f32x2_ p0 = __builtin_elementwise_fma((f32x2_){a_[0], a_[1]}, rg2, (f32x2_){s_[0], s_[1]}), p1 = __builtin_elementwise_fma((f32x2_){a_[2], a_[3]}, rg2, (f32x2_){s_[2], s_[3]});
                            const float e_[4] = {p0[0], p0[1], p1[0], p1[1]};
                            unsigned w_ = 0u;
#pragma unroll
                            for (int j = 0; j < 4; ++j) w_ = __builtin_amdgcn_cvt_pk_u8_f32(fast_rcp(__builtin_amdgcn_fmed3f(__builtin_amdgcn_exp2f(e_[j]) + (1.0f / 255.0f), 0.f, 1.f)), j, w_);
                            if (n == 0) wq.x = w_; else wq.y = w_; }
                        *(u32x2*)(gt + ((ai * 4 + m) * 2 + bj) * 4096) = wq;
                    }
                }
            return true;
        }
#pragma unroll
        for (int ai = 0; ai < 2; ++ai)
#pragma unroll
            for (int m = 0; m < 4; ++m) {
                const int r0 = u.pm * 256 + ai * 128 + wr * 64 + m * 16;
                const float rs = rsv[ai * 4 + m];
                u32x4 wp[2];
#pragma unroll
                for (int bj = 0; bj < 2; ++bj) {
                    const f32x4 v0 = acc[ai][bj][m][0] * rs + sh[bj][0], v1 = acc[ai][bj][m][1] * rs + sh[bj][1];
                    wp[bj].x = cvt_pk_bf16(v0[0], v0[1]); wp[bj].y = cvt_pk_bf16(v0[2], v0[3]); wp[bj].z = cvt_pk_bf16(v1[0], v1[1]); wp[bj].w = cvt_pk_bf16(v1[2], v1[3]);
                }
                st_rows16x2(tb, PM + (size_t)r0 * PMW + ctile + wc * 32, PMW, fr, fq, wp[0], wp[1]);
            }
        return true;
    }
};
struct EpiUp {
    typedef pg8::NoPre Pre; static constexpr bool ZC = true;
    __device__ __forceinline__ Pre pre(const pg8::Unit&, int, int, int, int) const { return Pre{}; }
    static constexpr bool PERM = true; static constexpr int XST = 16;
    const float* ss; const float* shw; bf16_t* UP; int g;
    __device__ __forceinline__ void prefetch(const pg8::Unit& u, int wid, int lane, LAS unsigned char* shb) const {
        if (wid == 0) { const RowInfo ri = row_info(g, u.pm); __builtin_amdgcn_global_load_lds((const unsigned*)(shw + (size_t)ri.mi * UPW + u.pn * 256 + lane * 4), (LAS unsigned*)shb, 16, 0, 0); }
        else if (wid == 1) __builtin_amdgcn_global_load_lds((const unsigned*)(ss + u.pm * 256 + lane * 4), (LAS unsigned*)(shb + 1024), 16, 0, 0);
    }
    __device__ __forceinline__ bool operator()(f32x4 (&acc)[2][2][4][2], const pg8::Unit& u, int wr, int wc, int fr, int fq, LAS unsigned char* tb, const LAS unsigned char* shb, const Pre&) const {
        const int ctile = u.pn * 256, cb = wc * 32 + 8 * fq;
        f32x4 sh[2][2];
#pragma unroll
        for (int bj = 0; bj < 2; ++bj)
#pragma unroll
            for (int n = 0; n < 2; ++n) sh[bj][n] = *(const LAS f32x4*)(shb + (bj * 128 + cb + 4 * n) * 4);
        float rsv[8];
#pragma unroll
        for (int q = 0; q < 8; ++q) rsv[q] = __builtin_amdgcn_rsqf(*(const LAS float*)(shb + 1024 + ((q >> 2) * 128 + wr * 64 + (q & 3) * 16 + fr) * 4) * (1.0f / 1024.0f) + EPS);
#pragma unroll
        for (int ai = 0; ai < 2; ++ai)
#pragma unroll
            for (int m = 0; m < 4; ++m) {
                const int r = u.pm * 256 + ai * 128 + wr * 64 + m * 16 + fr;
                const float rs = rsv[ai * 4 + m];
                u32x4 w[2];
#pragma unroll
                for (int bj = 0; bj < 2; ++bj) {
                    const f32x4 v0 = acc[ai][bj][m][0] * rs + sh[bj][0], v1 = acc[ai][bj][m][1] * rs + sh[bj][1];
                    w[bj].x = cvt_pk_bf16(v0[0], v0[1]); w[bj].y = cvt_pk_bf16(v0[2], v0[3]); w[bj].z = cvt_pk_bf16(v1[0], v1[1]); w[bj].w = cvt_pk_bf16(v1[2], v1[3]);
                }
                st_rows16x2(tb, UP + (size_t)(r - fr) * UPW + ctile + wc * 32, UPW, fr, fq, w[0], w[1]);
            }
        return true;
    }
};
struct EpiResid {
    typedef pg8::NoPre Pre; static constexpr bool ZC = true;
    __device__ __forceinline__ Pre pre(const pg8::Unit&, int, int, int, int) const { return Pre{}; }
    static constexpr bool PERM = true; static constexpr int XST = 0;
    static constexpr int XS = 2048, XH = 1024;
    const float *x32_lat, *x32_ctx; bf16_t *xb_lat, *xb_ctx; const float* ga; const float* Gn; bf16_t* AP; float* ss; int g;
    __device__ __forceinline__ void prefetch(const pg8::Unit& u, int wid, int lane, LAS unsigned char* shb) const {
        if (wid == 0) { const RowInfo ri = row_info(g, u.pm); __builtin_amdgcn_global_load_lds((const unsigned*)(ga + (size_t)ri.mi * 6144 + u.pn * 256 + lane * 4), (LAS unsigned*)shb, 16, 0, 0); }
        else if (wid == 1 && Gn) { const RowInfo ri = row_info(g, u.pm); __builtin_amdgcn_global_load_lds((const unsigned*)(Gn + (size_t)ri.mi * 6144 + u.pn * 256 + lane * 4), (LAS unsigned*)(shb + 1024), 16, 0, 0); }
    }
    __device__ __forceinline__ bool operator()(f32x4 (&acc)[2][2][4][2], const pg8::Unit& u, int wr, int wc, int fr, int fq, LAS unsigned char* tb, const LAS unsigned char* shb, const Pre&) const {
        const RowInfo ri = row_info(g, u.pm);
        const float* x32 = ri.is_ctx ? x32_ctx : x32_lat; bf16_t* xb = ri.is_ctx ? xb_ctx : xb_lat;
        const bool in32 = x32 != nullptr, gnp = Gn != nullptr;
        const int l2 = fq * 16 + fr, r2 = l2 >> 2, q2 = l2 & 3;
        LAS unsigned char* wa = tb + 64 * fr + 16 * (fq ^ ((fr >> 2) & 3));
        const LAS unsigned char* ra = tb + 64 * r2 + 16 * (q2 ^ ((r2 >> 2) & 3));
        const int c0 = u.pn * 256 + wc * 32 + 8 * q2;
        const LAS unsigned char* gl = shb + (wc * 32 + 8 * q2) * 4;
        const size_t xrow = ri.xrow0 + (size_t)(wr * 64 + r2);
        const int rbase = u.pm * 256 + wr * 64 + r2;
        f32x4 xc[2][2], xn_[2][2];
#pragma unroll
        for (int bj = 0; bj < 2; ++bj) {
            if (in32) { xc[bj][0] = *(const f32x4*)(x32 + xrow * D + c0 + bj * 128); xc[bj][1] = *(const f32x4*)(x32 + xrow * D + c0 + bj * 128 + 4); }
            else { const u32x4 t = *(const u32x4*)(xb + xrow * XS + XH + c0 + bj * 128); xc[bj][0] = (f32x4){__uint_as_float(t.x), __uint_as_float(t.y), __uint_as_float(t.z), __uint_as_float(t.w)}; } }
#pragma unroll
        for (int st = 0; st < 8; ++st) {
            const int ai = st >> 2, m = st & 3;
            if (st < 7) { const int ai2 = (st + 1) >> 2, m2 = (st + 1) & 3; const size_t xr2 = xrow + (size_t)(ai2 * 128 + m2 * 16);
#pragma unroll
                for (int bj = 0; bj < 2; ++bj) {
                    if (in32) { xn_[bj][0] = *(const f32x4*)(x32 + xr2 * D + c0 + bj * 128); xn_[bj][1] = *(const f32x4*)(x32 + xr2 * D + c0 + bj * 128 + 4); }
                    else { const u32x4 t = *(const u32x4*)(xb + xr2 * XS + XH + c0 + bj * 128); xn_[bj][0] = (f32x4){__uint_as_float(t.x), __uint_as_float(t.y), __uint_as_float(t.z), __uint_as_float(t.w)}; } } }
            asm volatile("" ::: "memory");
            const size_t xr = xrow + (size_t)(ai * 128 + m * 16); const int r = rbase + ai * 128 + m * 16;
            float sq = 0.f;
#pragma unroll
            for (int bj = 0; bj < 2; ++bj) {
                *(LAS f32x4*)wa = acc[ai][bj][m][0]; *(LAS f32x4*)(wa + TB2_DELTA) = acc[ai][bj][m][1];
                const f32x4 at0 = *(const LAS f32x4*)ra, at1 = *(const LAS f32x4*)(ra + TB2_DELTA);
                f32x4 x0, x1;
                if (in32) { x0 = xc[bj][0]; x1 = xc[bj][1]; }
                else { const f32x4 t = xc[bj][0]; const unsigned t0 = __float_as_uint(t[0]), t1 = __float_as_uint(t[1]), t2 = __float_as_uint(t[2]), t3 = __float_as_uint(t[3]);
                    x0 = (f32x4){__uint_as_float(t0 << 16), __uint_as_float(t0 & 0xffff0000u), __uint_as_float(t1 << 16), __uint_as_float(t1 & 0xffff0000u)};
                    x1 = (f32x4){__uint_as_float(t2 << 16), __uint_as_float(t2 & 0xffff0000u), __uint_as_float(t3 << 16), __uint_as_float(t3 & 0xffff0000u)}; }
                const f32x4 v0 = x0 + *(const LAS f32x4*)(gl + bj * 512) * at0, v1 = x1 + *(const LAS f32x4*)(gl + bj * 512 + 16) * at1;
                u32x4 w; w.x = cvt_pk_bf16(v0[0], v0[1]); w.y = cvt_pk_bf16(v0[2], v0[3]); w.z = cvt_pk_bf16(v1[0], v1[1]); w.w = cvt_pk_bf16(v1[2], v1[3]);
                *(u32x4*)(xb + xr * XS + XH + c0 + bj * 128) = w;
                sq += ((v0[0] * v0[0] + v0[1] * v0[1]) + (v0[2] * v0[2] + v0[3] * v0[3])) + ((v1[0] * v1[0] + v1[1] * v1[1]) + (v1[2] * v1[2] + v1[3] * v1[3]));
                if (gnp) { const f32x4 a0 = v0 * *(const LAS f32x4*)(gl + 1024 + bj * 512), a1 = v1 * *(const LAS f32x4*)(gl + 1024 + bj * 512 + 16);
                    u32x4 wA; wA.x = cvt_pk_bf16(a0[0], a0[1]); wA.y = cvt_pk_bf16(a0[2], a0[3]); wA.z = cvt_pk_bf16(a1[0], a1[1]); wA.w = cvt_pk_bf16(a1[2], a1[3]);
                    *(u32x4*)(AP + (size_t)r * D + c0 + bj * 128) = wA; } }
            sq += dpp_mov<0xB1>(sq); sq += dpp_mov<0x4E>(sq);
            if (q2 == 0) atomicAdd(ss + r, sq);
            asm volatile("" ::: "memory");
#pragma unroll
            for (int bj = 0; bj < 2; ++bj) { xc[bj][0] = xn_[bj][0]; xc[bj][1] = xn_[bj][1]; }
        }
        return true;
    }
};
struct EpiDft {
    typedef pg8::NoPre Pre; static constexpr bool ZC = true;
    __device__ __forceinline__ Pre pre(const pg8::Unit&, int, int, int, int) const { return Pre{}; }
    static constexpr bool PERM = true; static constexpr int XST = 0;
    bf16_t* S; int row_base, rows_per_seq; float scale;
    __device__ __forceinline__ void prefetch(const pg8::Unit&, int, int, LAS unsigned char*) const {}
    __device__ __forceinline__ bool operator()(f32x4 (&acc)[2][2][4][2], const pg8::Unit& u, int wr, int wc, int fr, int fq, LAS unsigned char* tb, const LAS unsigned char*, const Pre&) const {
        const int cb = wc * 32 + 8 * fq;
#pragma unroll
        for (int ai = 0; ai < 2; ++ai)
#pragma unroll
            for (int m = 0; m < 4; ++m) {
                const int r = row_base + u.pn * rows_per_seq + u.pm * 256 + ai * 128 + wr * 64 + m * 16 + fr;
#pragma unroll
                for (int bj = 0; bj < 2; ++bj) {
                    const f32x4 v0 = acc[ai][bj][m][0] * scale, v1 = acc[ai][bj][m][1] * scale;
                    u32x4 w; w.x = cvt_pk_bf16(v0[0], v0[1]); w.y = cvt_pk_bf16(v0[2], v0[3]); w.z = cvt_pk_bf16(v1[0], v1[1]); w.w = cvt_pk_bf16(v1[2], v1[3]);
                    st_rows16(tb, S + (size_t)(r - fr) * D + 768 + bj * 128 + wc * 32, D, fr, fq, w);
                }
            }
        return true;
    }
};
struct EpiMerge {
    static constexpr bool ZC = false;
    static constexpr bool PERM = true; static constexpr int NPQ = 4; static constexpr int XST = 2 * NPQ;
    const unsigned char* GT; bf16_t* MG;
    __device__ __forceinline__ void prefetch(const pg8::Unit&, int, int, LAS unsigned char*) const {}
    struct Pre { u32x2 ti[NPQ], tn[NPQ]; };
    __device__ __forceinline__ Pre pre(const pg8::Unit& u, int wr, int wc, int fr, int fq) const { Pre p_;
        const int i = u.seg, thr = ((wr * 4 + wc) * 64 + fq * 16 + fr) * 8;
        const unsigned char* gi = GT + (size_t)(u.pm * 16 + i * 4 + u.pn) * 16 * 4096 + thr;
        const unsigned char* gn = i < 3 ? gi + (size_t)4 * 16 * 4096 : gi;
#pragma unroll
        for (int q = 0; q < NPQ; ++q) { p_.ti[q] = *(const u32x2*)(gi + q * 4096); p_.tn[q] = *(const u32x2*)(gn + q * 4096); }
        return p_; }
    __device__ __forceinline__ bool operator()(f32x4 (&acc)[2][2][4][2], const pg8::Unit& u, int wr, int wc, int fr, int fq, LAS unsigned char* tb, const LAS unsigned char*, const Pre& p_) const {
        __builtin_amdgcn_s_waitcnt(0x0F78);
        const int cb = u.pn * 256 + wc * 32 + 8 * fq, i = u.seg;
        const int thr = ((wr * 4 + wc) * 64 + fq * 16 + fr) * 8;
        const unsigned char* gi = GT + (size_t)(u.pm * 16 + i * 4 + u.pn) * 16 * 4096 + thr;
        const unsigned char* gn = i < 3 ? gi + (size_t)4 * 16 * 4096 : gi;
        u32x2 ti[16], tn[16];
#pragma unroll
        for (int q = 0; q < 16; ++q) { if (q < NPQ) { ti[q] = p_.ti[q]; tn[q] = p_.tn[q]; } else { ti[q] = *(const u32x2*)(gi + q * 4096); tn[q] = *(const u32x2*)(gn + q * 4096); } }
        const unsigned last = i == 3 ? 0xffffffffu : 0u;
#pragma unroll
        for (int q = 0; q < 16; ++q) { const int ai = q >> 3, m = (q >> 1) & 3, bj = q & 1;
            f32x4 fa, fb;
#pragma unroll
            for (int j = 0; j < 4; ++j) {
                fa[j] = (float)((ti[q].x >> (8 * j)) & 0xffu) * fast_rcp((float)(((tn[q].x | last) >> (8 * j)) & 0xffu));
                fb[j] = (float)((ti[q].y >> (8 * j)) & 0xffu) * fast_rcp((float)(((tn[q].y | last) >> (8 * j)) & 0xffu)); }
            acc[ai][bj][m][0] *= fa; acc[ai][bj][m][1] *= fb;
        }
        if (i < 3) return false;
#pragma unroll
        for (int q = 0; q < 16; ++q) { const int ai = q >> 3, m = (q >> 1) & 3, bj = q & 1;
            const f32x4 v0 = acc[ai][bj][m][0], v1 = acc[ai][bj][m][1];
            const int r0 = u.pm * 256 + ai * 128 + wr * 64 + m * 16;
            u32x4 w; w.x = cvt_pk_bf16(v0[0], v0[1]); w.y = cvt_pk_bf16(v0[2], v0[3]); w.z = cvt_pk_bf16(v1[0], v1[1]); w.w = cvt_pk_bf16(v1[2], v1[3]);
            st_rows16(tb, MG + (size_t)r0 * D + u.pn * 256 + wc * 32 + bj * 128, D, fr, fq, w);
        }
        return true;
    }
};

__device__ __forceinline__ void transpose_item(const float* src, int ld_src, int k0, int n0, bf16_t* dst, int ld_dst, int dst_row0, LAS float* scr, int lane) {
    const int kr = lane >> 3, nq = lane & 7;
    f32x4 v[8];
#pragma unroll
    for (int i = 0; i < 8; ++i) v[i] = *(const f32x4*)(src + (size_t)(k0 + i * 8 + kr) * ld_src + n0 + nq * 4);
#pragma unroll
    for (int i = 0; i < 8; ++i) { LAS float* d_ = scr + (i * 8 + kr) * 33 + nq * 4; d_[0] = v[i][0]; d_[1] = v[i][1]; d_[2] = v[i][2]; d_[3] = v[i][3]; }
    asm volatile("s_waitcnt lgkmcnt(0)" ::: "memory");
    const int c = lane & 7;
#pragma unroll
    for (int j = 0; j < 4; ++j) { const int n = (lane >> 3) + 8 * j; const LAS float* s = scr + (8 * c) * 33 + n;
        u32x4 o; o.x = cvt_pk_bf16(s[0 * 33], s[1 * 33]); o.y = cvt_pk_bf16(s[2 * 33], s[3 * 33]); o.z = cvt_pk_bf16(s[4 * 33], s[5 * 33]); o.w = cvt_pk_bf16(s[6 * 33], s[7 * 33]);
        *(u32x4*)(dst + (size_t)(dst_row0 + n) * ld_dst + k0 + 8 * c) = o; }
    asm volatile("s_waitcnt lgkmcnt(0)" ::: "memory");
}

__device__ __forceinline__ void weight_prep(const KP& p, LAS unsigned char* lds, int l_lo, int l_hi, int b0, int nb) {
    int tid = p.tid_; asm volatile("" : "+v"(tid)); const int wave = tid >> 6, lane = tid & 63, G = nb, bx = p.bx_ - b0;
    unsigned char* ws = p.ws;
    if (bx < 0 || bx >= nb) return;
    {
        LAS float* scr = (LAS float*)(lds + wave * 16384);
        const int gw = bx * NWAVES + wave, NGW = G * NWAVES;
        constexpr int I_IN1 = 16 * 64, I_IN2 = 16 * 128, I_O = 4 * 32, I_OUT = 16 * 32, I_UP = 16 * 176, I_DN = 44 * 32;
        constexpr int PER_L = I_IN1 + I_IN2 + 4 * I_O + I_OUT + I_UP + I_DN;
        for (int it = l_lo * PER_L + gw; it < l_hi * PER_L; it += NGW) {
            const int l = it / PER_L; int r = it % PER_L;
            bf16_t* wl = (bf16_t*)(ws + OFF_W + (size_t)l * W_LAYER);
            if (r < I_IN1) { const int kb = r / 64, nb = r % 64; transpose_item(p.in(I_w_in) + (size_t)l * D * IN_COLS, IN_COLS, kb * 64, nb * 32, wl + W_IN / 2, D, nb * 32, scr, lane); continue; } r -= I_IN1;
            if (r < I_IN2) { const int kb = r / 128, nb = r % 128; transpose_item(p.in(I_w_in) + (size_t)l * D * IN_COLS, IN_COLS, kb * 64, 2304 + nb * 32, wl + W_IN / 2, D, PMW + nb * 32, scr, lane); continue; } r -= I_IN2;
            if (r < 4 * I_O) { const int br = r / I_O, rr = r % I_O, kb = rr / 32, nb = rr % 32;
                const float* src = (br == 0 ? p.in(I_w_ret_o) : br == 1 ? p.in(I_w_conv_o) : br == 2 ? p.in(I_w_gmlp_o) : p.in(I_w_fnet_o)) + (size_t)l * 256 * D;
                transpose_item(src, D, kb * 64, nb * 32, wl + W_O / 2 + (size_t)br * 1024 * 256, 256, nb * 32, scr, lane); continue; } r -= 4 * I_O;
            if (r < I_OUT) { const int kb = r / 32, nb = r % 32; transpose_item(p.in(I_w_out) + (size_t)l * D * D, D, kb * 64, nb * 32, wl + W_OUT / 2, D, nb * 32, scr, lane); continue; } r -= I_OUT;
            if (r < I_UP) { const int kb = r / 176, nb = r % 176; transpose_item(p.in(I_w_ffn_up) + (size_t)l * D * UPW, UPW, kb * 64, nb * 32, wl + W_UP / 2, D, nb * 32, scr, lane); continue; } r -= I_UP;
            { const int kb = r / 32, nb = r % 32; transpose_item(p.in(I_w_ffn_down) + (size_t)l * DFF * D, D, kb * 64, nb * 32, wl + W_DN / 2, DFF, nb * 32, scr, lane); }
        }
        __syncthreads();
    }
    {
        LAS float* tile = (LAS float*)lds;
        LAS float* tab = (LAS float*)(lds + 64 * 65 * 4);
        for (int it = l_lo * 64 + bx; it < l_hi * 64; it += G) {
            const int l = it / 64, gq = (it / 16) % 4, kb = it % 16;
            __syncthreads();
            if (tid < 64) { tab[tid] = cos_rev((float)tid * (1.0f / 64.0f)) * 0.125f; tab[64 + tid] = sin_rev((float)tid * (1.0f / 64.0f)) * 0.125f; }
            for (int i = tid; i < 64 * 64; i += NTHREADS) { const int kk = i / 64, cc = i % 64; tile[kk * 65 + cc] = p.in(I_w_in)[((size_t)l * D + kb * 64 + kk) * IN_COLS + 2048 + gq * 64 + cc]; }
            __syncthreads();
            const int which = tid >> 8, nl = (tid & 255) >> 2, kq = tid & 3;
            float acc[16];
#pragma unroll
            for (int j = 0; j < 16; ++j) acc[j] = 0.f;
            for (int cc = 0; cc < 64; ++cc) { const float coef = tab[which * 64 + ((cc * nl) & 63)];
#pragma unroll
                for (int j = 0; j < 16; ++j) acc[j] += coef * tile[(kq * 16 + j) * 65 + cc]; }
            bf16_t* wl = (bf16_t*)(ws + OFF_W + (size_t)l * W_LAYER + W_IN);
            bf16_t* dst = wl + (size_t)(2048 + which * 256 + gq * 64 + nl) * D + kb * 64 + kq * 16;
            *(u32x4*)dst = pack8(acc); *(u32x4*)(dst + 8) = pack8(acc + 8);
        }
        __syncthreads();
    }
}
__device__ __forceinline__ void phase_prep_a(const KP& p, LAS unsigned char* lds) {
    int tid = p.tid_; asm volatile("" : "+v"(tid)); const int wave = tid >> 6, lane = tid & 63, G = NBLK, bx = p.bx_;
    unsigned char* ws = p.ws;
    {
        LAS float* sl = (LAS float*)lds;
        float* adap = (float*)(ws + OFF_ADAP);
        for (int it = bx; it < 2 * 12 * 8; it += G) {
            const int l = it / 96, nch = (it / 8) % 12, kc = it % 8;
            __syncthreads();
            for (int i = tid; i < 17 * 128; i += NTHREADS) { const int mi = i / 128, k = kc * 128 + (i % 128); const float cv = mi < 16 ? p.in(I_c)[mi * D + k] : p.in(I_c_ctx)[k]; sl[i] = siluf_(cv); }
            __syncthreads();
            const int n = nch * 512 + tid;
            float acc[17];
#pragma unroll
            for (int mi = 0; mi < 17; ++mi) acc[mi] = 0.f;
            const float* wp = p.in(I_w_ada) + ((size_t)l * D + kc * 128) * 6144 + n;
#pragma unroll 1
            for (int k0 = 0; k0 < 128; k0 += 16) { float w[16];
#pragma unroll
                for (int k = 0; k < 16; ++k) w[k] = wp[(size_t)(k0 + k) * 6144];
#pragma unroll
                for (int k = 0; k < 16; ++k)
#pragma unroll
                    for (int mi = 0; mi < 17; ++mi) acc[mi] += sl[mi * 128 + k0 + k] * w[k]; }
#pragma unroll
            for (int mi = 0; mi < 17; ++mi) adap[(((size_t)kc * 2 + l) * 17 + mi) * 6144 + n] = acc[mi];
        }
        __syncthreads();
    }
    weight_prep(p, lds, 0, 1, 0, G);
    {
        const size_t gt = (size_t)bx * NTHREADS + tid, GT_ = (size_t)G * NTHREADS;
        float* rc = (float*)(ws + OFF_ROPE); float* rsn = rc + 2304 * 32;
        for (size_t i = gt; i < (size_t)2304 * 32; i += GT_) { const int pos = (int)(i / 32), fi = (int)(i % 32);
            const float inv = exp2f(-(float)fi * (13.287712379549449f / 32.0f));
            const float ang = (float)pos * inv;
            const double rev = (double)ang * 0.15915494309189535; const float fr_ = (float)(rev - floor(rev));
            rc[i] = cos_rev(fr_); rsn[i] = sin_rev(fr_); }
        bf16_t* dm = (bf16_t*)(ws + OFF_DM);
        for (size_t i = gt; i < (size_t)2048 * 256; i += GT_) { const int n = (int)(i / 256), k8 = (int)(i % 256) * 8; float v[8];
#pragma unroll
            for (int j = 0; j < 8; ++j) { const int kk = k8 + j; if (kk <= 1024) v[j] = cos_rev((float)((n * kk) & 2047) * (1.0f / 2048.0f)); else v[j] = -sin_rev((float)((n * (kk - 1024)) & 2047) * (1.0f / 2048.0f)); }
            *(u32x4*)(dm + (size_t)n * 2048 + k8) = pack8(v); }
        bf16_t* dc = (bf16_t*)(ws + OFF_DC);
        for (size_t i = gt; i < (size_t)256 * 32; i += GT_) { const int n = (int)(i / 32), k8 = (int)(i % 32) * 8; float v[8];
#pragma unroll
            for (int j = 0; j < 8; ++j) { const int kk = k8 + j; if (kk <= 128) v[j] = cos_rev((float)((n * kk) & 255) * (1.0f / 256.0f)); else v[j] = -sin_rev((float)((n * (kk - 128)) & 255) * (1.0f / 256.0f)); }
            *(u32x4*)(dc + (size_t)n * 256 + k8) = pack8(v); }
        if (gt < 16) { const float xx = p.in(I_ret_decay)[gt]; ((float*)(ws + OFF_LOGG))[gt] = (float)(-log1p(exp(-(double)xx))); }
    }
}

__device__ __forceinline__ void phase_prep_b(const KP& p) {
    const size_t gt = (size_t)p.bx_ * NTHREADS + p.tid_, GT_ = (size_t)NBLK * NTHREADS;
    const float* adap = (const float*)(p.ws + OFF_ADAP); float* mod = (float*)(p.ws + OFF_MOD);
    for (size_t i = gt; i < (size_t)2 * 17 * 6144; i += GT_) {
        const int l = (int)(i / (17 * 6144)), n = (int)(i % 6144), j = n / 1024, k = n % 1024;
        float v = p.in(I_b_ada)[l * 6144 + n];
#pragma unroll
        for (int kc = 0; kc < 8; ++kc) v += adap[(size_t)kc * 2 * 17 * 6144 + i];
        if (j == 1) v = p.in(I_g_norm1)[l * D + k] * (1.f + v);
        if (j == 4) v = p.in(I_g_norm2)[l * D + k] * (1.f + v);
        mod[i] = v;
    }
}

__device__ __forceinline__ void phase_prep_c(const KP& p, LAS unsigned char* lds, int l_lo, int l_hi, int b0, int nb) {
    int tid = p.tid_; asm volatile("" : "+v"(tid)); const int wave = tid >> 6, lane = tid & 63, G = nb;
    if (p.bx_ < b0 || p.bx_ >= b0 + nb) return;
    LAS unsigned char* shb = lds;
    const int gw = (p.bx_ - b0) * NWAVES + wave, NGW = G * NWAVES;
    const int c = lane & 15, gq = lane >> 4;
    for (int combo = 2 * l_lo; combo < 2 * l_hi; ++combo) {
        const int l = combo >> 1, which = combo & 1;
        const float* mod = (const float*)(p.ws + OFF_MOD) + (size_t)l * 17 * 6144 + (which ? 3 : 0) * 1024;
        __syncthreads();
        for (int i = tid; i < 32 * 128; i += NTHREADS) { const int row = i >> 7, ch = i & 127; float f[8];
#pragma unroll
            for (int j = 0; j < 8; ++j) f[j] = row < 17 ? mod[(size_t)row * 6144 + ch * 8 + j] : 0.f;
            *(LAS u32x4*)(shb + row * 2048 + ((ch ^ (row & 7)) << 4)) = pack8(f); }
        __syncthreads();
        const int ncol = which ? UPW : NCOLS;
        const bf16_t* W = (const bf16_t*)(p.ws + OFF_W + (size_t)l * W_LAYER + (which ? W_UP : W_IN));
        float* dst = (float*)(p.ws + (which ? OFF_SHW2 : OFF_SHW1)) + (size_t)l * 17 * ncol;
        for (int nb16 = gw; nb16 < ncol / 16; nb16 += NGW) {
            const bf16_t* wrow = W + (size_t)(nb16 * 16 + c) * D + 8 * gq;
            const f32x4 z4 = (f32x4){0.f, 0.f, 0.f, 0.f};
            f32x4 acc0 = z4, acc1 = z4;
#pragma unroll 1
            for (int t0 = 0; t0 < 32; t0 += 8) {
                bf16x8 bfr[8];
#pragma unroll
                for (int q = 0; q < 8; ++q) bfr[q] = *(const bf16x8*)(wrow + 32 * (t0 + q));
#pragma unroll
                for (int q = 0; q < 8; ++q) { const int ch = 4 * (t0 + q) + gq;
                    const bf16x8 a0 = *(const LAS bf16x8*)(shb + c * 2048 + ((ch ^ (c & 7)) << 4)), a1 = *(const LAS bf16x8*)(shb + (16 + c) * 2048 + ((ch ^ (c & 7)) << 4));
                    acc0 = mfma16(a0, bfr[q], acc0); acc1 = mfma16(a1, bfr[q], acc1); }
            }
            const int n = nb16 * 16 + c;
#pragma unroll
            for (int r = 0; r < 4; ++r) dst[(size_t)(4 * gq + r) * ncol + n] = acc0[r];
            if (gq == 0) dst[(size_t)16 * ncol + n] = acc1[0];
        }
    }
    __syncthreads();
}

__device__ __forceinline__ void phase_g0(const KP& p, int g, int b0, int nb) {
    int tid = p.tid_; asm volatile("" : "+v"(tid)); const int wave = tid >> 6, lane = tid & 63;
    if (p.bx_ < b0 || p.bx_ >= b0 + nb) return;
    const int gw = (p.bx_ - b0) * NWAVES + wave, NGW = nb * NWAVES;
    const float* mod = (const float*)(p.ws + OFF_MOD);
    bf16_t* AP = (bf16_t*)(p.ws + ap_off(g)); float* ss = (float*)(p.ws + ssa_off(g));
    const int nrows = g == 0 ? R : R_LAT;
    for (int r0 = gw; r0 < nrows; r0 += 2 * NGW) {
        f32x4 v[2][4], gg[2][4]; int rr[2]; bool ok[2];
#pragma unroll
        for (int h = 0; h < 2; ++h) { rr[h] = r0 + h * NGW; ok[h] = rr[h] < nrows; const int r = ok[h] ? rr[h] : r0;
            const RowInfo ri = row_info(g, r >> 8);
            const float* xr = (ri.is_ctx ? p.in(I_ctx) : p.in(I_x)) + (ri.xrow0 + (size_t)(r & 255)) * D;
            const float* G1 = mod + (size_t)ri.mi * 6144 + 1024;
#pragma unroll
            for (int j = 0; j < 4; ++j) { v[h][j] = *(const f32x4*)(xr + j * 256 + lane * 4); gg[h][j] = *(const f32x4*)(G1 + j * 256 + lane * 4); } }
#pragma unroll
        for (int h = 0; h < 2; ++h) { if (!ok[h]) continue; const int r = rr[h];
            float s_ = 0.f;
#pragma unroll
            for (int j = 0; j < 4; ++j) { const f32x4 x = v[h][j];
                s_ += (x[0] * x[0] + x[1] * x[1]) + (x[2] * x[2] + x[3] * x[3]);
                const f32x4 a = x * gg[h][j]; u32x2 w; w.x = cvt_pk_bf16(a[0], a[1]); w.y = cvt_pk_bf16(a[2], a[3]);
                *(u32x2*)(AP + (size_t)r * D + j * 256 + lane * 4) = w; }
            s_ = wave_sum(s_, lane);
            if (lane == 0) ss[r] = s_; }
    }
}

__device__ __forceinline__ void phase_final(const KP& p, int g, int b0, int nb) {
    int tid = p.tid_; asm volatile("" : "+v"(tid)); const int wave = tid >> 6, lane = tid & 63;
    if (p.bx_ < b0 || p.bx_ >= b0 + nb) return;
    const int gw = (p.bx_ - b0) * NWAVES + wave, NGW = nb * NWAVES;
    const float* ss = (const float*)(p.ws + ssa_off(g));
    const f32x4 gf0 = *(const f32x4*)(p.in(I_g_final) + lane * 4), gf1 = *(const f32x4*)(p.in(I_g_final) + 256 + lane * 4), gf2 = *(const f32x4*)(p.in(I_g_final) + 512 + lane * 4), gf3 = *(const f32x4*)(p.in(I_g_final) + 768 + lane * 4);
    for (int r0 = gw; r0 < R_LAT; r0 += 2 * NGW) {
        f32x4 v[2][4]; float sv[2];
#pragma unroll
        for (int h = 0; h < 2; ++h) { const int r = (r0 + h * NGW < R_LAT) ? r0 + h * NGW : r0; sv[h] = ss[r];
            const bf16_t* xr = (const bf16_t*)p.out + ((size_t)g * R_LAT + r) * 2048 + 1024;
#pragma unroll
            for (int j = 0; j < 4; ++j) { const u32x2 t = *(const u32x2*)(xr + j * 256 + lane * 4);
                v[h][j] = (f32x4){__uint_as_float(t.x << 16), __uint_as_float(t.x & 0xffff0000u), __uint_as_float(t.y << 16), __uint_as_float(t.y & 0xffff0000u)}; } }
        asm volatile("s_waitcnt vmcnt(0)" ::: "memory");
#pragma unroll
        for (int h = 0; h < 2; ++h) { const int r = r0 + h * NGW; if (r >= R_LAT) continue;
            const float rs = __builtin_amdgcn_rsqf(sv[h] * (1.0f / 1024.0f) + EPS);
            float* xr = p.out + ((size_t)g * R_LAT + r) * D;
            *(f32x4*)(xr + lane * 4) = v[h][0] * rs * gf0; *(f32x4*)(xr + 256 + lane * 4) = v[h][1] * rs * gf1;
            *(f32x4*)(xr + 512 + lane * 4) = v[h][2] * rs * gf2; *(f32x4*)(xr + 768 + lane * 4) = v[h][3] * rs * gf3; }
    }
}

struct ChunkInfo { int row0, pos0, h; };
__device__ __forceinline__ ChunkInfo chunk_info(int item) {
    ChunkInfo ci;
    if (item < N_KV_LAT) { const int gb = item >> 6, ch = item & 15; ci.h = (item >> 4) & 3; ci.row0 = gb * SEQ + ch * 128; ci.pos0 = CTXL + ch * 128; }
    else { const int it2 = item - N_KV_LAT, gb = it2 >> 3, ch = it2 & 1; ci.h = (it2 >> 1) & 3; ci.row0 = R_LAT + gb * CTXL + ch * 128; ci.pos0 = ch * 128; }
    return ci;
}
__device__ __forceinline__ void load_chunk_f32(const int tid, const bf16_t* PM, int row0, int col0, LAS float* dst, int st) {
#pragma unroll
    for (int q = 0; q < 2; ++q) { const int idx = tid + q * NTHREADS, row = idx >> 3, cc = idx & 7; float f[8];
        unpack8(*(const u32x4*)(PM + (size_t)(row0 + row) * PMW + col0 + cc * 8), f);
        *(LAS f32x4*)(dst + row * st + cc * 8) = (f32x4){f[0], f[1], f[2], f[3]}; *(LAS f32x4*)(dst + row * st + cc * 8 + 4) = (f32x4){f[4], f[5], f[6], f[7]}; }
}
__device__ __forceinline__ void rotary_lds(const int tid, LAS float* buf, int st, int pos0, const float* rc, const float* rsn, float scale) {
#pragma unroll
    for (int q = 0; q < 8; ++q) { const int pidx = tid + q * NTHREADS, row = pidx >> 5, i = pidx & 31;
        const float c = rc[(pos0 + row) * 32 + i], s = rsn[(pos0 + row) * 32 + i];
        const float t1 = buf[row * st + i], t2 = buf[row * st + i + 32];
        buf[row * st + i] = (t1 * c - t2 * s) * scale; buf[row * st + i + 32] = (t1 * s + t2 * c) * scale; }
}

__device__ __forceinline__ void ret_kv_item(const KP& p, LAS unsigned char* lds, int l, int item) {
    int tid = p.tid_; asm volatile("" : "+v"(tid));
    const bf16_t* PM = (const bf16_t*)(p.ws + OFF_BIG);
    const float* rc = (const float*)(p.ws + OFF_ROPE); const float* rsn = rc + 2304 * 32;
    const float* logg = (const float*)(p.ws + OFF_LOGG) + l * 8;
    LAS unsigned char* KfT = lds;
    LAS unsigned char* KbT = lds + 16384;
    LAS unsigned char* Vt = lds + 32768;
    const ChunkInfo ci = chunk_info(item);
    __syncthreads();
    {
        const int row = tid >> 2, pc = tid & 3, pos = ci.pos0 + row;
        const bf16_t* src = PM + (size_t)(ci.row0 + row) * PMW + ci.h * 64;
        const float lgf = logg[ci.h], lgb = logg[4 + ci.h];
        const float wf = 0.125f * __expf(lgf * (float)(127 - row)), wb = 0.125f * __expf(lgb * (float)row);
        float cs[8], sn[8], t1[8], t2[8];
        { const f32x4 c0 = *(const f32x4*)(rc + pos * 32 + pc * 8), c1 = *(const f32x4*)(rc + pos * 32 + pc * 8 + 4), s0 = *(const f32x4*)(rsn + pos * 32 + pc * 8), s1 = *(const f32x4*)(rsn + pos * 32 + pc * 8 + 4);
#pragma unroll
          for (int j = 0; j < 4; ++j) { cs[j] = c0[j]; cs[4 + j] = c1[j]; sn[j] = s0[j]; sn[4 + j] = s1[j]; } }
        unpack8(*(const u32x4*)(src + 256 + pc * 8), t1); unpack8(*(const u32x4*)(src + 256 + 32 + pc * 8), t2);
        const int jo = (row & 7) * 2, jc = row >> 3;
#pragma unroll
        for (int j = 0; j < 8; ++j) {
            const float o1 = t1[j] * cs[j] - t2[j] * sn[j], o2 = t1[j] * sn[j] + t2[j] * cs[j];
            const int d1 = pc * 8 + j, d2 = 32 + pc * 8 + j;
            *(LAS unsigned short*)(KfT + d1 * 256 + ((jc ^ (d1 & 15)) << 4) + jo) = f2bf(o1 * wf); *(LAS unsigned short*)(KfT + d2 * 256 + ((jc ^ (d2 & 15)) << 4) + jo) = f2bf(o2 * wf);
            *(LAS unsigned short*)(KbT + d1 * 256 + ((jc ^ (d1 & 15)) << 4) + jo) = f2bf(o1 * wb); *(LAS unsigned short*)(KbT + d2 * 256 + ((jc ^ (d2 & 15)) << 4) + jo) = f2bf(o2 * wb);
        }
        const u32x4 v0 = *(const u32x4*)(src + 512 + pc * 16), v1 = *(const u32x4*)(src + 512 + pc * 16 + 8);
        const unsigned vv[8] = {v0.x, v0.y, v0.z, v0.w, v1.x, v1.y, v1.z, v1.w};
#pragma unroll
        for (int e2 = 0; e2 < 8; ++e2)
#pragma unroll
            for (int hh = 0; hh < 2; ++hh) { const int e = pc * 16 + e2 * 2 + hh; const unsigned short val = (unsigned short)(hh ? (vv[e2] >> 16) : (vv[e2] & 0xffffu));
                *(LAS unsigned short*)(Vt + e * 256 + ((jc ^ (e & 15)) << 4) + jo) = val; }
    }
    __syncthreads();
    const int w = __builtin_amdgcn_readfirstlane(tid >> 6), lane = tid & 63, c = lane & 15, gq = lane >> 4;
    const int dir = w >> 2, db = w & 3, d = 16 * db + c;
    LAS unsigned char* KT = dir ? KbT : KfT;
    const f32x4 z4 = (f32x4){0.f, 0.f, 0.f, 0.f};
    f32x4 acc[4] = {z4, z4, z4, z4};
#pragma unroll
    for (int t = 0; t < 4; ++t) {
        const bf16x8 af = *(const LAS bf16x8*)(KT + d * 256 + (((4 * t + gq) ^ (d & 15)) << 4));
#pragma unroll
        for (int eb = 0; eb < 4; ++eb) { const int e = 16 * eb + c;
            const bf16x8 bfr = *(const LAS bf16x8*)(Vt + e * 256 + (((4 * t + gq) ^ (e & 15)) << 4));
            acc[eb] = mfma16(af, bfr, acc[eb]); }
    }
    float* kv = (item < N_KV_LAT ? (float*)(p.ws + OFF_KV) + (size_t)item * 8192 : (float*)(p.ws + OFF_KVC) + (size_t)(l * N_KV_CTX + item - N_KV_LAT) * 8192) + dir * 4096;
#pragma unroll
    for (int eb = 0; eb < 4; ++eb)
#pragma unroll
        for (int r = 0; r < 4; ++r) kv[(16 * db + 4 * gq + r) * 64 + 16 * eb + c] = acc[eb][r];
}

__device__ __forceinline__ void ret_out_item(const KP& p, LAS unsigned char* lds, int g, int l, int item) {
    int tid = p.tid_; asm volatile("" : "+v"(tid));
    const bf16_t* PM = (const bf16_t*)(p.ws + OFF_BIG);
    const float* rc = (const float*)(p.ws + OFF_ROPE); const float* rsn = rc + 2304 * 32;
    const float* logg = (const float*)(p.ws + OFF_LOGG) + l * 8;
    LAS unsigned char* Qb = lds;
    LAS unsigned char* Kb = lds + 16384;
    LAS unsigned char* Vt = lds + 32768;
    LAS unsigned char* SfT = lds + 49152;
    LAS unsigned char* SbT = lds + 57344;
    LAS float* dtab = (LAS float*)(lds + 65536);
    const ChunkInfo ci = chunk_info(item);
    __syncthreads();
    {
        const int row = tid >> 2, pc = tid & 3, pos = ci.pos0 + row;
        const bf16_t* src = PM + (size_t)(ci.row0 + row) * PMW + ci.h * 64;
        float cs[8], sn[8];
        { const f32x4 c0 = *(const f32x4*)(rc + pos * 32 + pc * 8), c1 = *(const f32x4*)(rc + pos * 32 + pc * 8 + 4), s0 = *(const f32x4*)(rsn + pos * 32 + pc * 8), s1 = *(const f32x4*)(rsn + pos * 32 + pc * 8 + 4);
#pragma unroll
          for (int j = 0; j < 4; ++j) { cs[j] = c0[j]; cs[4 + j] = c1[j]; sn[j] = s0[j]; sn[4 + j] = s1[j]; } }
#pragma unroll
        for (int qk = 0; qk < 2; ++qk) {
            float t1[8], t2[8], o1[8], o2[8];
            unpack8(*(const u32x4*)(src + qk * 256 + pc * 8), t1); unpack8(*(const u32x4*)(src + qk * 256 + 32 + pc * 8), t2);
            const float sc = qk ? 0.125f : 1.0f;
#pragma unroll
            for (int j = 0; j < 8; ++j) { o1[j] = (t1[j] * cs[j] - t2[j] * sn[j]) * sc; o2[j] = (t1[j] * sn[j] + t2[j] * cs[j]) * sc; }
            LAS unsigned char* dst = (qk ? Kb : Qb) + row * 128;
            *(LAS u32x4*)(dst + ((pc ^ (row & 7)) << 4)) = pack8(o1);
            *(LAS u32x4*)(dst + (((4 + pc) ^ (row & 7)) << 4)) = pack8(o2);
        }
        {
            const u32x4 v0 = *(const u32x4*)(src + 512 + pc * 16), v1 = *(const u32x4*)(src + 512 + pc * 16 + 8);
            const unsigned vv[8] = {v0.x, v0.y, v0.z, v0.w, v1.x, v1.y, v1.z, v1.w};
#pragma unroll
            for (int e2 = 0; e2 < 8; ++e2)
#pragma unroll
                for (int hh = 0; hh < 2; ++hh) { const int e = pc * 16 + e2 * 2 + hh; const unsigned short val = (unsigned short)(hh ? (vv[e2] >> 16) : (vv[e2] & 0xffffu));
                    *(LAS unsigned short*)(Vt + e * 256 + ((((row >> 2) ^ (2 * (e & 15))) << 3)) + (row & 3) * 2) = val; }
        }
        {
            const int d = tid >> 3, e0 = (tid & 7) * 8;
            const float* KV = (const float*)(p.ws + OFF_KV) + d * 64 + e0;
            const float* KVC = (const float*)(p.ws + OFF_KVC) + (size_t)l * N_KV_CTX * 8192 + d * 64 + e0;
            const f32x4 z = (f32x4){0.f, 0.f, 0.f, 0.f};
            f32x4 fa = z, fb = z, ba = z, bb = z;
            if (item < N_KV_LAT) {
                const int ch = item & 15, lat0 = item - ch, c0 = (g * GB + (item >> 6)) * 8 + ci.h * 2;
                const float l128f = logg[ci.h] * 128.f, l128b = logg[4 + ci.h] * 128.f;
#pragma unroll 1
                for (int t0 = 0; t0 < 20; t0 += 10) {
                    f32x4 xa[10], xb[10]; float wt[10]; bool isf[10];
#pragma unroll
                    for (int q = 0; q < 10; ++q) { const int t = t0 + q; const bool fw = t < ch + 2; isf[q] = fw;
                        const int k = fw ? t - 2 : t - (ch + 2) - 2;
                        const float* x; if (fw) x = k < 0 ? KVC + (size_t)(c0 + k + 2) * 8192 : KV + (size_t)(lat0 + k) * 8192;
                        else x = (k < 0 ? KVC + (size_t)(c0 - 1 - k) * 8192 : KV + (size_t)(lat0 + 15 - k) * 8192) + 4096;
                        const bool valid = t < 19; if (!valid) x = KVC;
                        wt[q] = valid ? (fw ? __expf(l128f * (float)(ch - 1 - k)) : __expf(l128b * (float)(14 - ch - k))) : 0.f;
                        xa[q] = *(const f32x4*)x; xb[q] = *(const f32x4*)(x + 4); }
#pragma unroll
                    for (int q = 0; q < 10; ++q) { if (isf[q]) { fa += xa[q] * wt[q]; fb += xb[q] * wt[q]; } else { ba += xa[q] * wt[q]; bb += xb[q] * wt[q]; } }
                }
            } else {
                const int it2 = item - N_KV_LAT, ch = it2 & 1, c0 = it2 - ch;
                if (ch == 1) { const float* x = KVC + (size_t)c0 * 8192; fa = *(const f32x4*)x; fb = *(const f32x4*)(x + 4); }
                else { const float* x = KVC + (size_t)(c0 + 1) * 8192 + 4096; ba = *(const f32x4*)x; bb = *(const f32x4*)(x + 4); }
            }
#pragma unroll
            for (int dir = 0; dir < 2; ++dir) { const f32x4 a = dir ? ba : fa, b = dir ? bb : fb;
                LAS unsigned char* dstT = dir ? SbT : SfT; const float vals[8] = {a[0], a[1], a[2], a[3], b[0], b[1], b[2], b[3]};
#pragma unroll
                for (int jj = 0; jj < 8; ++jj) { const int e = e0 + jj; *(LAS unsigned short*)(dstT + e * 128 + (((d >> 3) ^ (e & 7)) << 4) + (d & 7) * 2) = f2bf(vals[jj]); } }
        }
        const float lgf = logg[ci.h], lgb = logg[4 + ci.h];
        if (tid <= 256) { const int t = tid - 128; dtab[tid] = t > 0 ? __expf(lgf * (float)t) : (t < 0 ? __expf(lgb * (float)(-t)) : 2.0f); }
    }
    __syncthreads();
    const int w = __builtin_amdgcn_readfirstlane(tid >> 6), lane = tid & 63, c = lane & 15, gq = lane >> 4;
    const int il = 16 * w + c;
    f32x4 g4v[4]; u32x2 grv[4];
    { const float* gn_ = p.in(I_ret_gn) + l * 256 + ci.h * 64; const bf16_t* gsrc_ = PM + (size_t)(ci.row0 + il) * PMW + 768 + ci.h * 64;
#pragma unroll
      for (int eb = 0; eb < 4; ++eb) { g4v[eb] = *(const f32x4*)(gn_ + 16 * eb + 4 * gq); grv[eb] = *(const u32x2*)(gsrc_ + 16 * eb + 4 * gq); } }
    bf16x8 qf[2];
#pragma unroll
    for (int ks = 0; ks < 2; ++ks) qf[ks] = *(const LAS bf16x8*)(Qb + il * 128 + (((4 * ks + gq) ^ (il & 7)) << 4));
    const f32x4 z4 = (f32x4){0.f, 0.f, 0.f, 0.f};
    f32x4 st[8];
#pragma unroll
    for (int jb = 0; jb < 8; ++jb) { const int j = 16 * jb + c;
        const bf16x8 k0 = *(const LAS bf16x8*)(Kb + j * 128 + (((0 + gq) ^ (j & 7)) << 4)), k1 = *(const LAS bf16x8*)(Kb + j * 128 + (((4 + gq) ^ (j & 7)) << 4));
        st[jb] = mfma16(k0, qf[0], z4); st[jb] = mfma16(k1, qf[1], st[jb]); }
#pragma unroll
    for (int jb = 0; jb < 8; ++jb)
#pragma unroll
        for (int r = 0; r < 4; ++r) st[jb][r] *= dtab[128 + il - (16 * jb + 4 * gq + r)];
    f32x4 oT[4], cf[4], cb[4];
#pragma unroll
    for (int eb = 0; eb < 4; ++eb) { oT[eb] = z4; cf[eb] = z4; cb[eb] = z4; }
#pragma unroll
    for (int t = 0; t < 4; ++t) {
        union { u32x4 u; bf16x8 v; } pk;
        pk.u.x = cvt_pk_bf16(st[2 * t][0], st[2 * t][1]); pk.u.y = cvt_pk_bf16(st[2 * t][2], st[2 * t][3]);
        pk.u.z = cvt_pk_bf16(st[2 * t + 1][0], st[2 * t + 1][1]); pk.u.w = cvt_pk_bf16(st[2 * t + 1][2], st[2 * t + 1][3]);
#pragma unroll
        for (int eb = 0; eb < 4; ++eb) { const int e = 16 * eb + c;
            union { u32x4 u; bf16x8 v; } va;
            const u32x2 lo = *(const LAS u32x2*)(Vt + e * 256 + (((8 * t + gq) ^ (2 * (e & 15))) << 3)), hi = *(const LAS u32x2*)(Vt + e * 256 + (((8 * t + 4 + gq) ^ (2 * (e & 15))) << 3));
            va.u.x = lo.x; va.u.y = lo.y; va.u.z = hi.x; va.u.w = hi.y;
            oT[eb] = mfma16(va.v, pk.v, oT[eb]); }
    }
#pragma unroll
    for (int eb = 0; eb < 4; ++eb) { const int e = 16 * eb + c;
#pragma unroll
        for (int ks = 0; ks < 2; ++ks) {
            const bf16x8 af = *(const LAS bf16x8*)(SfT + e * 128 + (((4 * ks + gq) ^ (e & 7)) << 4)), ab = *(const LAS bf16x8*)(SbT + e * 128 + (((4 * ks + gq) ^ (e & 7)) << 4));
            cf[eb] = mfma16(af, qf[ks], cf[eb]); cb[eb] = mfma16(ab, qf[ks], cb[eb]); } }
    const float wqf = dtab[128 + il + 1], wqb = dtab[il];
    float o[16]; float sm = 0.f;
#pragma unroll
    for (int eb = 0; eb < 4; ++eb)
#pragma unroll
        for (int r = 0; r < 4; ++r) { o[eb * 4 + r] = oT[eb][r] + wqf * cf[eb][r] + wqb * cb[eb][r]; sm += o[eb * 4 + r]; }
    sm += shx(sm, 16, lane); sm += shx(sm, 32, lane);
    const float mean = sm * (1.0f / 64.0f);
    float vq = 0.f;
#pragma unroll
    for (int e = 0; e < 16; ++e) { o[e] -= mean; vq += o[e] * o[e]; }
    vq += shx(vq, 16, lane); vq += shx(vq, 32, lane);
    const float rstd = __builtin_amdgcn_rsqf(vq * (1.0f / 64.0f) + EPS);
    bf16_t* S = (bf16_t*)(p.ws + OFF_S) + (size_t)(ci.row0 + il) * D + ci.h * 64;
#pragma unroll
    for (int eb = 0; eb < 4; ++eb) { const int e0 = 16 * eb + 4 * gq;
        const f32x4 g4 = g4v[eb]; const u32x2 gr = grv[eb];
        const float g0 = bf2f(gr.x & 0xffffu), g1 = __uint_as_float(gr.x & 0xffff0000u), g2 = bf2f(gr.y & 0xffffu), g3 = __uint_as_float(gr.y & 0xffff0000u);
        u32x2 wv; wv.x = cvt_pk_bf16(o[eb * 4 + 0] * rstd * g4[0] * siluf_(g0), o[eb * 4 + 1] * rstd * g4[1] * siluf_(g1));
        wv.y = cvt_pk_bf16(o[eb * 4 + 2] * rstd * g4[2] * siluf_(g2), o[eb * 4 + 3] * rstd * g4[3] * siluf_(g3));
        *(u32x2*)(S + e0) = wv; }
}

__device__ __forceinline__ void conf_item(const KP& p, LAS unsigned char* lds, int l, int item) {
    int tid = p.tid_; asm volatile("" : "+v"(tid)); const int wave = tid >> 6, lane = tid & 63;
    const bf16_t* PM = (const bf16_t*)(p.ws + OFF_BIG);
    LAS float* hbuf = (LAS float*)lds;
    LAS float* ybuf = (LAS float*)(lds + 65536);
    int seqrow0, L, n0;
    if (item < R_LAT / 32) { seqrow0 = (item >> 6) * SEQ; L = SEQ; n0 = (item & 63) * 32; }
    else { const int it2 = item - R_LAT / 32; seqrow0 = R_LAT + (it2 >> 3) * CTXL; L = CTXL; n0 = (it2 & 7) * 32; }
    __syncthreads();
    {
        u32x4 a1[4], a2[4]; bool ok[4];
#pragma unroll
        for (int q = 0; q < 4; ++q) { const int idx = tid + q * NTHREADS, hr = idx >> 5, cc = idx & 31, tok = n0 - 15 + hr;
            ok[q] = idx < 62 * 32 && tok >= 0 && tok < L;
            const bf16_t* src = PM + (size_t)(seqrow0 + (ok[q] ? tok : n0)) * PMW + 1024 + cc * 8;
            a1[q] = *(const u32x4*)src; a2[q] = *(const u32x4*)(src + 256); }
#pragma unroll
        for (int q = 0; q < 4; ++q) { const int idx = tid + q * NTHREADS, hr = idx >> 5, cc = idx & 31;
            if (idx < 62 * 32) { float x1[8], x2[8], hv[8]; unpack8(a1[q], x1); unpack8(a2[q], x2);
#pragma unroll
                for (int j = 0; j < 8; ++j) hv[j] = ok[q] ? x1[j] * sigmoidf_(x2[j]) : 0.f;
                *(LAS f32x4*)(hbuf + hr * 256 + cc * 8) = (f32x4){hv[0], hv[1], hv[2], hv[3]}; *(LAS f32x4*)(hbuf + hr * 256 + cc * 8 + 4) = (f32x4){hv[4], hv[5], hv[6], hv[7]}; } }
    }
    __syncthreads();
    { const int c = tid & 255, q = tid >> 8;
      float w[31], xw[46];
#pragma unroll
      for (int j = 0; j < 31; ++j) w[j] = p.in(I_conv_dw)[((size_t)l * 31 + j) * 256 + c];
      const float bias = p.in(I_conv_db)[l * 256 + c];
#pragma unroll
      for (int j = 0; j < 46; ++j) xw[j] = hbuf[(q * 16 + j) * 256 + c];
#pragma unroll
      for (int tt = 0; tt < 16; ++tt) { float y = bias;
#pragma unroll
          for (int j = 0; j < 31; ++j) y += w[j] * xw[tt + j];
          ybuf[(q * 16 + tt) * 256 + c] = y; } }
    __syncthreads();
    { const f32x4 lg = *(const f32x4*)(p.in(I_conv_ln_g) + l * 256 + lane * 4), lb = *(const f32x4*)(p.in(I_conv_ln_b) + l * 256 + lane * 4);
      bf16_t* S = (bf16_t*)(p.ws + OFF_S);
#pragma unroll
      for (int t4 = 0; t4 < 4; ++t4) { const int tt = wave * 4 + t4;
          f32x4 v = *(const LAS f32x4*)(ybuf + tt * 256 + lane * 4);
          const float mean = wave_sum((v[0] + v[1]) + (v[2] + v[3]), lane) * (1.0f / 256.0f);
          v = v - mean;
          const float var = wave_sum((v[0] * v[0] + v[1] * v[1]) + (v[2] * v[2] + v[3] * v[3]), lane) * (1.0f / 256.0f);
          const float rstd = __builtin_amdgcn_rsqf(var + EPS);
          f32x4 y = v * rstd * lg + lb;
#pragma unroll
          for (int j = 0; j < 4; ++j) y[j] = siluf_(y[j]);
          u32x2 w2; w2.x = cvt_pk_bf16(y[0], y[1]); w2.y = cvt_pk_bf16(y[2], y[3]);
          *(u32x2*)(S + (size_t)(seqrow0 + n0 + tt) * D + 256 + lane * 4) = w2; } }
}

__device__ __forceinline__ void gmlp_item(const KP& p, LAS unsigned char* lds, int l, int item) {
    int tid = p.tid_; asm volatile("" : "+v"(tid)); const int wave = __builtin_amdgcn_readfirstlane(tid >> 6), lane = tid & 63;
    const bf16_t* PM = (const bf16_t*)(p.ws + OFF_BIG);
    LAS unsigned char* vT = lds;
    const int row0 = item * 128;
    __syncthreads();
    { const f32x4 lg = *(const f32x4*)(p.in(I_gmlp_ln_g) + l * 256 + lane * 4), lb = *(const f32x4*)(p.in(I_gmlp_ln_b) + l * 256 + lane * 4);
      u32x2 zz[16];
#pragma unroll
      for (int t16 = 0; t16 < 16; ++t16) zz[t16] = *(const u32x2*)(PM + (size_t)(row0 + wave * 16 + t16) * PMW + 1792 + lane * 4);
#pragma unroll
      for (int t16 = 0; t16 < 16; ++t16) { const int tt = wave * 16 + t16;
          f32x4 v = (f32x4){geluf_(bf2f(zz[t16].x & 0xffffu)), geluf_(__uint_as_float(zz[t16].x & 0xffff0000u)), geluf_(bf2f(zz[t16].y & 0xffffu)), geluf_(__uint_as_float(zz[t16].y & 0xffff0000u))};
          const float mean = wave_sum((v[0] + v[1]) + (v[2] + v[3]), lane) * (1.0f / 256.0f);
          v = v - mean;
          const float var = wave_sum((v[0] * v[0] + v[1] * v[1]) + (v[2] * v[2] + v[3] * v[3]), lane) * (1.0f / 256.0f);
          const float rstd = __builtin_amdgcn_rsqf(var + EPS);
          v = v * rstd * lg + lb;
          const int jc = tt >> 3, jo = (tt & 7) * 2;
#pragma unroll
          for (int q = 0; q < 4; ++q) { const int cc = lane * 4 + q; *(LAS unsigned short*)(vT + cc * 256 + ((jc ^ (cc & 15)) << 4) + jo) = f2bf(v[q]); } } }
    __syncthreads();
    const int c = lane & 15, gq = lane >> 4, gw = wave & 3, ih = wave >> 2;
    const float* wsr = p.in(I_gmlp_ws) + (((size_t)l * 4 + gw) * 128 + ih * 64) * 128 + (size_t)c * 128 + 8 * gq;
    const f32x4 z4 = (f32x4){0.f, 0.f, 0.f, 0.f};
    f32x4 acc[4][4];
#pragma unroll
    for (int ib = 0; ib < 4; ++ib)
#pragma unroll
        for (int cb = 0; cb < 4; ++cb) acc[ib][cb] = z4;
    f32x4 wa[4][2], wb[4][2];
#pragma unroll
    for (int ib = 0; ib < 4; ++ib) { wa[ib][0] = *(const f32x4*)(wsr + ib * 16 * 128); wa[ib][1] = *(const f32x4*)(wsr + ib * 16 * 128 + 4); }
#pragma unroll
    for (int t = 0; t < 4; ++t) {
        if (t < 3) {
#pragma unroll
            for (int ib = 0; ib < 4; ++ib) { wb[ib][0] = *(const f32x4*)(wsr + ib * 16 * 128 + 32 * (t + 1)); wb[ib][1] = *(const f32x4*)(wsr + ib * 16 * 128 + 32 * (t + 1) + 4); } }
        bf16x8 bfr[4];
#pragma unroll
        for (int cb = 0; cb < 4; ++cb) { const int cc = 64 * gw + 16 * cb + c; bfr[cb] = *(const LAS bf16x8*)(vT + cc * 256 + (((4 * t + gq) ^ (cc & 15)) << 4)); }
#pragma unroll
        for (int ib = 0; ib < 4; ++ib) {
            union { u32x4 u; bf16x8 v; } af;
            af.u.x = cvt_pk_bf16(wa[ib][0][0], wa[ib][0][1]); af.u.y = cvt_pk_bf16(wa[ib][0][2], wa[ib][0][3]); af.u.z = cvt_pk_bf16(wa[ib][1][0], wa[ib][1][1]); af.u.w = cvt_pk_bf16(wa[ib][1][2], wa[ib][1][3]);
#pragma unroll
            for (int cb = 0; cb < 4; ++cb) acc[ib][cb] = mfma16(af.v, bfr[cb], acc[ib][cb]);
        }
#pragma unroll
        for (int ib = 0; ib < 4; ++ib) { wa[ib][0] = wb[ib][0]; wa[ib][1] = wb[ib][1]; }
    }
    const float* bs = p.in(I_gmlp_bs) + ((size_t)l * 4 + gw) * 128 + ih * 64;
    bf16_t* S = (bf16_t*)(p.ws + OFF_S);
#pragma unroll
    for (int ib = 0; ib < 4; ++ib) {
        unsigned short uu[4][4]; float bsv[4];
#pragma unroll
        for (int r = 0; r < 4; ++r) { const int il = 16 * ib + 4 * gq + r; bsv[r] = bs[il];
#pragma unroll
            for (int cb = 0; cb < 4; ++cb) uu[r][cb] = PM[(size_t)(row0 + ih * 64 + il) * PMW + 1536 + 64 * gw + 16 * cb + c]; }
#pragma unroll
        for (int r = 0; r < 4; ++r) { const int i = ih * 64 + 16 * ib + 4 * gq + r;
#pragma unroll
            for (int cb = 0; cb < 4; ++cb) S[(size_t)(row0 + i) * D + 512 + 64 * gw + 16 * cb + c] = f2bf(geluf_(bf2f(uu[r][cb])) * (acc[ib][cb][r] + bsv[r])); }
    }
}

__device__ __forceinline__ void fnet_t_item(const KP& p, LAS unsigned char* lds, int item) {
    int tid = p.tid_; asm volatile("" : "+v"(tid));
    const bf16_t* PM = (const bf16_t*)(p.ws + OFF_BIG);
    LAS float* T = (LAS float*)lds;
    int seqrow0, L, s_local, cblk, kb; bf16_t* dstbase;
    if (item < GB * 4 * 16) { s_local = item >> 6; cblk = (item >> 4) & 3; kb = item & 15; L = SEQ; seqrow0 = s_local * SEQ; dstbase = (bf16_t*)(p.ws + OFF_PQT); }
    else { const int it2 = item - GB * 4 * 16; s_local = it2 >> 3; cblk = (it2 >> 1) & 3; kb = it2 & 1; L = CTXL; seqrow0 = R_LAT + s_local * CTXL; dstbase = (bf16_t*)(p.ws + OFF_PQTC); }
    __syncthreads();
    for (int idx = tid; idx < 4 * 64 * 8; idx += NTHREADS) { const int which = idx >> 9, r = (idx >> 3) & 63, cc = idx & 7, k = kb * 64 + r;
        const int tok = (which & 1) ? (L - k) : k; const int col = (which < 2 ? 2048 : 2304) + cblk * 64 + cc * 8; float f[8];
        if (tok < L) unpack8(*(const u32x4*)(PM + (size_t)(seqrow0 + tok) * PMW + col), f);
        else {
#pragma unroll
            for (int j = 0; j < 8; ++j) f[j] = 0.f; }
#pragma unroll
        for (int j = 0; j < 8; ++j) T[(which * 64 + r) * 65 + cc * 8 + j] = f[j]; }
    __syncthreads();
    const int c = tid >> 3, kq = tid & 7;
    float pe[8], qo[8];
#pragma unroll
    for (int e = 0; e < 8; ++e) { const int kl = kq * 8 + e; pe[e] = T[(0 * 64 + kl) * 65 + c] + T[(1 * 64 + kl) * 65 + c]; qo[e] = T[(2 * 64 + kl) * 65 + c] - T[(3 * 64 + kl) * 65 + c]; }
    if (kb == 0 && kq == 0) qo[0] = bf2f(PM[(size_t)(seqrow0 + L / 2) * PMW + 2048 + cblk * 64 + c]);
    bf16_t* dst = dstbase + (size_t)(s_local * 256 + cblk * 64 + c) * L;
    *(u32x4*)(dst + kb * 64 + kq * 8) = pack8(pe);
    *(u32x4*)(dst + L / 2 + kb * 64 + kq * 8) = pack8(qo);
}

__device__ __forceinline__ u32x4 ld8p(const bf16_t* p, bool ok) { return ok ? *(const u32x4*)p : (u32x4){0u, 0u, 0u, 0u}; }
__device__ __forceinline__ void fma8(float* y, const u32x4 a, const float* w) { float f[8]; unpack8(a, f);
#pragma unroll
    for (int j = 0; j < 8; ++j) y[j] += f[j] * w[j]; }
__device__ __forceinline__ void phase_ffn_conv(const KP& p, int g, int l, int parts, int b0, int nb, int halves) {
    int tid = p.tid_; asm volatile("" : "+v"(tid));
    if (parts & 1) { float* ssA = (float*)(p.ws + ssa_off(g)); for (int i = p.bx_ * NTHREADS + tid; i < R; i += NBLK * NTHREADS) ssA[i] = 0.f; }
    if (tid >= 352 || p.bx_ < b0 || p.bx_ >= b0 + nb) return;
    bf16_t* UP = (bf16_t*)(p.ws + OFF_BIG);
    const int c8 = tid * 8, G = nb, bx = p.bx_ - b0;
    const float* dw = p.in(I_ffn_dw) + (size_t)l * 9 * DFF + c8; const float* db = p.in(I_ffn_db) + (size_t)l * DFF + c8;
    float w[9][8], bias[8];
#pragma unroll
    for (int k = 0; k < 9; ++k) { const f32x4 w0 = *(const f32x4*)(dw + k * DFF), w1 = *(const f32x4*)(dw + k * DFF + 4);
#pragma unroll
        for (int j = 0; j < 4; ++j) { w[k][j] = w0[j]; w[k][4 + j] = w1[j]; } }
    { const f32x4 b0 = *(const f32x4*)db, b1 = *(const f32x4*)(db + 4);
#pragma unroll
      for (int j = 0; j < 4; ++j) { bias[j] = b0[j]; bias[4 + j] = b1[j]; } }
    if (parts & 2)
    for (int it0 = bx; it0 < GB * 32 * halves; it0 += G) {
        const int rid0 = it0 / halves, hf = it0 - rid0 * halves;
        const int rid = (G == 256 && halves == 1) ? ((rid0 & 7) * 32 + (rid0 >> 3)) : rid0;
        const int gb = rid >> 5, gr = rid & 31;
        const int c_lo = hf * (64 / halves), c_hi = c_lo + 64 / halves;
        const bool up = gr > 0, dn = gr < 31;
        const bf16_t* a1 = UP + (size_t)(gb * SEQ + gr * 64 + c_lo) * UPW + c8;
        const bf16_t* a0 = a1 - (size_t)64 * UPW; const bf16_t* a2 = a1 + (size_t)64 * UPW;
        const bool lf = c_lo > 0;
        u32x4 L0 = ld8p(a0 - UPW, up && lf), L1 = ld8p(a1 - UPW, lf), L2 = ld8p(a2 - UPW, dn && lf), M0 = ld8p(a0, up), M1 = ld8p(a1, true), M2 = ld8p(a2, dn);
        u32x4 R0 = ld8p(a0 + UPW, up), R1 = ld8p(a1 + UPW, true), R2 = ld8p(a2 + UPW, dn);
        bf16_t* hp = UP + (size_t)(gb * SEQ + gr * 64 + c_lo) * UPW + DFF + c8;
        u32x4 bq = *(const u32x4*)hp;
#pragma unroll 1
        for (int gc = c_lo; gc < c_hi; ++gc) {
            const bool nt2 = gc < 62; const size_t o = (size_t)(gc - c_lo + 2) * UPW;
            const u32x4 N0 = ld8p(a0 + o, up && nt2), N1 = ld8p(a1 + o, nt2), N2 = ld8p(a2 + o, dn && nt2);
            const u32x4 bn = ld8p(hp + UPW, gc < 63);
            float y[8];
#pragma unroll
            for (int j = 0; j < 8; ++j) y[j] = bias[j];
            fma8(y, L0, w[0]); fma8(y, M0, w[1]); fma8(y, R0, w[2]);
            fma8(y, L1, w[3]); fma8(y, M1, w[4]); fma8(y, R1, w[5]);
            fma8(y, L2, w[6]); fma8(y, M2, w[7]); fma8(y, R2, w[8]);
            float bv[8]; unpack8(bq, bv);
#pragma unroll
            for (int j = 0; j < 8; ++j) y[j] = siluf_(y[j]) * bv[j];
            *(u32x4*)hp = pack8(y);
            L0 = M0; L1 = M1; L2 = M2; M0 = R0; M1 = R1; M2 = R2; R0 = N0; R1 = N1; R2 = N2; bq = bn; hp += UPW;
        }
    }
    if (parts & 4) {
        for (int it = bx; it < R_CTX / 8; it += G) {
            const int s_ = it >> 5, t0 = (it & 31) * 8;
            const bf16_t* a = UP + (size_t)(R_LAT + s_ * CTXL + t0) * UPW + c8;
            u32x4 Lq = ld8p(a - UPW, t0 > 0), Mq = ld8p(a, true);
#pragma unroll 1
            for (int t = 0; t < 8; ++t) {
                const u32x4 Rq = ld8p(a + (size_t)(t + 1) * UPW, t0 + t + 1 < CTXL);
                bf16_t* hp = UP + (size_t)(R_LAT + s_ * CTXL + t0 + t) * UPW + DFF + c8;
                const u32x4 bq = *(const u32x4*)hp;
                float y[8];
#pragma unroll
                for (int j = 0; j < 8; ++j) y[j] = bias[j];
                fma8(y, Lq, w[3]); fma8(y, Mq, w[4]); fma8(y, Rq, w[5]);
                float bv[8]; unpack8(bq, bv);
#pragma unroll
                for (int j = 0; j < 8; ++j) y[j] = siluf_(y[j]) * bv[j];
                *(u32x4*)hp = pack8(y);
                Lq = Mq; Mq = Rq;
            }
        }
    }
}

#ifndef DUP_LP
#define DUP_LP 0
#endif

__device__ __forceinline__ unsigned wl_off(int l) { return (unsigned)OFF_W + (unsigned)l * (unsigned)W_LAYER; }
__device__ __forceinline__ unsigned mod_off(int l) { return (unsigned)OFF_MOD + (unsigned)l * (unsigned)(17 * 6144 * 4); }

__device__ __forceinline__ void ph_l1(const KP& p, LAS unsigned char* lds, int g, int l) {
    unsigned char* ws = p.ws; const bool ctx_full = (g == 0 && l == 0);
    pg8::TileSched S{}; S.G = NBLK; S.c = p.bx_; S.nseg = 1;
    S.n1M = NLT; S.n1N = NCOLS / 256; S.n2M = g == 0 ? NCT : 0; S.n2N = ctx_full ? NCOLS / 256 : 2; S.pn2_0 = ctx_full ? 0 : 1;
    S.A = ap_off(g); S.B = (unsigned)(wl_off(l) + (unsigned)W_IN); S.a_tstep = (unsigned)256 * D * 2; S.b_tstep = (unsigned)256 * D * 2;
    EpiWin E{(const float*)(ws + ssa_off(g)), (const float*)(ws + (unsigned)OFF_SHW1 + (unsigned)l * (unsigned)(17 * NCOLS * 4)), p.in(I_b_gate) + (size_t)l * GTW, (bf16_t*)(ws + OFF_BIG), (bf16_t*)(ws + OFF_GT), g};
    pg8::gemm_phase(lds, p.ws, p.tid_, D, D, D, true, S, E);
}
__device__ __forceinline__ void ph_l2(const KP& p, LAS unsigned char* lds, int g, int l) {
    const bool ctx_full = (g == 0 && l == 0); const int G = NBLK;
    const int n_kv = g == 0 ? N_KV : N_KV_LAT, n_conf = (ctx_full ? R : R_LAT) / 32, n_gm = (ctx_full ? R : R_LAT) / 128, n_fn = GB * 4 * 16 + (ctx_full ? NB * 4 * 2 : 0);
    const int total = n_kv + n_conf + n_gm + n_fn;
    { float* ssB = (float*)(p.ws + ssb_off(g)); for (int i = p.bx_ * NTHREADS + p.tid_; i < R; i += G * NTHREADS) ssB[i] = 0.f; }
    const int bx = p.bx_, n_small = total - n_gm, nb2 = G - n_gm, head = (nb2 > 0 && 7 * nb2 < n_small) ? 7 * nb2 : 0;
#define L2_SMALL(t_) do { int t = (t_); if (t < n_kv) ret_kv_item(p, lds, l, t); else if ((t -= n_kv) < n_fn) fnet_t_item(p, lds, t); else conf_item(p, lds, l, t - n_fn); } while (0)
    if (bx < n_gm) gmlp_item(p, lds, l, bx);
    else if (head) { for (int r7 = 0; r7 < 7; ++r7) L2_SMALL(r7 * nb2 + (bx - n_gm)); }
    for (int t2 = head + bx; t2 < n_small; t2 += G) L2_SMALL(t2);
#undef L2_SMALL
    __syncthreads();
}
__device__ __forceinline__ void ph_l3(const KP& p, LAS unsigned char* lds, int g, int l) {
    unsigned char* ws = p.ws; const bool ctx_full = (g == 0 && l == 0); const int G = NBLK, bx = p.bx_;
    const int nd = 64 + (ctx_full ? NB : 0);
    if (bx < nd) {
        const bool isc = bx >= 64;
        const int Kd = isc ? CTXL : SEQ;
        pg8::TileSched S{}; S.G = G; S.nseg = 1;
        S.n1M = isc ? 1 : 8; S.n1N = isc ? NB : GB; S.c = isc ? bx - 64 : bx;
        S.A = (unsigned)((isc ? OFF_DC : OFF_DM)); S.B = (unsigned)((isc ? OFF_PQTC : OFF_PQT)); S.a_tstep = (unsigned)256 * Kd * 2; S.b_tstep = (unsigned)256 * Kd * 2;
        EpiDft E{(bf16_t*)(ws + OFF_S), isc ? R_LAT : 0, Kd, isc ? 0.0625f : 0.02209708691207961f};
        pg8::gemm_phase(lds, p.ws, p.tid_, Kd, Kd, Kd, true, S, E);
    } else {
        const int n = ctx_full ? N_KV : N_KV_LAT;
        for (int it = bx - nd; it < n; it += G - nd) ret_out_item(p, lds, g, l, it);
        __syncthreads();
    }
}
__device__ __forceinline__ void ph_l5(const KP& p, LAS unsigned char* lds, int g, int l) {
    unsigned char* ws = p.ws; const bool ctx_full = (g == 0 && l == 0);
    pg8::TileSched S{}; S.G = NBLK; S.c = p.bx_; S.nseg = 4;
    S.n1M = NLT; S.n1N = 4; S.n2M = ctx_full ? NCT : 0; S.n2N = 4;
    S.A = (unsigned)(OFF_S); S.B = (unsigned)(wl_off(l) + (unsigned)W_O); S.a_tstep = (unsigned)256 * D * 2; S.b_tstep = (unsigned)256 * 256 * 2; S.a_segstep = (unsigned)256 * 2; S.b_segstep = (unsigned)1024 * 256 * 2;
    EpiMerge E{(const unsigned char*)(ws + OFF_GT), (bf16_t*)(ws + OFF_BIG)};
    pg8::gemm_phase(lds, p.ws, p.tid_, 256, D, 256, true, S, E);
}
__device__ __forceinline__ void ph_l6(const KP& p, LAS unsigned char* lds, int g, int l) {
    unsigned char* ws = p.ws; const bool ctx_full = (g == 0 && l == 0);
    pg8::TileSched S{}; S.G = NBLK; S.c = p.bx_; S.nseg = 1;
    S.n1M = NLT; S.n1N = 4; S.n2M = ctx_full ? NCT : 0; S.n2N = 4;
    S.A = (unsigned)(OFF_BIG); S.B = (unsigned)(wl_off(l) + (unsigned)W_OUT); S.a_tstep = (unsigned)256 * D * 2; S.b_tstep = (unsigned)256 * D * 2;
    EpiResid E{l == 0 ? p.in(I_x) : nullptr, l == 0 ? p.in(I_ctx) : nullptr, (bf16_t*)p.out, (bf16_t*)(ws + OFF_XC),
               (const float*)(ws + mod_off(l) + 2 * 4096), (const float*)(ws + mod_off(l) + 4 * 4096), (bf16_t*)(ws + ap_off(g)), (float*)(ws + ssb_off(g)), g};
    pg8::gemm_phase(lds, p.ws, p.tid_, D, D, D, true, S, E);
}
__device__ __forceinline__ void ph_l7(const KP& p, LAS unsigned char* lds, int g, int l) {
    unsigned char* ws = p.ws; const bool ctx_full = (g == 0 && l == 0);
    pg8::TileSched S{}; S.G = NBLK; S.c = p.bx_; S.nseg = 1;
    S.n1M = NLT; S.n1N = UPW / 256; S.n2M = ctx_full ? NCT : 0; S.n2N = UPW / 256;
    S.A = ap_off(g); S.B = (unsigned)(wl_off(l) + (unsigned)W_UP); S.a_tstep = (unsigned)256 * D * 2; S.b_tstep = (unsigned)256 * D * 2;
    EpiUp E{(const float*)(ws + ssb_off(g)), (const float*)(ws + (unsigned)OFF_SHW2 + (unsigned)l * (unsigned)(17 * UPW * 4)), (bf16_t*)(ws + OFF_BIG), g};
    pg8::gemm_phase(lds, p.ws, p.tid_, D, D, D, true, S, E);
}
__device__ __forceinline__ void ph_l9(const KP& p, LAS unsigned char* lds, int g, int l, int which = 0) {
    unsigned char* ws = p.ws; const bool ctx_full = (g == 0 && l == 0);
    pg8::TileSched S{}; S.G = NBLK; S.c = p.bx_; S.nseg = 1;
    S.n1M = which == 2 ? 0 : NLT; S.n1N = 4; S.n2M = (ctx_full && which != 1) ? NCT : 0; S.n2N = 4;
    if (which == 2) S.pm2_x = NLT;
    S.A = (unsigned)OFF_BIG + (unsigned)DFF * 2u; S.B = (unsigned)(wl_off(l) + (unsigned)W_DN); S.a_tstep = (unsigned)256 * UPW * 2; S.b_tstep = (unsigned)256 * DFF * 2;
    EpiResid E{nullptr, nullptr, (bf16_t*)p.out, (bf16_t*)(ws + OFF_XC), (const float*)(ws + mod_off(l) + 5 * 4096),
               l == 0 ? (const float*)(ws + mod_off(1) + 4096) : nullptr, (bf16_t*)(ws + ap_off(g)), (float*)(ws + ssa_off(g)), g};
    pg8::gemm_phase(lds, p.ws, p.tid_, DFF, UPW, DFF, true, S, E);
}

__global__ void __launch_bounds__(NTHREADS) mega(KArgs a) {
    extern __shared__ __attribute__((aligned(16))) unsigned char lds_raw[];
    LAS unsigned char* lds = (LAS unsigned char*)lds_raw;
    volatile LAS unsigned* misc = (volatile LAS unsigned*)(lds + MISC_OFF);
    if (threadIdx.x < 64) misc[threadIdx.x] = 0u;
    if (threadIdx.x < 30) { const unsigned long long v = (unsigned long long)a.in[threadIdx.x]; LAS unsigned* t = (LAS unsigned*)(lds + PTAB_OFF) + 2 * threadIdx.x; t[0] = (unsigned)v; t[1] = (unsigned)(v >> 32); }
    __syncthreads();
    const int wid_s = __builtin_amdgcn_readfirstlane((int)(threadIdx.x >> 6));
    cg::grid_group grid = cg::this_grid();
    XcdBarrier xb = xcd_barrier_post((unsigned*)(a.ws + OFF_BAR), misc + 8);
    grid.sync();
#define MK_Q() KP q; { int w_ = wid_s, b_ = blockIdx.x; unsigned z_ = 0u; asm volatile("" : "+s"(w_), "+s"(b_), "+s"(z_)); int t_ = (w_ << 6) | (int)__builtin_amdgcn_mbcnt_hi(~0u, __builtin_amdgcn_mbcnt_lo(~0u, z_)); asm volatile("" : "+v"(t_)); q.tid_ = t_; q.bx_ = b_; q.ws = a.ws + z_; q.out = a.out + z_; q.ldsb = lds; q.ptab = lds + PTAB_OFF + z_; }
#define PHASE(call) do { MK_Q(); call; xcd_barrier(xb); } while (0)
    PHASE(phase_prep_a(q, lds));
    PHASE(phase_prep_b(q));
    PHASE(phase_prep_c(q, lds, 0, 1, 0, NBLK); phase_g0(q, 0, 0, NBLK));
    for (int g = 0; g < NG; ++g) {
        for (int l = 0; l < 2; ++l) {
            { MK_Q(); ph_l1(q, lds, g, l); }
            PHASE(if (g == 0 && l == 0) weight_prep(q, lds, 1, 2, 32, NBLK - 32);
                  if (g == 1 && l == 0) phase_final(q, 0, 128, NBLK - 128));
            if (DUP_LP == 1) PHASE(ph_l1(q, lds, g, l));
            PHASE(ph_l2(q, lds, g, l));
            if (DUP_LP == 2) PHASE(ph_l2(q, lds, g, l));
            PHASE(ph_l3(q, lds, g, l));
            if (DUP_LP == 3) PHASE(ph_l3(q, lds, g, l));
            PHASE(ph_l5(q, lds, g, l); if (g == 0 && l == 0) phase_prep_c(q, lds, 1, 2, 64, NBLK - 64));
            if (DUP_LP == 5) PHASE(ph_l5(q, lds, g, l));
            PHASE(ph_l6(q, lds, g, l); if (g == 0 && l == 0) phase_g0(q, 1, 64, NBLK - 64));
            PHASE(ph_l7(q, lds, g, l));
            if (DUP_LP == 7) PHASE(ph_l7(q, lds, g, l));
            if (g == 0 && l == 0) {
                PHASE(phase_ffn_conv(q, g, l, 1 | 4, 0, NBLK, 1));
                PHASE(ph_l9(q, lds, g, l, 2); phase_ffn_conv(q, g, l, 2, 64, NBLK - 64, 4));
                PHASE(ph_l9(q, lds, g, l, 1));
            } else {
                PHASE(phase_ffn_conv(q, g, l, 1 | 2, 0, NBLK, 1));
                PHASE(ph_l9(q, lds, g, l));
            }
        }
        if (g == NG - 1) { MK_Q(); phase_final(q, g, 0, NBLK); }
    }
#undef PHASE
#undef MK_Q
}

extern "C" void kernel_launch(void* const* d_in, const int* in_sizes, int n_in, void* d_out, int out_size, void* d_ws, size_t ws_size, hipStream_t stream) {
    static int grid = 0;
    if (grid == 0) {
        int dev = 0, cus = 0, per_cu = 0;
        (void)hipGetDevice(&dev);
        (void)hipDeviceGetAttribute(&cus, hipDeviceAttributeMultiprocessorCount, dev);
        (void)hipFuncSetAttribute((const void*)mega, hipFuncAttributeMaxDynamicSharedMemorySize, LDS_BYTES);
        (void)hipOccupancyMaxActiveBlocksPerMultiprocessor(&per_cu, (const void*)mega, NTHREADS, LDS_BYTES);
        grid = NBLK;
        if (n_in != 30 || ws_size < WS_END || per_cu < 1 || cus * per_cu < NBLK) { fprintf(stderr, "kernel_launch: unexpected n_in %d / ws %zu (need %zu) / per_cu %d\n", n_in, ws_size, (size_t)WS_END, per_cu); }
    }
    (void)hipMemsetAsync(d_ws, 0, 16384, stream);
    KArgs a{};
    for (int i = 0; i < 30; ++i) a.in[i] = (const float*)d_in[i];
    a.out = (float*)d_out; a.ws = (unsigned char*)d_ws;
    void* args[] = {&a};
    hipError_t e = hipLaunchCooperativeKernel((const void*)mega, dim3(grid), dim3(NTHREADS), args, LDS_BYTES, stream);
    if (e != hipSuccess) fprintf(stderr, "cooperative launch failed: %s (grid %d)\n", hipGetErrorString(e), grid);
}
```

```cpp
#include <hip/hip_runtime.h>
#include <hip/hip_cooperative_groups.h>
#include <cstdio>
#include <cstdint>
namespace cg = cooperative_groups;

#define LAS __attribute__((address_space(3)))
typedef unsigned short bf16_t;
typedef short bf16x8 __attribute__((ext_vector_type(8)));
typedef float f32x4 __attribute__((ext_vector_type(4)));
typedef float f32x2 __attribute__((ext_vector_type(2)));
typedef unsigned u32x4 __attribute__((ext_vector_type(4)));
typedef unsigned u32x2 __attribute__((ext_vector_type(2)));

#ifndef ONE_LAUNCH
#define ONE_LAUNCH 1
#endif

constexpr int NTHREADS = 512, NWAVES = 8;
constexpr int NBLK = 256;
constexpr int D = 1024, NB = 16, SEQ = 2048, CTXL = 256, DFF = 2816;
constexpr int NCOLS = 6656;
constexpr int PMW = 2560, GTW = 4096, UPW = 5632;
constexpr int IN_COLS = 6400;
constexpr float EPS = 1e-6f;
constexpr int NG = 2, GB = 8;
constexpr int R_LAT = GB * SEQ, R_CTX = NB * CTXL, R = R_LAT + R_CTX;
constexpr int NLT = R_LAT / 256, NCT = R_CTX / 256;
constexpr int N_KV_LAT = GB * 4 * 16, N_KV_CTX = NB * 4 * 2, N_KV = N_KV_LAT + N_KV_CTX;

constexpr size_t al256(size_t x) { return (x + 255) & ~(size_t)255; }
constexpr size_t OFF_BAR = 0;
constexpr size_t OFF_ADAP = 65536;
constexpr size_t OFF_MOD = OFF_ADAP + al256((size_t)8 * 2 * 17 * 6144 * 4);
constexpr size_t OFF_SHW1 = OFF_MOD + al256((size_t)2 * 17 * 6144 * 4);
constexpr size_t OFF_SHW2 = OFF_SHW1 + al256((size_t)2 * 17 * NCOLS * 4);
constexpr size_t OFF_ROPE = OFF_SHW2 + al256((size_t)2 * 17 * UPW * 4);
constexpr size_t OFF_LOGG = OFF_ROPE + al256((size_t)2 * 2304 * 32 * 4);
constexpr size_t OFF_DM = OFF_LOGG + 256;
constexpr size_t OFF_DC = OFF_DM + (size_t)2048 * 2048 * 2;
constexpr size_t OFF_W = OFF_DC + (size_t)256 * 256 * 2;
constexpr size_t W_IN = 0, W_O = W_IN + (size_t)NCOLS * 1024 * 2, W_OUT = W_O + (size_t)4 * 1024 * 256 * 2, W_UP = W_OUT + (size_t)1024 * 1024 * 2,
                 W_DN = W_UP + (size_t)UPW * 1024 * 2, W_LAYER = W_DN + (size_t)1024 * DFF * 2;
constexpr size_t OFF_XC = OFF_W + 2 * W_LAYER;
constexpr size_t OFF_AP = OFF_XC + (size_t)NB * CTXL * D * 4;
constexpr size_t OFF_AP1 = OFF_AP + (size_t)R * D * 2;
constexpr size_t OFF_SS = OFF_AP1 + (size_t)R_LAT * D * 2;
constexpr size_t OFF_S = OFF_SS + (size_t)R * 16 * 4;
constexpr size_t OFF_KV = OFF_S + (size_t)R * D * 2;
constexpr size_t OFF_KVC = OFF_KV + (size_t)N_KV_LAT * 2 * 4096 * 4;
constexpr size_t OFF_PQT = OFF_KVC + (size_t)2 * N_KV_CTX * 2 * 4096 * 4;
constexpr size_t OFF_PQTC = OFF_PQT + (size_t)GB * 256 * 2048 * 2;
constexpr size_t OFF_BIG = OFF_PQTC + (size_t)NB * 256 * 256 * 2;
constexpr size_t OFF_GT = OFF_BIG + (size_t)R * PMW * 2;
constexpr size_t WS_END = OFF_BIG + ((size_t)R * PMW * 2 + (size_t)R * GTW > (size_t)R * UPW * 2 ? (size_t)R * PMW * 2 + (size_t)R * GTW : (size_t)R * UPW * 2);
static_assert(WS_END <= (size_t)512 * 1024 * 1024, "workspace map exceeds 512 MiB");
static_assert((size_t)R * UPW * 2 <= WS_END - OFF_BIG, "UP overlay");

constexpr int SCR_BYTES = 139264;
constexpr int MISC_OFF = SCR_BYTES;
constexpr int LDS_BYTES = 161792;

__device__ __forceinline__ float bf2f(unsigned v) { return __uint_as_float(v << 16); }
__device__ __forceinline__ unsigned cvt_pk_bf16(float lo, float hi) { unsigned r; asm volatile("v_cvt_pk_bf16_f32 %0, %1, %2" : "=v"(r) : "v"(lo), "v"(hi)); return r; }
__device__ __forceinline__ bf16_t f2bf(float f) { return (bf16_t)(cvt_pk_bf16(f, 0.f) & 0xffffu); }
__device__ __forceinline__ void unpack8(const u32x4 w, float* f) {
    f[0] = bf2f(w.x & 0xffffu); f[1] = __uint_as_float(w.x & 0xffff0000u); f[2] = bf2f(w.y & 0xffffu); f[3] = __uint_as_float(w.y & 0xffff0000u);
    f[4] = bf2f(w.z & 0xffffu); f[5] = __uint_as_float(w.z & 0xffff0000u); f[6] = bf2f(w.w & 0xffffu); f[7] = __uint_as_float(w.w & 0xffff0000u);
}
__device__ __forceinline__ u32x4 pack8(const float* f) { u32x4 w; w.x = cvt_pk_bf16(f[0], f[1]); w.y = cvt_pk_bf16(f[2], f[3]); w.z = cvt_pk_bf16(f[4], f[5]); w.w = cvt_pk_bf16(f[6], f[7]); return w; }
__device__ __forceinline__ float shx(float v, int m, int lane) { return __int_as_float(__builtin_amdgcn_ds_bpermute((lane ^ m) << 2, __float_as_int(v))); }
template <int CTRL> __device__ __forceinline__ float dpp_mov(float v) { return __int_as_float(__builtin_amdgcn_update_dpp(0, __float_as_int(v), CTRL, 0xF, 0xF, false)); }
__device__ __forceinline__ float wave_sum(float v, int  ) {
    v += dpp_mov<0xB1>(v); v += dpp_mov<0x4E>(v); v += dpp_mov<0x141>(v); v += dpp_mov<0x140>(v);
    const int vi = __float_as_int(v);
    const float s0 = __int_as_float(__builtin_amdgcn_readlane(vi, 0)), s1 = __int_as_float(__builtin_amdgcn_readlane(vi, 16)), s2 = __int_as_float(__builtin_amdgcn_readlane(vi, 32)), s3 = __int_as_float(__builtin_amdgcn_readlane(vi, 48));
    return (s0 + s1) + (s2 + s3);
}
__device__ __forceinline__ float fast_rcp(float x) { return __builtin_amdgcn_rcpf(x); }
__device__ __forceinline__ float sigmoidf_(float x) { return fast_rcp(1.f + __expf(-x)); }
__device__ __forceinline__ float siluf_(float x) { return x * sigmoidf_(x); }
__device__ __forceinline__ float geluf_(float v) {
    const float av = fabsf(v), d = av * 0.2316418882f + 1.0f;
    const float t = fast_rcp(d);
    float q = t * 0.5307027145f + (-0.7265760135f); q = q * t + 0.7107068705f; q = q * t + (-0.142248368f); q = q * t + 0.127414796f; q = q * t;
    const float e = __builtin_amdgcn_exp2f((v * v) * (-0.72134752044f));
    const float m = v * (q * e);
    return v < 0.f ? m : v - m;
}
__device__ __forceinline__ f32x4 mfma16(bf16x8 a, bf16x8 b, f32x4 c) { return __builtin_amdgcn_mfma_f32_16x16x32_bf16(a, b, c, 0, 0, 0); }
__device__ __forceinline__ float sin_rev(float r) { return __builtin_amdgcn_sinf(r); }
__device__ __forceinline__ float cos_rev(float r) { return __builtin_amdgcn_cosf(r); }

#define XB_TMO      128
#define XB_XCNT(j)  (256  + 64 * (j))
#define XB_XSUB(j)  (1280 + 64 * (j))
#define XB_XGEN(j)  (2304 + 64 * (j))
#define XB_TOP      3328
#define XB_TOPGEN   3392
#define XCD_BAR_WORDS 3456
#define XB_SPIN_CAP (1u << 20)
__device__ __forceinline__ unsigned xb_ld(unsigned* p)              { return __hip_atomic_load(p, __ATOMIC_RELAXED, __HIP_MEMORY_SCOPE_AGENT); }
__device__ __forceinline__ unsigned xb_add(unsigned* p, unsigned v) { return __hip_atomic_fetch_add(p, v, __ATOMIC_RELAXED, __HIP_MEMORY_SCOPE_AGENT); }
__device__ __forceinline__ unsigned xb_xcc_id() { return (unsigned)__builtin_amdgcn_s_getreg((3 << 11) | 20) & 0xFu; }
#define XB_SPIN(cond, bar) do { unsigned _sp = 0; while (cond) { __builtin_amdgcn_s_sleep(1); \
    if ((++_sp & 255u) == 0u) { if (xb_ld(&(bar)[XB_TMO])) break; if (_sp > XB_SPIN_CAP) { atomicAdd(&(bar)[XB_TMO], 1u); break; } } } } while (0)
struct XcdBarrier { unsigned* bar; unsigned x; volatile LAS unsigned* st; };
__device__ __forceinline__ XcdBarrier xcd_barrier_post(unsigned* bar, volatile LAS unsigned* st) {
    XcdBarrier b; b.bar = bar; b.x = xb_xcc_id(); b.st = st;
    if (threadIdx.x == 0) (void)xb_add(&bar[XB_XCNT(b.x)], 1u);
    return b;
}
__device__ __forceinline__ void xcd_barrier_complete(unsigned* bar, unsigned x, unsigned& nloc, unsigned& nx) {
    const unsigned G = NBLK;
    unsigned sum, cnt, mine, sp = 0u;
    for (;;) {
        sum = 0u; cnt = 0u; mine = 0u;
#pragma unroll
        for (unsigned j = 0; j < 16; ++j) { const unsigned c = xb_ld(&bar[XB_XCNT(j)]); sum += c; cnt += (c > 0u) ? 1u : 0u; mine = (j == x) ? c : mine; }
        if (sum == G) break;
        __builtin_amdgcn_s_sleep(1);
        if ((++sp & 255u) == 0u) { if (xb_ld(&bar[XB_TMO])) break; if (sp > XB_SPIN_CAP) { atomicAdd(&bar[XB_TMO], 1u); break; } }
    }
    nloc = mine > 0u ? mine : 1u; nx = cnt > 0u ? cnt : 1u;
}
__device__ __forceinline__ void xcd_barrier(const XcdBarrier& b) {
    asm volatile("s_waitcnt vmcnt(0)" ::: "memory");
    __syncthreads();
    if (threadIdx.x == 0) {
        unsigned* bar = b.bar; unsigned bx_ = b.x; asm volatile("" : "+s"(bx_));
        __builtin_amdgcn_s_waitcnt(0);
        unsigned nloc = b.st[0], nx = b.st[1];
        if (nloc == 0u) { xcd_barrier_complete(bar, bx_, nloc, nx); b.st[0] = nloc; b.st[1] = nx; }
        const unsigned old = xb_add(&bar[XB_XSUB(bx_)], 1u);
        const unsigned gen = old / nloc;
        if (old + 1u == (gen + 1u) * nloc) {
            __builtin_amdgcn_fence(__ATOMIC_RELEASE, "agent");
            asm volatile("s_waitcnt vmcnt(0)" ::: "memory");
            const unsigned og = xb_add(&bar[XB_TOP], 1u);
            const unsigned tg = og / nx;
            if (og + 1u == (tg + 1u) * nx) xb_add(&bar[XB_TOPGEN], 1u);
            else XB_SPIN(xb_ld(&bar[XB_TOPGEN]) == tg, bar);
            __builtin_amdgcn_fence(__ATOMIC_ACQUIRE, "agent");
            xb_add(&bar[XB_XGEN(bx_)], 1u);
            asm volatile("s_waitcnt vmcnt(0)" ::: "memory");
        } else {
            XB_SPIN(xb_ld(&bar[XB_XGEN(bx_)]) == gen, bar);
            __builtin_amdgcn_fence(__ATOMIC_ACQUIRE, "agent");
            asm volatile("s_waitcnt vmcnt(0)" ::: "memory");
        }
    }
    __syncthreads();
}

namespace pg8 {
constexpr int BM = 256, BK = 64, HALF = 128, HTB = HALF * BK * 2, NXCD = 8, WGM = 8;
__host__ __device__ __forceinline__ int lds_byte(int r, int c) { const int st = (r >> 4) * 2 + (c >> 5), rr = r & 15, cc = c & 31, ob = rr * 64 + cc * 2; return st * 1024 + (ob ^ (((ob >> 9) & 1) << 5)); }
__host__ __device__ __forceinline__ void stage_rc(int b, int& R_, int& C_) { const int st = b / 1024, sb = b % 1024, swz = sb ^ (((sb >> 9) & 1) << 5); R_ = (st >> 1) * 16 + swz / 64; C_ = (st & 1) * 32 + (swz % 64) / 2; }
__host__ __device__ __forceinline__ int perm32(int rho) { const int n = rho >> 4, i = rho & 15; return 8 * (i >> 2) + 4 * n + (i & 3); }

struct Unit { int pm, pn, seg; unsigned A, B; };
__device__ __forceinline__ const char* sgpr_ptr(const char* p) {
    const unsigned long long v = (unsigned long long)p;
    const unsigned lo = (unsigned)__builtin_amdgcn_readfirstlane((int)(unsigned)v), hi = (unsigned)__builtin_amdgcn_readfirstlane((int)(unsigned)(v >> 32));
    typedef const char __attribute__((address_space(1)))* gp_t;
    return (const char*)(gp_t)(((unsigned long long)hi << 32) | (unsigned long long)lo);
}

__device__ __forceinline__ void tile_order(int L, int nM, int nN, int& pm, int& pn) {
    const int nwg = nM * nN; int wgid = L;
    { const int q = nwg / NXCD, r = nwg % NXCD, xcd = wgid % NXCD, off = wgid / NXCD; wgid = (xcd < r ? xcd * (q + 1) : r * (q + 1) + (xcd - r) * q) + off; }
    const int nig = WGM * nN, gid = wgid / nig, fm = gid * WGM, gsz = (nM - fm) < WGM ? (nM - fm) : WGM;
    pm = fm + ((wgid % nig) % gsz); pn = (wgid % nig) / gsz;
}
struct TileSched {
    int n1M, n1N, n2M, n2N, pn2_0, pm2_x, G, c, nseg;
    unsigned A, B, a_tstep, b_tstep, a_segstep, b_segstep;
    __device__ __forceinline__ bool next(int i, Unit& u) const {
        const int ti = i / nseg, seg = i - ti * nseg;
        const int L = ti * G + c, n1 = n1M * n1N, n2 = n2M * n2N;
        int pm, pn;
        if (L < n1) tile_order(L, n1M, n1N, pm, pn);
        else if (L < n1 + n2) { tile_order(L - n1, n2M, n2N, pm, pn); pm += n1M + pm2_x; pn += pn2_0; }
        else return false;
        pm = __builtin_amdgcn_readfirstlane(pm); pn = __builtin_amdgcn_readfirstlane(pn);
        u.pm = pm; u.pn = pn; u.seg = seg;
        u.A = A + (unsigned)pm * a_tstep + (unsigned)seg * a_segstep; u.B = B + (unsigned)pn * b_tstep + (unsigned)seg * b_segstep;
        return true;
    }
};

struct NoPre {};
constexpr int TB_OFF = 131072;
constexpr int SHB_OFF = 147456;
template <class Epi, class Sched>
__device__ __forceinline__ void gemm_phase(LAS unsigned char* lds, const unsigned char* wsb, const int tid_in, const int K, const int lda, const int ldb, const bool perm, const Sched& S, const Epi& E) {
    __builtin_amdgcn_s_waitcnt(0x0F70);
    int tid = tid_in; asm volatile("" : "+v"(tid));
    const int wid = __builtin_amdgcn_readfirstlane(tid >> 6), lane = tid & 63, wr = wid >> 2, wc = wid & 3, fr = lane & 15, fq = lane >> 4;
    const int nt = K / BK;
    unsigned voffA[2], voffB[2];
#pragma unroll
    for (int i = 0; i < 2; ++i) { int R_, C_; stage_rc(tid * 16 + i * 8192, R_, C_); const int Rb = perm ? ((R_ & ~31) + perm32(R_ & 31)) : R_;
        voffA[i] = (unsigned)(R_ * lda + C_) * 2u; voffB[i] = (unsigned)(Rb * ldb + C_) * 2u; }
    const unsigned kstep = (unsigned)(BK * 2);
    const unsigned hA = (unsigned)HALF * lda * 2, hB = (unsigned)HALF * ldb * 2;
    const unsigned ldsw = (unsigned)wid * 1024u;
    const int aoff = lds_byte(wr * 64 + fr, fq * 8), boff = lds_byte(wc * 32 + fr, fq * 8);
#define PG8_SA(b, h) (((b) * 2 + (h)) * HTB)
#define PG8_SB(b, h) ((4 + (b) * 2 + (h)) * HTB)
#define PG8_STAGE(bufoff, goff, voff) do { _Pragma("unroll") for (int _i = 0; _i < 2; ++_i) \
        __builtin_amdgcn_global_load_lds((const unsigned*)(wsb + (unsigned)((goff) + (voff)[_i])), (LAS unsigned*)(lds + (bufoff) + ldsw + _i * 8192), 16, 0, 0); } while (0)
#define PG8_LDA(dst, b, h) do { _Pragma("unroll") for (int m = 0; m < 4; ++m) _Pragma("unroll") for (int k = 0; k < 2; ++k) dst[m][k] = *(const LAS bf16x8*)(lds + PG8_SA(b, h) + aoff + m * 2048 + k * 1024); } while (0)
#define PG8_LDB(dst, b, h) do { _Pragma("unroll") for (int n = 0; n < 2; ++n) _Pragma("unroll") for (int k = 0; k < 2; ++k) dst[n][k] = *(const LAS bf16x8*)(lds + PG8_SB(b, h) + boff + n * 2048 + k * 1024); } while (0)
#define PG8_MMA(ai, bj, At, Bt) do { __builtin_amdgcn_s_setprio(1); _Pragma("unroll") for (int m = 0; m < 4; ++m) _Pragma("unroll") for (int n = 0; n < 2; ++n) _Pragma("unroll") for (int k = 0; k < 2; ++k) \
        acc[ai][bj][m][n] = __builtin_amdgcn_mfma_f32_16x16x32_bf16(Bt[n][k], At[m][k], acc[ai][bj][m][n], 0, 0, 0); __builtin_amdgcn_s_setprio(0); } while (0)
#define PG8_MMA0(ai, bj, At, Bt) do { __builtin_amdgcn_s_setprio(1); _Pragma("unroll") for (int m = 0; m < 4; ++m) _Pragma("unroll") for (int n = 0; n < 2; ++n) { \
        acc[ai][bj][m][n] = __builtin_amdgcn_mfma_f32_16x16x32_bf16(Bt[n][0], At[m][0], (f32x4){0.f, 0.f, 0.f, 0.f}, 0, 0, 0); \
        acc[ai][bj][m][n] = __builtin_amdgcn_mfma_f32_16x16x32_bf16(Bt[n][1], At[m][1], acc[ai][bj][m][n], 0, 0, 0); } __builtin_amdgcn_s_setprio(0); } while (0)
#define PG8_WAIT_V(n) asm volatile("s_waitcnt vmcnt(" #n ")" ::: "memory")
#define PG8_WAIT_VN(n) asm volatile("s_waitcnt vmcnt(%0)" :: "n"(n) : "memory")
#define PG8_WAIT_L(n) asm volatile("s_waitcnt lgkmcnt(" #n ")" ::: "memory")
#define PG8_BAR __builtin_amdgcn_s_barrier()
#define PG8_SCHED __builtin_amdgcn_sched_barrier(0)
#define PG8_ZERO() do { _Pragma("unroll") for (int a = 0; a < 2; ++a) _Pragma("unroll") for (int b = 0; b < 2; ++b) _Pragma("unroll") for (int m = 0; m < 4; ++m) _Pragma("unroll") for (int n = 0; n < 2; ++n) acc[a][b][m][n] = (f32x4){0.f, 0.f, 0.f, 0.f}; } while (0)
    Unit cur, nxt; int ui = 0;
    if (!S.next(0, cur)) return;
    f32x4 acc[2][2][4][2];
    if (!Epi::ZC) PG8_ZERO();
    bf16x8 At[4][2], B0[2][2], B1[2][2];
    unsigned cA = cur.A, cB = cur.B;
    E.prefetch(cur, wid, lane, lds + SHB_OFF);
    typename Epi::Pre pre = E.pre(cur, wr, wc, fr, fq);
    PG8_STAGE(PG8_SB(0, 0), cB, voffB); PG8_STAGE(PG8_SB(0, 1), cB + hB, voffB); PG8_STAGE(PG8_SA(0, 0), cA, voffA); PG8_STAGE(PG8_SA(0, 1), cA + hA, voffA);
    if (wr == 1) PG8_BAR;
    PG8_WAIT_V(2); PG8_BAR;
    PG8_STAGE(PG8_SB(1, 0), cB + kstep, voffB); PG8_STAGE(PG8_SA(1, 0), cA + kstep, voffA); PG8_STAGE(PG8_SB(1, 1), cB + hB + kstep, voffB);
    PG8_WAIT_V(6); PG8_BAR;
    for (;;) {
        const bool has_next = S.next(ui + 1, nxt);
        const unsigned nA = has_next ? nxt.A : cA, nB = has_next ? nxt.B : cB;
#define PG8_PASS(WX, MM) do { \
            const bool last = (t == nt - 2); \
            unsigned tk = (unsigned)t * (unsigned)kstep; asm volatile("" : "+s"(tk)); \
            const unsigned a1 = cA + tk + kstep; \
            const unsigned a2 = last ? nA : cA + tk + 2 * kstep, b2 = last ? nB : cB + tk + 2 * kstep; \
            const unsigned a3 = a2 + kstep, b3 = b2 + kstep; \
            PG8_LDB(B0, 0, 0); PG8_LDB(B1, 0, 1); PG8_SCHED; PG8_LDA(At, 0, 0); PG8_STAGE(PG8_SA(1, 1), a1 + hA, voffA); \
            WX; PG8_WAIT_L(0); PG8_BAR; MM(0, 0, At, B0); MM(0, 1, At, B1); PG8_BAR; PG8_SCHED; \
            PG8_LDA(At, 0, 1); PG8_STAGE(PG8_SB(0, 0), b2, voffB); PG8_STAGE(PG8_SB(0, 1), b2 + hB, voffB); PG8_STAGE(PG8_SA(0, 0), a2, voffA); \
            WX; PG8_WAIT_L(0); PG8_BAR; MM(1, 0, At, B0); MM(1, 1, At, B1); PG8_BAR; PG8_SCHED; \
            PG8_LDB(B0, 1, 0); PG8_LDB(B1, 1, 1); PG8_SCHED; PG8_LDA(At, 1, 0); PG8_STAGE(PG8_SA(0, 1), a2 + hA, voffA); \
            PG8_WAIT_V(8); PG8_WAIT_L(0); PG8_BAR; PG8_MMA(0, 0, At, B0); PG8_MMA(0, 1, At, B1); PG8_BAR; PG8_SCHED; \
            PG8_LDA(At, 1, 1); PG8_STAGE(PG8_SB(1, 0), b3, voffB); PG8_STAGE(PG8_SB(1, 1), b3 + hB, voffB); PG8_STAGE(PG8_SA(1, 0), a3, voffA); \
            PG8_WAIT_V(8); PG8_WAIT_L(0); PG8_BAR; PG8_MMA(1, 0, At, B0); PG8_MMA(1, 1, At, B1); PG8_BAR; PG8_SCHED; \
        } while (0)
        int t = 0;
        if (Epi::ZC) {
            if (Epi::XST > 0 && ui > 0) PG8_PASS(PG8_WAIT_VN(8 + Epi::XST), PG8_MMA0); else PG8_PASS(PG8_WAIT_V(8), PG8_MMA0);
            t = 2;
        } else if (Epi::XST > 0 && ui > 0) { PG8_PASS(PG8_WAIT_VN(8 + Epi::XST), PG8_MMA); t = 2; }
        for (; t < nt; t += 2) PG8_PASS(PG8_WAIT_V(8), PG8_MMA);
#undef PG8_PASS
        if (wr == 0) PG8_BAR;
        unsigned zz = 0u; asm volatile("" : "+s"(zz)); const int le = (int)__builtin_amdgcn_mbcnt_hi(~0u, __builtin_amdgcn_mbcnt_lo(~0u, zz));
        if (E(acc, cur, wr, wc, le & 15, le >> 4, lds + TB_OFF + ldsw, lds + SHB_OFF + (ui & 1) * 3072, pre)) { if (!Epi::ZC) PG8_ZERO(); }
        if (!has_next) break;
        cur = nxt; cA = nA; cB = nB; ++ui;
        E.prefetch(cur, wid, le, lds + SHB_OFF + (ui & 1) * 3072);
        pre = E.pre(cur, wr, wc, le & 15, le >> 4);
        if (wr == 1) PG8_BAR;
    }
    PG8_WAIT_V(0);
    PG8_BAR;
#undef PG8_SA
#undef PG8_SB
#undef PG8_STAGE
#undef PG8_LDA
#undef PG8_LDB
#undef PG8_MMA
#undef PG8_MMA0
#undef PG8_WAIT_V
#undef PG8_WAIT_VN
#undef PG8_WAIT_L
#undef PG8_BAR
#undef PG8_SCHED
#undef PG8_ZERO
}
}

enum { I_x = 0, I_c = 1, I_ctx = 2, I_c_ctx = 3, I_w_ada = 4, I_b_ada = 5, I_g_norm1 = 6, I_g_norm2 = 7, I_w_in = 8, I_b_gate = 9, I_ret_decay = 10, I_ret_gn = 11, I_w_ret_o = 12, I_conv_dw = 13, I_conv_db = 14, I_conv_ln_g = 15, I_conv_ln_b = 16, I_w_conv_o = 17, I_gmlp_ln_g = 18, I_gmlp_ln_b = 19, I_gmlp_ws = 20, I_gmlp_bs = 21, I_w_gmlp_o = 22, I_w_fnet_o = 23, I_w_out = 24, I_w_ffn_up = 25, I_ffn_dw = 26, I_ffn_db = 27, I_w_ffn_down = 28, I_g_final = 29 };
struct KArgs { const float* in[30]; float* out; unsigned char* ws; int ph_lo, ph_hi; };
constexpr int PTAB_OFF = MISC_OFF + 4096;
struct KP {
    float* out; unsigned char* ws; LAS unsigned char* ldsb; LAS unsigned char* ptab; int tid_, bx_;
    __device__ __forceinline__ const float* in(int k) const {
        const LAS unsigned* t = (const LAS unsigned*)ptab + 2 * k;
        const unsigned lo = (unsigned)__builtin_amdgcn_readfirstlane((int)t[0]), hi = (unsigned)__builtin_amdgcn_readfirstlane((int)t[1]);
        typedef const float __attribute__((address_space(1)))* gcfp_t;
        return (const float*)(gcfp_t)(((unsigned long long)hi << 32) | (unsigned long long)lo);
    }
};

struct RowInfo { int mi; size_t xrow0; bool is_ctx; };
__device__ __forceinline__ RowInfo row_info(int g, int pm) {
    RowInfo ri;
    if (pm < NLT) { const int b = g * GB + (pm >> 3); ri.mi = b; ri.xrow0 = (size_t)b * SEQ + (size_t)(pm & 7) * 256; ri.is_ctx = false; }
    else { const int b = pm - NLT; ri.mi = 16; ri.xrow0 = (size_t)b * CTXL; ri.is_ctx = true; }
    return ri;
}

__device__ __forceinline__ unsigned ap_off(int g) { return g == 0 ? (unsigned)OFF_AP : (unsigned)OFF_AP1; }
__device__ __forceinline__ unsigned ssa_off(int g) { return (unsigned)OFF_SS + (unsigned)(g * 2) * (unsigned)(R * 4); }
__device__ __forceinline__ unsigned ssb_off(int g) { return (unsigned)OFF_SS + (unsigned)(g * 2 + 1) * (unsigned)(R * 4); }

constexpr int TB2_DELTA = 153600 - 131072;
__device__ __forceinline__ void st_rows16x2(LAS unsigned char* tb, bf16_t* base, size_t ld, int fr, int fq, u32x4 w0, u32x4 w1) {
    const int wo = 64 * fr + 16 * (fq ^ ((fr >> 2) & 3));
    *(LAS u32x4*)(tb + wo) = w0; *(LAS u32x4*)(tb + TB2_DELTA + wo) = w1;
    const int l2 = fq * 16 + fr, r2 = l2 >> 2, q2 = l2 & 3, ro = 64 * r2 + 16 * (q2 ^ ((r2 >> 2) & 3));
    const u32x4 t0 = *(const LAS u32x4*)(tb + ro), t1 = *(const LAS u32x4*)(tb + TB2_DELTA + ro);
    bf16_t* d = base + (size_t)r2 * ld + 8 * q2;
    *(u32x4*)d = t0; *(u32x4*)(d + 128) = t1;
}
__device__ __forceinline__ void st_rows16(LAS unsigned char* tb, bf16_t* base, size_t ld, int fr, int fq, u32x4 w) {
    *(LAS u32x4*)(tb + 64 * fr + 16 * (fq ^ ((fr >> 2) & 3))) = w;
    const int l2 = fq * 16 + fr, r2 = l2 >> 2, q2 = l2 & 3;
    const u32x4 t = *(const LAS u32x4*)(tb + 64 * r2 + 16 * (q2 ^ ((r2 >> 2) & 3)));
    *(u32x4*)(base + (size_t)r2 * ld + 8 * q2) = t;
}
struct EpiWin {
    typedef pg8::NoPre Pre; static constexpr bool ZC = true;
    __device__ __forceinline__ Pre pre(const pg8::Unit&, int, int, int, int) const { return Pre{}; }
    static constexpr bool PERM = true; static constexpr int XST = 16;
    const float* ss; const float* shw; const float* bgate; bf16_t* PM; bf16_t* GT; int g;
    __device__ __forceinline__ void prefetch(const pg8::Unit& u, int wid, int lane, LAS unsigned char* shb) const {
        const int ctile = u.pn * 256;
        if (wid == 0) { const RowInfo ri = row_info(g, u.pm); __builtin_amdgcn_global_load_lds((const unsigned*)(shw + (size_t)ri.mi * NCOLS + ctile + lane * 4), (LAS unsigned*)shb, 16, 0, 0); }
        else if (wid == 1) __builtin_amdgcn_global_load_lds((const unsigned*)(ss + u.pm * 256 + lane * 4), (LAS unsigned*)(shb + 1024), 16, 0, 0);
        else if (wid == 2 && ctile >= PMW) __builtin_amdgcn_global_load_lds((const unsigned*)(bgate + (ctile - PMW) + lane * 4), (LAS unsigned*)(shb + 2048), 16, 0, 0);
    }
    __device__ __forceinline__ bool operator()(f32x4 (&acc)[2][2][4][2], const pg8::Unit& u, int wr, int wc, int fr, int fq, LAS unsigned char* tb, const LAS unsigned char* shb, const Pre&) const {
        const int ctile = u.pn * 256, cb = wc * 32 + 8 * fq;
        const bool gate = ctile >= PMW;
        f32x4 sh[2][2];
#pragma unroll
        for (int bj = 0; bj < 2; ++bj)
#pragma unroll
            for (int n = 0; n < 2; ++n) { sh[bj][n] = *(const LAS f32x4*)(shb + (bj * 128 + cb + 4 * n) * 4);
                if (gate) sh[bj][n] = (sh[bj][n] + *(const LAS f32x4*)(shb + 2048 + (bj * 128 + cb + 4 * n) * 4)) * (-1.44269504089f) - 7.99435343686f; }
        float rsv[8];
#pragma unroll
        for (int q = 0; q < 8; ++q) rsv[q] = __builtin_amdgcn_rsqf(*(const LAS float*)(shb + 1024 + ((q >> 2) * 128 + wr * 64 + (q & 3) * 16 + fr) * 4) * (1.0f / 1024.0f) + EPS);
        if (gate) {
            typedef float f32x2_ __attribute__((ext_vector_type(2)));
            unsigned char* gt = (unsigned char*)GT + (size_t)(u.pm * 16 + ((ctile - PMW) >> 8)) * 16 * 4096 + ((wr * 4 + wc) * 64 + fq * 16 + fr) * 8;
#pragma unroll
            for (int ai = 0; ai < 2; ++ai)
#pragma unroll
                for (int m = 0; m < 4; ++m) {
                    const float rsg = rsv[ai * 4 + m] * (-1.44269504089f);
                    const f32x2_ rg2 = (f32x2_){rsg, rsg};
#pragma unroll
                    for (int bj = 0; bj < 2; ++bj) {
                        u32x2 wq = (u32x2){0u, 0u};
#pragma unroll
                        for (int n = 0; n < 2; ++n) { const f32x4 a_ = acc[ai][bj][m][n], s_ = sh[bj][n];
                            const f32x2_ p0 = __builtin_elementwise_fma((f32x2_){a_[0], a_[1]}, rg2, (f32x2_){s_[0], s_[1]}), p1 = __builtin_elementwise_fma((f32x2_){a_[2], a_[3]}, rg2, (f32x2_){s_[2], s_[3]});
                            const float e_[4] = {p0[0], p0[1], p1[0], p1[1]};
                            unsigned w_ = 0u;
#pragma unroll
                            for (int j = 0; j < 4; ++j) w_ = __builtin_amdgcn_cvt_pk_u8_f32(fast_rcp(__builtin_amdgcn_fmed3f(__builtin_amdgcn_exp2f(e_[j]) + (1.0f / 255.0f), 0.f, 1.f)), j, w_);
                            if (n == 0) wq.x = w_; else wq.y = w_; }
                        *(u32x2*)(gt + ((ai * 4 + m) * 2 + bj) * 4096) = wq;
                    }
                }
            return true;
        }
#pragma unroll
        for (int ai = 0; ai < 2; ++ai)
#pragma unroll
            for (int m = 0; m < 4; ++m) {
                const int r0 = u.pm * 256 + ai * 128 + wr * 64 + m * 16;
                const float rs = rsv[ai * 4 + m];
                u32x4 wp[2];
#pragma unroll
                for (int bj = 0; bj < 2; ++bj) {
                    const f32x4 v0 = acc[ai][bj][m][0] * rs + sh[bj][0], v1 = acc[ai][bj][m][1] * rs + sh[bj][1];
                    wp[bj].x = cvt_pk_bf16(v0[0], v0[1]); wp[bj].y = cvt_pk_bf16(v0[2], v0[3]); wp[bj].z = cvt_pk_bf16(v1[0], v1[1]); wp[bj].w = cvt_pk_bf16(v1[2], v1[3]);
                }
                st_rows16x2(tb, PM + (size_t)r0 * PMW + ctile + wc * 32, PMW, fr, fq, wp[0], wp[1]);
            }
        return true;
    }
};
struct EpiUp {
    typedef pg8::NoPre Pre; static constexpr bool ZC = true;
    __device__ __forceinline__ Pre pre(const pg8::Unit&, int, int, int, int) const { return Pre{}; }
    static constexpr bool PERM = true; static constexpr int XST = 16;
    const float* ss; const float* shw; bf16_t* UP; int g;
    __device__ __forceinline__ void prefetch(const pg8::Unit& u, int wid, int lane, LAS unsigned char* shb) const {
        if (wid == 0) { const RowInfo ri = row_info(g, u.pm); __builtin_amdgcn_global_load_lds((const unsigned*)(shw + (size_t)ri.mi * UPW + u.pn * 256 + lane * 4), (LAS unsigned*)shb, 16, 0, 0); }
        else if (wid == 1) __builtin_amdgcn_global_load_lds((const unsigned*)(ss + u.pm * 256 + lane * 4), (LAS unsigned*)(shb + 1024), 16, 0, 0);
    }
    __device__ __forceinline__ bool operator()(f32x4 (&acc)[2][2][4][2], const pg8::Unit& u, int wr, int wc, int fr, int fq, LAS unsigned char* tb, const LAS unsigned char* shb, const Pre&) const {
        const int ctile = u.pn * 256, cb = wc * 32 + 8 * fq;
        f32x4 sh[2][2];
#pragma unroll
        for (int bj = 0; bj < 2; ++bj)
#pragma unroll
            for (int n = 0; n < 2; ++n) sh[bj][n] = *(const LAS f32x4*)(shb + (bj * 128 + cb + 4 * n) * 4);
        float rsv[8];
#pragma unroll
        for (int q = 0; q < 8; ++q) rsv[q] = __builtin_amdgcn_rsqf(*(const LAS float*)(shb + 1024 + ((q >> 2) * 128 + wr * 64 + (q & 3) * 16 + fr) * 4) * (1.0f / 1024.0f) + EPS);
#pragma unroll
        for (int ai = 0; ai < 2; ++ai)
#pragma unroll
            for (int m = 0; m < 4; ++m) {
                const int r = u.pm * 256 + ai * 128 + wr * 64 + m * 16 + fr;
                const float rs = rsv[ai * 4 + m];
                u32x4 w[2];
#pragma unroll
                for (int bj = 0; bj < 2; ++bj) {
                    const f32x4 v0 = acc[ai][bj][m][0] * rs + sh[bj][0], v1 = acc[ai][bj][m][1] * rs + sh[bj][1];
                    w[bj].x = cvt_pk_bf16(v0[0], v0[1]); w[bj].y = cvt_pk_bf16(v0[2], v0[3]); w[bj].z = cvt_pk_bf16(v1[0], v1[1]); w[bj].w = cvt_pk_bf16(v1[2], v1[3]);
                }
                st_rows16x2(tb, UP + (size_t)(r - fr) * UPW + ctile + wc * 32, UPW, fr, fq, w[0], w[1]);
            }
        return true;
    }
};
struct EpiResid {
    typedef pg8::NoPre Pre; static constexpr bool ZC = true;
    __device__ __forceinline__ Pre pre(const pg8::Unit&, int, int, int, int) const { return Pre{}; }
    static constexpr bool PERM = true; static constexpr int XST = 0;
    static constexpr int XS = 2048, XH = 1024;
    const float *x32_lat, *x32_ctx; bf16_t *xb_lat, *xb_ctx; const float* ga; const float* Gn; bf16_t* AP; float* ss; int g;
    __device__ __forceinline__ void prefetch(const pg8::Unit& u, int wid, int lane, LAS unsigned char* shb) const {
        if (wid == 0) { const RowInfo ri = row_info(g, u.pm); __builtin_amdgcn_global_load_lds((const unsigned*)(ga + (size_t)ri.mi * 6144 + u.pn * 256 + lane * 4), (LAS unsigned*)shb, 16, 0, 0); }
        else if (wid == 1 && Gn) { const RowInfo ri = row_info(g, u.pm); __builtin_amdgcn_global_load_lds((const unsigned*)(Gn + (size_t)ri.mi * 6144 + u.pn * 256 + lane * 4), (LAS unsigned*)(shb + 1024), 16, 0, 0); }
    }
    __device__ __forceinline__ bool operator()(f32x4 (&acc)[2][2][4][2], const pg8::Unit& u, int wr, int wc, int fr, int fq, LAS unsigned char* tb, const LAS unsigned char* shb, const Pre&) const {
        const RowInfo ri = row_info(g, u.pm);
        const float* x32 = ri.is_ctx ? x32_ctx : x32_lat; bf16_t* xb = ri.is_ctx ? xb_ctx : xb_lat;
        const bool in32 = x32 != nullptr, gnp = Gn != nullptr;
        const int l2 = fq * 16 + fr, r2 = l2 >> 2, q2 = l2 & 3;
        LAS unsigned char* wa = tb + 64 * fr + 16 * (fq ^ ((fr >> 2) & 3));
        const LAS unsigned char* ra = tb + 64 * r2 + 16 * (q2 ^ ((r2 >> 2) & 3));
        const int c0 = u.pn * 256 + wc * 32 + 8 * q2;
        const LAS unsigned char* gl = shb + (wc * 32 + 8 * q2) * 4;
        const size_t xrow = ri.xrow0 + (size_t)(wr * 64 + r2);
        const int rbase = u.pm * 256 + wr * 64 + r2;
        f32x4 xq[3][2][2];
#define RESID_LD(dst, xrw) do { _Pragma("unroll") for (int bj = 0; bj < 2; ++bj) { \
            if (in32) { dst[bj][0] = *(const f32x4*)(x32 + (xrw) * D + c0 + bj * 128); dst[bj][1] = *(const f32x4*)(x32 + (xrw) * D + c0 + bj * 128 + 4); } \
            else { const u32x4 t = *(const u32x4*)(xb + (xrw) * XS + XH + c0 + bj * 128); dst[bj][0] = (f32x4){__uint_as_float(t.x), __uint_as_float(t.y), __uint_as_float(t.z), __uint_as_float(t.w)}; } } } while (0)
        RESID_LD(xq[0], xrow); RESID_LD(xq[1], xrow + 16);
#pragma unroll
        for (int st = 0; st < 8; ++st) {
            const int ai = st >> 2, m = st & 3;
            if (st < 6) { const int ai2 = (st + 2) >> 2, m2 = (st + 2) & 3; RESID_LD(xq[(st + 2) % 3], xrow + (size_t)(ai2 * 128 + m2 * 16)); }
            f32x4 (&xc)[2][2] = xq[st % 3];
            asm volatile("" ::: "memory");
            const size_t xr = xrow + (size_t)(ai * 128 + m * 16); const int r = rbase + ai * 128 + m * 16;
            float sq = 0.f;
#pragma unroll
            for (int bj = 0; bj < 2; ++bj) {
                *(LAS f32x4*)wa = acc[ai][bj][m][0]; *(LAS f32x4*)(wa + TB2_DELTA) = acc[ai][bj][m][1];
                const f32x4 at0 = *(const LAS f32x4*)ra, at1 = *(const LAS f32x4*)(ra + TB2_DELTA);
                f32x4 x0, x1;
                if (in32) { x0 = xc[bj][0]; x1 = xc[bj][1]; }
                else { const f32x4 t = xc[bj][0]; const unsigned t0 = __float_as_uint(t[0]), t1 = __float_as_uint(t[1]), t2 = __float_as_uint(t[2]), t3 = __float_as_uint(t[3]);
                    x0 = (f32x4){__uint_as_float(t0 << 16), __uint_as_float(t0 & 0xffff0000u), __uint_as_float(t1 << 16), __uint_as_float(t1 & 0xffff0000u)};
                    x1 = (f32x4){__uint_as_float(t2 << 16), __uint_as_float(t2 & 0xffff0000u), __uint_as_float(t3 << 16), __uint_as_float(t3 & 0xffff0000u)}; }
                const f32x4 v0 = x0 + *(const LAS f32x4*)(gl + bj * 512) * at0, v1 = x1 + *(const LAS f32x4*)(gl + bj * 512 + 16) * at1;
                u32x4 w; w.x = cvt_pk_bf16(v0[0], v0[1]); w.y = cvt_pk_bf16(v0[2], v0[3]); w.z = cvt_pk_bf16(v1[0], v1[1]); w.w = cvt_pk_bf16(v1[2], v1[3]);
                *(u32x4*)(xb + xr * XS + XH + c0 + bj * 128) = w;
                sq += ((v0[0] * v0[0] + v0[1] * v0[1]) + (v0[2] * v0[2] + v0[3] * v0[3])) + ((v1[0] * v1[0] + v1[1] * v1[1]) + (v1[2] * v1[2] + v1[3] * v1[3]));
                if (gnp) { const f32x4 a0 = v0 * *(const LAS f32x4*)(gl + 1024 + bj * 512), a1 = v1 * *(const LAS f32x4*)(gl + 1024 + bj * 512 + 16);
                    u32x4 wA; wA.x = cvt_pk_bf16(a0[0], a0[1]); wA.y = cvt_pk_bf16(a0[2], a0[3]); wA.z = cvt_pk_bf16(a1[0], a1[1]); wA.w = cvt_pk_bf16(a1[2], a1[3]);
                    *(u32x4*)(AP + (size_t)r * D + c0 + bj * 128) = wA; } }
            sq += dpp_mov<0xB1>(sq); sq += dpp_mov<0x4E>(sq);
            if (q2 == 0) atomicAdd(ss + r, sq);
            asm volatile("" ::: "memory");
        }
#undef RESID_LD
        return true;
    }
};
struct EpiDft {
    typedef pg8::NoPre Pre; static constexpr bool ZC = true;
    __device__ __forceinline__ Pre pre(const pg8::Unit&, int, int, int, int) const { return Pre{}; }
    static constexpr bool PERM = true; static constexpr int XST = 0;
    bf16_t* S; int row_base, rows_per_seq; float scale;
    __device__ __forceinline__ void prefetch(const pg8::Unit&, int, int, LAS unsigned char*) const {}
    __device__ __forceinline__ bool operator()(f32x4 (&acc)[2][2][4][2], const pg8::Unit& u, int wr, int wc, int fr, int fq, LAS unsigned char* tb, const LAS unsigned char*, const Pre&) const {
        const int cb = wc * 32 + 8 * fq;
#pragma unroll
        for (int ai = 0; ai < 2; ++ai)
#pragma unroll
            for (int m = 0; m < 4; ++m) {
                const int r = row_base + u.pn * rows_per_seq + u.pm * 256 + ai * 128 + wr * 64 + m * 16 + fr;
#pragma unroll
                for (int bj = 0; bj < 2; ++bj) {
                    const f32x4 v0 = acc[ai][bj][m][0] * scale, v1 = acc[ai][bj][m][1] * scale;
                    u32x4 w; w.x = cvt_pk_bf16(v0[0], v0[1]); w.y = cvt_pk_bf16(v0[2], v0[3]); w.z = cvt_pk_bf16(v1[0], v1[1]); w.w = cvt_pk_bf16(v1[2], v1[3]);
                    st_rows16(tb, S + (size_t)(r - fr) * D + 768 + bj * 128 + wc * 32, D, fr, fq, w);
                }
            }
        return true;
    }
};
struct EpiMerge {
    static constexpr bool ZC = false;
    static constexpr bool PERM = true; static constexpr int NPQ = 4; static constexpr int XST = 2 * NPQ;
    const unsigned char* GT; bf16_t* MG;
    __device__ __forceinline__ void prefetch(const pg8::Unit&, int, int, LAS unsigned char*) const {}
    struct Pre { u32x2 ti[NPQ], tn[NPQ]; };
    __device__ __forceinline__ Pre pre(const pg8::Unit& u, int wr, int wc, int fr, int fq) const { Pre p_;
        const int i = u.seg, thr = ((wr * 4 + wc) * 64 + fq * 16 + fr) * 8;
        const unsigned char* gi = GT + (size_t)(u.pm * 16 + i * 4 + u.pn) * 16 * 4096 + thr;
        const unsigned char* gn = i < 3 ? gi + (size_t)4 * 16 * 4096 : gi;
#pragma unroll
        for (int q = 0; q < NPQ; ++q) { p_.ti[q] = *(const u32x2*)(gi + q * 4096); p_.tn[q] = *(const u32x2*)(gn + q * 4096); }
        return p_; }
    __device__ __forceinline__ bool operator()(f32x4 (&acc)[2][2][4][2], const pg8::Unit& u, int wr, int wc, int fr, int fq, LAS unsigned char* tb, const LAS unsigned char*, const Pre& p_) const {
        __builtin_amdgcn_s_waitcnt(0x0F78);
        const int cb = u.pn * 256 + wc * 32 + 8 * fq, i = u.seg;
        const int thr = ((wr * 4 + wc) * 64 + fq * 16 + fr) * 8;
        const unsigned char* gi = GT + (size_t)(u.pm * 16 + i * 4 + u.pn) * 16 * 4096 + thr;
        const unsigned char* gn = i < 3 ? gi + (size_t)4 * 16 * 4096 : gi;
        u32x2 ti[16], tn[16];
#pragma unroll
        for (int q = 0; q < 16; ++q) { if (q < NPQ) { ti[q] = p_.ti[q]; tn[q] = p_.tn[q]; } else { ti[q] = *(const u32x2*)(gi + q * 4096); tn[q] = *(const u32x2*)(gn + q * 4096); } }
        const unsigned last = i == 3 ? 0xffffffffu : 0u;
#pragma unroll
        for (int q = 0; q < 16; ++q) { const int ai = q >> 3, m = (q >> 1) & 3, bj = q & 1;
            f32x4 fa, fb;
#pragma unroll
            for (int j = 0; j < 4; ++j) {
                fa[j] = (float)((ti[q].x >> (8 * j)) & 0xffu) * fast_rcp((float)(((tn[q].x | last) >> (8 * j)) & 0xffu));
                fb[j] = (float)((ti[q].y >> (8 * j)) & 0xffu) * fast_rcp((float)(((tn[q].y | last) >> (8 * j)) & 0xffu)); }
            acc[ai][bj][m][0] *= fa; acc[ai][bj][m][1] *= fb;
        }
        if (i < 3) return false;
#pragma unroll
        for (int q = 0; q < 16; ++q) { const int ai = q >> 3, m = (q >> 1) & 3, bj = q & 1;
            const f32x4 v0 = acc[ai][bj][m][0], v1 = acc[ai][bj][m][1];
            const int r0 = u.pm * 256 + ai * 128 + wr * 64 + m * 16;
            u32x4 w; w.x = cvt_pk_bf16(v0[0], v0[1]); w.y = cvt_pk_bf16(v0[2], v0[3]); w.z = cvt_pk_bf16(v1[0], v1[1]); w.w = cvt_pk_bf16(v1[2], v1[3]);
            st_rows16(tb, MG + (size_t)r0 * D + u.pn * 256 + wc * 32 + bj * 128, D, fr, fq, w);
        }
        return true;
    }
};

__device__ __forceinline__ void transpose_item(const float* src, int ld_src, int k0, int n0, bf16_t* dst, int ld_dst, int dst_row0, LAS float* scr, int lane) {
    const int kr = lane >> 3, nq = lane & 7;
    f32x4 v[8];
#pragma unroll
    for (int i = 0; i < 8; ++i) v[i] = *(const f32x4*)(src + (size_t)(k0 + i * 8 + kr) * ld_src + n0 + nq * 4);
#pragma unroll
    for (int i = 0; i < 8; ++i) { LAS float* d_ = scr + (i * 8 + kr) * 33 + nq * 4; d_[0] = v[i][0]; d_[1] = v[i][1]; d_[2] = v[i][2]; d_[3] = v[i][3]; }
    asm volatile("s_waitcnt lgkmcnt(0)" ::: "memory");
    const int c = lane & 7;
#pragma unroll
    for (int j = 0; j < 4; ++j) { const int n = (lane >> 3) + 8 * j; const LAS float* s = scr + (8 * c) * 33 + n;
        u32x4 o; o.x = cvt_pk_bf16(s[0 * 33], s[1 * 33]); o.y = cvt_pk_bf16(s[2 * 33], s[3 * 33]); o.z = cvt_pk_bf16(s[4 * 33], s[5 * 33]); o.w = cvt_pk_bf16(s[6 * 33], s[7 * 33]);
        *(u32x4*)(dst + (size_t)(dst_row0 + n) * ld_dst + k0 + 8 * c) = o; }
    asm volatile("s_waitcnt lgkmcnt(0)" ::: "memory");
}

__device__ __forceinline__ void weight_prep(const KP& p, LAS unsigned char* lds, int l_lo, int l_hi, int b0, int nb) {
    int tid = p.tid_; asm volatile("" : "+v"(tid)); const int wave = tid >> 6, lane = tid & 63, G = nb, bx = p.bx_ - b0;
    unsigned char* ws = p.ws;
    if (bx < 0 || bx >= nb) return;
    {
        LAS float* scr = (LAS float*)(lds + wave * 16384);
        const int gw = bx * NWAVES + wave, NGW = G * NWAVES;
        constexpr int I_IN1 = 16 * 64, I_IN2 = 16 * 128, I_O = 4 * 32, I_OUT = 16 * 32, I_UP = 16 * 176, I_DN = 44 * 32;
        constexpr int PER_L = I_IN1 + I_IN2 + 4 * I_O + I_OUT + I_UP + I_DN;
        for (int it = l_lo * PER_L + gw; it < l_hi * PER_L; it += NGW) {
            const int l = it / PER_L; int r = it % PER_L;
            bf16_t* wl = (bf16_t*)(ws + OFF_W + (size_t)l * W_LAYER);
            if (r < I_IN1) { const int kb = r / 64, nb = r % 64; transpose_item(p.in(I_w_in) + (size_t)l * D * IN_COLS, IN_COLS, kb * 64, nb * 32, wl + W_IN / 2, D, nb * 32, scr, lane); continue; } r -= I_IN1;
            if (r < I_IN2) { const int kb = r / 128, nb = r % 128; transpose_item(p.in(I_w_in) + (size_t)l * D * IN_COLS, IN_COLS, kb * 64, 2304 + nb * 32, wl + W_IN / 2, D, PMW + nb * 32, scr, lane); continue; } r -= I_IN2;
            if (r < 4 * I_O) { const int br = r / I_O, rr = r % I_O, kb = rr / 32, nb = rr % 32;
                const float* src = (br == 0 ? p.in(I_w_ret_o) : br == 1 ? p.in(I_w_conv_o) : br == 2 ? p.in(I_w_gmlp_o) : p.in(I_w_fnet_o)) + (size_t)l * 256 * D;
                transpose_item(src, D, kb * 64, nb * 32, wl + W_O / 2 + (size_t)br * 1024 * 256, 256, nb * 32, scr, lane); continue; } r -= 4 * I_O;
            if (r < I_OUT) { const int kb = r / 32, nb = r % 32; transpose_item(p.in(I_w_out) + (size_t)l * D * D, D, kb * 64, nb * 32, wl + W_OUT / 2, D, nb * 32, scr, lane); continue; } r -= I_OUT;
            if (r < I_UP) { const int kb = r / 176, nb = r % 176; transpose_item(p.in(I_w_ffn_up) + (size_t)l * D * UPW, UPW, kb * 64, nb * 32, wl + W_UP / 2, D, nb * 32, scr, lane); continue; } r -= I_UP;
            { const int kb = r / 32, nb = r % 32; transpose_item(p.in(I_w_ffn_down) + (size_t)l * DFF * D, D, kb * 64, nb * 32, wl + W_DN / 2, DFF, nb * 32, scr, lane); }
        }
        __syncthreads();
    }
    {
        LAS float* tile = (LAS float*)lds;
        LAS float* tab = (LAS float*)(lds + 64 * 65 * 4);
        for (int it = l_lo * 64 + bx; it < l_hi * 64; it += G) {
            const int l = it / 64, gq = (it / 16) % 4, kb = it % 16;
            __syncthreads();
            if (tid < 64) { tab[tid] = cos_rev((float)tid * (1.0f / 64.0f)) * 0.125f; tab[64 + tid] = sin_rev((float)tid * (1.0f / 64.0f)) * 0.125f; }
            for (int i = tid; i < 64 * 64; i += NTHREADS) { const int kk = i / 64, cc = i % 64; tile[kk * 65 + cc] = p.in(I_w_in)[((size_t)l * D + kb * 64 + kk) * IN_COLS + 2048 + gq * 64 + cc]; }
            __syncthreads();
            const int which = tid >> 8, nl = (tid & 255) >> 2, kq = tid & 3;
            float acc[16];
#pragma unroll
            for (int j = 0; j < 16; ++j) acc[j] = 0.f;
            for (int cc = 0; cc < 64; ++cc) { const float coef = tab[which * 64 + ((cc * nl) & 63)];
#pragma unroll
                for (int j = 0; j < 16; ++j) acc[j] += coef * tile[(kq * 16 + j) * 65 + cc]; }
            bf16_t* wl = (bf16_t*)(ws + OFF_W + (size_t)l * W_LAYER + W_IN);
            bf16_t* dst = wl + (size_t)(2048 + which * 256 + gq * 64 + nl) * D + kb * 64 + kq * 16;
            *(u32x4*)dst = pack8(acc); *(u32x4*)(dst + 8) = pack8(acc + 8);
        }
        __syncthreads();
    }
}
__device__ __forceinline__ void phase_prep_a(const KP& p, LAS unsigned char* lds) {
    int tid = p.tid_; asm volatile("" : "+v"(tid)); const int wave = tid >> 6, lane = tid & 63, G = NBLK, bx = p.bx_;
    unsigned char* ws = p.ws;
    {
        LAS float* sl = (LAS float*)lds;
        float* adap = (float*)(ws + OFF_ADAP);
        for (int it = bx; it < 2 * 12 * 8; it += G) {
            const int l = it / 96, nch = (it / 8) % 12, kc = it % 8;
            __syncthreads();
            for (int i = tid; i < 17 * 128; i += NTHREADS) { const int mi = i / 128, k = kc * 128 + (i % 128); const float cv = mi < 16 ? p.in(I_c)[mi * D + k] : p.in(I_c_ctx)[k]; sl[i] = siluf_(cv); }
            __syncthreads();
            const int n = nch * 512 + tid;
            float acc[17];
#pragma unroll
            for (int mi = 0; mi < 17; ++mi) acc[mi] = 0.f;
            const float* wp = p.in(I_w_ada) + ((size_t)l * D + kc * 128) * 6144 + n;
#pragma unroll 1
            for (int k0 = 0; k0 < 128; k0 += 16) { float w[16];
#pragma unroll
                for (int k = 0; k < 16; ++k) w[k] = wp[(size_t)(k0 + k) * 6144];
#pragma unroll
                for (int k = 0; k < 16; ++k)
#pragma unroll
                    for (int mi = 0; mi < 17; ++mi) acc[mi] += sl[mi * 128 + k0 + k] * w[k]; }
#pragma unroll
            for (int mi = 0; mi < 17; ++mi) adap[(((size_t)kc * 2 + l) * 17 + mi) * 6144 + n] = acc[mi];
        }
        __syncthreads();
    }
    weight_prep(p, lds, 0, 1, 0, G);
    {
        const size_t gt = (size_t)bx * NTHREADS + tid, GT_ = (size_t)G * NTHREADS;
        float* rc = (float*)(ws + OFF_ROPE); float* rsn = rc + 2304 * 32;
        for (size_t i = gt; i < (size_t)2304 * 32; i += GT_) { const int pos = (int)(i / 32), fi = (int)(i % 32);
            const float inv = exp2f(-(float)fi * (13.287712379549449f / 32.0f));
            const float ang = (float)pos * inv;
            const double rev = (double)ang * 0.15915494309189535; const float fr_ = (float)(rev - floor(rev));
            rc[i] = cos_rev(fr_); rsn[i] = sin_rev(fr_); }
        bf16_t* dm = (bf16_t*)(ws + OFF_DM);
        for (size_t i = gt; i < (size_t)2048 * 256; i += GT_) { const int n = (int)(i / 256), k8 = (int)(i % 256) * 8; float v[8];
#pragma unroll
            for (int j = 0; j < 8; ++j) { const int kk = k8 + j; if (kk <= 1024) v[j] = cos_rev((float)((n * kk) & 2047) * (1.0f / 2048.0f)); else v[j] = -sin_rev((float)((n * (kk - 1024)) & 2047) * (1.0f / 2048.0f)); }
            *(u32x4*)(dm + (size_t)n * 2048 + k8) = pack8(v); }
        bf16_t* dc = (bf16_t*)(ws + OFF_DC);
        for (size_t i = gt; i < (size_t)256 * 32; i += GT_) { const int n = (int)(i / 32), k8 = (int)(i % 32) * 8; float v[8];
#pragma unroll
            for (int j = 0; j < 8; ++j) { const int kk = k8 + j; if (kk <= 128) v[j] = cos_rev((float)((n * kk) & 255) * (1.0f / 256.0f)); else v[j] = -sin_rev((float)((n * (kk - 128)) & 255) * (1.0f / 256.0f)); }
            *(u32x4*)(dc + (size_t)n * 256 + k8) = pack8(v); }
        if (gt < 16) { const float xx = p.in(I_ret_decay)[gt]; ((float*)(ws + OFF_LOGG))[gt] = (float)(-log1p(exp(-(double)xx))); }
    }
}

__device__ __forceinline__ void phase_prep_b(const KP& p) {
    const size_t gt = (size_t)p.bx_ * NTHREADS + p.tid_, GT_ = (size_t)NBLK * NTHREADS;
    const float* adap = (const float*)(p.ws + OFF_ADAP); float* mod = (float*)(p.ws + OFF_MOD);
    for (size_t i = gt; i < (size_t)2 * 17 * 6144; i += GT_) {
        const int l = (int)(i / (17 * 6144)), n = (int)(i % 6144), j = n / 1024, k = n % 1024;
        float v = p.in(I_b_ada)[l * 6144 + n];
#pragma unroll
        for (int kc = 0; kc < 8; ++kc) v += adap[(size_t)kc * 2 * 17 * 6144 + i];
        if (j == 1) v = p.in(I_g_norm1)[l * D + k] * (1.f + v);
        if (j == 4) v = p.in(I_g_norm2)[l * D + k] * (1.f + v);
        mod[i] = v;
    }
}

__device__ __forceinline__ void phase_prep_c(const KP& p, LAS unsigned char* lds, int l_lo, int l_hi, int b0, int nb) {
    int tid = p.tid_; asm volatile("" : "+v"(tid)); const int wave = tid >> 6, lane = tid & 63, G = nb;
    if (p.bx_ < b0 || p.bx_ >= b0 + nb) return;
    LAS unsigned char* shb = lds;
    const int gw = (p.bx_ - b0) * NWAVES + wave, NGW = G * NWAVES;
    const int c = lane & 15, gq = lane >> 4;
    for (int combo = 2 * l_lo; combo < 2 * l_hi; ++combo) {
        const int l = combo >> 1, which = combo & 1;
        const float* mod = (const float*)(p.ws + OFF_MOD) + (size_t)l * 17 * 6144 + (which ? 3 : 0) * 1024;
        __syncthreads();
        for (int i = tid; i < 32 * 128; i += NTHREADS) { const int row = i >> 7, ch = i & 127; float f[8];
#pragma unroll
            for (int j = 0; j < 8; ++j) f[j] = row < 17 ? mod[(size_t)row * 6144 + ch * 8 + j] : 0.f;
            *(LAS u32x4*)(shb + row * 2048 + ((ch ^ (row & 7)) << 4)) = pack8(f); }
        __syncthreads();
        const int ncol = which ? UPW : NCOLS;
        const bf16_t* W = (const bf16_t*)(p.ws + OFF_W + (size_t)l * W_LAYER + (which ? W_UP : W_IN));
        float* dst = (float*)(p.ws + (which ? OFF_SHW2 : OFF_SHW1)) + (size_t)l * 17 * ncol;
        for (int nb16 = gw; nb16 < ncol / 16; nb16 += NGW) {
            const bf16_t* wrow = W + (size_t)(nb16 * 16 + c) * D + 8 * gq;
            const f32x4 z4 = (f32x4){0.f, 0.f, 0.f, 0.f};
            f32x4 acc0 = z4, acc1 = z4;
#pragma unroll 1
            for (int t0 = 0; t0 < 32; t0 += 8) {
                bf16x8 bfr[8];
#pragma unroll
                for (int q = 0; q < 8; ++q) bfr[q] = *(const bf16x8*)(wrow + 32 * (t0 + q));
#pragma unroll
                for (int q = 0; q < 8; ++q) { const int ch = 4 * (t0 + q) + gq;
                    const bf16x8 a0 = *(const LAS bf16x8*)(shb + c * 2048 + ((ch ^ (c & 7)) << 4)), a1 = *(const LAS bf16x8*)(shb + (16 + c) * 2048 + ((ch ^ (c & 7)) << 4));
                    acc0 = mfma16(a0, bfr[q], acc0); acc1 = mfma16(a1, bfr[q], acc1); }
            }
            const int n = nb16 * 16 + c;
#pragma unroll
            for (int r = 0; r < 4; ++r) dst[(size_t)(4 * gq + r) * ncol + n] = acc0[r];
            if (gq == 0) dst[(size_t)16 * ncol + n] = acc1[0];
        }
    }
    __syncthreads();
}

__device__ __forceinline__ void phase_g0(const KP& p, int g, int b0, int nb) {
    int tid = p.tid_; asm volatile("" : "+v"(tid)); const int wave = tid >> 6, lane = tid & 63;
    if (p.bx_ < b0 || p.bx_ >= b0 + nb) return;
    const int gw = (p.bx_ - b0) * NWAVES + wave, NGW = nb * NWAVES;
    const float* mod = (const float*)(p.ws + OFF_MOD);
    bf16_t* AP = (bf16_t*)(p.ws + ap_off(g)); float* ss = (float*)(p.ws + ssa_off(g));
    const int nrows = g == 0 ? R : R_LAT;
    for (int r0 = gw; r0 < nrows; r0 += 2 * NGW) {
        f32x4 v[2][4], gg[2][4]; int rr[2]; bool ok[2];
#pragma unroll
        for (int h = 0; h < 2; ++h) { rr[h] = r0 + h * NGW; ok[h] = rr[h] < nrows; const int r = ok[h] ? rr[h] : r0;
            const RowInfo ri = row_info(g, r >> 8);
            const float* xr = (ri.is_ctx ? p.in(I_ctx) : p.in(I_x)) + (ri.xrow0 + (size_t)(r & 255)) * D;
            const float* G1 = mod + (size_t)ri.mi * 6144 + 1024;
#pragma unroll
            for (int j = 0; j < 4; ++j) { v[h][j] = *(const f32x4*)(xr + j * 256 + lane * 4); gg[h][j] = *(const f32x4*)(G1 + j * 256 + lane * 4); } }
#pragma unroll
        for (int h = 0; h < 2; ++h) { if (!ok[h]) continue; const int r = rr[h];
            float s_ = 0.f;
#pragma unroll
            for (int j = 0; j < 4; ++j) { const f32x4 x = v[h][j];
                s_ += (x[0] * x[0] + x[1] * x[1]) + (x[2] * x[2] + x[3] * x[3]);
                const f32x4 a = x * gg[h][j]; u32x2 w; w.x = cvt_pk_bf16(a[0], a[1]); w.y = cvt_pk_bf16(a[2], a[3]);
                *(u32x2*)(AP + (size_t)r * D + j * 256 + lane * 4) = w; }
            s_ = wave_sum(s_, lane);
            if (lane == 0) ss[r] = s_; }
    }
}

__device__ __forceinline__ void phase_final(const KP& p, int g, int b0, int nb) {
    int tid = p.tid_; asm volatile("" : "+v"(tid)); const int wave = tid >> 6, lane = tid & 63;
    if (p.bx_ < b0 || p.bx_ >= b0 + nb) return;
    const int gw = (p.bx_ - b0) * NWAVES + wave, NGW = nb * NWAVES;
    const float* ss = (const float*)(p.ws + ssa_off(g));
    const f32x4 gf0 = *(const f32x4*)(p.in(I_g_final) + lane * 4), gf1 = *(const f32x4*)(p.in(I_g_final) + 256 + lane * 4), gf2 = *(const f32x4*)(p.in(I_g_final) + 512 + lane * 4), gf3 = *(const f32x4*)(p.in(I_g_final) + 768 + lane * 4);
    for (int r0 = gw; r0 < R_LAT; r0 += 2 * NGW) {
        f32x4 v[2][4]; float sv[2];
#pragma unroll
        for (int h = 0; h < 2; ++h) { const int r = (r0 + h * NGW < R_LAT) ? r0 + h * NGW : r0; sv[h] = ss[r];
            const bf16_t* xr = (const bf16_t*)p.out + ((size_t)g * R_LAT + r) * 2048 + 1024;
#pragma unroll
            for (int j = 0; j < 4; ++j) { const u32x2 t = *(const u32x2*)(xr + j * 256 + lane * 4);
                v[h][j] = (f32x4){__uint_as_float(t.x << 16), __uint_as_float(t.x & 0xffff0000u), __uint_as_float(t.y << 16), __uint_as_float(t.y & 0xffff0000u)}; } }
        asm volatile("s_waitcnt vmcnt(0)" ::: "memory");
#pragma unroll
        for (int h = 0; h < 2; ++h) { const int r = r0 + h * NGW; if (r >= R_LAT) continue;
            const float rs = __builtin_amdgcn_rsqf(sv[h] * (1.0f / 1024.0f) + EPS);
            float* xr = p.out + ((size_t)g * R_LAT + r) * D;
            *(f32x4*)(xr + lane * 4) = v[h][0] * rs * gf0; *(f32x4*)(xr + 256 + lane * 4) = v[h][1] * rs * gf1;
            *(f32x4*)(xr + 512 + lane * 4) = v[h][2] * rs * gf2; *(f32x4*)(xr + 768 + lane * 4) = v[h][3] * rs * gf3; }
    }
}

struct ChunkInfo { int row0, pos0, h; };
__device__ __forceinline__ ChunkInfo chunk_info(int item) {
    ChunkInfo ci;
    if (item < N_KV_LAT) { const int gb = item >> 6, ch = item & 15; ci.h = (item >> 4) & 3; ci.row0 = gb * SEQ + ch * 128; ci.pos0 = CTXL + ch * 128; }
    else { const int it2 = item - N_KV_LAT, gb = it2 >> 3, ch = it2 & 1; ci.h = (it2 >> 1) & 3; ci.row0 = R_LAT + gb * CTXL + ch * 128; ci.pos0 = ch * 128; }
    return ci;
}
__device__ __forceinline__ void load_chunk_f32(const int tid, const bf16_t* PM, int row0, int col0, LAS float* dst, int st) {
#pragma unroll
    for (int q = 0; q < 2; ++q) { const int idx = tid + q * NTHREADS, row = idx >> 3, cc = idx & 7; float f[8];
        unpack8(*(const u32x4*)(PM + (size_t)(row0 + row) * PMW + col0 + cc * 8), f);
        *(LAS f32x4*)(dst + row * st + cc * 8) = (f32x4){f[0], f[1], f[2], f[3]}; *(LAS f32x4*)(dst + row * st + cc * 8 + 4) = (f32x4){f[4], f[5], f[6], f[7]}; }
}
__device__ __forceinline__ void rotary_lds(const int tid, LAS float* buf, int st, int pos0, const float* rc, const float* rsn, float scale) {
#pragma unroll
    for (int q = 0; q < 8; ++q) { const int pidx = tid + q * NTHREADS, row = pidx >> 5, i = pidx & 31;
        const float c = rc[(pos0 + row) * 32 + i], s = rsn[(pos0 + row) * 32 + i];
        const float t1 = buf[row * st + i], t2 = buf[row * st + i + 32];
        buf[row * st + i] = (t1 * c - t2 * s) * scale; buf[row * st + i + 32] = (t1 * s + t2 * c) * scale; }
}

__device__ __forceinline__ void ret_kv_item(const KP& p, LAS unsigned char* lds, int l, int item) {
    int tid = p.tid_; asm volatile("" : "+v"(tid));
    const bf16_t* PM = (const bf16_t*)(p.ws + OFF_BIG);
    const float* rc = (const float*)(p.ws + OFF_ROPE); const float* rsn = rc + 2304 * 32;
    const float* logg = (const float*)(p.ws + OFF_LOGG) + l * 8;
    LAS unsigned char* KfT = lds;
    LAS unsigned char* KbT = lds + 16384;
    LAS unsigned char* Vt = lds + 32768;
    const ChunkInfo ci = chunk_info(item);
    __syncthreads();
    {
        const int row = tid >> 2, pc = tid & 3, pos = ci.pos0 + row;
        const bf16_t* src = PM + (size_t)(ci.row0 + row) * PMW + ci.h * 64;
        const float lgf = logg[ci.h], lgb = logg[4 + ci.h];
        const float wf = 0.125f * __expf(lgf * (float)(127 - row)), wb = 0.125f * __expf(lgb * (float)row);
        float cs[8], sn[8], t1[8], t2[8];
        { const f32x4 c0 = *(const f32x4*)(rc + pos * 32 + pc * 8), c1 = *(const f32x4*)(rc + pos * 32 + pc * 8 + 4), s0 = *(const f32x4*)(rsn + pos * 32 + pc * 8), s1 = *(const f32x4*)(rsn + pos * 32 + pc * 8 + 4);
#pragma unroll
          for (int j = 0; j < 4; ++j) { cs[j] = c0[j]; cs[4 + j] = c1[j]; sn[j] = s0[j]; sn[4 + j] = s1[j]; } }
        unpack8(*(const u32x4*)(src + 256 + pc * 8), t1); unpack8(*(const u32x4*)(src + 256 + 32 + pc * 8), t2);
        const int jo = (row & 7) * 2, jc = row >> 3;
#pragma unroll
        for (int j = 0; j < 8; ++j) {
            const float o1 = t1[j] * cs[j] - t2[j] * sn[j], o2 = t1[j] * sn[j] + t2[j] * cs[j];
            const int d1 = pc * 8 + j, d2 = 32 + pc * 8 + j;
            *(LAS unsigned short*)(KfT + d1 * 256 + ((jc ^ (d1 & 15)) << 4) + jo) = f2bf(o1 * wf); *(LAS unsigned short*)(KfT + d2 * 256 + ((jc ^ (d2 & 15)) << 4) + jo) = f2bf(o2 * wf);
            *(LAS unsigned short*)(KbT + d1 * 256 + ((jc ^ (d1 & 15)) << 4) + jo) = f2bf(o1 * wb); *(LAS unsigned short*)(KbT + d2 * 256 + ((jc ^ (d2 & 15)) << 4) + jo) = f2bf(o2 * wb);
        }
        const u32x4 v0 = *(const u32x4*)(src + 512 + pc * 16), v1 = *(const u32x4*)(src + 512 + pc * 16 + 8);
        const unsigned vv[8] = {v0.x, v0.y, v0.z, v0.w, v1.x, v1.y, v1.z, v1.w};
#pragma unroll
        for (int e2 = 0; e2 < 8; ++e2)
#pragma unroll
            for (int hh = 0; hh < 2; ++hh) { const int e = pc * 16 + e2 * 2 + hh; const unsigned short val = (unsigned short)(hh ? (vv[e2] >> 16) : (vv[e2] & 0xffffu));
                *(LAS unsigned short*)(Vt + e * 256 + ((jc ^ (e & 15)) << 4) + jo) = val; }
    }
    __syncthreads();
    const int w = __builtin_amdgcn_readfirstlane(tid >> 6), lane = tid & 63, c = lane & 15, gq = lane >> 4;
    const int dir = w >> 2, db = w & 3, d = 16 * db + c;
    LAS unsigned char* KT = dir ? KbT : KfT;
    const f32x4 z4 = (f32x4){0.f, 0.f, 0.f, 0.f};
    f32x4 acc[4] = {z4, z4, z4, z4};
#pragma unroll
    for (int t = 0; t < 4; ++t) {
        const bf16x8 af = *(const LAS bf16x8*)(KT + d * 256 + (((4 * t + gq) ^ (d & 15)) << 4));
#pragma unroll
        for (int eb = 0; eb < 4; ++eb) { const int e = 16 * eb + c;
            const bf16x8 bfr = *(const LAS bf16x8*)(Vt + e * 256 + (((4 * t + gq) ^ (e & 15)) << 4));
            acc[eb] = mfma16(af, bfr, acc[eb]); }
    }
    float* kv = (item < N_KV_LAT ? (float*)(p.ws + OFF_KV) + (size_t)item * 8192 : (float*)(p.ws + OFF_KVC) + (size_t)(l * N_KV_CTX + item - N_KV_LAT) * 8192) + dir * 4096;
#pragma unroll
    for (int eb = 0; eb < 4; ++eb)
#pragma unroll
        for (int r = 0; r < 4; ++r) kv[(16 * db + 4 * gq + r) * 64 + 16 * eb + c] = acc[eb][r];
}

__device__ __forceinline__ void ret_out_item(const KP& p, LAS unsigned char* lds, int g, int l, int item) {
    int tid = p.tid_; asm volatile("" : "+v"(tid));
    const bf16_t* PM = (const bf16_t*)(p.ws + OFF_BIG);
    const float* rc = (const float*)(p.ws + OFF_ROPE); const float* rsn = rc + 2304 * 32;
    const float* logg = (const float*)(p.ws + OFF_LOGG) + l * 8;
    LAS unsigned char* Qb = lds;
    LAS unsigned char* Kb = lds + 16384;
    LAS unsigned char* Vt = lds + 32768;
    LAS unsigned char* SfT = lds + 49152;
    LAS unsigned char* SbT = lds + 57344;
    LAS float* dtab = (LAS float*)(lds + 65536);
    const ChunkInfo ci = chunk_info(item);
    __syncthreads();
    {
        const int row = tid >> 2, pc = tid & 3, pos = ci.pos0 + row;
        const bf16_t* src = PM + (size_t)(ci.row0 + row) * PMW + ci.h * 64;
        float cs[8], sn[8];
        { const f32x4 c0 = *(const f32x4*)(rc + pos * 32 + pc * 8), c1 = *(const f32x4*)(rc + pos * 32 + pc * 8 + 4), s0 = *(const f32x4*)(rsn + pos * 32 + pc * 8), s1 = *(const f32x4*)(rsn + pos * 32 + pc * 8 + 4);
#pragma unroll
          for (int j = 0; j < 4; ++j) { cs[j] = c0[j]; cs[4 + j] = c1[j]; sn[j] = s0[j]; sn[4 + j] = s1[j]; } }
#pragma unroll
        for (int qk = 0; qk < 2; ++qk) {
            float t1[8], t2[8], o1[8], o2[8];
            unpack8(*(const u32x4*)(src + qk * 256 + pc * 8), t1); unpack8(*(const u32x4*)(src + qk * 256 + 32 + pc * 8), t2);
            const float sc = qk ? 0.125f : 1.0f;
#pragma unroll
            for (int j = 0; j < 8; ++j) { o1[j] = (t1[j] * cs[j] - t2[j] * sn[j]) * sc; o2[j] = (t1[j] * sn[j] + t2[j] * cs[j]) * sc; }
            LAS unsigned char* dst = (qk ? Kb : Qb) + row * 128;
            *(LAS u32x4*)(dst + ((pc ^ (row & 7)) << 4)) = pack8(o1);
            *(LAS u32x4*)(dst + (((4 + pc) ^ (row & 7)) << 4)) = pack8(o2);
        }
        {
            const u32x4 v0 = *(const u32x4*)(src + 512 + pc * 16), v1 = *(const u32x4*)(src + 512 + pc * 16 + 8);
            const unsigned vv[8] = {v0.x, v0.y, v0.z, v0.w, v1.x, v1.y, v1.z, v1.w};
#pragma unroll
            for (int e2 = 0; e2 < 8; ++e2)
#pragma unroll
                for (int hh = 0; hh < 2; ++hh) { const int e = pc * 16 + e2 * 2 + hh; const unsigned short val = (unsigned short)(hh ? (vv[e2] >> 16) : (vv[e2] & 0xffffu));
                    *(LAS unsigned short*)(Vt + e * 256 + ((((row >> 2) ^ (2 * (e & 15))) << 3)) + (row & 3) * 2) = val; }
        }
        {
            const int d = tid >> 3, e0 = (tid & 7) * 8;
            const float* KV = (const float*)(p.ws + OFF_KV) + d * 64 + e0;
            const float* KVC = (const float*)(p.ws + OFF_KVC) + (size_t)l * N_KV_CTX * 8192 + d * 64 + e0;
            const f32x4 z = (f32x4){0.f, 0.f, 0.f, 0.f};
            f32x4 fa = z, fb = z, ba = z, bb = z;
            if (item < N_KV_LAT) {
                const int ch = item & 15, lat0 = item - ch, c0 = (g * GB + (item >> 6)) * 8 + ci.h * 2;
                const float l128f = logg[ci.h] * 128.f, l128b = logg[4 + ci.h] * 128.f;
#pragma unroll 1
                for (int t0 = 0; t0 < 20; t0 += 10) {
                    f32x4 xa[10], xb[10]; float wt[10]; bool isf[10];
#pragma unroll
                    for (int q = 0; q < 10; ++q) { const int t = t0 + q; const bool fw = t < ch + 2; isf[q] = fw;
                        const int k = fw ? t - 2 : t - (ch + 2) - 2;
                        const float* x; if (fw) x = k < 0 ? KVC + (size_t)(c0 + k + 2) * 8192 : KV + (size_t)(lat0 + k) * 8192;
                        else x = (k < 0 ? KVC + (size_t)(c0 - 1 - k) * 8192 : KV + (size_t)(lat0 + 15 - k) * 8192) + 4096;
                        const bool valid = t < 19; if (!valid) x = KVC;
                        wt[q] = valid ? (fw ? __expf(l128f * (float)(ch - 1 - k)) : __expf(l128b * (float)(14 - ch - k))) : 0.f;
                        xa[q] = *(const f32x4*)x; xb[q] = *(const f32x4*)(x + 4); }
#pragma unroll
                    for (int q = 0; q < 10; ++q) { if (isf[q]) { fa += xa[q] * wt[q]; fb += xb[q] * wt[q]; } else { ba += xa[q] * wt[q]; bb += xb[q] * wt[q]; } }
                }
            } else {
                const int it2 = item - N_KV_LAT, ch = it2 & 1, c0 = it2 - ch;
                if (ch == 1) { const float* x = KVC + (size_t)c0 * 8192; fa = *(const f32x4*)x; fb = *(const f32x4*)(x + 4); }
                else { const float* x = KVC + (size_t)(c0 + 1) * 8192 + 4096; ba = *(const f32x4*)x; bb = *(const f32x4*)(x + 4); }
            }
#pragma unroll
            for (int dir = 0; dir < 2; ++dir) { const f32x4 a = dir ? ba : fa, b = dir ? bb : fb;
                LAS unsigned char* dstT = dir ? SbT : SfT; const float vals[8] = {a[0], a[1], a[2], a[3], b[0], b[1], b[2], b[3]};
#pragma unroll
                for (int jj = 0; jj < 8; ++jj) { const int e = e0 + jj; *(LAS unsigned short*)(dstT + e * 128 + (((d >> 3) ^ (e & 7)) << 4) + (d & 7) * 2) = f2bf(vals[jj]); } }
        }
        const float lgf = logg[ci.h], lgb = logg[4 + ci.h];
        if (tid <= 256) { const int t = tid - 128; dtab[tid] = t > 0 ? __expf(lgf * (float)t) : (t < 0 ? __expf(lgb * (float)(-t)) : 2.0f); }
    }
    __syncthreads();
    const int w = __builtin_amdgcn_readfirstlane(tid >> 6), lane = tid & 63, c = lane & 15, gq = lane >> 4;
    const int il = 16 * w + c;
    f32x4 g4v[4]; u32x2 grv[4];
    { const float* gn_ = p.in(I_ret_gn) + l * 256 + ci.h * 64; const bf16_t* gsrc_ = PM + (size_t)(ci.row0 + il) * PMW + 768 + ci.h * 64;
#pragma unroll
      for (int eb = 0; eb < 4; ++eb) { g4v[eb] = *(const f32x4*)(gn_ + 16 * eb + 4 * gq); grv[eb] = *(const u32x2*)(gsrc_ + 16 * eb + 4 * gq); } }
    bf16x8 qf[2];
#pragma unroll
    for (int ks = 0; ks < 2; ++ks) qf[ks] = *(const LAS bf16x8*)(Qb + il * 128 + (((4 * ks + gq) ^ (il & 7)) << 4));
    const f32x4 z4 = (f32x4){0.f, 0.f, 0.f, 0.f};
    f32x4 st[8];
#pragma unroll
    for (int jb = 0; jb < 8; ++jb) { const int j = 16 * jb + c;
        const bf16x8 k0 = *(const LAS bf16x8*)(Kb + j * 128 + (((0 + gq) ^ (j & 7)) << 4)), k1 = *(const LAS bf16x8*)(Kb + j * 128 + (((4 + gq) ^ (j & 7)) << 4));
        st[jb] = mfma16(k0, qf[0], z4); st[jb] = mfma16(k1, qf[1], st[jb]); }
#pragma unroll
    for (int jb = 0; jb < 8; ++jb)
#pragma unroll
        for (int r = 0; r < 4; ++r) st[jb][r] *= dtab[128 + il - (16 * jb + 4 * gq + r)];
    f32x4 oT[4], cf[4], cb[4];
#pragma unroll
    for (int eb = 0; eb < 4; ++eb) { oT[eb] = z4; cf[eb] = z4; cb[eb] = z4; }
#pragma unroll
    for (int t = 0; t < 4; ++t) {
        union { u32x4 u; bf16x8 v; } pk;
        pk.u.x = cvt_pk_bf16(st[2 * t][0], st[2 * t][1]); pk.u.y = cvt_pk_bf16(st[2 * t][2], st[2 * t][3]);
        pk.u.z = cvt_pk_bf16(st[2 * t + 1][0], st[2 * t + 1][1]); pk.u.w = cvt_pk_bf16(st[2 * t + 1][2], st[2 * t + 1][3]);
#pragma unroll
        for (int eb = 0; eb < 4; ++eb) { const int e = 16 * eb + c;
            union { u32x4 u; bf16x8 v; } va;
            const u32x2 lo = *(const LAS u32x2*)(Vt + e * 256 + (((8 * t + gq) ^ (2 * (e & 15))) << 3)), hi = *(const LAS u32x2*)(Vt + e * 256 + (((8 * t + 4 + gq) ^ (2 * (e & 15))) << 3));
            va.u.x = lo.x; va.u.y = lo.y; va.u.z = hi.x; va.u.w = hi.y;
            oT[eb] = mfma16(va.v, pk.v, oT[eb]); }
    }
#pragma unroll
    for (int eb = 0; eb < 4; ++eb) { const int e = 16 * eb + c;
#pragma unroll
        for (int ks = 0; ks < 2; ++ks) {
            const bf16x8 af = *(const LAS bf16x8*)(SfT + e * 128 + (((4 * ks + gq) ^ (e & 7)) << 4)), ab = *(const LAS bf16x8*)(SbT + e * 128 + (((4 * ks + gq) ^ (e & 7)) << 4));
            cf[eb] = mfma16(af, qf[ks], cf[eb]); cb[eb] = mfma16(ab, qf[ks], cb[eb]); } }
    const float wqf = dtab[128 + il + 1], wqb = dtab[il];
    float o[16]; float sm = 0.f;
#pragma unroll
    for (int eb = 0; eb < 4; ++eb)
#pragma unroll
        for (int r = 0; r < 4; ++r) { o[eb * 4 + r] = oT[eb][r] + wqf * cf[eb][r] + wqb * cb[eb][r]; sm += o[eb * 4 + r]; }
    sm += shx(sm, 16, lane); sm += shx(sm, 32, lane);
    const float mean = sm * (1.0f / 64.0f);
    float vq = 0.f;
#pragma unroll
    for (int e = 0; e < 16; ++e) { o[e] -= mean; vq += o[e] * o[e]; }
    vq += shx(vq, 16, lane); vq += shx(vq, 32, lane);
    const float rstd = __builtin_amdgcn_rsqf(vq * (1.0f / 64.0f) + EPS);
    bf16_t* S = (bf16_t*)(p.ws + OFF_S) + (size_t)(ci.row0 + il) * D + ci.h * 64;
#pragma unroll
    for (int eb = 0; eb < 4; ++eb) { const int e0 = 16 * eb + 4 * gq;
        const f32x4 g4 = g4v[eb]; const u32x2 gr = grv[eb];
        const float g0 = bf2f(gr.x & 0xffffu), g1 = __uint_as_float(gr.x & 0xffff0000u), g2 = bf2f(gr.y & 0xffffu), g3 = __uint_as_float(gr.y & 0xffff0000u);
        u32x2 wv; wv.x = cvt_pk_bf16(o[eb * 4 + 0] * rstd * g4[0] * siluf_(g0), o[eb * 4 + 1] * rstd * g4[1] * siluf_(g1));
        wv.y = cvt_pk_bf16(o[eb * 4 + 2] * rstd * g4[2] * siluf_(g2), o[eb * 4 + 3] * rstd * g4[3] * siluf_(g3));
        *(u32x2*)(S + e0) = wv; }
}

__device__ __forceinline__ void conf_item(const KP& p, LAS unsigned char* lds, int l, int item) {
    int tid = p.tid_; asm volatile("" : "+v"(tid)); const int wave = tid >> 6, lane = tid & 63;
    const bf16_t* PM = (const bf16_t*)(p.ws + OFF_BIG);
    LAS float* hbuf = (LAS float*)lds;
    LAS float* ybuf = (LAS float*)(lds + 65536);
    int seqrow0, L, n0;
    if (item < R_LAT / 32) { seqrow0 = (item >> 6) * SEQ; L = SEQ; n0 = (item & 63) * 32; }
    else { const int it2 = item - R_LAT / 32; seqrow0 = R_LAT + (it2 >> 3) * CTXL; L = CTXL; n0 = (it2 & 7) * 32; }
    __syncthreads();
    {
        u32x4 a1[4], a2[4]; bool ok[4];
#pragma unroll
        for (int q = 0; q < 4; ++q) { const int idx = tid + q * NTHREADS, hr = idx >> 5, cc = idx & 31, tok = n0 - 15 + hr;
            ok[q] = idx < 62 * 32 && tok >= 0 && tok < L;
            const bf16_t* src = PM + (size_t)(seqrow0 + (ok[q] ? tok : n0)) * PMW + 1024 + cc * 8;
            a1[q] = *(const u32x4*)src; a2[q] = *(const u32x4*)(src + 256); }
#pragma unroll
        for (int q = 0; q < 4; ++q) { const int idx = tid + q * NTHREADS, hr = idx >> 5, cc = idx & 31;
            if (idx < 62 * 32) { float x1[8], x2[8], hv[8]; unpack8(a1[q], x1); unpack8(a2[q], x2);
#pragma unroll
                for (int j = 0; j < 8; ++j) hv[j] = ok[q] ? x1[j] * sigmoidf_(x2[j]) : 0.f;
                *(LAS f32x4*)(hbuf + hr * 256 + cc * 8) = (f32x4){hv[0], hv[1], hv[2], hv[3]}; *(LAS f32x4*)(hbuf + hr * 256 + cc * 8 + 4) = (f32x4){hv[4], hv[5], hv[6], hv[7]}; } }
    }
    __syncthreads();
    { const int c = tid & 255, q = tid >> 8;
      float w[31], xw[46];
#pragma unroll
      for (int j = 0; j < 31; ++j) w[j] = p.in(I_conv_dw)[((size_t)l * 31 + j) * 256 + c];
      const float bias = p.in(I_conv_db)[l * 256 + c];
#pragma unroll
      for (int j = 0; j < 46; ++j) xw[j] = hbuf[(q * 16 + j) * 256 + c];
#pragma unroll
      for (int tt = 0; tt < 16; ++tt) { float y = bias;
#pragma unroll
          for (int j = 0; j < 31; ++j) y += w[j] * xw[tt + j];
          ybuf[(q * 16 + tt) * 256 + c] = y; } }
    __syncthreads();
    { const f32x4 lg = *(const f32x4*)(p.in(I_conv_ln_g) + l * 256 + lane * 4), lb = *(const f32x4*)(p.in(I_conv_ln_b) + l * 256 + lane * 4);
      bf16_t* S = (bf16_t*)(p.ws + OFF_S);
#pragma unroll
      for (int t4 = 0; t4 < 4; ++t4) { const int tt = wave * 4 + t4;
          f32x4 v = *(const LAS f32x4*)(ybuf + tt * 256 + lane * 4);
          const float mean = wave_sum((v[0] + v[1]) + (v[2] + v[3]), lane) * (1.0f / 256.0f);
          v = v - mean;
          const float var = wave_sum((v[0] * v[0] + v[1] * v[1]) + (v[2] * v[2] + v[3] * v[3]), lane) * (1.0f / 256.0f);
          const float rstd = __builtin_amdgcn_rsqf(var + EPS);
          f32x4 y = v * rstd * lg + lb;
#pragma unroll
          for (int j = 0; j < 4; ++j) y[j] = siluf_(y[j]);
          u32x2 w2; w2.x = cvt_pk_bf16(y[0], y[1]); w2.y = cvt_pk_bf16(y[2], y[3]);
          *(u32x2*)(S + (size_t)(seqrow0 + n0 + tt) * D + 256 + lane * 4) = w2; } }
}

__device__ __forceinline__ void gmlp_item(const KP& p, LAS unsigned char* lds, int l, int item) {
    int tid = p.tid_; asm volatile("" : "+v"(tid)); const int wave = __builtin_amdgcn_readfirstlane(tid >> 6), lane = tid & 63;
    const bf16_t* PM = (const bf16_t*)(p.ws + OFF_BIG);
    LAS unsigned char* vT = lds;
    const int row0 = item * 128;
    __syncthreads();
    { const f32x4 lg = *(const f32x4*)(p.in(I_gmlp_ln_g) + l * 256 + lane * 4), lb = *(const f32x4*)(p.in(I_gmlp_ln_b) + l * 256 + lane * 4);
      u32x2 zz[16];
#pragma unroll
      for (int t16 = 0; t16 < 16; ++t16) zz[t16] = *(const u32x2*)(PM + (size_t)(row0 + wave * 16 + t16) * PMW + 1792 + lane * 4);
#pragma unroll
      for (int t16 = 0; t16 < 16; ++t16) { const int tt = wave * 16 + t16;
          f32x4 v = (f32x4){geluf_(bf2f(zz[t16].x & 0xffffu)), geluf_(__uint_as_float(zz[t16].x & 0xffff0000u)), geluf_(bf2f(zz[t16].y & 0xffffu)), geluf_(__uint_as_float(zz[t16].y & 0xffff0000u))};
          const float mean = wave_sum((v[0] + v[1]) + (v[2] + v[3]), lane) * (1.0f / 256.0f);
          v = v - mean;
          const float var = wave_sum((v[0] * v[0] + v[1] * v[1]) + (v[2] * v[2] + v[3] * v[3]), lane) * (1.0f / 256.0f);
          const float rstd = __builtin_amdgcn_rsqf(var + EPS);
          v = v * rstd * lg + lb;
          const int jc = tt >> 3, jo = (tt & 7) * 2;
#pragma unroll
          for (int q = 0; q < 4; ++q) { const int cc = lane * 4 + q; *(LAS unsigned short*)(vT + cc * 256 + ((jc ^ (cc & 15)) << 4) + jo) = f2bf(v[q]); } } }
    __syncthreads();
    const int c = lane & 15, gq = lane >> 4, gw = wave & 3, ih = wave >> 2;
    const float* wsr = p.in(I_gmlp_ws) + (((size_t)l * 4 + gw) * 128 + ih * 64) * 128 + (size_t)c * 128 + 8 * gq;
    const f32x4 z4 = (f32x4){0.f, 0.f, 0.f, 0.f};
    f32x4 acc[4][4];
#pragma unroll
    for (int ib = 0; ib < 4; ++ib)
#pragma unroll
        for (int cb = 0; cb < 4; ++cb) acc[ib][cb] = z4;
    f32x4 wa[4][2], wb[4][2];
#pragma unroll
    for (int ib = 0; ib < 4; ++ib) { wa[ib][0] = *(const f32x4*)(wsr + ib * 16 * 128); wa[ib][1] = *(const f32x4*)(wsr + ib * 16 * 128 + 4); }
#pragma unroll
    for (int t = 0; t < 4; ++t) {
        if (t < 3) {
#pragma unroll
            for (int ib = 0; ib < 4; ++ib) { wb[ib][0] = *(const f32x4*)(wsr + ib * 16 * 128 + 32 * (t + 1)); wb[ib][1] = *(const f32x4*)(wsr + ib * 16 * 128 + 32 * (t + 1) + 4); } }
        bf16x8 bfr[4];
#pragma unroll
        for (int cb = 0; cb < 4; ++cb) { const int cc = 64 * gw + 16 * cb + c; bfr[cb] = *(const LAS bf16x8*)(vT + cc * 256 + (((4 * t + gq) ^ (cc & 15)) << 4)); }
#pragma unroll
        for (int ib = 0; ib < 4; ++ib) {
            union { u32x4 u; bf16x8 v; } af;
            af.u.x = cvt_pk_bf16(wa[ib][0][0], wa[ib][0][1]); af.u.y = cvt_pk_bf16(wa[ib][0][2], wa[ib][0][3]); af.u.z = cvt_pk_bf16(wa[ib][1][0], wa[ib][1][1]); af.u.w = cvt_pk_bf16(wa[ib][1][2], wa[ib][1][3]);
#pragma unroll
            for (int cb = 0; cb < 4; ++cb) acc[ib][cb] = mfma16(af.v, bfr[cb], acc[ib][cb]);
        }
#pragma unroll
        for (int ib = 0; ib < 4; ++ib) { wa[ib][0] = wb[ib][0]; wa[ib][1] = wb[ib][1]; }
    }
    const float* bs = p.in(I_gmlp_bs) + ((size_t)l * 4 + gw) * 128 + ih * 64;
    bf16_t* S = (bf16_t*)(p.ws + OFF_S);
#pragma unroll
    for (int ib = 0; ib < 4; ++ib) {
        unsigned short uu[4][4]; float bsv[4];
#pragma unroll
        for (int r = 0; r < 4; ++r) { const int il = 16 * ib + 4 * gq + r; bsv[r] = bs[il];
#pragma unroll
            for (int cb = 0; cb < 4; ++cb) uu[r][cb] = PM[(size_t)(row0 + ih * 64 + il) * PMW + 1536 + 64 * gw + 16 * cb + c]; }
#pragma unroll
        for (int r = 0; r < 4; ++r) { const int i = ih * 64 + 16 * ib + 4 * gq + r;
#pragma unroll
            for (int cb = 0; cb < 4; ++cb) S[(size_t)(row0 + i) * D + 512 + 64 * gw + 16 * cb + c] = f2bf(geluf_(bf2f(uu[r][cb])) * (acc[ib][cb][r] + bsv[r])); }
    }
}

__device__ __forceinline__ void fnet_t_item(const KP& p, LAS unsigned char* lds, int item) {
    int tid = p.tid_; asm volatile("" : "+v"(tid));
    const bf16_t* PM = (const bf16_t*)(p.ws + OFF_BIG);
    LAS float* T = (LAS float*)lds;
    int seqrow0, L, s_local, cblk, kb; bf16_t* dstbase;
    if (item < GB * 4 * 16) { s_local = item >> 6; cblk = (item >> 4) & 3; kb = item & 15; L = SEQ; seqrow0 = s_local * SEQ; dstbase = (bf16_t*)(p.ws + OFF_PQT); }
    else { const int it2 = item - GB * 4 * 16; s_local = it2 >> 3; cblk = (it2 >> 1) & 3; kb = it2 & 1; L = CTXL; seqrow0 = R_LAT + s_local * CTXL; dstbase = (bf16_t*)(p.ws + OFF_PQTC); }
    __syncthreads();
    for (int idx = tid; idx < 4 * 64 * 8; idx += NTHREADS) { const int which = idx >> 9, r = (idx >> 3) & 63, cc = idx & 7, k = kb * 64 + r;
        const int tok = (which & 1) ? (L - k) : k; const int col = (which < 2 ? 2048 : 2304) + cblk * 64 + cc * 8; float f[8];
        if (tok < L) unpack8(*(const u32x4*)(PM + (size_t)(seqrow0 + tok) * PMW + col), f);
        else {
#pragma unroll
            for (int j = 0; j < 8; ++j) f[j] = 0.f; }
#pragma unroll
        for (int j = 0; j < 8; ++j) T[(which * 64 + r) * 65 + cc * 8 + j] = f[j]; }
    __syncthreads();
    const int c = tid >> 3, kq = tid & 7;
    float pe[8], qo[8];
#pragma unroll
    for (int e = 0; e < 8; ++e) { const int kl = kq * 8 + e; pe[e] = T[(0 * 64 + kl) * 65 + c] + T[(1 * 64 + kl) * 65 + c]; qo[e] = T[(2 * 64 + kl) * 65 + c] - T[(3 * 64 + kl) * 65 + c]; }
    if (kb == 0 && kq == 0) qo[0] = bf2f(PM[(size_t)(seqrow0 + L / 2) * PMW + 2048 + cblk * 64 + c]);
    bf16_t* dst = dstbase + (size_t)(s_local * 256 + cblk * 64 + c) * L;
    *(u32x4*)(dst + kb * 64 + kq * 8) = pack8(pe);
    *(u32x4*)(dst + L / 2 + kb * 64 + kq * 8) = pack8(qo);
}

__device__ __forceinline__ u32x4 ld8p(const bf16_t* p, bool ok) { return ok ? *(const u32x4*)p : (u32x4){0u, 0u, 0u, 0u}; }
__device__ __forceinline__ void fma8(float* y, const u32x4 a, const float* w) { float f[8]; unpack8(a, f);
#pragma unroll
    for (int j = 0; j < 8; ++j) y[j] += f[j] * w[j]; }
__device__ __forceinline__ void phase_ffn_conv(const KP& p, int g, int l, int parts, int b0, int nb, int halves) {
    int tid = p.tid_; asm volatile("" : "+v"(tid));
    if (parts & 1) { float* ssA = (float*)(p.ws + ssa_off(g)); for (int i = p.bx_ * NTHREADS + tid; i < R; i += NBLK * NTHREADS) ssA[i] = 0.f; }
    if (tid >= 352 || p.bx_ < b0 || p.bx_ >= b0 + nb) return;
    bf16_t* UP = (bf16_t*)(p.ws + OFF_BIG);
    const int c8 = tid * 8, G = nb, bx = p.bx_ - b0;
    const float* dw = p.in(I_ffn_dw) + (size_t)l * 9 * DFF + c8; const float* db = p.in(I_ffn_db) + (size_t)l * DFF + c8;
    float w[9][8], bias[8];
#pragma unroll
    for (int k = 0; k < 9; ++k) { const f32x4 w0 = *(const f32x4*)(dw + k * DFF), w1 = *(const f32x4*)(dw + k * DFF + 4);
#pragma unroll
        for (int j = 0; j < 4; ++j) { w[k][j] = w0[j]; w[k][4 + j] = w1[j]; } }
    { const f32x4 b0 = *(const f32x4*)db, b1 = *(const f32x4*)(db + 4);
#pragma unroll
      for (int j = 0; j < 4; ++j) { bias[j] = b0[j]; bias[4 + j] = b1[j]; } }
    if (parts & 2)
    for (int it0 = bx; it0 < GB * 32 * halves; it0 += G) {
        const int rid0 = it0 / halves, hf = it0 - rid0 * halves;
        const int rid = (G == 256 && halves == 1) ? ((rid0 & 7) * 32 + (rid0 >> 3)) : rid0;
        const int gb = rid >> 5, gr = rid & 31;
        const int c_lo = hf * (64 / halves), c_hi = c_lo + 64 / halves;
        const bool up = gr > 0, dn = gr < 31;
        const bf16_t* a1 = UP + (size_t)(gb * SEQ + gr * 64 + c_lo) * UPW + c8;
        const bf16_t* a0 = a1 - (size_t)64 * UPW; const bf16_t* a2 = a1 + (size_t)64 * UPW;
        const bool lf = c_lo > 0;
        u32x4 L0 = ld8p(a0 - UPW, up && lf), L1 = ld8p(a1 - UPW, lf), L2 = ld8p(a2 - UPW, dn && lf), M0 = ld8p(a0, up), M1 = ld8p(a1, true), M2 = ld8p(a2, dn);
        u32x4 R0 = ld8p(a0 + UPW, up), R1 = ld8p(a1 + UPW, true), R2 = ld8p(a2 + UPW, dn);
        bf16_t* hp = UP + (size_t)(gb * SEQ + gr * 64 + c_lo) * UPW + DFF + c8;
        u32x4 bq = *(const u32x4*)hp;
#pragma unroll 1
        for (int gc = c_lo; gc < c_hi; ++gc) {
            const bool nt2 = gc < 62; const size_t o = (size_t)(gc - c_lo + 2) * UPW;
            const u32x4 N0 = ld8p(a0 + o, up && nt2), N1 = ld8p(a1 + o, nt2), N2 = ld8p(a2 + o, dn && nt2);
            const u32x4 bn = ld8p(hp + UPW, gc < 63);
            float y[8];
#pragma unroll
            for (int j = 0; j < 8; ++j) y[j] = bias[j];
            fma8(y, L0, w[0]); fma8(y, M0, w[1]); fma8(y, R0, w[2]);
            fma8(y, L1, w[3]); fma8(y, M1, w[4]); fma8(y, R1, w[5]);
            fma8(y, L2, w[6]); fma8(y, M2, w[7]); fma8(y, R2, w[8]);
            float bv[8]; unpack8(bq, bv);
#pragma unroll
            for (int j = 0; j < 8; ++j) y[j] = siluf_(y[j]) * bv[j];
            *(u32x4*)hp = pack8(y);
            L0 = M0; L1 = M1; L2 = M2; M0 = R0; M1 = R1; M2 = R2; R0 = N0; R1 = N1; R2 = N2; bq = bn; hp += UPW;
        }
    }
    if (parts & 4) {
        for (int it = bx; it < R_CTX / 8; it += G) {
            const int s_ = it >> 5, t0 = (it & 31) * 8;
            const bf16_t* a = UP + (size_t)(R_LAT + s_ * CTXL + t0) * UPW + c8;
            u32x4 Lq = ld8p(a - UPW, t0 > 0), Mq = ld8p(a, true);
#pragma unroll 1
            for (int t = 0; t < 8; ++t) {
                const u32x4 Rq = ld8p(a + (size_t)(t + 1) * UPW, t0 + t + 1 < CTXL);
                bf16_t* hp = UP + (size_t)(R_LAT + s_ * CTXL + t0 + t) * UPW + DFF + c8;
                const u32x4 bq = *(const u32x4*)hp;
                float y[8];
#pragma unroll
                for (int j = 0; j < 8; ++j) y[j] = bias[j];
                fma8(y, Lq, w[3]); fma8(y, Mq, w[4]); fma8(y, Rq, w[5]);
                float bv[8]; unpack8(bq, bv);
#pragma unroll
                for (int j = 0; j < 8; ++j) y[j] = siluf_(y[j]) * bv[j];
                *(u32x4*)hp = pack8(y);
                Lq = Mq; Mq = Rq;
            }
        }
    }
}

#ifndef DUP_LP
#define DUP_LP 0
#endif

__device__ __forceinline__ unsigned wl_off(int l) { return (unsigned)OFF_W + (unsigned)l * (unsigned)W_LAYER; }
__device__ __forceinline__ unsigned mod_off(int l) { return (unsigned)OFF_MOD + (unsigned)l * (unsigned)(17 * 6144 * 4); }

__device__ __forceinline__ void ph_l1(const KP& p, LAS unsigned char* lds, int g, int l) {
    unsigned char* ws = p.ws; const bool ctx_full = (g == 0 && l == 0);
    pg8::TileSched S{}; S.G = NBLK; S.c = p.bx_; S.nseg = 1;
    S.n1M = NLT; S.n1N = NCOLS / 256; S.n2M = g == 0 ? NCT : 0; S.n2N = ctx_full ? NCOLS / 256 : 2; S.pn2_0 = ctx_full ? 0 : 1;
    S.A = ap_off(g); S.B = (unsigned)(wl_off(l) + (unsigned)W_IN); S.a_tstep = (unsigned)256 * D * 2; S.b_tstep = (unsigned)256 * D * 2;
    EpiWin E{(const float*)(ws + ssa_off(g)), (const float*)(ws + (unsigned)OFF_SHW1 + (unsigned)l * (unsigned)(17 * NCOLS * 4)), p.in(I_b_gate) + (size_t)l * GTW, (bf16_t*)(ws + OFF_BIG), (bf16_t*)(ws + OFF_GT), g};
    pg8::gemm_phase(lds, p.ws, p.tid_, D, D, D, true, S, E);
}
__device__ __forceinline__ void ph_l2(const KP& p, LAS unsigned char* lds, int g, int l) {
    const bool ctx_full = (g == 0 && l == 0); const int G = NBLK;
    const int n_kv = g == 0 ? N_KV : N_KV_LAT, n_conf = (ctx_full ? R : R_LAT) / 32, n_gm = (ctx_full ? R : R_LAT) / 128, n_fn = GB * 4 * 16 + (ctx_full ? NB * 4 * 2 : 0);
    const int total = n_kv + n_conf + n_gm + n_fn;
    { float* ssB = (float*)(p.ws + ssb_off(g)); for (int i = p.bx_ * NTHREADS + p.tid_; i < R; i += G * NTHREADS) ssB[i] = 0.f; }
    const int bx = p.bx_, n_small = total - n_gm, nb2 = G - n_gm, head = (nb2 > 0 && 7 * nb2 < n_small) ? 7 * nb2 : 0;
#define L2_SMALL(t_) do { int t = (t_); if (t < n_kv) ret_kv_item(p, lds, l, t); else if ((t -= n_kv) < n_fn) fnet_t_item(p, lds, t); else conf_item(p, lds, l, t - n_fn); } while (0)
    if (bx < n_gm) gmlp_item(p, lds, l, bx);
    else if (head) { for (int r7 = 0; r7 < 7; ++r7) L2_SMALL(r7 * nb2 + (bx - n_gm)); }
    for (int t2 = head + bx; t2 < n_small; t2 += G) L2_SMALL(t2);
#undef L2_SMALL
    __syncthreads();
}
__device__ __forceinline__ void ph_l3(const KP& p, LAS unsigned char* lds, int g, int l) {
    unsigned char* ws = p.ws; const bool ctx_full = (g == 0 && l == 0); const int G = NBLK, bx = p.bx_;
    const int nd = 64 + (ctx_full ? NB : 0);
    if (bx < nd) {
        const bool isc = bx >= 64;
        const int Kd = isc ? CTXL : SEQ;
        pg8::TileSched S{}; S.G = G; S.nseg = 1;
        S.n1M = isc ? 1 : 8; S.n1N = isc ? NB : GB; S.c = isc ? bx - 64 : bx;
        S.A = (unsigned)((isc ? OFF_DC : OFF_DM)); S.B = (unsigned)((isc ? OFF_PQTC : OFF_PQT)); S.a_tstep = (unsigned)256 * Kd * 2; S.b_tstep = (unsigned)256 * Kd * 2;
        EpiDft E{(bf16_t*)(ws + OFF_S), isc ? R_LAT : 0, Kd, isc ? 0.0625f : 0.02209708691207961f};
        pg8::gemm_phase(lds, p.ws, p.tid_, Kd, Kd, Kd, true, S, E);
    } else {
        const int n = ctx_full ? N_KV : N_KV_LAT;
        for (int it = bx - nd; it < n; it += G - nd) ret_out_item(p, lds, g, l, it);
        __syncthreads();
    }
}
__device__ __forceinline__ void ph_l5(const KP& p, LAS unsigned char* lds, int g, int l) {
    unsigned char* ws = p.ws; const bool ctx_full = (g == 0 && l == 0);
    pg8::TileSched S{}; S.G = NBLK; S.c = p.bx_; S.nseg = 4;
    S.n1M = NLT; S.n1N = 4; S.n2M = ctx_full ? NCT : 0; S.n2N = 4;
    S.A = (unsigned)(OFF_S); S.B = (unsigned)(wl_off(l) + (unsigned)W_O); S.a_tstep = (unsigned)256 * D * 2; S.b_tstep = (unsigned)256 * 256 * 2; S.a_segstep = (unsigned)256 * 2; S.b_segstep = (unsigned)1024 * 256 * 2;
    EpiMerge E{(const unsigned char*)(ws + OFF_GT), (bf16_t*)(ws + OFF_BIG)};
    pg8::gemm_phase(lds, p.ws, p.tid_, 256, D, 256, true, S, E);
}
__device__ __forceinline__ void ph_l6(const KP& p, LAS unsigned char* lds, int g, int l) {
    unsigned char* ws = p.ws; const bool ctx_full = (g == 0 && l == 0);
    pg8::TileSched S{}; S.G = NBLK; S.c = p.bx_; S.nseg = 1;
    S.n1M = NLT; S.n1N = 4; S.n2M = ctx_full ? NCT : 0; S.n2N = 4;
    S.A = (unsigned)(OFF_BIG); S.B = (unsigned)(wl_off(l) + (unsigned)W_OUT); S.a_tstep = (unsigned)256 * D * 2; S.b_tstep = (unsigned)256 * D * 2;
    EpiResid E{l == 0 ? p.in(I_x) : nullptr, l == 0 ? p.in(I_ctx) : nullptr, (bf16_t*)p.out, (bf16_t*)(ws + OFF_XC),
               (const float*)(ws + mod_off(l) + 2 * 4096), (const float*)(ws + mod_off(l) + 4 * 4096), (bf16_t*)(ws + ap_off(g)), (float*)(ws + ssb_off(g)), g};
    pg8::gemm_phase(lds, p.ws, p.tid_, D, D, D, true, S, E);
}
__device__ __forceinline__ void ph_l7(const KP& p, LAS unsigned char* lds, int g, int l) {
    unsigned char* ws = p.ws; const bool ctx_full = (g == 0 && l == 0);
    pg8::TileSched S{}; S.G = NBLK; S.c = p.bx_; S.nseg = 1;
    S.n1M = NLT; S.n1N = UPW / 256; S.n2M = ctx_full ? NCT : 0; S.n2N = UPW / 256;
    S.A = ap_off(g); S.B = (unsigned)(wl_off(l) + (unsigned)W_UP); S.a_tstep = (unsigned)256 * D * 2; S.b_tstep = (unsigned)256 * D * 2;
    EpiUp E{(const float*)(ws + ssb_off(g)), (const float*)(ws + (unsigned)OFF_SHW2 + (unsigned)l * (unsigned)(17 * UPW * 4)), (bf16_t*)(ws + OFF_BIG), g};
    pg8::gemm_phase(lds, p.ws, p.tid_, D, D, D, true, S, E);
}
__device__ __forceinline__ void ph_l9(const KP& p, LAS unsigned char* lds, int g, int l, int which = 0) {
    unsigned char* ws = p.ws; const bool ctx_full = (g == 0 && l == 0);
    pg8::TileSched S{}; S.G = NBLK; S.c = p.bx_; S.nseg = 1;
    S.n1M = which == 2 ? 0 : NLT; S.n1N = 4; S.n2M = (ctx_full && which != 1) ? NCT : 0; S.n2N = 4;
    if (which == 2) S.pm2_x = NLT;
    S.A = (unsigned)OFF_BIG + (unsigned)DFF * 2u; S.B = (unsigned)(wl_off(l) + (unsigned)W_DN); S.a_tstep = (unsigned)256 * UPW * 2; S.b_tstep = (unsigned)256 * DFF * 2;
    EpiResid E{nullptr, nullptr, (bf16_t*)p.out, (bf16_t*)(ws + OFF_XC), (const float*)(ws + mod_off(l) + 5 * 4096),
               l == 0 ? (const float*)(ws + mod_off(1) + 4096) : nullptr, (bf16_t*)(ws + ap_off(g)), (float*)(ws + ssa_off(g)), g};
    pg8::gemm_phase(lds, p.ws, p.tid_, DFF, UPW, DFF, true, S, E);
}

__global__ void __launch_bounds__(NTHREADS) mega(KArgs a) {
    extern __shared__ __attribute__((aligned(16))) unsigned char lds_raw[];
    LAS unsigned char* lds = (LAS unsigned char*)lds_raw;
    volatile LAS unsigned* misc = (volatile LAS unsigned*)(lds + MISC_OFF);
    if (threadIdx.x < 64) misc[threadIdx.x] = 0u;
    if (threadIdx.x < 30) { const unsigned long long v = (unsigned long long)a.in[threadIdx.x]; LAS unsigned* t = (LAS unsigned*)(lds + PTAB_OFF) + 2 * threadIdx.x; t[0] = (unsigned)v; t[1] = (unsigned)(v >> 32); }
    __syncthreads();
    const int wid_s = __builtin_amdgcn_readfirstlane((int)(threadIdx.x >> 6));
    cg::grid_group grid = cg::this_grid();
    XcdBarrier xb = xcd_barrier_post((unsigned*)(a.ws + OFF_BAR), misc + 8);
    grid.sync();
#define MK_Q() KP q; { int w_ = wid_s, b_ = blockIdx.x; unsigned z_ = 0u; asm volatile("" : "+s"(w_), "+s"(b_), "+s"(z_)); int t_ = (w_ << 6) | (int)__builtin_amdgcn_mbcnt_hi(~0u, __builtin_amdgcn_mbcnt_lo(~0u, z_)); asm volatile("" : "+v"(t_)); q.tid_ = t_; q.bx_ = b_; q.ws = a.ws + z_; q.out = a.out + z_; q.ldsb = lds; q.ptab = lds + PTAB_OFF + z_; }
#define PHASE(call) do { MK_Q(); call; xcd_barrier(xb); } while (0)
    PHASE(phase_prep_a(q, lds));
    PHASE(phase_prep_b(q));
    PHASE(phase_prep_c(q, lds, 0, 1, 0, NBLK); phase_g0(q, 0, 0, NBLK));
    for (int g = 0; g < NG; ++g) {
        for (int l = 0; l < 2; ++l) {
            { MK_Q(); ph_l1(q, lds, g, l); }
            PHASE(if (g == 0 && l == 0) weight_prep(q, lds, 1, 2, 32, NBLK - 32);
                  if (g == 1 && l == 0) phase_final(q, 0, 128, NBLK - 128));
            if (DUP_LP == 1) PHASE(ph_l1(q, lds, g, l));
            PHASE(ph_l2(q, lds, g, l));
            if (DUP_LP == 2) PHASE(ph_l2(q, lds, g, l));
            PHASE(ph_l3(q, lds, g, l));
            if (DUP_LP == 3) PHASE(ph_l3(q, lds, g, l));
            PHASE(ph_l5(q, lds, g, l); if (g == 0 && l == 0) phase_prep_c(q, lds, 1, 2, 64, NBLK - 64));
            if (DUP_LP == 5) PHASE(ph_l5(q, lds, g, l));
            PHASE(ph_l6(q, lds, g, l); if (g == 0 && l == 0) phase_g0(q, 1, 64, NBLK - 64));
            PHASE(ph_l7(q, lds, g, l));
            if (DUP_LP == 7) PHASE(ph_l7(q, lds, g, l));
            if (g == 0 && l == 0) {
                PHASE(phase_ffn_conv(q, g, l, 1 | 4, 0, NBLK, 1));
                PHASE(ph_l9(q, lds, g, l, 2); phase_ffn_conv(q, g, l, 2, 64, NBLK - 64, 4));
                PHASE(ph_l9(q, lds, g, l, 1));
            } else {
                PHASE(phase_ffn_conv(q, g, l, 1 | 2, 0, NBLK, 1));
                PHASE(ph_l9(q, lds, g, l));
            }
        }
        if (g == NG - 1) { MK_Q(); phase_final(q, g, 0, NBLK); }
    }
#undef PHASE
#undef MK_Q
}

extern "C" void kernel_launch(void* const* d_in, const int* in_sizes, int n_in, void* d_out, int out_size, void* d_ws, size_t ws_size, hipStream_t stream) {
    static int grid = 0;
    if (grid == 0) {
        int dev = 0, cus = 0, per_cu = 0;
        (void)hipGetDevice(&dev);
        (void)hipDeviceGetAttribute(&cus, hipDeviceAttributeMultiprocessorCount, dev);
        (void)hipFuncSetAttribute((const void*)mega, hipFuncAttributeMaxDynamicSharedMemorySize, LDS_BYTES);
        (void)hipOccupancyMaxActiveBlocksPerMultiprocessor(&per_cu, (const void*)mega, NTHREADS, LDS_BYTES);
        grid = NBLK;
        if (n_in != 30 || ws_size < WS_END || per_cu < 1 || cus * per_cu < NBLK) { fprintf(stderr, "kernel_launch: unexpected n_in %d / ws %zu (need %zu) / per_cu %d\n", n_in, ws_size, (size_t)WS_END, per_cu); }
    }
    (void)hipMemsetAsync(d_ws, 0, 16384, stream);
    KArgs a{};
    for (int i = 0; i < 30; ++i) a.in[i] = (const float*)d_in[i];
    a.out = (float*)d_out; a.ws = (unsigned char*)d_ws;
    void* args[] = {&a};
    hipError_t e = hipLaunchCooperativeKernel((const void*)mega, dim3(grid), dim3(NTHREADS), args, LDS_BYTES, stream);
    if (e != hipSuccess) fprintf(stderr, "cooperative launch failed: %s (grid %d)\n", hipGetErrorString(e), grid);
}
```
